# Optimizing an MI355X kernel written in HIP

```python
import math
import jax, jax.numpy as jnp
from jax import lax
import numpy as np

D_MODEL = 1024
BATCH = 8
SEQ = 2048
DEPTH = 4
DEC_BATCH = 128
DEC_SEQ = 1
PAST_LEN = 16384
PAGE_SIZE = 128

N_BRANCH = 4
BR_WIDTH = D_MODEL // N_BRANCH
HEAD_DIM = 64
N_HEADS = BR_WIDTH // HEAD_DIM
CONV_W = 4
CHUNK = 64
GLA_GATE_RANK = 16
GLA_GATE_NORM = 16.0
S5_GROUP = 16
S5_GROUPS = BR_WIDTH // S5_GROUP
S5_P = 64
D_FF = -(-8 * D_MODEL // (3 * 256)) * 256
EPS = 1e-6
SPLIT_SIZES = (3 * BR_WIDTH, N_HEADS, N_HEADS, BR_WIDTH,
               BR_WIDTH, BR_WIDTH, BR_WIDTH, GLA_GATE_RANK, BR_WIDTH,
               BR_WIDTH,
               BR_WIDTH, BR_WIDTH, BR_WIDTH, BR_WIDTH,
               N_BRANCH * D_MODEL)
N_IN = sum(SPLIT_SIZES)
F32 = jnp.float32

kernel_name = 'hybrid_gdn_gla_s5_hgrn2_decode_step'


def rmsnorm(x, w):
    xf = x.astype(F32)
    y = xf * lax.rsqrt(jnp.mean(xf * xf, axis=-1, keepdims=True) + EPS)
    return (y * w.astype(F32)).astype(x.dtype)


def l2norm(x):
    return x * lax.rsqrt(jnp.sum(x * x, axis=-1, keepdims=True) + EPS)


def to_heads(t):
    b, l, _ = t.shape
    return t.reshape(b, l, N_HEADS, HEAD_DIM).transpose(0, 2, 1, 3)


def gated_head_norm(o, gate, w):
    b, h, l, d = o.shape
    o = o * lax.rsqrt(jnp.mean(o * o, axis=-1, keepdims=True) + EPS)
    o = o.transpose(0, 2, 1, 3).reshape(b, l, h * d)
    return o * w.astype(F32) * jax.nn.silu(gate.astype(F32))


def chunk_len(l):
    return CHUNK if l % CHUNK == 0 else l


def to_chunks(t, c):
    b, h, l = t.shape[:3]
    return jnp.moveaxis(t.reshape((b, h, l // c, c) + t.shape[3:]), 2, 0)


def from_chunks(t):
    n, b, h, c, d = t.shape
    return jnp.moveaxis(t, 0, 2).reshape(b, h, n * c, d)


def split_cols(p):
    out, off = [], 0
    for n in SPLIT_SIZES:
        out.append(p[..., off:off + n])
        off += n
    return out


def short_conv(x, buf, w):
    l = x.shape[1]
    xp = jnp.concatenate([buf.astype(x.dtype), x], axis=1)
    xf, wf = xp.astype(F32), w.astype(F32)
    y = sum(xf[:, j:j + l] * wf[j] for j in range(CONV_W))
    return jax.nn.silu(y), xp[:, l:]


def gated_delta_rule(q, k, v, g, beta, s0):
    dv = v.shape[-1]
    c = chunk_len(q.shape[2])
    q, k, v, g, beta = (to_chunks(t, c) for t in (q, k, v, g, beta))
    gam = jnp.cumsum(g, axis=-1)
    idx = jnp.arange(c)
    incl = idx[:, None] >= idx[None, :]
    strict = idx[:, None] > idx[None, :]
    decay = jnp.exp(jnp.where(incl, gam[..., :, None] - gam[..., None, :], -jnp.inf))
    kk = jnp.einsum('nbhid,nbhjd->nbhij', k, k)
    tmat = jnp.where(strict, beta[..., :, None] * kk * decay, 0.0) + jnp.eye(c, dtype=F32)
    rhs = jnp.concatenate([beta[..., None] * v, (beta * jnp.exp(gam))[..., None] * k], axis=-1)
    sol = lax.linalg.triangular_solve(tmat, rhs, left_side=True, lower=True, unit_diagonal=True)
    u_v, w_k = sol[..., :dv], sol[..., dv:]
    attn = jnp.einsum('nbhid,nbhjd->nbhij', q, k) * decay
    dec_last = jnp.exp(gam[..., -1:] - gam)
    g_last = jnp.exp(gam[..., -1])

    def step(s, xs):
        qc, kc, uvc, wkc, ac, gc, dl, gl = xs
        u = uvc - jnp.einsum('bhik,bhkv->bhiv', wkc, s)
        o = jnp.exp(gc)[..., None] * jnp.einsum('bhik,bhkv->bhiv', qc, s) + jnp.einsum('bhij,bhjv->bhiv', ac, u)
        s_new = gl[..., None, None] * s + jnp.einsum('bhjk,bhjv->bhkv', kc * dl[..., None], u)
        return s_new, o

    s_fin, o = lax.scan(step, s0, (q, k, u_v, w_k, attn, gam, dec_last, g_last))
    return from_chunks(o), s_fin


def gla_recurrence(q, k, v, logf, s0):
    c = chunk_len(q.shape[2])
    q, k, v, logf = (to_chunks(t, c) for t in (q, k, v, logf))
    bcum = jnp.cumsum(logf, axis=-2)
    idx = jnp.arange(c)
    incl = (idx[:, None] >= idx[None, :])[:, :, None]

    def step(s, xs):
        qc, kc, vc, bc = xs
        dec = jnp.exp(jnp.where(incl, bc[:, :, :, None, :] - bc[:, :, None, :, :], -jnp.inf))
        attn = jnp.einsum('bhid,bhjd,bhijd->bhij', qc, kc, dec)
        o = jnp.einsum('bhid,bhdv->bhiv', qc * jnp.exp(bc), s) + jnp.einsum('bhij,bhjv->bhiv', attn, vc)
        s_new = jnp.exp(bc[:, :, -1, :])[..., None] * s + jnp.einsum('bhjd,bhjv->bhdv', kc * jnp.exp(bc[:, :, -1:, :] - bc), vc)
        return s_new, o

    s_fin, o = lax.scan(step, s0, (q, k, v, bcum))
    return from_chunks(o), s_fin


def complex_affine_combine(e1, e2):
    a1r, a1i, b1r, b1i = e1
    a2r, a2i, b2r, b2i = e2
    return (a2r * a1r - a2i * a1i, a2r * a1i + a2i * a1r,
            a2r * b1r - a2i * b1i + b2r, a2r * b1i + a2i * b1r + b2i)


def s5_branch(u, x0_re, x0_im, lam_re, lam_im, b_re, b_im, c_re, c_im, d, log_dt, glu_w):
    bsz, l = u.shape[:2]
    lr = jnp.minimum(lam_re.astype(F32), -1e-4)
    li = lam_im.astype(F32)
    dt = jnp.exp(log_dt.astype(F32))[:, None]
    mag = jnp.exp(lr * dt)
    ab_re, ab_im = mag * jnp.cos(li * dt), mag * jnp.sin(li * dt)
    den = lr * lr + li * li
    z_re = ((ab_re - 1.0) * lr + ab_im * li) / den
    z_im = (ab_im * lr - (ab_re - 1.0) * li) / den
    br_, bi_ = b_re.astype(F32), b_im.astype(F32)
    bb_re = z_re[..., None] * br_ - z_im[..., None] * bi_
    bb_im = z_re[..., None] * bi_ + z_im[..., None] * br_
    bu_re = jnp.einsum('blgh,gph->blgp', u, bb_re)
    bu_im = jnp.einsum('blgh,gph->blgp', u, bb_im)
    x0r, x0i = x0_re.astype(F32), x0_im.astype(F32)
    bu_re = bu_re.at[:, 0].add(ab_re * x0r - ab_im * x0i)
    bu_im = bu_im.at[:, 0].add(ab_re * x0i + ab_im * x0r)
    a_re = jnp.broadcast_to(ab_re, bu_re.shape)
    a_im = jnp.broadcast_to(ab_im, bu_im.shape)
    _, _, xr, xi = lax.associative_scan(complex_affine_combine, (a_re, a_im, bu_re, bu_im), axis=1)
    y = (jnp.einsum('blgp,ghp->blgh', xr, c_re.astype(F32))
         - jnp.einsum('blgp,ghp->blgh', xi, c_im.astype(F32))).reshape(bsz, l, BR_WIDTH)
    y = y + d.astype(F32) * u.reshape(bsz, l, BR_WIDTH)
    hg = jax.nn.gelu(y) @ glu_w.astype(F32)
    return hg[..., :BR_WIDTH] * jax.nn.sigmoid(hg[..., BR_WIDTH:]), xr[:, -1], xi[:, -1]


def hgrn_lower_bounds(logits):
    p = jax.nn.softmax(logits.astype(F32), axis=0)
    return jnp.cumsum(p, axis=0) - p[0]


def hgrn_log_forget(xf, lb):
    ls_pos = jax.nn.log_sigmoid(xf)
    pos = lb > 0
    lb_safe = jnp.where(pos, lb, 1.0)
    mixed = jnp.logaddexp(ls_pos, jnp.log(lb_safe) + jax.nn.log_sigmoid(-xf))
    return jnp.where(pos, mixed, ls_pos)


def trunk(x, states, prm):
    b, l, _ = x.shape
    conv_in, gdn_in, gla_in, s5r_in, s5i_in, hg_in = states
    lb_all = hgrn_lower_bounds(prm['hgrn_lb_logits'])
    new_states = ([], [], [], [], [], [])
    h = x
    for i in range(DEPTH):
        xn = rmsnorm(h, prm['norm1_w'][i])
        (a_qkv, a_alpha, a_beta, a_gate, b_q, b_k, b_v, b_gk, b_gate, c_u,
         d_q, d_f, d_i, d_gate, merge) = split_cols(xn @ prm['w_in'][i])

        qkv, conv_new = short_conv(a_qkv, conv_in[i], prm['gdn_conv_w'][i])
        qa, ka, va = jnp.split(qkv, 3, axis=-1)
        beta = jax.nn.sigmoid(a_beta.astype(F32)).transpose(0, 2, 1)
        g = (-jnp.exp(prm['gdn_a_log'][i].astype(F32))
             * jax.nn.softplus(a_alpha.astype(F32) + prm['gdn_dt_bias'][i].astype(F32))).transpose(0, 2, 1)
        o_a, s_a = gated_delta_rule(l2norm(to_heads(qa)) * HEAD_DIM ** -0.5, l2norm(to_heads(ka)),
                                    to_heads(va), g, beta, gdn_in[i].astype(F32))
        o_a = gated_head_norm(o_a, a_gate, prm['gdn_norm_w'][i])

        logf_b = jax.nn.log_sigmoid(b_gk.astype(F32) @ prm['gla_gk_w'][i].astype(F32)
                                    + prm['gla_gk_b'][i].astype(F32)) / GLA_GATE_NORM
        o_b, s_b = gla_recurrence(to_heads(b_q.astype(F32)) * HEAD_DIM ** -0.5, to_heads(b_k.astype(F32)),
                                  to_heads(b_v.astype(F32)), to_heads(logf_b), gla_in[i].astype(F32))
        o_b = gated_head_norm(o_b, b_gate, prm['gla_norm_w'][i])

        o_c, s5r, s5i = s5_branch(c_u.astype(F32).reshape(b, l, S5_GROUPS, S5_GROUP), s5r_in[i], s5i_in[i],
                                  prm['s5_lambda_re'][i], prm['s5_lambda_im'][i], prm['s5_b_re'][i],
                                  prm['s5_b_im'][i], prm['s5_c_re'][i], prm['s5_c_im'][i], prm['s5_d'][i],
                                  prm['s5_log_dt'][i], prm['s5_glu_w'][i])

        lb = lb_all[i]
        xf = d_f.astype(F32)
        logf_d = hgrn_log_forget(xf, lb)
        k_d = (1.0 - lb) * jax.nn.sigmoid(-xf)
        o_d, s_d = gla_recurrence(to_heads(jax.nn.silu(d_q.astype(F32))) * HEAD_DIM ** -0.5, to_heads(k_d),
                                  to_heads(d_i.astype(F32)), to_heads(logf_d), hg_in[i].astype(F32))
        o_d = gated_head_norm(o_d, d_gate, prm['hgrn_norm_w'][i])

        branches = jnp.stack([o_a, o_b, o_c, o_d], axis=2).astype(x.dtype)
        br = jnp.einsum('blkw,kwd->blkd', branches, prm['w_branch'][i])
        gates = jax.nn.sigmoid(merge.reshape(b, l, N_BRANCH, D_MODEL))
        h = h + jnp.sum(gates * br, axis=2) @ prm['w_out'][i]

        hn = rmsnorm(h, prm['norm2_w'][i])
        h = h + (jax.nn.silu(hn @ prm['ffn_w_gate'][i]) * (hn @ prm['ffn_w_up'][i])) @ prm['ffn_w_down'][i]

        for lst, s, ref in zip(new_states, (conv_new, s_a, s_b, s5r, s5i, s_d), states):
            lst.append(s.astype(ref.dtype))
    y = rmsnorm(h, prm['final_norm_w'])
    return y, [jnp.stack(lst) for lst in new_states]


def setup_inputs(seed: int = 0) -> dict:
    key = jax.random.key(seed)
    ks = iter(jax.random.split(key, 48))

    def nrm(shape, scale):
        return scale * jax.random.normal(next(ks), shape, F32)

    def log_uniform(shape, lo, hi):
        return jnp.exp(jax.random.uniform(next(ks), shape, F32, math.log(lo), math.log(hi)))

    W, H, G, P = BR_WIDTH, N_HEADS, S5_GROUPS, S5_P
    dt = log_uniform((DEPTH, H), 1e-3, 0.1)
    return {
        'x_prompt': nrm((BATCH, SEQ, D_MODEL), 1.0),
        'x_sample': nrm((DEC_BATCH, DEC_SEQ, D_MODEL), 1.0),
        'state_gdn_conv': nrm((DEPTH, DEC_BATCH, CONV_W - 1, 3 * W), 1.0),
        'state_gdn': nrm((DEPTH, DEC_BATCH, H, HEAD_DIM, HEAD_DIM), HEAD_DIM ** -0.5),
        'state_gla': nrm((DEPTH, DEC_BATCH, H, HEAD_DIM, HEAD_DIM), 1.0),
        'state_s5_re': nrm((DEPTH, DEC_BATCH, G, P), 0.5),
        'state_s5_im': nrm((DEPTH, DEC_BATCH, G, P), 0.5),
        'state_hgrn': nrm((DEPTH, DEC_BATCH, H, HEAD_DIM, HEAD_DIM), 1.0),
        'norm1_w': 1.0 + nrm((DEPTH, D_MODEL), 0.02),
        'w_in': nrm((DEPTH, D_MODEL, N_IN), D_MODEL ** -0.5),
        'gdn_conv_w': nrm((DEPTH, CONV_W, 3 * W), CONV_W ** -0.5),
        'gdn_a_log': jnp.log(jax.random.uniform(next(ks), (DEPTH, H), F32, 1.0, 16.0)),
        'gdn_dt_bias': dt + jnp.log(-jnp.expm1(-dt)),
        'gdn_norm_w': 1.0 + nrm((DEPTH, W), 0.02),
        'gla_gk_w': nrm((DEPTH, GLA_GATE_RANK, W), GLA_GATE_RANK ** -0.5),
        'gla_gk_b': nrm((DEPTH, W), 0.1),
        'gla_norm_w': 1.0 + nrm((DEPTH, W), 0.02),
        's5_lambda_re': -0.5 + nrm((DEPTH, G, P), 0.01),
        's5_lambda_im': jnp.pi * jnp.arange(P, dtype=F32) + nrm((DEPTH, G, P), 0.01),
        's5_b_re': nrm((DEPTH, G, P, S5_GROUP), (2 * S5_GROUP) ** -0.5),
        's5_b_im': nrm((DEPTH, G, P, S5_GROUP), (2 * S5_GROUP) ** -0.5),
        's5_c_re': nrm((DEPTH, G, S5_GROUP, P), P ** -0.5),
        's5_c_im': nrm((DEPTH, G, S5_GROUP, P), P ** -0.5),
        's5_d': nrm((DEPTH, W), 1.0),
        's5_log_dt': jnp.log(log_uniform((DEPTH, G), 1e-3, 0.1)),
        's5_glu_w': nrm((DEPTH, W, 2 * W), W ** -0.5),
        'hgrn_lb_logits': nrm((DEPTH, W), 0.5),
        'hgrn_norm_w': 1.0 + nrm((DEPTH, W), 0.02),
        'w_branch': nrm((DEPTH, N_BRANCH, W, D_MODEL), W ** -0.5),
        'w_out': nrm((DEPTH, D_MODEL, D_MODEL), D_MODEL ** -0.5),
        'norm2_w': 1.0 + nrm((DEPTH, D_MODEL), 0.02),
        'ffn_w_gate': nrm((DEPTH, D_MODEL, D_FF), D_MODEL ** -0.5),
        'ffn_w_up': nrm((DEPTH, D_MODEL, D_FF), D_MODEL ** -0.5),
        'ffn_w_down': nrm((DEPTH, D_FF, D_MODEL), D_FF ** -0.5),
        'final_norm_w': 1.0 + nrm((D_MODEL,), 0.02),
    }


def reference(x_prompt, x_sample, state_gdn_conv, state_gdn, state_gla, state_s5_re, state_s5_im, state_hgrn,
              norm1_w, w_in, gdn_conv_w, gdn_a_log, gdn_dt_bias, gdn_norm_w, gla_gk_w, gla_gk_b, gla_norm_w,
              s5_lambda_re, s5_lambda_im, s5_b_re, s5_b_im, s5_c_re, s5_c_im, s5_d, s5_log_dt, s5_glu_w,
              hgrn_lb_logits, hgrn_norm_w, w_branch, w_out, norm2_w, ffn_w_gate, ffn_w_up, ffn_w_down,
              final_norm_w):
    prm = dict(norm1_w=norm1_w, w_in=w_in, gdn_conv_w=gdn_conv_w, gdn_a_log=gdn_a_log, gdn_dt_bias=gdn_dt_bias,
               gdn_norm_w=gdn_norm_w, gla_gk_w=gla_gk_w, gla_gk_b=gla_gk_b, gla_norm_w=gla_norm_w,
               s5_lambda_re=s5_lambda_re, s5_lambda_im=s5_lambda_im, s5_b_re=s5_b_re, s5_b_im=s5_b_im,
               s5_c_re=s5_c_re, s5_c_im=s5_c_im, s5_d=s5_d, s5_log_dt=s5_log_dt, s5_glu_w=s5_glu_w,
               hgrn_lb_logits=hgrn_lb_logits, hgrn_norm_w=hgrn_norm_w, w_branch=w_branch, w_out=w_out,
               norm2_w=norm2_w, ffn_w_gate=ffn_w_gate, ffn_w_up=ffn_w_up, ffn_w_down=ffn_w_down,
               final_norm_w=final_norm_w)
    sample_states = (state_gdn_conv, state_gdn, state_gla, state_s5_re, state_s5_im, state_hgrn)
    prompt_states = tuple(jnp.zeros((DEPTH, x_prompt.shape[0]) + s.shape[2:], s.dtype) for s in sample_states)
    y_prompt, ps = trunk(x_prompt, prompt_states, prm)
    y_sample, ss = trunk(x_sample, sample_states, prm)
    return (y_prompt, y_sample, ps[0], ps[1], ps[2], ps[3], ps[4], ps[5],
            ss[0], ss[1], ss[2], ss[3], ss[4], ss[5])
```

```cpp
#include <hip/hip_runtime.h>
#include <hip/hip_cooperative_groups.h>
#include <cstdio>
namespace cg = cooperative_groups;

#ifndef MULTI_LAUNCH
#define MULTI_LAUNCH 0
#endif

#define LAS __attribute__((address_space(3)))
typedef unsigned short bf16_t;
typedef short bf16x8 __attribute__((ext_vector_type(8)));
typedef float f32x4 __attribute__((ext_vector_type(4)));
typedef float f32x2 __attribute__((ext_vector_type(2)));
typedef unsigned u32x2 __attribute__((ext_vector_type(2)));
typedef unsigned u32x4 __attribute__((ext_vector_type(4)));

constexpr int DM = 1024, SEQ = 2048, NBATCH = 8, NDEC = 128;
constexpr int MPROMPT = NBATCH * SEQ;
constexpr int MTOK = MPROMPT + NDEC;
constexpr int MP = 16640;
constexpr int NPM = 3584, NGATE = 4096, NIN = 7448, DFF = 2816;
constexpr int A_QKV = 0, A_GATE = 768, B_Q = 1024, B_K = 1280, B_V = 1536, B_GATE = 1792, C_U = 2048, D_Q = 2304, D_F = 2560, D_I = 2816, D_GATE = 3072,
              A_ALPHA = 3328, A_BETA = 3332, B_GK = 3336;
constexpr float EPS = 1e-6f;

constexpr size_t SZ_WIN = (size_t)7680 * 1024 * 2, SZ_WGU = (size_t)5632 * 1024 * 2, SZ_WDN = (size_t)1024 * 2816 * 2, SZ_WOUT = (size_t)1024 * 1024 * 2,
                 SZ_WBR = (size_t)4096 * 256 * 2, SZ_WGLU = (size_t)512 * 256 * 2;
constexpr size_t OFF_WIN = 0, OFF_WGU = OFF_WIN + SZ_WIN, OFF_WDN = OFF_WGU + SZ_WGU, OFF_WOUT = OFF_WDN + SZ_WDN, OFF_WBR = OFF_WOUT + SZ_WOUT,
                 OFF_WGLU = OFF_WBR + SZ_WBR, OFF_H = OFF_WGLU + SZ_WGLU, OFF_XN = OFF_H + (size_t)MP * 1024 * 4, OFF_BR = OFF_XN + (size_t)MP * 1024 * 2,
                 OFF_PM = OFF_BR + (size_t)MP * 1024 * 2, OFF_GATES = OFF_PM + (size_t)MP * NPM * 2, OFF_ORAW = OFF_GATES + (size_t)MP * NGATE * 2,
                 OFF_YG = OFF_ORAW + (size_t)MP * 768 * 2, OFF_BAR = OFF_YG + (size_t)MP * 256 * 2, WS_NEED = OFF_BAR + 256;
constexpr size_t O_PCONV = 16908288, O_PGDN = 16982016, O_PGLA = 17506304, O_PS5R = 18030592, O_PS5I = 18063360, O_PHG = 18096128,
                 O_SCONV = 18620416, O_SGDN = 19800064, O_SGLA = 28188672, O_SS5R = 36577280, O_SS5I = 37101568, O_SHG = 37625856;

struct KP { const float* in[35]; float* out; unsigned char* ws; };
#define CAS __attribute__((address_space(4)))
typedef const CAS KP& KPR;

__device__ __forceinline__ int otid() { return threadIdx.x; }
__device__ __forceinline__ float bf2f(bf16_t b) { return __uint_as_float(((unsigned)b) << 16); }
__device__ __forceinline__ unsigned cvt_pk_bf16(float lo, float hi) { unsigned r; asm volatile("v_cvt_pk_bf16_f32 %0, %1, %2" : "=v"(r) : "v"(lo), "v"(hi)); return r; }
__device__ __forceinline__ bf16_t f2bf(float f) { return (bf16_t)(cvt_pk_bf16(f, 0.f) & 0xffffu); }
__device__ __forceinline__ float lo_bf(unsigned w) { return __uint_as_float(w << 16); }
__device__ __forceinline__ float hi_bf(unsigned w) { return __uint_as_float(w & 0xffff0000u); }
__device__ __forceinline__ float sigmoidf_(float x) { return 1.0f / (1.0f + __expf(-x)); }
__device__ __forceinline__ float siluf_(float x) { return x / (1.0f + __expf(-x)); }
__device__ __forceinline__ float wave_sum(float v) {
#pragma unroll
    for (int o = 32; o >= 1; o >>= 1) v += __shfl_xor(v, o);
    return v;
}
template <int CTRL> __device__ __forceinline__ float dpp_f(float v) { return __int_as_float(__builtin_amdgcn_update_dpp(0, __float_as_int(v), CTRL, 0xf, 0xf, true)); }
__device__ __forceinline__ float red8(float v) { v += dpp_f<0xB1>(v); v += dpp_f<0x4E>(v); v += dpp_f<0x141>(v); return v; }

namespace pg8 {
constexpr int BM = 256, BK = 64, HALF = 128, HTB = HALF * BK * 2, STAGE_BYTES = 8 * HTB, NXCD = 8, WGM = 8;
__device__ __forceinline__ int lds_byte(int r, int c) { const int st = (r >> 4) * 2 + (c >> 5), rr = r & 15, cc = c & 31, ob = rr * 64 + cc * 2; return st * 1024 + (ob ^ (((ob >> 9) & 1) << 5)); }
__device__ __forceinline__ void stage_rc(int b, int& R, int& C) { const int st = b / 1024, sb = b % 1024, swz = sb ^ (((sb >> 9) & 1) << 5); R = (st >> 1) * 16 + swz / 64; C = (st & 1) * 32 + (swz % 64) / 2; }

struct Unit { int pm, pn, kk; };
struct Gemm { const bf16_t* A; const bf16_t* Bt; int lda, ldb, nt; size_t a_kk, b_kk; };
struct Sched {
    int nM, nN, nKK, nwg, G, c;
    __device__ void init(int nM_, int nN_, int nKK_, int G_, int c_) { nM = nM_; nN = nN_; nKK = nKK_; nwg = nM * nN; G = G_; c = c_; }
    __device__ bool next(int i, Unit& u) const {
        const int it = i / nKK; u.kk = i - it * nKK;
        const long L = (long)it * G + c; if (L >= nwg) return false;
        int wgid = (int)L; { const int q = nwg / NXCD, r = nwg % NXCD, xcd = wgid % NXCD, off = wgid / NXCD; wgid = (xcd < r ? xcd * (q + 1) : r * (q + 1) + (xcd - r) * q) + off; }
        const int nig = WGM * nN, gid = wgid / nig, fm = gid * WGM, gsz = (nM - fm) < WGM ? (nM - fm) : WGM;
        u.pm = fm + ((wgid % nig) % gsz); u.pn = (wgid % nig) / gsz; return true;
    }
};

template <class Epi>
__device__ __forceinline__ void gemm_phase(LAS unsigned char* lds, const Gemm g, const Sched& S, const Epi& E) {
    const int tid = otid(), wid = __builtin_amdgcn_readfirstlane(tid >> 6), lane = tid & 63, wr = wid >> 2, wc = wid & 3, fr = lane & 15, fq = lane >> 4;
    int nt = g.nt; asm volatile("" : "+s"(nt));
    unsigned voffA[2], voffB[2];
#pragma unroll
    for (int i = 0; i < 2; ++i) { int R, C; stage_rc(tid * 16 + i * 8192, R, C); voffA[i] = (unsigned)(R * g.lda + C) * 2u; voffB[i] = (unsigned)(R * g.ldb + C) * 2u; }
    const size_t kstep = (size_t)(BK * 2);
    const size_t hstepA = (size_t)HALF * g.lda * 2, hstepB = (size_t)HALF * g.ldb * 2;
    const size_t tstepA = 2 * hstepA, tstepB = 2 * hstepB;
    const unsigned ldsw = (unsigned)wid * 1024u;
    const int aoff = lds_byte(wr * 64 + fr, fq * 8), boff = lds_byte(wc * 32 + fr, fq * 8);
#define PG8_SA(b, h) (((b) * 2 + (h)) * HTB)
#define PG8_SB(b, h) ((4 + (b) * 2 + (h)) * HTB)
#define PG8_STAGE(bufoff, gbase, voff) do { _Pragma("unroll") for (int _i = 0; _i < 2; ++_i) \
        __builtin_amdgcn_global_load_lds((const unsigned*)((const char*)(gbase) + (voff)[_i]), (LAS unsigned*)(lds + (bufoff) + ldsw + _i * 8192), 16, 0, 0); } while (0)
#define PG8_LDA(dst, b, h) do { _Pragma("unroll") for (int m = 0; m < 4; ++m) _Pragma("unroll") for (int k = 0; k < 2; ++k) dst[m][k] = *(const LAS bf16x8*)(lds + PG8_SA(b, h) + aoff + m * 2048 + k * 1024); } while (0)
#define PG8_LDB(dst, b, h) do { _Pragma("unroll") for (int n = 0; n < 2; ++n) _Pragma("unroll") for (int k = 0; k < 2; ++k) dst[n][k] = *(const LAS bf16x8*)(lds + PG8_SB(b, h) + boff + n * 2048 + k * 1024); } while (0)
#define PG8_MMA(ai, bj, At, Bt) do { __builtin_amdgcn_s_setprio(1); _Pragma("unroll") for (int m = 0; m < 4; ++m) _Pragma("unroll") for (int n = 0; n < 2; ++n) _Pragma("unroll") for (int k = 0; k < 2; ++k) \
        acc[ai][bj][m][n] = __builtin_amdgcn_mfma_f32_16x16x32_bf16(Bt[n][k], At[m][k], acc[ai][bj][m][n], 0, 0, 0); __builtin_amdgcn_s_setprio(0); } while (0)
#define PG8_WAIT_V(n) asm volatile("s_waitcnt vmcnt(" #n ")" ::: "memory")
#define PG8_WAIT_L(n) asm volatile("s_waitcnt lgkmcnt(" #n ")" ::: "memory")
#define PG8_BAR __builtin_amdgcn_s_barrier()
#define PG8_SCHED __builtin_amdgcn_sched_barrier(0)
    Unit cur, nxt; int ui = 0;
    if (!S.next(0, cur)) return;
    f32x4 acc[2][2][4][2];
#pragma unroll
    for (int a = 0; a < 2; ++a)
#pragma unroll
        for (int b = 0; b < 2; ++b)
#pragma unroll
            for (int m = 0; m < 4; ++m)
#pragma unroll
                for (int n = 0; n < 2; ++n) acc[a][b][m][n] = (f32x4){0.f, 0.f, 0.f, 0.f};
    bf16x8 At[4][2], B0[2][2], B1[2][2];
    const char* cA = (const char*)(g.A + (size_t)cur.kk * g.a_kk) + (size_t)cur.pm * tstepA; const char* cB = (const char*)(g.Bt + (size_t)cur.kk * g.b_kk) + (size_t)cur.pn * tstepB;
    PG8_STAGE(PG8_SB(0, 0), cB, voffB); PG8_STAGE(PG8_SA(0, 0), cA, voffA); PG8_STAGE(PG8_SB(0, 1), cB + hstepB, voffB); PG8_STAGE(PG8_SA(0, 1), cA + hstepA, voffA);
    if (wr == 1) PG8_BAR;
    PG8_WAIT_V(4); PG8_BAR;
    PG8_STAGE(PG8_SB(1, 0), cB + kstep, voffB); PG8_STAGE(PG8_SA(1, 0), cA + kstep, voffA); PG8_STAGE(PG8_SB(1, 1), cB + hstepB + kstep, voffB);
    PG8_WAIT_V(6); PG8_BAR;
    for (;;) {
        const bool has_next = S.next(ui + 1, nxt);
        const char* nA = has_next ? (const char*)(g.A + (size_t)nxt.kk * g.a_kk) + (size_t)nxt.pm * tstepA : cA;
        const char* nB = has_next ? (const char*)(g.Bt + (size_t)nxt.kk * g.b_kk) + (size_t)nxt.pn * tstepB : cB;
        for (int t = 0; t < nt; t += 2) {
            const bool last = (t == nt - 2);
            const char* a1 = cA + (size_t)(t + 1) * kstep;
            const char* a2 = last ? nA : cA + (size_t)(t + 2) * kstep; const char* b2 = last ? nB : cB + (size_t)(t + 2) * kstep;
            const char* a3 = a2 + kstep; const char* b3 = b2 + kstep;
            PG8_LDB(B0, 0, 0); PG8_SCHED; PG8_LDA(At, 0, 0); PG8_STAGE(PG8_SA(1, 1), a1 + hstepA, voffA);
            PG8_WAIT_L(8); PG8_BAR; PG8_WAIT_L(0); PG8_MMA(0, 0, At, B0); PG8_BAR; PG8_SCHED;
            PG8_LDB(B1, 0, 1); PG8_STAGE(PG8_SB(0, 0), b2, voffB);
            PG8_BAR; PG8_WAIT_L(0); PG8_MMA(0, 1, At, B1); PG8_BAR;
            PG8_LDA(At, 0, 1); PG8_STAGE(PG8_SA(0, 0), a2, voffA);
            PG8_BAR; PG8_WAIT_L(0); PG8_MMA(1, 0, At, B0); PG8_BAR; PG8_SCHED;
            PG8_STAGE(PG8_SB(0, 1), b2 + hstepB, voffB);
            PG8_WAIT_V(6); PG8_BAR; PG8_MMA(1, 1, At, B1); PG8_BAR;
            PG8_LDB(B0, 1, 0); PG8_SCHED; PG8_LDA(At, 1, 0); PG8_STAGE(PG8_SA(0, 1), a2 + hstepA, voffA);
            PG8_WAIT_L(8); PG8_BAR; PG8_WAIT_L(0); PG8_MMA(0, 0, At, B0); PG8_BAR; PG8_SCHED;
            PG8_LDB(B1, 1, 1); PG8_STAGE(PG8_SB(1, 0), b3, voffB);
            PG8_BAR; PG8_WAIT_L(0); PG8_MMA(0, 1, At, B1); PG8_BAR;
            PG8_LDA(At, 1, 1); PG8_STAGE(PG8_SA(1, 0), a3, voffA);
            PG8_BAR; PG8_WAIT_L(0); PG8_MMA(1, 0, At, B0); PG8_BAR; PG8_SCHED;
            PG8_STAGE(PG8_SB(1, 1), b3 + hstepB, voffB);
            PG8_WAIT_V(6); PG8_BAR; PG8_MMA(1, 1, At, B1); PG8_BAR;
        }
        E(acc, cur, wr, wc, fr, fq);
        if (!has_next) break;
#pragma unroll
        for (int a = 0; a < 2; ++a)
#pragma unroll
            for (int b = 0; b < 2; ++b)
#pragma unroll
                for (int m = 0; m < 4; ++m)
#pragma unroll
                    for (int n = 0; n < 2; ++n) acc[a][b][m][n] = (f32x4){0.f, 0.f, 0.f, 0.f};
        cur = nxt; cA = nA; cB = nB; ++ui;
    }
    PG8_WAIT_V(0);
    if (wr == 0) PG8_BAR;
    PG8_BAR;
    __builtin_amdgcn_s_waitcnt(0);
#undef PG8_SA
#undef PG8_SB
#undef PG8_STAGE
#undef PG8_LDA
#undef PG8_LDB
#undef PG8_MMA
#undef PG8_WAIT_V
#undef PG8_WAIT_L
#undef PG8_BAR
#undef PG8_SCHED
}
}
using pg8::Unit;

#define EPI_LOOP_BEGIN _Pragma("unroll") for (int ai = 0; ai < 2; ++ai) _Pragma("unroll") for (int m = 0; m < 4; ++m) { const size_t row = (size_t)(u.pm * 256 + ai * 128 + wr * 64 + m * 16 + fr); \
        _Pragma("unroll") for (int bj = 0; bj < 2; ++bj) {
#define EPI_LOOP_END } }
struct EpiIn {
    bf16_t* pm; bf16_t* gates;
    __device__ __forceinline__ void operator()(const f32x4 (&acc)[2][2][4][2], const Unit& u, int wr, int wc, int fr, int fq) const {
        const bool main_ = u.pn < 14;
        EPI_LOOP_BEGIN
#pragma unroll
            for (int n = 0; n < 2; ++n) { const int col = u.pn * 256 + bj * 128 + wc * 32 + n * 16 + fq * 4; f32x4 v = acc[ai][bj][m][n]; u32x2 w;
                if (main_) { w.x = cvt_pk_bf16(v[0], v[1]); w.y = cvt_pk_bf16(v[2], v[3]); *(u32x2*)(pm + row * NPM + col) = w; }
                else { w.x = cvt_pk_bf16(sigmoidf_(v[0]), sigmoidf_(v[1])); w.y = cvt_pk_bf16(sigmoidf_(v[2]), sigmoidf_(v[3])); *(u32x2*)(gates + row * NGATE + (col - NPM)) = w; } }
        EPI_LOOP_END
    }
};
struct EpiGlu {
    bf16_t* br;
    __device__ __forceinline__ void operator()(const f32x4 (&acc)[2][2][4][2], const Unit& u, int wr, int wc, int fr, int fq) const {
        EPI_LOOP_BEGIN
            const int j = u.pn * 128 + bj * 64 + wc * 16 + fq * 4; const f32x4 a = acc[ai][bj][m][0], b = acc[ai][bj][m][1]; u32x2 w;
            w.x = cvt_pk_bf16(a[0] * sigmoidf_(b[0]), a[1] * sigmoidf_(b[1])); w.y = cvt_pk_bf16(a[2] * sigmoidf_(b[2]), a[3] * sigmoidf_(b[3]));
            *(u32x2*)(br + row * 1024 + 512 + j) = w;
        EPI_LOOP_END
    }
};
struct EpiGU {
    bf16_t* a;
    __device__ __forceinline__ void operator()(const f32x4 (&acc)[2][2][4][2], const Unit& u, int wr, int wc, int fr, int fq) const {
        EPI_LOOP_BEGIN
            const int j = u.pn * 128 + bj * 64 + wc * 16 + fq * 4; const f32x4 g = acc[ai][bj][m][0], b = acc[ai][bj][m][1]; u32x2 w;
            w.x = cvt_pk_bf16(siluf_(g[0]) * b[0], siluf_(g[1]) * b[1]); w.y = cvt_pk_bf16(siluf_(g[2]) * b[2], siluf_(g[3]) * b[3]);
            *(u32x2*)(a + row * DFF + j) = w;
        EPI_LOOP_END
    }
};
struct EpiBr {
    const bf16_t* gates; bf16_t* mm;
    __device__ __forceinline__ void operator()(const f32x4 (&acc)[2][2][4][2], const Unit& u, int wr, int wc, int fr, int fq) const {
        EPI_LOOP_BEGIN
#pragma unroll
            for (int n = 0; n < 2; ++n) { const int col = u.pn * 256 + bj * 128 + wc * 32 + n * 16 + fq * 4; const f32x4 v = acc[ai][bj][m][n];
                const u32x2 gw = *(const u32x2*)(gates + row * NGATE + u.kk * 1024 + col);
                float r0 = lo_bf(gw.x) * v[0], r1 = hi_bf(gw.x) * v[1], r2 = lo_bf(gw.y) * v[2], r3 = hi_bf(gw.y) * v[3];
                if (u.kk > 0) { const u32x2 pw = *(const u32x2*)(mm + row * 1024 + col); r0 += lo_bf(pw.x); r1 += hi_bf(pw.x); r2 += lo_bf(pw.y); r3 += hi_bf(pw.y); }
                u32x2 w; w.x = cvt_pk_bf16(r0, r1); w.y = cvt_pk_bf16(r2, r3); *(u32x2*)(mm + row * 1024 + col) = w; }
        EPI_LOOP_END
    }
};
struct EpiRes {
    float* h;
    __device__ __forceinline__ void operator()(const f32x4 (&acc)[2][2][4][2], const Unit& u, int wr, int wc, int fr, int fq) const {
        EPI_LOOP_BEGIN
#pragma unroll
            for (int n = 0; n < 2; ++n) { const int col = u.pn * 256 + bj * 128 + wc * 32 + n * 16 + fq * 4; float* ptr = h + row * 1024 + col;
                const f32x4 o = *(const f32x4*)ptr; *(f32x4*)ptr = o + acc[ai][bj][m][n]; }
        EPI_LOOP_END
    }
};

__device__ __forceinline__ int win_src_col(int n) {
    if (n < 768) return n;
    if (n < 1024) return 776 + (n - 768);
    if (n < 1792) return 1032 + (n - 1024);
    if (n < 2048) return 1816 + (n - 1792);
    if (n < 2304) return 2072 + (n - 2048);
    if (n < 3072) return 2328 + (n - 2304);
    if (n < 3328) return 3096 + (n - 3072);
    if (n < 3336) return 768 + (n - 3328);
    if (n < 3352) return 1800 + (n - 3336);
    if (n < 3584) return -1;
    return 3352 + (n - 3584);
}
__device__ __forceinline__ void phase_convert(KPR p, int layer, LAS float* tile, int bid, int G) {
    const int tid = otid(), tn = tid & 63, tk = __builtin_amdgcn_readfirstlane(tid >> 6);
    constexpr int T0 = 120 * 16, T1 = T0 + 88 * 16, T2 = T1 + 16 * 44, T3 = T2 + 16 * 16, T4 = T3 + 64 * 4, T5 = T4 + 8 * 4;
    for (int j = bid; j < T5; j += G) {
        int n0, k0, K, ld; bf16_t* dst; const float* cp = nullptr;
        if (j < T0) { const int q = j; n0 = (q >> 4) * 64; k0 = (q & 15) * 64; K = 1024; ld = NIN; dst = (bf16_t*)(p.ws + OFF_WIN);
            const int sc = win_src_col(n0 + tn); if (sc >= 0) cp = p.in[9] + (size_t)layer * 1024 * NIN + sc; }
        else if (j < T1) { const int q = j - T0; n0 = (q >> 4) * 64; k0 = (q & 15) * 64; K = 1024; ld = DFF; dst = (bf16_t*)(p.ws + OFF_WGU);
            const int n = n0 + tn, g32 = n >> 5, w = n & 31, jj = g32 * 16 + (w & 15); cp = (w < 16 ? p.in[31] : p.in[32]) + (size_t)layer * 1024 * DFF + jj; }
        else if (j < T2) { const int q = j - T1; n0 = (q / 44) * 64; k0 = (q % 44) * 64; K = DFF; ld = 1024; dst = (bf16_t*)(p.ws + OFF_WDN);
            cp = p.in[33] + (size_t)layer * DFF * 1024 + (n0 + tn); }
        else if (j < T3) { const int q = j - T2; n0 = (q >> 4) * 64; k0 = (q & 15) * 64; K = 1024; ld = 1024; dst = (bf16_t*)(p.ws + OFF_WOUT);
            cp = p.in[29] + (size_t)layer * 1024 * 1024 + (n0 + tn); }
        else if (j < T4) { const int q = j - T3; n0 = (q >> 2) * 64; k0 = (q & 3) * 64; K = 256; ld = 1024; dst = (bf16_t*)(p.ws + OFF_WBR);
            const int n = n0 + tn, kk = n >> 10, d = n & 1023; cp = p.in[28] + ((size_t)(layer * 4 + kk) * 256) * 1024 + d; }
        else { const int q = j - T4; n0 = (q >> 2) * 64; k0 = (q & 3) * 64; K = 256; ld = 512; dst = (bf16_t*)(p.ws + OFF_WGLU);
            const int n = n0 + tn, g32 = n >> 5, w = n & 31, jj = g32 * 16 + (w & 15); cp = p.in[25] + (size_t)layer * 256 * 512 + (w < 16 ? jj : 256 + jj); }
        __syncthreads();
#pragma unroll
        for (int e = 0; e < 8; ++e) { const int k = k0 + tk * 8 + e; tile[tn * 65 + tk * 8 + e] = cp ? cp[(size_t)k * ld] : 0.f; }
        __syncthreads();
        { const int n = tid >> 3, ks = tid & 7; const LAS float* tp = tile + n * 65 + ks * 8; u32x4 w;
          w.x = cvt_pk_bf16(tp[0], tp[1]); w.y = cvt_pk_bf16(tp[2], tp[3]); w.z = cvt_pk_bf16(tp[4], tp[5]); w.w = cvt_pk_bf16(tp[6], tp[7]);
          *(u32x4*)(dst + (size_t)(n0 + n) * K + k0 + ks * 8) = w; }
    }
    __syncthreads();
}

__device__ __forceinline__ void phase_norm(KPR p, const float* w, int mode, int bid, int G) {
    const int tid_ = otid(); const int wid = __builtin_amdgcn_readfirstlane(tid_ >> 6), lane = tid_ & 63;
    float* h = (float*)(p.ws + OFF_H); bf16_t* xn = (bf16_t*)(p.ws + OFF_XN);
    f32x4 wv[4];
#pragma unroll
    for (int i = 0; i < 4; ++i) wv[i] = *(const f32x4*)(w + i * 256 + lane * 4);
    for (int r = bid * 8 + wid; r < MTOK; r += G * 8) {
        const float* src = (mode == 0) ? (r < MPROMPT ? p.in[0] + (size_t)r * 1024 : p.in[1] + (size_t)(r - MPROMPT) * 1024) : h + (size_t)r * 1024;
        f32x4 v[4]; float ss = 0.f;
#pragma unroll
        for (int i = 0; i < 4; ++i) { v[i] = *(const f32x4*)(src + i * 256 + lane * 4); ss += v[i][0] * v[i][0] + v[i][1] * v[i][1] + v[i][2] * v[i][2] + v[i][3] * v[i][3]; }
        ss = wave_sum(ss);
        const float rs = rsqrtf(ss * (1.0f / 1024.0f) + EPS);
#pragma unroll
        for (int i = 0; i < 4; ++i) {
            const f32x4 y = v[i] * rs * wv[i];
            if (mode == 2) *(f32x4*)(p.out + (size_t)r * 1024 + i * 256 + lane * 4) = y;
            else { u32x2 o; o.x = cvt_pk_bf16(y[0], y[1]); o.y = cvt_pk_bf16(y[2], y[3]); *(u32x2*)(xn + (size_t)r * 1024 + i * 256 + lane * 4) = o;
                   if (mode == 0) *(f32x4*)(h + (size_t)r * 1024 + i * 256 + lane * 4) = v[i]; }
        }
    }
}

constexpr int TCH = 32;
constexpr int MIXBUF_FLOATS = 4 * TCH * 64 + TCH * 4;
template <int MIX>
__device__ __forceinline__ void mix_item(KPR p, int layer, LAS float* lds, int tokbase, int L, int h, int col0, int ncols,
                         const float* s_in, float* s_out, const float* conv_in, float* conv_out) {
    const int tid = otid(), wid = __builtin_amdgcn_readfirstlane(tid >> 6), lane = tid & 63;
    const int nscan = ncols * 8; const bool is_scan = wid < (nscan >> 6);
    const int ksl = lane & 7, cl = wid * 8 + (lane >> 3), col = col0 + cl;
    const bf16_t* pm = (const bf16_t*)(p.ws + OFF_PM);
    bf16_t* oraw = (bf16_t*)(p.ws + OFF_ORAW);
    __syncthreads();
    float S[8];
#pragma unroll
    for (int i = 0; i < 8; ++i) S[i] = (is_scan && s_in) ? s_in[(ksl * 8 + i) * 64 + col] : 0.f;
    const int hd = h * 64 + lane;
    float cw[3][4]; float c_a = 0.f, c_dt = 0.f; float gkw[16]; float gkb = 0.f, lb = 0.f;
    if (MIX == 0) {
        const float* cwp = p.in[10] + (size_t)layer * 4 * 768;
#pragma unroll
        for (int s = 0; s < 3; ++s)
#pragma unroll
            for (int j = 0; j < 4; ++j) cw[s][j] = cwp[j * 768 + s * 256 + hd];
        c_a = -__expf(p.in[11][layer * 4 + h]); c_dt = p.in[12][layer * 4 + h];
        if (conv_out && col0 == 0 && h == 0) {
            for (int idx = tid; idx < 3 * 768; idx += 512) { const int i = idx / 768, c = idx - i * 768, ti = L - 3 + i;
                conv_out[idx] = ti >= 0 ? bf2f(pm[(size_t)(tokbase + ti) * NPM + A_QKV + c]) : (conv_in ? conv_in[(3 + ti) * 768 + c] : 0.f); }
        }
    } else if (MIX == 1) {
#pragma unroll
        for (int r = 0; r < 16; ++r) gkw[r] = p.in[14][((size_t)layer * 16 + r) * 256 + hd];
        gkb = p.in[15][layer * 256 + hd];
    } else {
        const float* lg = p.in[26]; float l0 = lg[hd], l1 = lg[256 + hd], l2 = lg[512 + hd], l3 = lg[768 + hd];
        const float mx = fmaxf(fmaxf(l0, l1), fmaxf(l2, l3)); l0 = __expf(l0 - mx); l1 = __expf(l1 - mx); l2 = __expf(l2 - mx); l3 = __expf(l3 - mx);
        const float inv = 1.0f / (l0 + l1 + l2 + l3);
        lb = (layer == 0) ? 0.f : (layer == 1) ? l1 * inv : (layer == 2) ? (l1 + l2) * inv : (l1 + l2 + l3) * inv;
    }
    const int nch = (L + TCH - 1) / TCH;
    auto prep = [&](int c, int pw, int npw) {
        LAS float* kb = lds + (c & 1) * MIXBUF_FLOATS; LAS float* qb = kb + TCH * 64; LAS float* fb = qb + TCH * 64; LAS float* vb = fb + TCH * 64; LAS float* sc = vb + TCH * 64;
        for (int tt = pw; tt < TCH; tt += npw) {
            const int t = c * TCH + tt; if (t >= L) break;
            const bf16_t* row = pm + (size_t)(tokbase + t) * NPM;
            if (MIX == 0) {
                float y[3];
#pragma unroll
                for (int s = 0; s < 3; ++s) { float a = 0.f;
#pragma unroll
                    for (int j = 0; j < 4; ++j) { const int ti = t - 3 + j; const int cc = s * 256 + hd;
                        const float xv = ti >= 0 ? bf2f(pm[(size_t)(tokbase + ti) * NPM + A_QKV + cc]) : (conv_in ? conv_in[(3 + ti) * 768 + cc] : 0.f);
                        a += xv * cw[s][j]; }
                    y[s] = siluf_(a); }
                float qq = wave_sum(y[0] * y[0]), kk2 = wave_sum(y[1] * y[1]);
                const float qn = y[0] * rsqrtf(qq + EPS) * 0.125f, kn = y[1] * rsqrtf(kk2 + EPS);
                const float kq = wave_sum(qn * kn);
                kb[tt * 64 + lane] = kn; qb[tt * 64 + lane] = qn; vb[tt * 64 + lane] = y[2];
                if (lane == 0) { const float al = bf2f(row[A_ALPHA + h]) + c_dt; const float sp = fmaxf(al, 0.f) + __logf(1.0f + __expf(-fabsf(al)));
                    sc[tt * 4 + 0] = __expf(c_a * sp); sc[tt * 4 + 1] = sigmoidf_(bf2f(row[A_BETA + h])); sc[tt * 4 + 2] = kq; }
            } else if (MIX == 1) {
                const u32x4 g0 = *(const u32x4*)(row + B_GK), g1 = *(const u32x4*)(row + B_GK + 8);
                float z = gkb;
                z += lo_bf(g0.x) * gkw[0] + hi_bf(g0.x) * gkw[1] + lo_bf(g0.y) * gkw[2] + hi_bf(g0.y) * gkw[3] + lo_bf(g0.z) * gkw[4] + hi_bf(g0.z) * gkw[5] + lo_bf(g0.w) * gkw[6] + hi_bf(g0.w) * gkw[7];
                z += lo_bf(g1.x) * gkw[8] + hi_bf(g1.x) * gkw[9] + lo_bf(g1.y) * gkw[10] + hi_bf(g1.y) * gkw[11] + lo_bf(g1.z) * gkw[12] + hi_bf(g1.z) * gkw[13] + lo_bf(g1.w) * gkw[14] + hi_bf(g1.w) * gkw[15];
                const float sp = fmaxf(-z, 0.f) + __logf(1.0f + __expf(-fabsf(z)));
                fb[tt * 64 + lane] = __expf(-sp * (1.0f / 16.0f));
                qb[tt * 64 + lane] = bf2f(row[B_Q + hd]) * 0.125f; kb[tt * 64 + lane] = bf2f(row[B_K + hd]); vb[tt * 64 + lane] = bf2f(row[B_V + hd]);
            } else {
                const float xf = bf2f(row[D_F + hd]); const float sg = sigmoidf_(xf);
                fb[tt * 64 + lane] = lb + (1.0f - lb) * sg; kb[tt * 64 + lane] = (1.0f - lb) * (1.0f - sg);
                qb[tt * 64 + lane] = siluf_(bf2f(row[D_Q + hd])) * 0.125f; vb[tt * 64 + lane] = bf2f(row[D_I + hd]);
            }
        }
    };
    prep(0, wid, 8);
    __syncthreads();
    for (int c = 0; c < nch; ++c) {
        if (is_scan) {
            const LAS float* kb = lds + (c & 1) * MIXBUF_FLOATS; const LAS float* qb = kb + TCH * 64; const LAS float* fb = qb + TCH * 64; const LAS float* vb = fb + TCH * 64; const LAS float* sc = vb + TCH * 64;
            const int ntok = (L - c * TCH) < TCH ? (L - c * TCH) : TCH;
            bf16_t* op = oraw + (size_t)(tokbase + c * TCH) * 768 + MIX * 256 + h * 64 + col;
#pragma unroll 4
            for (int tt = 0; tt < ntok; ++tt) {
                const f32x4 k0 = *(const LAS f32x4*)(kb + tt * 64 + ksl * 8), k1 = *(const LAS f32x4*)(kb + tt * 64 + ksl * 8 + 4);
                const f32x4 q0 = *(const LAS f32x4*)(qb + tt * 64 + ksl * 8), q1 = *(const LAS f32x4*)(qb + tt * 64 + ksl * 8 + 4);
                const float v = vb[tt * 64 + col];
                float o;
                if (MIX == 0) {
                    const float eg = sc[tt * 4 + 0], beta = sc[tt * 4 + 1], kq = sc[tt * 4 + 2];
                    float dk = (S[0] * k0[0] + S[1] * k0[1]) + (S[2] * k0[2] + S[3] * k0[3]) + (S[4] * k1[0] + S[5] * k1[1]) + (S[6] * k1[2] + S[7] * k1[3]);
                    float dq = (S[0] * q0[0] + S[1] * q0[1]) + (S[2] * q0[2] + S[3] * q0[3]) + (S[4] * q1[0] + S[5] * q1[1]) + (S[6] * q1[2] + S[7] * q1[3]);
                    dk = red8(dk); dq = red8(dq);
                    const float delta = beta * (v - eg * dk);
#pragma unroll
                    for (int i = 0; i < 4; ++i) { S[i] = eg * S[i] + k0[i] * delta; S[4 + i] = eg * S[4 + i] + k1[i] * delta; }
                    o = eg * dq + kq * delta;
                } else {
                    const f32x4 f0 = *(const LAS f32x4*)(fb + tt * 64 + ksl * 8), f1 = *(const LAS f32x4*)(fb + tt * 64 + ksl * 8 + 4);
#pragma unroll
                    for (int i = 0; i < 4; ++i) { S[i] = f0[i] * S[i] + k0[i] * v; S[4 + i] = f1[i] * S[4 + i] + k1[i] * v; }
                    float dq = (S[0] * q0[0] + S[1] * q0[1]) + (S[2] * q0[2] + S[3] * q0[3]) + (S[4] * q1[0] + S[5] * q1[1]) + (S[6] * q1[2] + S[7] * q1[3]);
                    o = red8(dq);
                }
                if (ksl == 0) op[(size_t)tt * 768] = f2bf(o);
            }
        } else if (c + 1 < nch) prep(c + 1, wid - (nscan >> 6), 8 - (nscan >> 6));
        __syncthreads();
    }
    if (is_scan) {
#pragma unroll
        for (int i = 0; i < 8; ++i) s_out[(ksl * 8 + i) * 64 + col] = S[i];
    }
}

constexpr int S5_BU_LD = 132, S5_XB_LD = 136, S5_WAVE_BYTES = 16 * S5_BU_LD * 4 + 16 * S5_XB_LD * 2;
template <bool SAMPLE>
__device__ __forceinline__ void s5_wave_item(KPR p, int layer, LAS unsigned char* wl, int g, int tokbase, int L, int seq0) {
    const int lane = otid() & 63, col = lane & 15, quad = lane >> 4;
    const bf16_t* pm = (const bf16_t*)(p.ws + OFF_PM); bf16_t* yg = (bf16_t*)(p.ws + OFF_YG);
    LAS float* bu = (LAS float*)wl; LAS bf16_t* xb = (LAS bf16_t*)(wl + 16 * S5_BU_LD * 4);
    const int lg = layer * 16 + g;
    float ar, ai, zr, zi;
    { const float lr = fminf(p.in[17][lg * 64 + lane], -1e-4f), li = p.in[18][lg * 64 + lane], dt = __expf(p.in[24][lg]);
      const float mag = __expf(lr * dt); float rev = li * dt * 0.15915494309f; rev -= rintf(rev);
      const float sn = __builtin_amdgcn_sinf(rev), cs = __builtin_amdgcn_cosf(rev); ar = mag * cs; ai = mag * sn;
      const float den = lr * lr + li * li; zr = ((ar - 1.0f) * lr + ai * li) / den; zi = (ai * lr - (ar - 1.0f) * li) / den; }
    bf16x8 Bf[8], Cf[4];
#pragma unroll
    for (int tt = 0; tt < 4; ++tt) {
        const int pp = tt * 16 + col; const float zr2 = __shfl(zr, pp), zi2 = __shfl(zi, pp);
        float bre[8], bim[8];
#pragma unroll
        for (int j = 0; j < 8; ++j) { bre[j] = 0.f; bim[j] = 0.f; }
        if (quad < 2) {
            const float* br_ = p.in[19] + ((size_t)lg * 64 + pp) * 16 + quad * 8; const float* bi_ = p.in[20] + ((size_t)lg * 64 + pp) * 16 + quad * 8;
#pragma unroll
            for (int j = 0; j < 8; ++j) { const float r = br_[j], i = bi_[j]; bre[j] = zr2 * r - zi2 * i; bim[j] = zr2 * i + zi2 * r; }
        }
        u32x4 wr_, wi_;
        wr_.x = cvt_pk_bf16(bre[0], bre[1]); wr_.y = cvt_pk_bf16(bre[2], bre[3]); wr_.z = cvt_pk_bf16(bre[4], bre[5]); wr_.w = cvt_pk_bf16(bre[6], bre[7]);
        wi_.x = cvt_pk_bf16(bim[0], bim[1]); wi_.y = cvt_pk_bf16(bim[2], bim[3]); wi_.z = cvt_pk_bf16(bim[4], bim[5]); wi_.w = cvt_pk_bf16(bim[6], bim[7]);
        Bf[tt] = __builtin_bit_cast(bf16x8, wr_); Bf[4 + tt] = __builtin_bit_cast(bf16x8, wi_);
    }
#pragma unroll
    for (int kb = 0; kb < 4; ++kb) {
        const int k0 = (kb & 1) * 32 + quad * 8; const float sgn = kb < 2 ? 1.0f : -1.0f;
        const float* cp = (kb < 2 ? p.in[21] : p.in[22]) + ((size_t)lg * 16 + col) * 64 + k0;
        u32x4 w; w.x = cvt_pk_bf16(sgn * cp[0], sgn * cp[1]); w.y = cvt_pk_bf16(sgn * cp[2], sgn * cp[3]); w.z = cvt_pk_bf16(sgn * cp[4], sgn * cp[5]); w.w = cvt_pk_bf16(sgn * cp[6], sgn * cp[7]);
        Cf[kb] = __builtin_bit_cast(bf16x8, w);
    }
    const float dcoef = p.in[23][layer * 256 + g * 16 + col];
    float xr = 0.f, xi = 0.f;
    const int nch = SAMPLE ? 1 : (L + 15) / 16;
    for (int c = 0; c < nch; ++c) {
        const int t0 = c * 16; const int nrow = SAMPLE ? 16 : ((L - t0) < 16 ? (L - t0) : 16);
        u32x4 aw = (u32x4){0u, 0u, 0u, 0u};
        if (quad < 2 && col < nrow) aw = *(const u32x4*)(pm + (size_t)(tokbase + t0 + col) * NPM + C_U + g * 16 + quad * 8);
        const bf16x8 af = __builtin_bit_cast(bf16x8, aw);
#pragma unroll
        for (int tile = 0; tile < 8; ++tile) {
            const f32x4 d = __builtin_amdgcn_mfma_f32_16x16x32_bf16(af, Bf[tile], (f32x4){0.f, 0.f, 0.f, 0.f}, 0, 0, 0);
#pragma unroll
            for (int i = 0; i < 4; ++i) bu[(quad * 4 + i) * S5_BU_LD + tile * 16 + col] = d[i];
        }
        __builtin_amdgcn_fence(__ATOMIC_RELEASE, "wavefront"); __builtin_amdgcn_wave_barrier(); __builtin_amdgcn_fence(__ATOMIC_ACQUIRE, "wavefront");
        for (int r = 0; r < 16; ++r) {
            float nr = 0.f, ni = 0.f;
            if (r < nrow) {
                if (SAMPLE) { const size_t si = ((size_t)(layer * NDEC + seq0 + r) * 16 + g) * 64 + lane; xr = p.in[5][si]; xi = p.in[6][si]; }
                const float br_ = bu[r * S5_BU_LD + lane], bi_ = bu[r * S5_BU_LD + 64 + lane];
                nr = ar * xr - ai * xi + br_; ni = ar * xi + ai * xr + bi_; xr = nr; xi = ni;
                if (SAMPLE) { const size_t so = ((size_t)(layer * NDEC + seq0 + r) * 16 + g) * 64 + lane; p.out[O_SS5R + so] = nr; p.out[O_SS5I + so] = ni; }
            }
            xb[r * S5_XB_LD + lane] = f2bf(nr); xb[r * S5_XB_LD + 64 + lane] = f2bf(ni);
        }
        __builtin_amdgcn_fence(__ATOMIC_RELEASE, "wavefront"); __builtin_amdgcn_wave_barrier(); __builtin_amdgcn_fence(__ATOMIC_ACQUIRE, "wavefront");
        f32x4 ya = (f32x4){0.f, 0.f, 0.f, 0.f};
#pragma unroll
        for (int kb = 0; kb < 4; ++kb) { const bf16x8 xf = *(const LAS bf16x8*)(xb + col * S5_XB_LD + kb * 32 + quad * 8); ya = __builtin_amdgcn_mfma_f32_16x16x32_bf16(xf, Cf[kb], ya, 0, 0, 0); }
#pragma unroll
        for (int i = 0; i < 4; ++i) { const int r = quad * 4 + i;
            if (r < nrow) { const size_t tok = (size_t)(tokbase + t0 + r); const float uu = bf2f(pm[tok * NPM + C_U + g * 16 + col]);
                const float y = ya[i] + dcoef * uu; const float ge = y / (1.0f + __expf(-1.5957691216f * (y + 0.044715f * y * y * y)));
                yg[tok * 256 + g * 16 + col] = f2bf(ge); } }
        __builtin_amdgcn_fence(__ATOMIC_RELEASE, "wavefront"); __builtin_amdgcn_wave_barrier(); __builtin_amdgcn_fence(__ATOMIC_ACQUIRE, "wavefront");
    }
    if (!SAMPLE) { const size_t so = ((size_t)(layer * NBATCH + seq0) * 16 + g) * 64 + lane; p.out[O_PS5R + so] = xr; p.out[O_PS5I + so] = xi; }
}

__device__ __forceinline__ void phase_mix(KPR p, int layer, LAS unsigned char* ldsb, int bid, int G) {
    LAS float* lds = (LAS float*)ldsb;
    const int wid = __builtin_amdgcn_readfirstlane(otid() >> 6);
    constexpr int NLONG = 208, NSHORT = 16 + 1536;
    for (int it = bid; it < NLONG; it += G) {
        if (it < 192) {
            const int mix = it >> 6, r = it & 63, b = r >> 3, hh = (r >> 1) & 3, half = r & 1;
            const size_t so = ((size_t)(layer * NBATCH + b) * 4 + hh) * 4096;
            if (mix == 0) mix_item<0>(p, layer, lds, b * SEQ, SEQ, hh, half * 32, 32, nullptr, p.out + O_PGDN + so, nullptr, p.out + O_PCONV + (size_t)(layer * NBATCH + b) * 2304);
            else if (mix == 1) mix_item<1>(p, layer, lds, b * SEQ, SEQ, hh, half * 32, 32, nullptr, p.out + O_PGLA + so, nullptr, nullptr);
            else mix_item<2>(p, layer, lds, b * SEQ, SEQ, hh, half * 32, 32, nullptr, p.out + O_PHG + so, nullptr, nullptr);
        } else {
            __syncthreads();
            const int j = (it - 192) * 8 + wid, b = j >> 4, g = j & 15;
            s5_wave_item<false>(p, layer, ldsb + wid * S5_WAVE_BYTES, g, b * SEQ, SEQ, b);
        }
    }
    const int w0 = (G >= 256) ? 192 : 0, nw = G - w0;
    if (bid >= w0) for (int j = bid - w0; j < NSHORT; j += nw) {
        if (j < 16) {
            __syncthreads();
            const int jj = j * 8 + wid, g = jj & 15, s0 = (jj >> 4) * 16;
            s5_wave_item<true>(p, layer, ldsb + wid * S5_WAVE_BYTES, g, MPROMPT + s0, 16, s0);
        } else {
            const int jj = j - 16, mix = jj >> 9, s = (jj & 511) >> 2, hh = jj & 3;
            const size_t so = ((size_t)(layer * NDEC + s) * 4 + hh) * 4096;
            if (mix == 0) mix_item<0>(p, layer, lds, MPROMPT + s, 1, hh, 0, 64, p.in[3] + so, p.out + O_SGDN + so, p.in[2] + (size_t)(layer * NDEC + s) * 2304, p.out + O_SCONV + (size_t)(layer * NDEC + s) * 2304);
            else if (mix == 1) mix_item<1>(p, layer, lds, MPROMPT + s, 1, hh, 0, 64, p.in[4] + so, p.out + O_SGLA + so, nullptr, nullptr);
            else mix_item<2>(p, layer, lds, MPROMPT + s, 1, hh, 0, 64, p.in[7] + so, p.out + O_SHG + so, nullptr, nullptr);
        }
    }
    __syncthreads();
}

__device__ __forceinline__ void phase_headnorm(KPR p, int layer, int bid, int G) {
    const int tid_ = otid(); const int wid = __builtin_amdgcn_readfirstlane(tid_ >> 6), lane = tid_ & 63;
    const bf16_t* pm = (const bf16_t*)(p.ws + OFF_PM); const bf16_t* oraw = (const bf16_t*)(p.ws + OFF_ORAW); bf16_t* br = (bf16_t*)(p.ws + OFF_BR);
    for (int j = bid * 8 + wid; j < MTOK * 3; j += G * 8) {
        const int tok = j / 3, mix = j - tok * 3;
        const int gcol = mix == 0 ? A_GATE : (mix == 1 ? B_GATE : D_GATE), slot = mix == 2 ? 3 : mix;
        const float* nw = (mix == 0 ? p.in[13] : (mix == 1 ? p.in[16] : p.in[27])) + layer * 256 + lane * 4;
        const u32x2 ow = *(const u32x2*)(oraw + (size_t)tok * 768 + mix * 256 + lane * 4);
        const u32x2 gw = *(const u32x2*)(pm + (size_t)tok * NPM + gcol + lane * 4);
        const float o0 = lo_bf(ow.x), o1 = hi_bf(ow.x), o2 = lo_bf(ow.y), o3 = hi_bf(ow.y);
        float ss = o0 * o0 + o1 * o1 + o2 * o2 + o3 * o3;
        ss += __shfl_xor(ss, 1); ss += __shfl_xor(ss, 2); ss += __shfl_xor(ss, 4); ss += __shfl_xor(ss, 8);
        const float rs = rsqrtf(ss * (1.0f / 64.0f) + EPS);
        const f32x4 w = *(const f32x4*)nw;
        u32x2 r; r.x = cvt_pk_bf16(o0 * rs * w[0] * siluf_(lo_bf(gw.x)), o1 * rs * w[1] * siluf_(hi_bf(gw.x)));
        r.y = cvt_pk_bf16(o2 * rs * w[2] * siluf_(lo_bf(gw.y)), o3 * rs * w[3] * siluf_(hi_bf(gw.y)));
        *(u32x2*)(br + (size_t)tok * 1024 + slot * 256 + lane * 4) = r;
    }
}

constexpr int PH_PER_LAYER = 9, N_PHASES = 4 * PH_PER_LAYER + 1;
__device__ __forceinline__ void run_phase(KPR p, int ph, LAS unsigned char* lds, int bid, int G) {
    unsigned char* ws = p.ws;
    if (ph == N_PHASES - 1) { phase_norm(p, p.in[34], 2, bid, G); return; }
    const int layer = ph / PH_PER_LAYER, s = ph - layer * PH_PER_LAYER;
    pg8::Sched S; pg8::Gemm g;
    switch (s) {
    case 0: phase_convert(p, layer, (LAS float*)lds, bid, G); phase_norm(p, p.in[8] + layer * 1024, layer == 0 ? 0 : 1, bid, G); break;
    case 1: { S.init(65, 30, 1, G, bid); g = pg8::Gemm{(const bf16_t*)(ws + OFF_XN), (const bf16_t*)(ws + OFF_WIN), 1024, 1024, 16, 0, 0};
              pg8::gemm_phase(lds, g, S, EpiIn{(bf16_t*)(ws + OFF_PM), (bf16_t*)(ws + OFF_GATES)}); } break;
    case 2: phase_mix(p, layer, lds, bid, G); break;
    case 3: { S.init(65, 2, 1, G, bid); g = pg8::Gemm{(const bf16_t*)(ws + OFF_YG), (const bf16_t*)(ws + OFF_WGLU), 256, 256, 4, 0, 0};
              pg8::gemm_phase(lds, g, S, EpiGlu{(bf16_t*)(ws + OFF_BR)}); phase_headnorm(p, layer, bid, G); } break;
    case 4: { S.init(65, 4, 4, G, bid); g = pg8::Gemm{(const bf16_t*)(ws + OFF_BR), (const bf16_t*)(ws + OFF_WBR), 1024, 256, 4, 256, (size_t)1024 * 256};
              pg8::gemm_phase(lds, g, S, EpiBr{(const bf16_t*)(ws + OFF_GATES), (bf16_t*)(ws + OFF_PM)}); } break;
    case 5: { S.init(65, 4, 1, G, bid); g = pg8::Gemm{(const bf16_t*)(ws + OFF_PM), (const bf16_t*)(ws + OFF_WOUT), 1024, 1024, 16, 0, 0};
              pg8::gemm_phase(lds, g, S, EpiRes{(float*)(ws + OFF_H)}); } break;
    case 6: phase_norm(p, p.in[30] + layer * 1024, 1, bid, G); break;
    case 7: { S.init(65, 22, 1, G, bid); g = pg8::Gemm{(const bf16_t*)(ws + OFF_XN), (const bf16_t*)(ws + OFF_WGU), 1024, 1024, 16, 0, 0};
              pg8::gemm_phase(lds, g, S, EpiGU{(bf16_t*)(ws + OFF_PM)}); } break;
    case 8: { S.init(65, 4, 1, G, bid); g = pg8::Gemm{(const bf16_t*)(ws + OFF_PM), (const bf16_t*)(ws + OFF_WDN), DFF, DFF, 44, 0, 0};
              pg8::gemm_phase(lds, g, S, EpiRes{(float*)(ws + OFF_H)}); } break;
    }
}

extern __shared__ __attribute__((aligned(16))) unsigned char dyn_smem[];
#if MULTI_LAUNCH
__global__ void __launch_bounds__(512) k_phase(KP parg, int ph) {
    KPR p = *(const CAS KP*)__builtin_amdgcn_kernarg_segment_ptr();
    run_phase(p, ph, (LAS unsigned char*)dyn_smem, blockIdx.x, gridDim.x);
}
#else
__device__ __forceinline__ void grid_bar(unsigned* bar, unsigned target) {
    asm volatile("s_waitcnt vmcnt(0)" ::: "memory");
    __syncthreads();
    if (otid() == 0) {
        __builtin_amdgcn_fence(__ATOMIC_RELEASE, "agent");
        asm volatile("s_waitcnt vmcnt(0)" ::: "memory");
        __hip_atomic_fetch_add(bar, 1u, __ATOMIC_RELAXED, __HIP_MEMORY_SCOPE_AGENT);
        while (__hip_atomic_load(bar, __ATOMIC_RELAXED, __HIP_MEMORY_SCOPE_AGENT) < target) __builtin_amdgcn_s_sleep(2);
    }
    __syncthreads();
    __builtin_amdgcn_fence(__ATOMIC_ACQUIRE, "agent");
    asm volatile("s_waitcnt vmcnt(0)" ::: "memory");
}
template <int PH> __device__ __forceinline__ void run_from(KPR p, cg::grid_group& grid) {
    const CAS KP* pp = &p; asm volatile("" : "+s"(pp));
    int bid = blockIdx.x, G = gridDim.x; asm volatile("" : "+s"(bid), "+s"(G));
    run_phase(*pp, PH, (LAS unsigned char*)dyn_smem, bid, G);
    if constexpr (PH + 1 < N_PHASES) {
        if constexpr (PH == 0) grid.sync();
        else grid_bar((unsigned*)(pp->ws + OFF_BAR), (unsigned)PH * (unsigned)G);
        run_from<PH + 1>(p, grid);
    }
}
__global__ void __launch_bounds__(512) k_mega(KP parg) {
    cg::grid_group grid = cg::this_grid();
    KPR p = *(const CAS KP*)__builtin_amdgcn_kernarg_segment_ptr();
    run_from<0>(p, grid);
}
#endif

extern "C" void kernel_launch(void* const* d_in, const int* in_sizes, int n_in, void* d_out, int out_size, void* d_ws, size_t ws_size, hipStream_t stream) {
    if (ws_size < WS_NEED || n_in < 35) { fprintf(stderr, "workspace too small: %zu < %zu\n", ws_size, (size_t)WS_NEED); return; }
    KP p{};
    for (int i = 0; i < 35; ++i) p.in[i] = (const float*)d_in[i];
    p.out = (float*)d_out; p.ws = (unsigned char*)d_ws;
    constexpr size_t kDynLds = pg8::STAGE_BYTES;
#if MULTI_LAUNCH
    static bool once = false;
    if (!once) { hipFuncSetAttribute((const void*)k_phase, hipFuncAttributeMaxDynamicSharedMemorySize, (int)kDynLds); once = true; }
    for (int ph = 0; ph < N_PHASES; ++ph) hipLaunchKernelGGL(k_phase, dim3(256), dim3(512), kDynLds, stream, p, ph);
#else
    static int grid_blocks = 0;
    if (!grid_blocks) {
        hipFuncSetAttribute((const void*)k_mega, hipFuncAttributeMaxDynamicSharedMemorySize, (int)kDynLds);
        int dev = 0, cus = 0, per_cu = 0;
        hipGetDevice(&dev);
        hipDeviceGetAttribute(&cus, hipDeviceAttributeMultiprocessorCount, dev);
        hipOccupancyMaxActiveBlocksPerMultiprocessor(&per_cu, k_mega, 512, kDynLds);
        if (per_cu < 1) per_cu = 1;
        grid_blocks = cus * per_cu; if (grid_blocks > 256) grid_blocks = 256;
    }
    hipMemsetAsync((unsigned char*)d_ws + OFF_BAR, 0, 256, stream);
    void* args[] = {&p};
    hipError_t e = hipLaunchCooperativeKernel((void*)k_mega, dim3(grid_blocks), dim3(512), args, kDynLds, stream);
    if (e != hipSuccess) fprintf(stderr, "cooperative launch failed: %s (grid %d)\n", hipGetErrorString(e), grid_blocks);
#endif
}
```

```cpp
#include <hip/hip_runtime.h>
#include <hip/hip_cooperative_groups.h>
#include <cstdio>
namespace cg = cooperative_groups;

#ifndef MULTI_LAUNCH
#define MULTI_LAUNCH 0
#endif

#define LAS __attribute__((address_space(3)))
typedef unsigned short bf16_t;
typedef short bf16x8 __attribute__((ext_vector_type(8)));
typedef float f32x4 __attribute__((ext_vector_type(4)));
typedef float f32x2 __attribute__((ext_vector_type(2)));
typedef unsigned u32x2 __attribute__((ext_vector_type(2)));
typedef unsigned u32x4 __attribute__((ext_vector_type(4)));

constexpr int DM = 1024, SEQ = 2048, NBATCH = 8, NDEC = 128;
constexpr int MPROMPT = NBATCH * SEQ;
constexpr int MTOK = MPROMPT + NDEC;
constexpr int MP = 16640;
constexpr int NPM = 3584, NGATE = 4096, NIN = 7448, DFF = 2816;
constexpr int A_QKV = 0, A_GATE = 768, B_Q = 1024, B_K = 1280, B_V = 1536, B_GATE = 1792, C_U = 2048, D_Q = 2304, D_F = 2560, D_I = 2816, D_GATE = 3072,
              A_ALPHA = 3328, A_BETA = 3332, B_GK = 3336;
constexpr float EPS = 1e-6f;

constexpr size_t SZ_WIN = (size_t)7680 * 1024 * 2, SZ_WGU = (size_t)5632 * 1024 * 2, SZ_WDN = (size_t)1024 * 2816 * 2, SZ_WOUT = (size_t)1024 * 1024 * 2,
                 SZ_WBR = (size_t)4096 * 256 * 2, SZ_WGLU = (size_t)512 * 256 * 2;
constexpr size_t OFF_WIN = 0, OFF_WGU = OFF_WIN + SZ_WIN, OFF_WDN = OFF_WGU + SZ_WGU, OFF_WOUT = OFF_WDN + SZ_WDN, OFF_WBR = OFF_WOUT + SZ_WOUT,
                 OFF_WGLU = OFF_WBR + SZ_WBR, OFF_H = OFF_WGLU + SZ_WGLU, OFF_XN = OFF_H + (size_t)MP * 1024 * 4, OFF_BR = OFF_XN + (size_t)MP * 1024 * 2,
                 OFF_PM = OFF_BR + (size_t)MP * 1024 * 2, OFF_GATES = OFF_PM + (size_t)MP * NPM * 2, OFF_ORAW = OFF_GATES + (size_t)MP * NGATE * 2,
                 OFF_YG = OFF_ORAW + (size_t)MP * 768 * 2, OFF_BAR = OFF_YG + (size_t)MP * 256 * 2, WS_NEED = OFF_BAR + 256;
constexpr size_t O_PCONV = 16908288, O_PGDN = 16982016, O_PGLA = 17506304, O_PS5R = 18030592, O_PS5I = 18063360, O_PHG = 18096128,
                 O_SCONV = 18620416, O_SGDN = 19800064, O_SGLA = 28188672, O_SS5R = 36577280, O_SS5I = 37101568, O_SHG = 37625856;

struct KP { const float* in[35]; float* out; unsigned char* ws; };
#define CAS __attribute__((address_space(4)))
typedef const CAS KP& KPR;

__device__ __forceinline__ int otid() { return threadIdx.x; }
__device__ __forceinline__ float bf2f(bf16_t b) { return __uint_as_float(((unsigned)b) << 16); }
__device__ __forceinline__ unsigned cvt_pk_bf16(float lo, float hi) { unsigned r; asm volatile("v_cvt_pk_bf16_f32 %0, %1, %2" : "=v"(r) : "v"(lo), "v"(hi)); return r; }
__device__ __forceinline__ bf16_t f2bf(float f) { return (bf16_t)(cvt_pk_bf16(f, 0.f) & 0xffffu); }
__device__ __forceinline__ float lo_bf(unsigned w) { return __uint_as_float(w << 16); }
__device__ __forceinline__ float hi_bf(unsigned w) { return __uint_as_float(w & 0xffff0000u); }
__device__ __forceinline__ float sigmoidf_(float x) { return 1.0f / (1.0f + __expf(-x)); }
__device__ __forceinline__ float siluf_(float x) { return x / (1.0f + __expf(-x)); }
__device__ __forceinline__ float wave_sum(float v) {
#pragma unroll
    for (int o = 32; o >= 1; o >>= 1) v += __shfl_xor(v, o);
    return v;
}
template <int CTRL> __device__ __forceinline__ float dpp_f(float v) { return __int_as_float(__builtin_amdgcn_update_dpp(0, __float_as_int(v), CTRL, 0xf, 0xf, true)); }
__device__ __forceinline__ float red16(float v) { v += dpp_f<0xB1>(v); v += dpp_f<0x4E>(v); v += dpp_f<0x141>(v); v += dpp_f<0x140>(v); return v; }
__device__ __forceinline__ float red8(float v) { v += dpp_f<0xB1>(v); v += dpp_f<0x4E>(v); v += dpp_f<0x141>(v); return v; }

namespace pg8 {
constexpr int BM = 256, BK = 64, HALF = 128, HTB = HALF * BK * 2, STAGE_BYTES = 8 * HTB, NXCD = 8, WGM = 8;
__device__ __forceinline__ int lds_byte(int r, int c) { const int st = (r >> 4) * 2 + (c >> 5), rr = r & 15, cc = c & 31, ob = rr * 64 + cc * 2; return st * 1024 + (ob ^ (((ob >> 9) & 1) << 5)); }
__device__ __forceinline__ void stage_rc(int b, int& R, int& C) { const int st = b / 1024, sb = b % 1024, swz = sb ^ (((sb >> 9) & 1) << 5); R = (st >> 1) * 16 + swz / 64; C = (st & 1) * 32 + (swz % 64) / 2; }

struct Unit { int pm, pn, kk; };
struct Gemm { const bf16_t* A; const bf16_t* Bt; int lda, ldb, nt; size_t a_kk, b_kk; };
struct Sched {
    int nM, nN, nKK, nwg, G, c;
    __device__ void init(int nM_, int nN_, int nKK_, int G_, int c_) { nM = nM_; nN = nN_; nKK = nKK_; nwg = nM * nN; G = G_; c = c_; }
    __device__ bool next(int i, Unit& u) const {
        const int it = i / nKK; u.kk = i - it * nKK;
        const long L = (long)it * G + c; if (L >= nwg) return false;
        int wgid = (int)L; { const int q = nwg / NXCD, r = nwg % NXCD, xcd = wgid % NXCD, off = wgid / NXCD; wgid = (xcd < r ? xcd * (q + 1) : r * (q + 1) + (xcd - r) * q) + off; }
        const int nig = WGM * nN, gid = wgid / nig, fm = gid * WGM, gsz = (nM - fm) < WGM ? (nM - fm) : WGM;
        u.pm = fm + ((wgid % nig) % gsz); u.pn = (wgid % nig) / gsz; return true;
    }
};

template <class Epi>
__device__ __forceinline__ void gemm_phase(LAS unsigned char* lds, const Gemm g, const Sched& S, const Epi& E) {
    const int tid = otid(), wid = __builtin_amdgcn_readfirstlane(tid >> 6), lane = tid & 63, wr = wid >> 2, wc = wid & 3, fr = lane & 15, fq = lane >> 4;
    int nt = g.nt; asm volatile("" : "+s"(nt));
    unsigned voffA[2], voffB[2];
#pragma unroll
    for (int i = 0; i < 2; ++i) { int R, C; stage_rc(tid * 16 + i * 8192, R, C); voffA[i] = (unsigned)(R * g.lda + C) * 2u; voffB[i] = (unsigned)(R * g.ldb + C) * 2u; }
    const size_t kstep = (size_t)(BK * 2);
    const size_t hstepA = (size_t)HALF * g.lda * 2, hstepB = (size_t)HALF * g.ldb * 2;
    const size_t tstepA = 2 * hstepA, tstepB = 2 * hstepB;
    const unsigned ldsw = (unsigned)wid * 1024u;
    const int aoff = lds_byte(wr * 64 + fr, fq * 8), boff = lds_byte(wc * 32 + fr, fq * 8);
#define PG8_SA(b, h) (((b) * 2 + (h)) * HTB)
#define PG8_SB(b, h) ((4 + (b) * 2 + (h)) * HTB)
#define PG8_STAGE(bufoff, gbase, voff) do { _Pragma("unroll") for (int _i = 0; _i < 2; ++_i) \
        __builtin_amdgcn_global_load_lds((const unsigned*)((const char*)(gbase) + (voff)[_i]), (LAS unsigned*)(lds + (bufoff) + ldsw + _i * 8192), 16, 0, 0); } while (0)
#define PG8_LDA(dst, b, h) do { _Pragma("unroll") for (int m = 0; m < 4; ++m) _Pragma("unroll") for (int k = 0; k < 2; ++k) dst[m][k] = *(const LAS bf16x8*)(lds + PG8_SA(b, h) + aoff + m * 2048 + k * 1024); } while (0)
#define PG8_LDB(dst, b, h) do { _Pragma("unroll") for (int n = 0; n < 2; ++n) _Pragma("unroll") for (int k = 0; k < 2; ++k) dst[n][k] = *(const LAS bf16x8*)(lds + PG8_SB(b, h) + boff + n * 2048 + k * 1024); } while (0)
#define PG8_MMA(ai, bj, At, Bt) do { __builtin_amdgcn_s_setprio(1); _Pragma("unroll") for (int m = 0; m < 4; ++m) _Pragma("unroll") for (int n = 0; n < 2; ++n) _Pragma("unroll") for (int k = 0; k < 2; ++k) \
        acc[ai][bj][m][n] = __builtin_amdgcn_mfma_f32_16x16x32_bf16(Bt[n][k], At[m][k], acc[ai][bj][m][n], 0, 0, 0); __builtin_amdgcn_s_setprio(0); } while (0)
#define PG8_WAIT_V(n) asm volatile("s_waitcnt vmcnt(" #n ")" ::: "memory")
#define PG8_WAIT_L(n) asm volatile("s_waitcnt lgkmcnt(" #n ")" ::: "memory")
#define PG8_BAR __builtin_amdgcn_s_barrier()
#define PG8_SCHED __builtin_amdgcn_sched_barrier(0)
    Unit cur, nxt; int ui = 0;
    if (!S.next(0, cur)) return;
    f32x4 acc[2][2][4][2];
#pragma unroll
    for (int a = 0; a < 2; ++a)
#pragma unroll
        for (int b = 0; b < 2; ++b)
#pragma unroll
            for (int m = 0; m < 4; ++m)
#pragma unroll
                for (int n = 0; n < 2; ++n) acc[a][b][m][n] = (f32x4){0.f, 0.f, 0.f, 0.f};
    bf16x8 At[4][2], B0[2][2], B1[2][2];
    const char* cA = (const char*)(g.A + (size_t)cur.kk * g.a_kk) + (size_t)cur.pm * tstepA; const char* cB = (const char*)(g.Bt + (size_t)cur.kk * g.b_kk) + (size_t)cur.pn * tstepB;
    PG8_STAGE(PG8_SB(0, 0), cB, voffB); PG8_STAGE(PG8_SA(0, 0), cA, voffA); PG8_STAGE(PG8_SB(0, 1), cB + hstepB, voffB); PG8_STAGE(PG8_SA(0, 1), cA + hstepA, voffA);
    if (wr == 1) PG8_BAR;
    PG8_WAIT_V(4); PG8_BAR;
    PG8_STAGE(PG8_SB(1, 0), cB + kstep, voffB); PG8_STAGE(PG8_SA(1, 0), cA + kstep, voffA); PG8_STAGE(PG8_SB(1, 1), cB + hstepB + kstep, voffB);
    PG8_WAIT_V(6); PG8_BAR;
    for (;;) {
        const bool has_next = S.next(ui + 1, nxt);
        const char* nA = has_next ? (const char*)(g.A + (size_t)nxt.kk * g.a_kk) + (size_t)nxt.pm * tstepA : cA;
        const char* nB = has_next ? (const char*)(g.Bt + (size_t)nxt.kk * g.b_kk) + (size_t)nxt.pn * tstepB : cB;
        for (int t = 0; t < nt; t += 2) {
            const bool last = (t == nt - 2);
            const char* a1 = cA + (size_t)(t + 1) * kstep;
            const char* a2 = last ? nA : cA + (size_t)(t + 2) * kstep; const char* b2 = last ? nB : cB + (size_t)(t + 2) * kstep;
            const char* a3 = a2 + kstep; const char* b3 = b2 + kstep;
            PG8_LDB(B0, 0, 0); PG8_SCHED; PG8_LDA(At, 0, 0); PG8_STAGE(PG8_SA(1, 1), a1 + hstepA, voffA);
            PG8_WAIT_L(8); PG8_BAR; PG8_WAIT_L(0); PG8_MMA(0, 0, At, B0); PG8_BAR; PG8_SCHED;
            PG8_LDB(B1, 0, 1); PG8_STAGE(PG8_SB(0, 0), b2, voffB);
            PG8_BAR; PG8_WAIT_L(0); PG8_MMA(0, 1, At, B1); PG8_BAR;
            PG8_LDA(At, 0, 1); PG8_STAGE(PG8_SA(0, 0), a2, voffA);
            PG8_BAR; PG8_WAIT_L(0); PG8_MMA(1, 0, At, B0); PG8_BAR; PG8_SCHED;
            PG8_STAGE(PG8_SB(0, 1), b2 + hstepB, voffB);
            PG8_WAIT_V(6); PG8_BAR; PG8_MMA(1, 1, At, B1); PG8_BAR;
            PG8_LDB(B0, 1, 0); PG8_SCHED; PG8_LDA(At, 1, 0); PG8_STAGE(PG8_SA(0, 1), a2 + hstepA, voffA);
            PG8_WAIT_L(8); PG8_BAR; PG8_WAIT_L(0); PG8_MMA(0, 0, At, B0); PG8_BAR; PG8_SCHED;
            PG8_LDB(B1, 1, 1); PG8_STAGE(PG8_SB(1, 0), b3, voffB);
            PG8_BAR; PG8_WAIT_L(0); PG8_MMA(0, 1, At, B1); PG8_BAR;
            PG8_LDA(At, 1, 1); PG8_STAGE(PG8_SA(1, 0), a3, voffA);
            PG8_BAR; PG8_WAIT_L(0); PG8_MMA(1, 0, At, B0); PG8_BAR; PG8_SCHED;
            PG8_STAGE(PG8_SB(1, 1), b3 + hstepB, voffB);
            PG8_WAIT_V(6); PG8_BAR; PG8_MMA(1, 1, At, B1); PG8_BAR;
        }
        E(acc, cur, wr, wc, fr, fq);
        if (!has_next) break;
#pragma unroll
        for (int a = 0; a < 2; ++a)
#pragma unroll
            for (int b = 0; b < 2; ++b)
#pragma unroll
                for (int m = 0; m < 4; ++m)
#pragma unroll
                    for (int n = 0; n < 2; ++n) acc[a][b][m][n] = (f32x4){0.f, 0.f, 0.f, 0.f};
        cur = nxt; cA = nA; cB = nB; ++ui;
    }
    PG8_WAIT_V(0);
    if (wr == 0) PG8_BAR;
    PG8_BAR;
    __builtin_amdgcn_s_waitcnt(0);
#undef PG8_SA
#undef PG8_SB
#undef PG8_STAGE
#undef PG8_LDA
#undef PG8_LDB
#undef PG8_MMA
#undef PG8_WAIT_V
#undef PG8_WAIT_L
#undef PG8_BAR
#undef PG8_SCHED
}
}
using pg8::Unit;

#define EPI_LOOP_BEGIN _Pragma("unroll") for (int ai = 0; ai < 2; ++ai) _Pragma("unroll") for (int m = 0; m < 4; ++m) { const size_t row = (size_t)(u.pm * 256 + ai * 128 + wr * 64 + m * 16 + fr); \
        _Pragma("unroll") for (int bj = 0; bj < 2; ++bj) {
#define EPI_LOOP_END } }
struct EpiIn {
    bf16_t* pm; bf16_t* gates;
    __device__ __forceinline__ void operator()(const f32x4 (&acc)[2][2][4][2], const Unit& u, int wr, int wc, int fr, int fq) const {
        const bool main_ = u.pn < 14;
        EPI_LOOP_BEGIN
#pragma unroll
            for (int n = 0; n < 2; ++n) { const int col = u.pn * 256 + bj * 128 + wc * 32 + n * 16 + fq * 4; f32x4 v = acc[ai][bj][m][n]; u32x2 w;
                if (main_) { w.x = cvt_pk_bf16(v[0], v[1]); w.y = cvt_pk_bf16(v[2], v[3]); *(u32x2*)(pm + row * NPM + col) = w; }
                else { w.x = cvt_pk_bf16(sigmoidf_(v[0]), sigmoidf_(v[1])); w.y = cvt_pk_bf16(sigmoidf_(v[2]), sigmoidf_(v[3])); *(u32x2*)(gates + row * NGATE + (col - NPM)) = w; } }
        EPI_LOOP_END
    }
};
struct EpiGlu {
    bf16_t* br;
    __device__ __forceinline__ void operator()(const f32x4 (&acc)[2][2][4][2], const Unit& u, int wr, int wc, int fr, int fq) const {
        EPI_LOOP_BEGIN
            const int j = u.pn * 128 + bj * 64 + wc * 16 + fq * 4; const f32x4 a = acc[ai][bj][m][0], b = acc[ai][bj][m][1]; u32x2 w;
            w.x = cvt_pk_bf16(a[0] * sigmoidf_(b[0]), a[1] * sigmoidf_(b[1])); w.y = cvt_pk_bf16(a[2] * sigmoidf_(b[2]), a[3] * sigmoidf_(b[3]));
            *(u32x2*)(br + row * 1024 + 512 + j) = w;
        EPI_LOOP_END
    }
};
struct EpiGU {
    bf16_t* a;
    __device__ __forceinline__ void operator()(const f32x4 (&acc)[2][2][4][2], const Unit& u, int wr, int wc, int fr, int fq) const {
        EPI_LOOP_BEGIN
            const int j = u.pn * 128 + bj * 64 + wc * 16 + fq * 4; const f32x4 g = acc[ai][bj][m][0], b = acc[ai][bj][m][1]; u32x2 w;
            w.x = cvt_pk_bf16(siluf_(g[0]) * b[0], siluf_(g[1]) * b[1]); w.y = cvt_pk_bf16(siluf_(g[2]) * b[2], siluf_(g[3]) * b[3]);
            *(u32x2*)(a + row * DFF + j) = w;
        EPI_LOOP_END
    }
};
struct EpiBr {
    const bf16_t* gates; bf16_t* mm;
    __device__ __forceinline__ void operator()(const f32x4 (&acc)[2][2][4][2], const Unit& u, int wr, int wc, int fr, int fq) const {
        EPI_LOOP_BEGIN
#pragma unroll
            for (int n = 0; n < 2; ++n) { const int col = u.pn * 256 + bj * 128 + wc * 32 + n * 16 + fq * 4; const f32x4 v = acc[ai][bj][m][n];
                const u32x2 gw = *(const u32x2*)(gates + row * NGATE + u.kk * 1024 + col);
                float r0 = lo_bf(gw.x) * v[0], r1 = hi_bf(gw.x) * v[1], r2 = lo_bf(gw.y) * v[2], r3 = hi_bf(gw.y) * v[3];
                if (u.kk > 0) { const u32x2 pw = *(const u32x2*)(mm + row * 1024 + col); r0 += lo_bf(pw.x); r1 += hi_bf(pw.x); r2 += lo_bf(pw.y); r3 += hi_bf(pw.y); }
                u32x2 w; w.x = cvt_pk_bf16(r0, r1); w.y = cvt_pk_bf16(r2, r3); *(u32x2*)(mm + row * 1024 + col) = w; }
        EPI_LOOP_END
    }
};
struct EpiRes {
    float* h;
    __device__ __forceinline__ void operator()(const f32x4 (&acc)[2][2][4][2], const Unit& u, int wr, int wc, int fr, int fq) const {
        EPI_LOOP_BEGIN
#pragma unroll
            for (int n = 0; n < 2; ++n) { const int col = u.pn * 256 + bj * 128 + wc * 32 + n * 16 + fq * 4; float* ptr = h + row * 1024 + col;
                const f32x4 o = *(const f32x4*)ptr; *(f32x4*)ptr = o + acc[ai][bj][m][n]; }
        EPI_LOOP_END
    }
};

__device__ __forceinline__ int win_src_col(int n) {
    if (n < 768) return n;
    if (n < 1024) return 776 + (n - 768);
    if (n < 1792) return 1032 + (n - 1024);
    if (n < 2048) return 1816 + (n - 1792);
    if (n < 2304) return 2072 + (n - 2048);
    if (n < 3072) return 2328 + (n - 2304);
    if (n < 3328) return 3096 + (n - 3072);
    if (n < 3336) return 768 + (n - 3328);
    if (n < 3352) return 1800 + (n - 3336);
    if (n < 3584) return -1;
    return 3352 + (n - 3584);
}
__device__ __forceinline__ void phase_convert(KPR p, int layer, LAS float* tile, int bid, int G) {
    const int tid = otid(), tn = tid & 63, tk = __builtin_amdgcn_readfirstlane(tid >> 6);
    constexpr int T0 = 120 * 16, T1 = T0 + 88 * 16, T2 = T1 + 16 * 44, T3 = T2 + 16 * 16, T4 = T3 + 64 * 4, T5 = T4 + 8 * 4;
    for (int j = bid; j < T5; j += G) {
        int n0, k0, K, ld; bf16_t* dst; const float* cp = nullptr;
        if (j < T0) { const int q = j; n0 = (q >> 4) * 64; k0 = (q & 15) * 64; K = 1024; ld = NIN; dst = (bf16_t*)(p.ws + OFF_WIN);
            const int sc = win_src_col(n0 + tn); if (sc >= 0) cp = p.in[9] + (size_t)layer * 1024 * NIN + sc; }
        else if (j < T1) { const int q = j - T0; n0 = (q >> 4) * 64; k0 = (q & 15) * 64; K = 1024; ld = DFF; dst = (bf16_t*)(p.ws + OFF_WGU);
            const int n = n0 + tn, g32 = n >> 5, w = n & 31, jj = g32 * 16 + (w & 15); cp = (w < 16 ? p.in[31] : p.in[32]) + (size_t)layer * 1024 * DFF + jj; }
        else if (j < T2) { const int q = j - T1; n0 = (q / 44) * 64; k0 = (q % 44) * 64; K = DFF; ld = 1024; dst = (bf16_t*)(p.ws + OFF_WDN);
            cp = p.in[33] + (size_t)layer * DFF * 1024 + (n0 + tn); }
        else if (j < T3) { const int q = j - T2; n0 = (q >> 4) * 64; k0 = (q & 15) * 64; K = 1024; ld = 1024; dst = (bf16_t*)(p.ws + OFF_WOUT);
            cp = p.in[29] + (size_t)layer * 1024 * 1024 + (n0 + tn); }
        else if (j < T4) { const int q = j - T3; n0 = (q >> 2) * 64; k0 = (q & 3) * 64; K = 256; ld = 1024; dst = (bf16_t*)(p.ws + OFF_WBR);
            const int n = n0 + tn, kk = n >> 10, d = n & 1023; cp = p.in[28] + ((size_t)(layer * 4 + kk) * 256) * 1024 + d; }
        else { const int q = j - T4; n0 = (q >> 2) * 64; k0 = (q & 3) * 64; K = 256; ld = 512; dst = (bf16_t*)(p.ws + OFF_WGLU);
            const int n = n0 + tn, g32 = n >> 5, w = n & 31, jj = g32 * 16 + (w & 15); cp = p.in[25] + (size_t)layer * 256 * 512 + (w < 16 ? jj : 256 + jj); }
        __syncthreads();
#pragma unroll
        for (int e = 0; e < 8; ++e) { const int k = k0 + tk * 8 + e; tile[tn * 65 + tk * 8 + e] = cp ? cp[(size_t)k * ld] : 0.f; }
        __syncthreads();
        { const int n = tid >> 3, ks = tid & 7; const LAS float* tp = tile + n * 65 + ks * 8; u32x4 w;
          w.x = cvt_pk_bf16(tp[0], tp[1]); w.y = cvt_pk_bf16(tp[2], tp[3]); w.z = cvt_pk_bf16(tp[4], tp[5]); w.w = cvt_pk_bf16(tp[6], tp[7]);
          *(u32x4*)(dst + (size_t)(n0 + n) * K + k0 + ks * 8) = w; }
    }
    __syncthreads();
}

__device__ __forceinline__ void phase_norm(KPR p, const float* w, int mode, int bid, int G) {
    const int tid_ = otid(); const int wid = __builtin_amdgcn_readfirstlane(tid_ >> 6), lane = tid_ & 63;
    float* h = (float*)(p.ws + OFF_H); bf16_t* xn = (bf16_t*)(p.ws + OFF_XN);
    f32x4 wv[4];
#pragma unroll
    for (int i = 0; i < 4; ++i) wv[i] = *(const f32x4*)(w + i * 256 + lane * 4);
    for (int r = bid * 8 + wid; r < MTOK; r += G * 8) {
        const float* src = (mode == 0) ? (r < MPROMPT ? p.in[0] + (size_t)r * 1024 : p.in[1] + (size_t)(r - MPROMPT) * 1024) : h + (size_t)r * 1024;
        f32x4 v[4]; float ss = 0.f;
#pragma unroll
        for (int i = 0; i < 4; ++i) { v[i] = *(const f32x4*)(src + i * 256 + lane * 4); ss += v[i][0] * v[i][0] + v[i][1] * v[i][1] + v[i][2] * v[i][2] + v[i][3] * v[i][3]; }
        ss = wave_sum(ss);
        const float rs = rsqrtf(ss * (1.0f / 1024.0f) + EPS);
#pragma unroll
        for (int i = 0; i < 4; ++i) {
            const f32x4 y = v[i] * rs * wv[i];
            if (mode == 2) *(f32x4*)(p.out + (size_t)r * 1024 + i * 256 + lane * 4) = y;
            else { u32x2 o; o.x = cvt_pk_bf16(y[0], y[1]); o.y = cvt_pk_bf16(y[2], y[3]); *(u32x2*)(xn + (size_t)r * 1024 + i * 256 + lane * 4) = o;
                   if (mode == 0) *(f32x4*)(h + (size_t)r * 1024 + i * 256 + lane * 4) = v[i]; }
        }
    }
}

constexpr int TCH = 32;
constexpr int MIXBUF_FLOATS = 4 * TCH * 64 + TCH * 4;
template <int MIX>
__device__ __forceinline__ void mix_item(KPR p, int layer, LAS float* lds, int tokbase, int L, int h, int col0, int ncols,
                         const float* s_in, float* s_out, const float* conv_in, float* conv_out) {
    const int tid = otid(), wid = __builtin_amdgcn_readfirstlane(tid >> 6), lane = tid & 63;
    const int nscan = ncols * 8; const bool is_scan = wid < (nscan >> 6);
    const int ksl = lane & 7, cl = wid * 8 + (lane >> 3), col = col0 + cl;
    const bf16_t* pm = (const bf16_t*)(p.ws + OFF_PM);
    bf16_t* oraw = (bf16_t*)(p.ws + OFF_ORAW);
    __syncthreads();
    float S[8];
#pragma unroll
    for (int i = 0; i < 8; ++i) S[i] = (is_scan && s_in) ? s_in[(ksl * 8 + i) * 64 + col] : 0.f;
    const int tl = lane >> 4, d4 = (lane & 15) * 4, hd4 = h * 64 + d4;
    f32x4 cw[3][4]; float c_a = 0.f, c_dt = 0.f; f32x4 gkw[16]; f32x4 gkb = (f32x4){0.f, 0.f, 0.f, 0.f}, lb4 = (f32x4){0.f, 0.f, 0.f, 0.f};
    if (MIX == 0) {
        const float* cwp = p.in[10] + (size_t)layer * 4 * 768;
#pragma unroll
        for (int s = 0; s < 3; ++s)
#pragma unroll
            for (int j = 0; j < 4; ++j) cw[s][j] = *(const f32x4*)(cwp + j * 768 + s * 256 + hd4);
        c_a = -__expf(p.in[11][layer * 4 + h]); c_dt = p.in[12][layer * 4 + h];
        if (conv_out && col0 == 0 && h == 0) {
            for (int idx = tid; idx < 3 * 768; idx += 512) { const int i = idx / 768, c = idx - i * 768, ti = L - 3 + i;
                conv_out[idx] = ti >= 0 ? bf2f(pm[(size_t)(tokbase + ti) * NPM + A_QKV + c]) : (conv_in ? conv_in[(3 + ti) * 768 + c] : 0.f); }
        }
    } else if (MIX == 1) {
#pragma unroll
        for (int r = 0; r < 16; ++r) gkw[r] = *(const f32x4*)(p.in[14] + ((size_t)layer * 16 + r) * 256 + hd4);
        gkb = *(const f32x4*)(p.in[15] + layer * 256 + hd4);
    } else {
        const float* lg = p.in[26] + hd4; const f32x4 a0 = *(const f32x4*)lg, a1 = *(const f32x4*)(lg + 256), a2 = *(const f32x4*)(lg + 512), a3 = *(const f32x4*)(lg + 768);
#pragma unroll
        for (int e = 0; e < 4; ++e) {
            const float mx = fmaxf(fmaxf(a0[e], a1[e]), fmaxf(a2[e], a3[e])); const float l0 = __expf(a0[e] - mx), l1 = __expf(a1[e] - mx), l2 = __expf(a2[e] - mx), l3 = __expf(a3[e] - mx);
            const float inv = 1.0f / (l0 + l1 + l2 + l3);
            lb4[e] = (layer == 0) ? 0.f : (layer == 1) ? l1 * inv : (layer == 2) ? (l1 + l2) * inv : (l1 + l2 + l3) * inv;
        }
    }
    const int nch = (L + TCH - 1) / TCH;
    auto prep = [&](int c, int pw, int npw) {
        LAS float* kb = lds + (c & 1) * MIXBUF_FLOATS; LAS float* qb = kb + TCH * 64; LAS float* fb = qb + TCH * 64; LAS float* vb = fb + TCH * 64; LAS float* sc = vb + TCH * 64;
#pragma unroll
        for (int pass = 0; pass < 2; ++pass) {
            const int tt0 = (pass * npw + pw) * 4;
            if (tt0 < TCH) {
                const int tt = tt0 + tl, t = c * TCH + tt;
                if (t < L) {
                    const bf16_t* row = pm + (size_t)(tokbase + t) * NPM;
                    if (MIX == 0) {
                        f32x4 y[3];
#pragma unroll
                        for (int s = 0; s < 3; ++s) { f32x4 a = (f32x4){0.f, 0.f, 0.f, 0.f};
#pragma unroll
                            for (int j = 0; j < 4; ++j) { const int ti = t - 3 + j; f32x4 xv = (f32x4){0.f, 0.f, 0.f, 0.f};
                                if (ti >= 0) { const u32x2 w = *(const u32x2*)(pm + (size_t)(tokbase + ti) * NPM + A_QKV + s * 256 + hd4); xv = (f32x4){lo_bf(w.x), hi_bf(w.x), lo_bf(w.y), hi_bf(w.y)}; }
                                else if (conv_in) xv = *(const f32x4*)(conv_in + (3 + ti) * 768 + s * 256 + hd4);
                                a += xv * cw[s][j]; }
                            y[s] = (f32x4){siluf_(a[0]), siluf_(a[1]), siluf_(a[2]), siluf_(a[3])}; }
                        const float qq = red16(y[0][0] * y[0][0] + y[0][1] * y[0][1] + y[0][2] * y[0][2] + y[0][3] * y[0][3]);
                        const float kk2 = red16(y[1][0] * y[1][0] + y[1][1] * y[1][1] + y[1][2] * y[1][2] + y[1][3] * y[1][3]);
                        const f32x4 qn = y[0] * (rsqrtf(qq + EPS) * 0.125f), kn = y[1] * rsqrtf(kk2 + EPS);
                        const float kq = red16(qn[0] * kn[0] + qn[1] * kn[1] + qn[2] * kn[2] + qn[3] * kn[3]);
                        *(LAS f32x4*)(kb + tt * 64 + d4) = kn; *(LAS f32x4*)(qb + tt * 64 + d4) = qn; *(LAS f32x4*)(vb + tt * 64 + d4) = y[2];
                        if ((lane & 15) == 0) { const float al = bf2f(row[A_ALPHA + h]) + c_dt; const float sp = fmaxf(al, 0.f) + __logf(1.0f + __expf(-fabsf(al)));
                            *(LAS f32x4*)(sc + tt * 4) = (f32x4){__expf(c_a * sp), sigmoidf_(bf2f(row[A_BETA + h])), kq, 0.f}; }
                    } else if (MIX == 1) {
                        const u32x4 g0 = *(const u32x4*)(row + B_GK), g1 = *(const u32x4*)(row + B_GK + 8);
                        const u32x2 wq = *(const u32x2*)(row + B_Q + hd4), wk = *(const u32x2*)(row + B_K + hd4), wv = *(const u32x2*)(row + B_V + hd4);
                        f32x4 z = gkb;
                        z += lo_bf(g0.x) * gkw[0] + hi_bf(g0.x) * gkw[1] + lo_bf(g0.y) * gkw[2] + hi_bf(g0.y) * gkw[3] + lo_bf(g0.z) * gkw[4] + hi_bf(g0.z) * gkw[5] + lo_bf(g0.w) * gkw[6] + hi_bf(g0.w) * gkw[7];
                        z += lo_bf(g1.x) * gkw[8] + hi_bf(g1.x) * gkw[9] + lo_bf(g1.y) * gkw[10] + hi_bf(g1.y) * gkw[11] + lo_bf(g1.z) * gkw[12] + hi_bf(g1.z) * gkw[13] + lo_bf(g1.w) * gkw[14] + hi_bf(g1.w) * gkw[15];
                        f32x4 f;
#pragma unroll
                        for (int e = 0; e < 4; ++e) { const float sp = fmaxf(-z[e], 0.f) + __logf(1.0f + __expf(-fabsf(z[e]))); f[e] = __expf(-sp * (1.0f / 16.0f)); }
                        *(LAS f32x4*)(fb + tt * 64 + d4) = f;
                        *(LAS f32x4*)(qb + tt * 64 + d4) = (f32x4){lo_bf(wq.x), hi_bf(wq.x), lo_bf(wq.y), hi_bf(wq.y)} * 0.125f;
                        *(LAS f32x4*)(kb + tt * 64 + d4) = (f32x4){lo_bf(wk.x), hi_bf(wk.x), lo_bf(wk.y), hi_bf(wk.y)};
                        *(LAS f32x4*)(vb + tt * 64 + d4) = (f32x4){lo_bf(wv.x), hi_bf(wv.x), lo_bf(wv.y), hi_bf(wv.y)};
                    } else {
                        const u32x2 wq = *(const u32x2*)(row + D_Q + hd4), wf = *(const u32x2*)(row + D_F + hd4), wv = *(const u32x2*)(row + D_I + hd4);
                        const f32x4 xq = (f32x4){lo_bf(wq.x), hi_bf(wq.x), lo_bf(wq.y), hi_bf(wq.y)}, xf = (f32x4){lo_bf(wf.x), hi_bf(wf.x), lo_bf(wf.y), hi_bf(wf.y)};
                        f32x4 f, k, q;
#pragma unroll
                        for (int e = 0; e < 4; ++e) { const float sg = sigmoidf_(xf[e]); f[e] = lb4[e] + (1.0f - lb4[e]) * sg; k[e] = (1.0f - lb4[e]) * (1.0f - sg); q[e] = siluf_(xq[e]) * 0.125f; }
                        *(LAS f32x4*)(fb + tt * 64 + d4) = f; *(LAS f32x4*)(kb + tt * 64 + d4) = k; *(LAS f32x4*)(qb + tt * 64 + d4) = q;
                        *(LAS f32x4*)(vb + tt * 64 + d4) = (f32x4){lo_bf(wv.x), hi_bf(wv.x), lo_bf(wv.y), hi_bf(wv.y)};
                    }
                }
            }
        }
    };
    prep(0, wid, 8);
    __syncthreads();
    for (int c = 0; c < nch; ++c) {
        if (is_scan) {
            const LAS float* kb = lds + (c & 1) * MIXBUF_FLOATS; const LAS float* qb = kb + TCH * 64; const LAS float* fb = qb + TCH * 64; const LAS float* vb = fb + TCH * 64; const LAS float* sc = vb + TCH * 64;
            const int ntok = (L - c * TCH) < TCH ? (L - c * TCH) : TCH;
            bf16_t* op = oraw + (size_t)(tokbase + c * TCH) * 768 + MIX * 256 + h * 64 + col;
            const LAS float* kp = kb + ksl * 8; const LAS float* qp = qb + ksl * 8; const LAS float* fp = fb + ksl * 8; const LAS float* vp = vb + col;
            f32x4 k0 = *(const LAS f32x4*)kp, k1 = *(const LAS f32x4*)(kp + 4), q0 = *(const LAS f32x4*)qp, q1 = *(const LAS f32x4*)(qp + 4);
            f32x4 f0 = (f32x4){0.f, 0.f, 0.f, 0.f}, f1 = f0, scv = f0;
            if (MIX == 0) scv = *(const LAS f32x4*)sc; else { f0 = *(const LAS f32x4*)fp; f1 = *(const LAS f32x4*)(fp + 4); }
            float v = vp[0];
#pragma unroll 2
            for (int tt = 0; tt < ntok; ++tt) {
                const int tn = (tt + 1 < TCH) ? tt + 1 : tt;
                const f32x4 nk0 = *(const LAS f32x4*)(kp + tn * 64), nk1 = *(const LAS f32x4*)(kp + tn * 64 + 4), nq0 = *(const LAS f32x4*)(qp + tn * 64), nq1 = *(const LAS f32x4*)(qp + tn * 64 + 4);
                f32x4 nf0 = f0, nf1 = f1, nsc = scv;
                if (MIX == 0) nsc = *(const LAS f32x4*)(sc + tn * 4); else { nf0 = *(const LAS f32x4*)(fp + tn * 64); nf1 = *(const LAS f32x4*)(fp + tn * 64 + 4); }
                const float nv = vp[tn * 64];
                float o;
                if (MIX == 0) {
                    const float eg = scv[0], beta = scv[1], kq = scv[2];
                    float dk = (S[0] * k0[0] + S[1] * k0[1]) + (S[2] * k0[2] + S[3] * k0[3]) + (S[4] * k1[0] + S[5] * k1[1]) + (S[6] * k1[2] + S[7] * k1[3]);
                    float dq = (S[0] * q0[0] + S[1] * q0[1]) + (S[2] * q0[2] + S[3] * q0[3]) + (S[4] * q1[0] + S[5] * q1[1]) + (S[6] * q1[2] + S[7] * q1[3]);
                    dk = red8(dk); dq = red8(dq);
                    const float delta = beta * (v - eg * dk);
#pragma unroll
                    for (int i = 0; i < 4; ++i) { S[i] = eg * S[i] + k0[i] * delta; S[4 + i] = eg * S[4 + i] + k1[i] * delta; }
                    o = eg * dq + kq * delta;
                } else {
#pragma unroll
                    for (int i = 0; i < 4; ++i) { S[i] = f0[i] * S[i] + k0[i] * v; S[4 + i] = f1[i] * S[4 + i] + k1[i] * v; }
                    float dq = (S[0] * q0[0] + S[1] * q0[1]) + (S[2] * q0[2] + S[3] * q0[3]) + (S[4] * q1[0] + S[5] * q1[1]) + (S[6] * q1[2] + S[7] * q1[3]);
                    o = red8(dq);
                }
                if (ksl == 0) op[(size_t)tt * 768] = f2bf(o);
                k0 = nk0; k1 = nk1; q0 = nq0; q1 = nq1; f0 = nf0; f1 = nf1; scv = nsc; v = nv;
            }
        } else if (c + 1 < nch) prep(c + 1, wid - (nscan >> 6), 8 - (nscan >> 6));
        __syncthreads();
    }
    if (is_scan) {
#pragma unroll
        for (int i = 0; i < 8; ++i) s_out[(ksl * 8 + i) * 64 + col] = S[i];
    }
}

constexpr int S5_BU_LD = 132, S5_XB_LD = 136, S5_WAVE_BYTES = 16 * S5_BU_LD * 4 + 16 * S5_XB_LD * 2;
template <bool SAMPLE>
__device__ __forceinline__ void s5_wave_item(KPR p, int layer, LAS unsigned char* wl, int g, int tokbase, int L, int seq0) {
    const int lane = otid() & 63, col = lane & 15, quad = lane >> 4;
    const bf16_t* pm = (const bf16_t*)(p.ws + OFF_PM); bf16_t* yg = (bf16_t*)(p.ws + OFF_YG);
    LAS float* bu = (LAS float*)wl; LAS bf16_t* xb = (LAS bf16_t*)(wl + 16 * S5_BU_LD * 4);
    const int lg = layer * 16 + g;
    float ar, ai, zr, zi;
    { const float lr = fminf(p.in[17][lg * 64 + lane], -1e-4f), li = p.in[18][lg * 64 + lane], dt = __expf(p.in[24][lg]);
      const float mag = __expf(lr * dt); float rev = li * dt * 0.15915494309f; rev -= rintf(rev);
      const float sn = __builtin_amdgcn_sinf(rev), cs = __builtin_amdgcn_cosf(rev); ar = mag * cs; ai = mag * sn;
      const float den = lr * lr + li * li; zr = ((ar - 1.0f) * lr + ai * li) / den; zi = (ai * lr - (ar - 1.0f) * li) / den; }
    bf16x8 Bf[8], Cf[4];
#pragma unroll
    for (int tt = 0; tt < 4; ++tt) {
        const int pp = tt * 16 + col; const float zr2 = __shfl(zr, pp), zi2 = __shfl(zi, pp);
        float bre[8], bim[8];
#pragma unroll
        for (int j = 0; j < 8; ++j) { bre[j] = 0.f; bim[j] = 0.f; }
        if (quad < 2) {
            const float* br_ = p.in[19] + ((size_t)lg * 64 + pp) * 16 + quad * 8; const float* bi_ = p.in[20] + ((size_t)lg * 64 + pp) * 16 + quad * 8;
#pragma unroll
            for (int j = 0; j < 8; ++j) { const float r = br_[j], i = bi_[j]; bre[j] = zr2 * r - zi2 * i; bim[j] = zr2 * i + zi2 * r; }
        }
        u32x4 wr_, wi_;
        wr_.x = cvt_pk_bf16(bre[0], bre[1]); wr_.y = cvt_pk_bf16(bre[2], bre[3]); wr_.z = cvt_pk_bf16(bre[4], bre[5]); wr_.w = cvt_pk_bf16(bre[6], bre[7]);
        wi_.x = cvt_pk_bf16(bim[0], bim[1]); wi_.y = cvt_pk_bf16(bim[2], bim[3]); wi_.z = cvt_pk_bf16(bim[4], bim[5]); wi_.w = cvt_pk_bf16(bim[6], bim[7]);
        Bf[tt] = __builtin_bit_cast(bf16x8, wr_); Bf[4 + tt] = __builtin_bit_cast(bf16x8, wi_);
    }
#pragma unroll
    for (int kb = 0; kb < 4; ++kb) {
        const int k0 = (kb & 1) * 32 + quad * 8; const float sgn = kb < 2 ? 1.0f : -1.0f;
        const float* cp = (kb < 2 ? p.in[21] : p.in[22]) + ((size_t)lg * 16 + col) * 64 + k0;
        u32x4 w; w.x = cvt_pk_bf16(sgn * cp[0], sgn * cp[1]); w.y = cvt_pk_bf16(sgn * cp[2], sgn * cp[3]); w.z = cvt_pk_bf16(sgn * cp[4], sgn * cp[5]); w.w = cvt_pk_bf16(sgn * cp[6], sgn * cp[7]);
        Cf[kb] = __builtin_bit_cast(bf16x8, w);
    }
    const float dcoef = p.in[23][layer * 256 + g * 16 + col];
    float xr = 0.f, xi = 0.f;
    const int nch = SAMPLE ? 1 : (L + 15) / 16;
    u32x4 awn = (u32x4){0u, 0u, 0u, 0u}; bf16_t un[4] = {0, 0, 0, 0};
    auto pf = [&](int cc) {
        const int t0 = cc * 16; const int nrow = SAMPLE ? 16 : ((L - t0) < 16 ? (L - t0) : 16);
        awn = (u32x4){0u, 0u, 0u, 0u};
        if (quad < 2 && col < nrow) awn = *(const u32x4*)(pm + (size_t)(tokbase + t0 + col) * NPM + C_U + g * 16 + quad * 8);
#pragma unroll
        for (int i = 0; i < 4; ++i) { const int r = quad * 4 + i; un[i] = (r < nrow) ? pm[(size_t)(tokbase + t0 + r) * NPM + C_U + g * 16 + col] : (bf16_t)0; }
    };
    pf(0);
    for (int c = 0; c < nch; ++c) {
        const int t0 = c * 16; const int nrow = SAMPLE ? 16 : ((L - t0) < 16 ? (L - t0) : 16);
        const u32x4 aw = awn; bf16_t uc[4];
#pragma unroll
        for (int i = 0; i < 4; ++i) uc[i] = un[i];
        if (c + 1 < nch) pf(c + 1);
        const bf16x8 af = __builtin_bit_cast(bf16x8, aw);
#pragma unroll
        for (int tile = 0; tile < 8; ++tile) {
            const f32x4 d = __builtin_amdgcn_mfma_f32_16x16x32_bf16(af, Bf[tile], (f32x4){0.f, 0.f, 0.f, 0.f}, 0, 0, 0);
#pragma unroll
            for (int i = 0; i < 4; ++i) bu[(quad * 4 + i) * S5_BU_LD + tile * 16 + col] = d[i];
        }
        __builtin_amdgcn_fence(__ATOMIC_RELEASE, "wavefront"); __builtin_amdgcn_wave_barrier(); __builtin_amdgcn_fence(__ATOMIC_ACQUIRE, "wavefront");
        for (int r = 0; r < 16; ++r) {
            float nr = 0.f, ni = 0.f;
            if (r < nrow) {
                if (SAMPLE) { const size_t si = ((size_t)(layer * NDEC + seq0 + r) * 16 + g) * 64 + lane; xr = p.in[5][si]; xi = p.in[6][si]; }
                const float br_ = bu[r * S5_BU_LD + lane], bi_ = bu[r * S5_BU_LD + 64 + lane];
                nr = ar * xr - ai * xi + br_; ni = ar * xi + ai * xr + bi_; xr = nr; xi = ni;
                if (SAMPLE) { const size_t so = ((size_t)(layer * NDEC + seq0 + r) * 16 + g) * 64 + lane; p.out[O_SS5R + so] = nr; p.out[O_SS5I + so] = ni; }
            }
            xb[r * S5_XB_LD + lane] = f2bf(nr); xb[r * S5_XB_LD + 64 + lane] = f2bf(ni);
        }
        __builtin_amdgcn_fence(__ATOMIC_RELEASE, "wavefront"); __builtin_amdgcn_wave_barrier(); __builtin_amdgcn_fence(__ATOMIC_ACQUIRE, "wavefront");
        f32x4 ya = (f32x4){0.f, 0.f, 0.f, 0.f};
#pragma unroll
        for (int kb = 0; kb < 4; ++kb) { const bf16x8 xf = *(const LAS bf16x8*)(xb + col * S5_XB_LD + kb * 32 + quad * 8); ya = __builtin_amdgcn_mfma_f32_16x16x32_bf16(xf, Cf[kb], ya, 0, 0, 0); }
#pragma unroll
        for (int i = 0; i < 4; ++i) { const int r = quad * 4 + i;
            if (r < nrow) { const size_t tok = (size_t)(tokbase + t0 + r); const float uu = bf2f(uc[i]);
                const float y = ya[i] + dcoef * uu; const float ge = y / (1.0f + __expf(-1.5957691216f * (y + 0.044715f * y * y * y)));
                yg[tok * 256 + g * 16 + col] = f2bf(ge); } }
        __builtin_amdgcn_fence(__ATOMIC_RELEASE, "wavefront"); __builtin_amdgcn_wave_barrier(); __builtin_amdgcn_fence(__ATOMIC_ACQUIRE, "wavefront");
    }
    if (!SAMPLE) { const size_t so = ((size_t)(layer * NBATCH + seq0) * 16 + g) * 64 + lane; p.out[O_PS5R + so] = xr; p.out[O_PS5I + so] = xi; }
}

__device__ __forceinline__ void phase_mix(KPR p, int layer, LAS unsigned char* ldsb, int bid, int G) {
    LAS float* lds = (LAS float*)ldsb;
    const int wid = __builtin_amdgcn_readfirstlane(otid() >> 6);
    constexpr int NLONG = 208, NSHORT = 16 + 1536;
    for (int it = bid; it < NLONG; it += G) {
        if (it < 192) {
            const int mix = it >> 6, r = it & 63, b = r >> 3, hh = (r >> 1) & 3, half = r & 1;
            const size_t so = ((size_t)(layer * NBATCH + b) * 4 + hh) * 4096;
            if (mix == 0) mix_item<0>(p, layer, lds, b * SEQ, SEQ, hh, half * 32, 32, nullptr, p.out + O_PGDN + so, nullptr, p.out + O_PCONV + (size_t)(layer * NBATCH + b) * 2304);
            else if (mix == 1) mix_item<1>(p, layer, lds, b * SEQ, SEQ, hh, half * 32, 32, nullptr, p.out + O_PGLA + so, nullptr, nullptr);
            else mix_item<2>(p, layer, lds, b * SEQ, SEQ, hh, half * 32, 32, nullptr, p.out + O_PHG + so, nullptr, nullptr);
        } else {
            __syncthreads();
            const int j = (it - 192) * 8 + wid, b = j >> 4, g = j & 15;
            s5_wave_item<false>(p, layer, ldsb + wid * S5_WAVE_BYTES, g, b * SEQ, SEQ, b);
        }
    }
    const int w0 = (G >= 256) ? 192 : 0, nw = G - w0;
    if (bid >= w0) for (int j = bid - w0; j < NSHORT; j += nw) {
        if (j < 16) {
            __syncthreads();
            const int jj = j * 8 + wid, g = jj & 15, s0 = (jj >> 4) * 16;
            s5_wave_item<true>(p, layer, ldsb + wid * S5_WAVE_BYTES, g, MPROMPT + s0, 16, s0);
        } else {
            const int jj = j - 16, mix = jj >> 9, s = (jj & 511) >> 2, hh = jj & 3;
            const size_t so = ((size_t)(layer * NDEC + s) * 4 + hh) * 4096;
            if (mix == 0) mix_item<0>(p, layer, lds, MPROMPT + s, 1, hh, 0, 64, p.in[3] + so, p.out + O_SGDN + so, p.in[2] + (size_t)(layer * NDEC + s) * 2304, p.out + O_SCONV + (size_t)(layer * NDEC + s) * 2304);
            else if (mix == 1) mix_item<1>(p, layer, lds, MPROMPT + s, 1, hh, 0, 64, p.in[4] + so, p.out + O_SGLA + so, nullptr, nullptr);
            else mix_item<2>(p, layer, lds, MPROMPT + s, 1, hh, 0, 64, p.in[7] + so, p.out + O_SHG + so, nullptr, nullptr);
        }
    }
    __syncthreads();
}

__device__ __forceinline__ void phase_headnorm(KPR p, int layer, int bid, int G) {
    const int tid_ = otid(); const int wid = __builtin_amdgcn_readfirstlane(tid_ >> 6), lane = tid_ & 63;
    const bf16_t* pm = (const bf16_t*)(p.ws + OFF_PM); const bf16_t* oraw = (const bf16_t*)(p.ws + OFF_ORAW); bf16_t* br = (bf16_t*)(p.ws + OFF_BR);
    for (int j = bid * 8 + wid; j < MTOK * 3; j += G * 8) {
        const int tok = j / 3, mix = j - tok * 3;
        const int gcol = mix == 0 ? A_GATE : (mix == 1 ? B_GATE : D_GATE), slot = mix == 2 ? 3 : mix;
        const float* nw = (mix == 0 ? p.in[13] : (mix == 1 ? p.in[16] : p.in[27])) + layer * 256 + lane * 4;
        const u32x2 ow = *(const u32x2*)(oraw + (size_t)tok * 768 + mix * 256 + lane * 4);
        const u32x2 gw = *(const u32x2*)(pm + (size_t)tok * NPM + gcol + lane * 4);
        const float o0 = lo_bf(ow.x), o1 = hi_bf(ow.x), o2 = lo_bf(ow.y), o3 = hi_bf(ow.y);
        float ss = o0 * o0 + o1 * o1 + o2 * o2 + o3 * o3;
        ss += __shfl_xor(ss, 1); ss += __shfl_xor(ss, 2); ss += __shfl_xor(ss, 4); ss += __shfl_xor(ss, 8);
        const float rs = rsqrtf(ss * (1.0f / 64.0f) + EPS);
        const f32x4 w = *(const f32x4*)nw;
        u32x2 r; r.x = cvt_pk_bf16(o0 * rs * w[0] * siluf_(lo_bf(gw.x)), o1 * rs * w[1] * siluf_(hi_bf(gw.x)));
        r.y = cvt_pk_bf16(o2 * rs * w[2] * siluf_(lo_bf(gw.y)), o3 * rs * w[3] * siluf_(hi_bf(gw.y)));
        *(u32x2*)(br + (size_t)tok * 1024 + slot * 256 + lane * 4) = r;
    }
}

constexpr int PH_PER_LAYER = 9, N_PHASES = 4 * PH_PER_LAYER + 1;
__device__ __forceinline__ void run_phase(KPR p, int ph, LAS unsigned char* lds, int bid, int G) {
    unsigned char* ws = p.ws;
    if (ph == N_PHASES - 1) { phase_norm(p, p.in[34], 2, bid, G); return; }
    const int layer = ph / PH_PER_LAYER, s = ph - layer * PH_PER_LAYER;
    pg8::Sched S; pg8::Gemm g;
    switch (s) {
    case 0: phase_convert(p, layer, (LAS float*)lds, bid, G); phase_norm(p, p.in[8] + layer * 1024, layer == 0 ? 0 : 1, bid, G); break;
    case 1: { S.init(65, 30, 1, G, bid); g = pg8::Gemm{(const bf16_t*)(ws + OFF_XN), (const bf16_t*)(ws + OFF_WIN), 1024, 1024, 16, 0, 0};
              pg8::gemm_phase(lds, g, S, EpiIn{(bf16_t*)(ws + OFF_PM), (bf16_t*)(ws + OFF_GATES)}); } break;
    case 2: phase_mix(p, layer, lds, bid, G); break;
    case 3: { S.init(65, 2, 1, G, bid); g = pg8::Gemm{(const bf16_t*)(ws + OFF_YG), (const bf16_t*)(ws + OFF_WGLU), 256, 256, 4, 0, 0};
              pg8::gemm_phase(lds, g, S, EpiGlu{(bf16_t*)(ws + OFF_BR)}); phase_headnorm(p, layer, bid, G); } break;
    case 4: { S.init(65, 4, 4, G, bid); g = pg8::Gemm{(const bf16_t*)(ws + OFF_BR), (const bf16_t*)(ws + OFF_WBR), 1024, 256, 4, 256, (size_t)1024 * 256};
              pg8::gemm_phase(lds, g, S, EpiBr{(const bf16_t*)(ws + OFF_GATES), (bf16_t*)(ws + OFF_PM)}); } break;
    case 5: { S.init(65, 4, 1, G, bid); g = pg8::Gemm{(const bf16_t*)(ws + OFF_PM), (const bf16_t*)(ws + OFF_WOUT), 1024, 1024, 16, 0, 0};
              pg8::gemm_phase(lds, g, S, EpiRes{(float*)(ws + OFF_H)}); } break;
    case 6: phase_norm(p, p.in[30] + layer * 1024, 1, bid, G); break;
    case 7: { S.init(65, 22, 1, G, bid); g = pg8::Gemm{(const bf16_t*)(ws + OFF_XN), (const bf16_t*)(ws + OFF_WGU), 1024, 1024, 16, 0, 0};
              pg8::gemm_phase(lds, g, S, EpiGU{(bf16_t*)(ws + OFF_PM)}); } break;
    case 8: { S.init(65, 4, 1, G, bid); g = pg8::Gemm{(const bf16_t*)(ws + OFF_PM), (const bf16_t*)(ws + OFF_WDN), DFF, DFF, 44, 0, 0};
              pg8::gemm_phase(lds, g, S, EpiRes{(float*)(ws + OFF_H)}); } break;
    }
}

extern __shared__ __attribute__((aligned(16))) unsigned char dyn_smem[];
#if MULTI_LAUNCH
__global__ void __launch_bounds__(512) k_phase(KP parg, int ph) {
    KPR p = *(const CAS KP*)__builtin_amdgcn_kernarg_segment_ptr();
    run_phase(p, ph, (LAS unsigned char*)dyn_smem, blockIdx.x, gridDim.x);
}
#else
__device__ __forceinline__ void grid_bar(unsigned* bar, unsigned target) {
    asm volatile("s_waitcnt vmcnt(0)" ::: "memory");
    __syncthreads();
    if (otid() == 0) {
        __builtin_amdgcn_fence(__ATOMIC_RELEASE, "agent");
        asm volatile("s_waitcnt vmcnt(0)" ::: "memory");
        __hip_atomic_fetch_add(bar, 1u, __ATOMIC_RELAXED, __HIP_MEMORY_SCOPE_AGENT);
        while (__hip_atomic_load(bar, __ATOMIC_RELAXED, __HIP_MEMORY_SCOPE_AGENT) < target) __builtin_amdgcn_s_sleep(2);
    }
    __syncthreads();
    __builtin_amdgcn_fence(__ATOMIC_ACQUIRE, "agent");
    asm volatile("s_waitcnt vmcnt(0)" ::: "memory");
}
template <int PH> __device__ __forceinline__ void run_from(KPR p, cg::grid_group& grid) {
    const CAS KP* pp = &p; asm volatile("" : "+s"(pp));
    int bid = blockIdx.x, G = gridDim.x; asm volatile("" : "+s"(bid), "+s"(G));
    run_phase(*pp, PH, (LAS unsigned char*)dyn_smem, bid, G);
    if constexpr (PH + 1 < N_PHASES) {
        if constexpr (PH == 0) grid.sync();
        else grid_bar((unsigned*)(pp->ws + OFF_BAR), (unsigned)PH * (unsigned)G);
        run_from<PH + 1>(p, grid);
    }
}
__global__ void __launch_bounds__(512) k_mega(KP parg) {
    cg::grid_group grid = cg::this_grid();
    KPR p = *(const CAS KP*)__builtin_amdgcn_kernarg_segment_ptr();
    run_from<0>(p, grid);
}
#endif

extern "C" void kernel_launch(void* const* d_in, const int* in_sizes, int n_in, void* d_out, int out_size, void* d_ws, size_t ws_size, hipStream_t stream) {
    if (ws_size < WS_NEED || n_in < 35) { fprintf(stderr, "workspace too small: %zu < %zu\n", ws_size, (size_t)WS_NEED); return; }
    KP p{};
    for (int i = 0; i < 35; ++i) p.in[i] = (const float*)d_in[i];
    p.out = (float*)d_out; p.ws = (unsigned char*)d_ws;
    constexpr size_t kDynLds = pg8::STAGE_BYTES;
#if MULTI_LAUNCH
    static bool once = false;
    if (!once) { hipFuncSetAttribute((const void*)k_phase, hipFuncAttributeMaxDynamicSharedMemorySize, (int)kDynLds); once = true; }
    for (int ph = 0; ph < N_PHASES; ++ph) hipLaunchKernelGGL(k_phase, dim3(256), dim3(512), kDynLds, stream, p, ph);
#else
    static int grid_blocks = 0;
    if (!grid_blocks) {
        hipFuncSetAttribute((const void*)k_mega, hipFuncAttributeMaxDynamicSharedMemorySize, (int)kDynLds);
        int dev = 0, cus = 0, per_cu = 0;
        hipGetDevice(&dev);
        hipDeviceGetAttribute(&cus, hipDeviceAttributeMultiprocessorCount, dev);
        hipOccupancyMaxActiveBlocksPerMultiprocessor(&per_cu, k_mega, 512, kDynLds);
        if (per_cu < 1) per_cu = 1;
        grid_blocks = cus * per_cu; if (grid_blocks > 256) grid_blocks = 256;
    }
    hipMemsetAsync((unsigned char*)d_ws + OFF_BAR, 0, 256, stream);
    void* args[] = {&p};
    hipError_t e = hipLaunchCooperativeKernel((void*)k_mega, dim3(grid_blocks), dim3(512), args, kDynLds, stream);
    if (e != hipSuccess) fprintf(stderr, "cooperative launch failed: %s (grid %d)\n", hipGetErrorString(e), grid_blocks);
#endif
}
```

```cpp
#include <hip/hip_runtime.h>
#include <hip/hip_cooperative_groups.h>
#include <cstdio>
namespace cg = cooperative_groups;

#ifndef MULTI_LAUNCH
#define MULTI_LAUNCH 0
#endif

#define LAS __attribute__((address_space(3)))
typedef unsigned short bf16_t;
typedef short bf16x8 __attribute__((ext_vector_type(8)));
typedef float f32x4 __attribute__((ext_vector_type(4)));
typedef float f32x2 __attribute__((ext_vector_type(2)));
typedef unsigned u32x2 __attribute__((ext_vector_type(2)));
typedef unsigned u32x4 __attribute__((ext_vector_type(4)));

constexpr int DM = 1024, SEQ = 2048, NBATCH = 8, NDEC = 128;
constexpr int MPROMPT = NBATCH * SEQ;
constexpr int MTOK = MPROMPT + NDEC;
constexpr int MP = 16640;
constexpr int NPM = 3584, NGATE = 4096, NIN = 7448, DFF = 2816;
constexpr int A_QKV = 0, A_GATE = 768, B_Q = 1024, B_K = 1280, B_V = 1536, B_GATE = 1792, C_U = 2048, D_Q = 2304, D_F = 2560, D_I = 2816, D_GATE = 3072,
              A_ALPHA = 3328, A_BETA = 3332, B_GK = 3336;
constexpr float EPS = 1e-6f;

constexpr size_t SZ_WIN = (size_t)7680 * 1024 * 2, SZ_WGU = (size_t)5632 * 1024 * 2, SZ_WDN = (size_t)1024 * 2816 * 2, SZ_WOUT = (size_t)1024 * 1024 * 2,
                 SZ_WBR = (size_t)4096 * 256 * 2, SZ_WGLU = (size_t)512 * 256 * 2;
constexpr size_t OFF_WIN = 0, OFF_WGU = OFF_WIN + SZ_WIN, OFF_WDN = OFF_WGU + SZ_WGU, OFF_WOUT = OFF_WDN + SZ_WDN, OFF_WBR = OFF_WOUT + SZ_WOUT,
                 OFF_WGLU = OFF_WBR + SZ_WBR, OFF_H = OFF_WGLU + SZ_WGLU, OFF_XN = OFF_H + (size_t)MP * 1024 * 4, OFF_BR = OFF_XN + (size_t)MP * 1024 * 2,
                 OFF_PM = OFF_BR + (size_t)MP * 1024 * 2, OFF_GATES = OFF_PM + (size_t)MP * NPM * 2, OFF_ORAW = OFF_GATES + (size_t)MP * NGATE * 2,
                 OFF_YG = OFF_ORAW + (size_t)MP * 768 * 2, OFF_BAR = OFF_YG + (size_t)MP * 256 * 2, WS_NEED = OFF_BAR + 4096;
constexpr size_t O_PCONV = 16908288, O_PGDN = 16982016, O_PGLA = 17506304, O_PS5R = 18030592, O_PS5I = 18063360, O_PHG = 18096128,
                 O_SCONV = 18620416, O_SGDN = 19800064, O_SGLA = 28188672, O_SS5R = 36577280, O_SS5I = 37101568, O_SHG = 37625856;

struct KP { const float* in[35]; float* out; unsigned char* ws; };
#define CAS __attribute__((address_space(4)))
typedef const CAS KP& KPR;

__device__ __forceinline__ int otid() { return threadIdx.x; }
__device__ __forceinline__ float bf2f(bf16_t b) { return __uint_as_float(((unsigned)b) << 16); }
typedef __bf16 bf16x2_t __attribute__((ext_vector_type(2)));
__device__ __forceinline__ unsigned cvt_pk_bf16(float lo, float hi) { const f32x2 f = {lo, hi}; const bf16x2_t v = __builtin_convertvector(f, bf16x2_t); return __builtin_bit_cast(unsigned, v); }
__device__ __forceinline__ bf16_t f2bf(float f) { return (bf16_t)(cvt_pk_bf16(f, 0.f) & 0xffffu); }
__device__ __forceinline__ float lo_bf(unsigned w) { return __uint_as_float(w << 16); }
__device__ __forceinline__ float hi_bf(unsigned w) { return __uint_as_float(w & 0xffff0000u); }
__device__ __forceinline__ float sigmoidf_(float x) { return __builtin_amdgcn_rcpf(1.0f + __expf(-x)); }
__device__ __forceinline__ float siluf_(float x) { return x * __builtin_amdgcn_rcpf(1.0f + __expf(-x)); }
__device__ __forceinline__ float wave_sum(float v) {
#pragma unroll
    for (int o = 32; o >= 1; o >>= 1) v += __shfl_xor(v, o);
    return v;
}
template <int CTRL> __device__ __forceinline__ float dpp_f(float v) { return __int_as_float(__builtin_amdgcn_update_dpp(0, __float_as_int(v), CTRL, 0xf, 0xf, true)); }
__device__ __forceinline__ float red16(float v) { v += dpp_f<0xB1>(v); v += dpp_f<0x4E>(v); v += dpp_f<0x141>(v); v += dpp_f<0x140>(v); return v; }
__device__ __forceinline__ float red8(float v) { v += dpp_f<0xB1>(v); v += dpp_f<0x4E>(v); v += dpp_f<0x141>(v); return v; }

namespace pg8 {
constexpr int BM = 256, BK = 64, HALF = 128, HTB = HALF * BK * 2, STAGE_BYTES = 8 * HTB, NXCD = 8, WGM = 8;
__device__ __forceinline__ int lds_byte(int r, int c) { const int st = (r >> 4) * 2 + (c >> 5), rr = r & 15, cc = c & 31, ob = rr * 64 + cc * 2; return st * 1024 + (ob ^ (((ob >> 9) & 1) << 5)); }
__device__ __forceinline__ void stage_rc(int b, int& R, int& C) { const int st = b / 1024, sb = b % 1024, swz = sb ^ (((sb >> 9) & 1) << 5); R = (st >> 1) * 16 + swz / 64; C = (st & 1) * 32 + (swz % 64) / 2; }

struct Unit { int pm, pn, kk; };
struct Gemm { const bf16_t* A; const bf16_t* Bt; int lda, ldb, nt; size_t a_kk, b_kk; };
struct Sched {
    int nM, nN, nKK, nwg, G, c;
    __device__ void init(int nM_, int nN_, int nKK_, int G_, int c_) { nM = nM_; nN = nN_; nKK = nKK_; nwg = nM * nN; G = G_; c = c_; }
    __device__ bool next(int i, Unit& u) const {
        const int it = i / nKK; u.kk = i - it * nKK;
        const long L = (long)it * G + c; if (L >= nwg) return false;
        int wgid = (int)L; { const int q = nwg / NXCD, r = nwg % NXCD, xcd = wgid % NXCD, off = wgid / NXCD; wgid = (xcd < r ? xcd * (q + 1) : r * (q + 1) + (xcd - r) * q) + off; }
        const int nig = WGM * nN, gid = wgid / nig, fm = gid * WGM, gsz = (nM - fm) < WGM ? (nM - fm) : WGM;
        u.pm = fm + ((wgid % nig) % gsz); u.pn = (wgid % nig) / gsz; return true;
    }
};

template <class Epi>
__device__ __forceinline__ void gemm_phase(LAS unsigned char* lds, const Gemm g, const Sched& S, const Epi& E) {
    const int tid = otid(), wid = __builtin_amdgcn_readfirstlane(tid >> 6), lane = tid & 63, wr = wid >> 2, wc = wid & 3, fr = lane & 15, fq = lane >> 4;
    int nt = g.nt; asm volatile("" : "+s"(nt));
    unsigned voffA[2], voffB[2];
#pragma unroll
    for (int i = 0; i < 2; ++i) { int R, C; stage_rc(tid * 16 + i * 8192, R, C); voffA[i] = (unsigned)(R * g.lda + C) * 2u; voffB[i] = (unsigned)(R * g.ldb + C) * 2u; }
    const size_t kstep = (size_t)(BK * 2);
    const size_t hstepA = (size_t)HALF * g.lda * 2, hstepB = (size_t)HALF * g.ldb * 2;
    const size_t tstepA = 2 * hstepA, tstepB = 2 * hstepB;
    const unsigned ldsw = (unsigned)wid * 1024u;
    const int aoff = lds_byte(wr * 64 + fr, fq * 8), boff = lds_byte(wc * 32 + fr, fq * 8);
#define PG8_SA(b, h) (((b) * 2 + (h)) * HTB)
#define PG8_SB(b, h) ((4 + (b) * 2 + (h)) * HTB)
#define PG8_STAGE(bufoff, gbase, voff) do { _Pragma("unroll") for (int _i = 0; _i < 2; ++_i) \
        __builtin_amdgcn_global_load_lds((const unsigned*)((const char*)(gbase) + (voff)[_i]), (LAS unsigned*)(lds + (bufoff) + ldsw + _i * 8192), 16, 0, 0); } while (0)
#define PG8_LDA(dst, b, h) do { _Pragma("unroll") for (int m = 0; m < 4; ++m) _Pragma("unroll") for (int k = 0; k < 2; ++k) dst[m][k] = *(const LAS bf16x8*)(lds + PG8_SA(b, h) + aoff + m * 2048 + k * 1024); } while (0)
#define PG8_LDB(dst, b, h) do { _Pragma("unroll") for (int n = 0; n < 2; ++n) _Pragma("unroll") for (int k = 0; k < 2; ++k) dst[n][k] = *(const LAS bf16x8*)(lds + PG8_SB(b, h) + boff + n * 2048 + k * 1024); } while (0)
#define PG8_MMA(ai, bj, At, Bt) do { __builtin_amdgcn_s_setprio(1); _Pragma("unroll") for (int m = 0; m < 4; ++m) _Pragma("unroll") for (int n = 0; n < 2; ++n) _Pragma("unroll") for (int k = 0; k < 2; ++k) \
        acc[ai][bj][m][n] = __builtin_amdgcn_mfma_f32_16x16x32_bf16(Bt[n][k], At[m][k], acc[ai][bj][m][n], 0, 0, 0); __builtin_amdgcn_s_setprio(0); } while (0)
#define PG8_WAIT_V(n) asm volatile("s_waitcnt vmcnt(" #n ")" ::: "memory")
#define PG8_WAIT_L(n) asm volatile("s_waitcnt lgkmcnt(" #n ")" ::: "memory")
#define PG8_BAR __builtin_amdgcn_s_barrier()
#define PG8_SCHED __builtin_amdgcn_sched_barrier(0)
    Unit cur, nxt; int ui = 0;
    if (!S.next(0, cur)) return;
    f32x4 acc[2][2][4][2];
#pragma unroll
    for (int a = 0; a < 2; ++a)
#pragma unroll
        for (int b = 0; b < 2; ++b)
#pragma unroll
            for (int m = 0; m < 4; ++m)
#pragma unroll
                for (int n = 0; n < 2; ++n) acc[a][b][m][n] = (f32x4){0.f, 0.f, 0.f, 0.f};
    bf16x8 At[4][2], B0[2][2], B1[2][2];
    const char* cA = (const char*)(g.A + (size_t)cur.kk * g.a_kk) + (size_t)cur.pm * tstepA; const char* cB = (const char*)(g.Bt + (size_t)cur.kk * g.b_kk) + (size_t)cur.pn * tstepB;
    PG8_STAGE(PG8_SB(0, 0), cB, voffB); PG8_STAGE(PG8_SA(0, 0), cA, voffA); PG8_STAGE(PG8_SB(0, 1), cB + hstepB, voffB); PG8_STAGE(PG8_SA(0, 1), cA + hstepA, voffA);
    if (wr == 1) PG8_BAR;
    PG8_WAIT_V(4); PG8_BAR;
    PG8_STAGE(PG8_SB(1, 0), cB + kstep, voffB); PG8_STAGE(PG8_SA(1, 0), cA + kstep, voffA); PG8_STAGE(PG8_SB(1, 1), cB + hstepB + kstep, voffB);
    PG8_WAIT_V(6); PG8_BAR;
    for (;;) {
        const bool has_next = S.next(ui + 1, nxt);
        const char* nA = has_next ? (const char*)(g.A + (size_t)nxt.kk * g.a_kk) + (size_t)nxt.pm * tstepA : cA;
        const char* nB = has_next ? (const char*)(g.Bt + (size_t)nxt.kk * g.b_kk) + (size_t)nxt.pn * tstepB : cB;
        for (int t = 0; t < nt; t += 2) {
            const bool last = (t == nt - 2);
            const char* a1 = cA + (size_t)(t + 1) * kstep;
            const char* a2 = last ? nA : cA + (size_t)(t + 2) * kstep; const char* b2 = last ? nB : cB + (size_t)(t + 2) * kstep;
            const char* a3 = a2 + kstep; const char* b3 = b2 + kstep;
            PG8_LDB(B0, 0, 0); PG8_SCHED; PG8_LDA(At, 0, 0); PG8_STAGE(PG8_SA(1, 1), a1 + hstepA, voffA);
            PG8_WAIT_L(8); PG8_BAR; PG8_WAIT_L(0); PG8_MMA(0, 0, At, B0); PG8_BAR; PG8_SCHED;
            PG8_LDB(B1, 0, 1); PG8_STAGE(PG8_SB(0, 0), b2, voffB);
            PG8_BAR; PG8_WAIT_L(0); PG8_MMA(0, 1, At, B1); PG8_BAR;
            PG8_LDA(At, 0, 1); PG8_STAGE(PG8_SA(0, 0), a2, voffA);
            PG8_BAR; PG8_WAIT_L(0); PG8_MMA(1, 0, At, B0); PG8_BAR; PG8_SCHED;
            PG8_STAGE(PG8_SB(0, 1), b2 + hstepB, voffB);
            PG8_WAIT_V(6); PG8_BAR; PG8_MMA(1, 1, At, B1); PG8_BAR;
            PG8_LDB(B0, 1, 0); PG8_SCHED; PG8_LDA(At, 1, 0); PG8_STAGE(PG8_SA(0, 1), a2 + hstepA, voffA);
            PG8_WAIT_L(8); PG8_BAR; PG8_WAIT_L(0); PG8_MMA(0, 0, At, B0); PG8_BAR; PG8_SCHED;
            PG8_LDB(B1, 1, 1); PG8_STAGE(PG8_SB(1, 0), b3, voffB);
            PG8_BAR; PG8_WAIT_L(0); PG8_MMA(0, 1, At, B1); PG8_BAR;
            PG8_LDA(At, 1, 1); PG8_STAGE(PG8_SA(1, 0), a3, voffA);
            PG8_BAR; PG8_WAIT_L(0); PG8_MMA(1, 0, At, B0); PG8_BAR; PG8_SCHED;
            PG8_STAGE(PG8_SB(1, 1), b3 + hstepB, voffB);
            PG8_WAIT_V(6); PG8_BAR; PG8_MMA(1, 1, At, B1); PG8_BAR;
        }
        E(acc, cur, wr, wc, fr, fq);
        if (!has_next) break;
#pragma unroll
        for (int a = 0; a < 2; ++a)
#pragma unroll
            for (int b = 0; b < 2; ++b)
#pragma unroll
                for (int m = 0; m < 4; ++m)
#pragma unroll
                    for (int n = 0; n < 2; ++n) acc[a][b][m][n] = (f32x4){0.f, 0.f, 0.f, 0.f};
        cur = nxt; cA = nA; cB = nB; ++ui;
    }
    PG8_WAIT_V(0);
    if (wr == 0) PG8_BAR;
    PG8_BAR;
    __builtin_amdgcn_s_waitcnt(0);
#undef PG8_SA
#undef PG8_SB
#undef PG8_STAGE
#undef PG8_LDA
#undef PG8_LDB
#undef PG8_MMA
#undef PG8_WAIT_V
#undef PG8_WAIT_L
#undef PG8_BAR
#undef PG8_SCHED
}
}
using pg8::Unit;

#define EPI_LOOP_BEGIN _Pragma("unroll") for (int ai = 0; ai < 2; ++ai) _Pragma("unroll") for (int m = 0; m < 4; ++m) { const size_t row = (size_t)(u.pm * 256 + ai * 128 + wr * 64 + m * 16 + fr); \
        _Pragma("unroll") for (int bj = 0; bj < 2; ++bj) {
#define EPI_LOOP_END } }
struct EpiIn {
    bf16_t* pm; bf16_t* gates;
    __device__ __forceinline__ void operator()(const f32x4 (&acc)[2][2][4][2], const Unit& u, int wr, int wc, int fr, int fq) const {
        const bool main_ = u.pn < 14;
        EPI_LOOP_BEGIN
#pragma unroll
            for (int n = 0; n < 2; ++n) { const int col = u.pn * 256 + bj * 128 + wc * 32 + n * 16 + fq * 4; f32x4 v = acc[ai][bj][m][n]; u32x2 w;
                if (main_) { w.x = cvt_pk_bf16(v[0], v[1]); w.y = cvt_pk_bf16(v[2], v[3]); *(u32x2*)(pm + row * NPM + col) = w; }
                else { w.x = cvt_pk_bf16(sigmoidf_(v[0]), sigmoidf_(v[1])); w.y = cvt_pk_bf16(sigmoidf_(v[2]), sigmoidf_(v[3])); *(u32x2*)(gates + row * NGATE + (col - NPM)) = w; } }
        EPI_LOOP_END
    }
};
struct EpiGlu {
    bf16_t* br;
    __device__ __forceinline__ void operator()(const f32x4 (&acc)[2][2][4][2], const Unit& u, int wr, int wc, int fr, int fq) const {
        EPI_LOOP_BEGIN
            const int j = u.pn * 128 + bj * 64 + wc * 16 + fq * 4; const f32x4 a = acc[ai][bj][m][0], b = acc[ai][bj][m][1]; u32x2 w;
            w.x = cvt_pk_bf16(a[0] * sigmoidf_(b[0]), a[1] * sigmoidf_(b[1])); w.y = cvt_pk_bf16(a[2] * sigmoidf_(b[2]), a[3] * sigmoidf_(b[3]));
            *(u32x2*)(br + row * 1024 + 512 + j) = w;
        EPI_LOOP_END
    }
};
struct EpiGU {
    bf16_t* a;
    __device__ __forceinline__ void operator()(const f32x4 (&acc)[2][2][4][2], const Unit& u, int wr, int wc, int fr, int fq) const {
        EPI_LOOP_BEGIN
            const int j = u.pn * 128 + bj * 64 + wc * 16 + fq * 4; const f32x4 g = acc[ai][bj][m][0], b = acc[ai][bj][m][1]; u32x2 w;
            w.x = cvt_pk_bf16(siluf_(g[0]) * b[0], siluf_(g[1]) * b[1]); w.y = cvt_pk_bf16(siluf_(g[2]) * b[2], siluf_(g[3]) * b[3]);
            *(u32x2*)(a + row * DFF + j) = w;
        EPI_LOOP_END
    }
};
struct EpiBr {
    const bf16_t* gates; bf16_t* mm;
    __device__ __forceinline__ void operator()(const f32x4 (&acc)[2][2][4][2], const Unit& u, int wr, int wc, int fr, int fq) const {
        EPI_LOOP_BEGIN
#pragma unroll
            for (int n = 0; n < 2; ++n) { const int col = u.pn * 256 + bj * 128 + wc * 32 + n * 16 + fq * 4; const f32x4 v = acc[ai][bj][m][n];
                const u32x2 gw = *(const u32x2*)(gates + row * NGATE + u.kk * 1024 + col);
                float r0 = lo_bf(gw.x) * v[0], r1 = hi_bf(gw.x) * v[1], r2 = lo_bf(gw.y) * v[2], r3 = hi_bf(gw.y) * v[3];
                if (u.kk > 0) { const u32x2 pw = *(const u32x2*)(mm + row * 1024 + col); r0 += lo_bf(pw.x); r1 += hi_bf(pw.x); r2 += lo_bf(pw.y); r3 += hi_bf(pw.y); }
                u32x2 w; w.x = cvt_pk_bf16(r0, r1); w.y = cvt_pk_bf16(r2, r3); *(u32x2*)(mm + row * 1024 + col) = w; }
        EPI_LOOP_END
    }
};
struct EpiRes {
    float* h;
    __device__ __forceinline__ void operator()(const f32x4 (&acc)[2][2][4][2], const Unit& u, int wr, int wc, int fr, int fq) const {
        EPI_LOOP_BEGIN
#pragma unroll
            for (int n = 0; n < 2; ++n) { const int col = u.pn * 256 + bj * 128 + wc * 32 + n * 16 + fq * 4; float* ptr = h + row * 1024 + col;
                const f32x4 o = *(const f32x4*)ptr; *(f32x4*)ptr = o + acc[ai][bj][m][n]; }
        EPI_LOOP_END
    }
};

__device__ __forceinline__ int win_src_col(int n) {
    if (n < 768) return n;
    if (n < 1024) return 776 + (n - 768);
    if (n < 1792) return 1032 + (n - 1024);
    if (n < 2048) return 1816 + (n - 1792);
    if (n < 2304) return 2072 + (n - 2048);
    if (n < 3072) return 2328 + (n - 2304);
    if (n < 3328) return 3096 + (n - 3072);
    if (n < 3336) return 768 + (n - 3328);
    if (n < 3352) return 1800 + (n - 3336);
    if (n < 3584) return -1;
    return 3352 + (n - 3584);
}
__device__ __forceinline__ void phase_convert(KPR p, int layer, LAS float* tile, int bid, int G) {
    const int tid = otid(), tn = tid & 63, tk = __builtin_amdgcn_readfirstlane(tid >> 6);
    constexpr int T0 = 120 * 16, T1 = T0 + 88 * 16, T2 = T1 + 16 * 44, T3 = T2 + 16 * 16, T4 = T3 + 64 * 4, T5 = T4 + 8 * 4;
    for (int j = bid; j < T5; j += G) {
        int n0, k0, K, ld; bf16_t* dst; const float* cp = nullptr;
        if (j < T0) { const int q = j; n0 = (q >> 4) * 64; k0 = (q & 15) * 64; K = 1024; ld = NIN; dst = (bf16_t*)(p.ws + OFF_WIN);
            const int sc = win_src_col(n0 + tn); if (sc >= 0) cp = p.in[9] + (size_t)layer * 1024 * NIN + sc; }
        else if (j < T1) { const int q = j - T0; n0 = (q >> 4) * 64; k0 = (q & 15) * 64; K = 1024; ld = DFF; dst = (bf16_t*)(p.ws + OFF_WGU);
            const int n = n0 + tn, g32 = n >> 5, w = n & 31, jj = g32 * 16 + (w & 15); cp = (w < 16 ? p.in[31] : p.in[32]) + (size_t)layer * 1024 * DFF + jj; }
        else if (j < T2) { const int q = j - T1; n0 = (q / 44) * 64; k0 = (q % 44) * 64; K = DFF; ld = 1024; dst = (bf16_t*)(p.ws + OFF_WDN);
            cp = p.in[33] + (size_t)layer * DFF * 1024 + (n0 + tn); }
        else if (j < T3) { const int q = j - T2; n0 = (q >> 4) * 64; k0 = (q & 15) * 64; K = 1024; ld = 1024; dst = (bf16_t*)(p.ws + OFF_WOUT);
            cp = p.in[29] + (size_t)layer * 1024 * 1024 + (n0 + tn); }
        else if (j < T4) { const int q = j - T3; n0 = (q >> 2) * 64; k0 = (q & 3) * 64; K = 256; ld = 1024; dst = (bf16_t*)(p.ws + OFF_WBR);
            const int n = n0 + tn, kk = n >> 10, d = n & 1023; cp = p.in[28] + ((size_t)(layer * 4 + kk) * 256) * 1024 + d; }
        else { const int q = j - T4; n0 = (q >> 2) * 64; k0 = (q & 3) * 64; K = 256; ld = 512; dst = (bf16_t*)(p.ws + OFF_WGLU);
            const int n = n0 + tn, g32 = n >> 5, w = n & 31, jj = g32 * 16 + (w & 15); cp = p.in[25] + (size_t)layer * 256 * 512 + (w < 16 ? jj : 256 + jj); }
        __syncthreads();
#pragma unroll
        for (int e = 0; e < 8; ++e) { const int k = k0 + tk * 8 + e; tile[tn * 65 + tk * 8 + e] = cp ? cp[(size_t)k * ld] : 0.f; }
        __syncthreads();
        { const int n = tid >> 3, ks = tid & 7; const LAS float* tp = tile + n * 65 + ks * 8; u32x4 w;
          w.x = cvt_pk_bf16(tp[0], tp[1]); w.y = cvt_pk_bf16(tp[2], tp[3]); w.z = cvt_pk_bf16(tp[4], tp[5]); w.w = cvt_pk_bf16(tp[6], tp[7]);
          *(u32x4*)(dst + (size_t)(n0 + n) * K + k0 + ks * 8) = w; }
    }
    __syncthreads();
}

__device__ __forceinline__ void phase_norm(KPR p, const float* w, int mode, int bid, int G) {
    const int tid_ = otid(); const int wid = __builtin_amdgcn_readfirstlane(tid_ >> 6), lane = tid_ & 63;
    float* h = (float*)(p.ws + OFF_H); bf16_t* xn = (bf16_t*)(p.ws + OFF_XN);
    f32x4 wv[4];
#pragma unroll
    for (int i = 0; i < 4; ++i) wv[i] = *(const f32x4*)(w + i * 256 + lane * 4);
    for (int r = bid * 8 + wid; r < MTOK; r += G * 8) {
        const float* src = (mode == 0) ? (r < MPROMPT ? p.in[0] + (size_t)r * 1024 : p.in[1] + (size_t)(r - MPROMPT) * 1024) : h + (size_t)r * 1024;
        f32x4 v[4]; float ss = 0.f;
#pragma unroll
        for (int i = 0; i < 4; ++i) { v[i] = *(const f32x4*)(src + i * 256 + lane * 4); ss += v[i][0] * v[i][0] + v[i][1] * v[i][1] + v[i][2] * v[i][2] + v[i][3] * v[i][3]; }
        ss = wave_sum(ss);
        const float rs = rsqrtf(ss * (1.0f / 1024.0f) + EPS);
#pragma unroll
        for (int i = 0; i < 4; ++i) {
            const f32x4 y = v[i] * rs * wv[i];
            if (mode == 2) *(f32x4*)(p.out + (size_t)r * 1024 + i * 256 + lane * 4) = y;
            else { u32x2 o; o.x = cvt_pk_bf16(y[0], y[1]); o.y = cvt_pk_bf16(y[2], y[3]); *(u32x2*)(xn + (size_t)r * 1024 + i * 256 + lane * 4) = o;
                   if (mode == 0) *(f32x4*)(h + (size_t)r * 1024 + i * 256 + lane * 4) = v[i]; }
        }
    }
}

constexpr int TCH = 32;
constexpr int MIXBUF_FLOATS = 4 * TCH * 64 + TCH * 4;
template <int MIX>
__device__ __forceinline__ void mix_item(KPR p, int layer, LAS float* lds, int tokbase, int L, int h, int col0, int ncols,
                         const float* s_in, float* s_out, const float* conv_in, float* conv_out) {
    const int tid = otid(), wid = __builtin_amdgcn_readfirstlane(tid >> 6), lane = tid & 63;
    const int nscan = ncols * 8; const bool is_scan = wid < (nscan >> 6);
    const int ksl = lane & 7, cl = wid * 8 + (lane >> 3), col = col0 + cl;
    const bf16_t* pm = (const bf16_t*)(p.ws + OFF_PM);
    bf16_t* oraw = (bf16_t*)(p.ws + OFF_ORAW);
    __syncthreads();
    float S[8];
#pragma unroll
    for (int i = 0; i < 8; ++i) S[i] = (is_scan && s_in) ? s_in[(ksl * 8 + i) * 64 + col] : 0.f;
    const int tl = lane >> 4, d4 = (lane & 15) * 4, hd4 = h * 64 + d4;
    f32x4 cw[3][4]; float c_a = 0.f, c_dt = 0.f; f32x4 gkw[16]; f32x4 gkb = (f32x4){0.f, 0.f, 0.f, 0.f}, lb4 = (f32x4){0.f, 0.f, 0.f, 0.f};
    if (MIX == 0) {
        const float* cwp = p.in[10] + (size_t)layer * 4 * 768;
#pragma unroll
        for (int s = 0; s < 3; ++s)
#pragma unroll
            for (int j = 0; j < 4; ++j) cw[s][j] = *(const f32x4*)(cwp + j * 768 + s * 256 + hd4);
        c_a = -__expf(p.in[11][layer * 4 + h]); c_dt = p.in[12][layer * 4 + h];
        if (conv_out && col0 == 0 && h == 0) {
            for (int idx = tid; idx < 3 * 768; idx += 512) { const int i = idx / 768, c = idx - i * 768, ti = L - 3 + i;
                conv_out[idx] = ti >= 0 ? bf2f(pm[(size_t)(tokbase + ti) * NPM + A_QKV + c]) : (conv_in ? conv_in[(3 + ti) * 768 + c] : 0.f); }
        }
    } else if (MIX == 1) {
#pragma unroll
        for (int r = 0; r < 16; ++r) gkw[r] = *(const f32x4*)(p.in[14] + ((size_t)layer * 16 + r) * 256 + hd4);
        gkb = *(const f32x4*)(p.in[15] + layer * 256 + hd4);
    } else {
        const float* lg = p.in[26] + hd4; const f32x4 a0 = *(const f32x4*)lg, a1 = *(const f32x4*)(lg + 256), a2 = *(const f32x4*)(lg + 512), a3 = *(const f32x4*)(lg + 768);
#pragma unroll
        for (int e = 0; e < 4; ++e) {
            const float mx = fmaxf(fmaxf(a0[e], a1[e]), fmaxf(a2[e], a3[e])); const float l0 = __expf(a0[e] - mx), l1 = __expf(a1[e] - mx), l2 = __expf(a2[e] - mx), l3 = __expf(a3[e] - mx);
            const float inv = 1.0f / (l0 + l1 + l2 + l3);
            lb4[e] = (layer == 0) ? 0.f : (layer == 1) ? l1 * inv : (layer == 2) ? (l1 + l2) * inv : (l1 + l2 + l3) * inv;
        }
    }
    const int nch = (L + TCH - 1) / TCH;
    auto prep = [&](int c, int pw, int npw) {
        LAS float* kb = lds + (c & 1) * MIXBUF_FLOATS; LAS float* qb = kb + TCH * 64; LAS float* fb = qb + TCH * 64; LAS float* vb = fb + TCH * 64; LAS float* sc = vb + TCH * 64;
#pragma unroll
        for (int pass = 0; pass < 2; ++pass) {
            const int tt0 = (pass * npw + pw) * 4;
            if (tt0 < TCH) {
                const int tt = tt0 + tl, t = c * TCH + tt;
                if (t < L) {
                    const bf16_t* row = pm + (size_t)(tokbase + t) * NPM;
                    if (MIX == 0) {
                        f32x4 y[3];
#pragma unroll
                        for (int s = 0; s < 3; ++s) { f32x4 a = (f32x4){0.f, 0.f, 0.f, 0.f};
#pragma unroll
                            for (int j = 0; j < 4; ++j) { const int ti = t - 3 + j; f32x4 xv = (f32x4){0.f, 0.f, 0.f, 0.f};
                                if (ti >= 0) { const u32x2 w = *(const u32x2*)(pm + (size_t)(tokbase + ti) * NPM + A_QKV + s * 256 + hd4); xv = (f32x4){lo_bf(w.x), hi_bf(w.x), lo_bf(w.y), hi_bf(w.y)}; }
                                else if (conv_in) xv = *(const f32x4*)(conv_in + (3 + ti) * 768 + s * 256 + hd4);
                                a += xv * cw[s][j]; }
                            y[s] = (f32x4){siluf_(a[0]), siluf_(a[1]), siluf_(a[2]), siluf_(a[3])}; }
                        const float qq = red16(y[0][0] * y[0][0] + y[0][1] * y[0][1] + y[0][2] * y[0][2] + y[0][3] * y[0][3]);
                        const float kk2 = red16(y[1][0] * y[1][0] + y[1][1] * y[1][1] + y[1][2] * y[1][2] + y[1][3] * y[1][3]);
                        const f32x4 qn = y[0] * (rsqrtf(qq + EPS) * 0.125f), kn = y[1] * rsqrtf(kk2 + EPS);
                        const float kq = red16(qn[0] * kn[0] + qn[1] * kn[1] + qn[2] * kn[2] + qn[3] * kn[3]);
                        *(LAS f32x4*)(kb + tt * 64 + d4) = kn; *(LAS f32x4*)(qb + tt * 64 + d4) = qn; *(LAS f32x4*)(vb + tt * 64 + d4) = y[2];
                        if ((lane & 15) == 0) { const float al = bf2f(row[A_ALPHA + h]) + c_dt; const float sp = fmaxf(al, 0.f) + __logf(1.0f + __expf(-fabsf(al)));
                            *(LAS f32x4*)(sc + tt * 4) = (f32x4){__expf(c_a * sp), sigmoidf_(bf2f(row[A_BETA + h])), kq, 0.f}; }
                    } else if (MIX == 1) {
                        const u32x4 g0 = *(const u32x4*)(row + B_GK), g1 = *(const u32x4*)(row + B_GK + 8);
                        const u32x2 wq = *(const u32x2*)(row + B_Q + hd4), wk = *(const u32x2*)(row + B_K + hd4), wv = *(const u32x2*)(row + B_V + hd4);
                        f32x4 z = gkb;
                        z += lo_bf(g0.x) * gkw[0] + hi_bf(g0.x) * gkw[1] + lo_bf(g0.y) * gkw[2] + hi_bf(g0.y) * gkw[3] + lo_bf(g0.z) * gkw[4] + hi_bf(g0.z) * gkw[5] + lo_bf(g0.w) * gkw[6] + hi_bf(g0.w) * gkw[7];
                        z += lo_bf(g1.x) * gkw[8] + hi_bf(g1.x) * gkw[9] + lo_bf(g1.y) * gkw[10] + hi_bf(g1.y) * gkw[11] + lo_bf(g1.z) * gkw[12] + hi_bf(g1.z) * gkw[13] + lo_bf(g1.w) * gkw[14] + hi_bf(g1.w) * gkw[15];
                        f32x4 f;
#pragma unroll
                        for (int e = 0; e < 4; ++e) { const float sp = fmaxf(-z[e], 0.f) + __logf(1.0f + __expf(-fabsf(z[e]))); f[e] = __expf(-sp * (1.0f / 16.0f)); }
                        *(LAS f32x4*)(fb + tt * 64 + d4) = f;
                        *(LAS f32x4*)(qb + tt * 64 + d4) = (f32x4){lo_bf(wq.x), hi_bf(wq.x), lo_bf(wq.y), hi_bf(wq.y)} * 0.125f;
                        *(LAS f32x4*)(kb + tt * 64 + d4) = (f32x4){lo_bf(wk.x), hi_bf(wk.x), lo_bf(wk.y), hi_bf(wk.y)};
                        *(LAS f32x4*)(vb + tt * 64 + d4) = (f32x4){lo_bf(wv.x), hi_bf(wv.x), lo_bf(wv.y), hi_bf(wv.y)};
                    } else {
                        const u32x2 wq = *(const u32x2*)(row + D_Q + hd4), wf = *(const u32x2*)(row + D_F + hd4), wv = *(const u32x2*)(row + D_I + hd4);
                        const f32x4 xq = (f32x4){lo_bf(wq.x), hi_bf(wq.x), lo_bf(wq.y), hi_bf(wq.y)}, xf = (f32x4){lo_bf(wf.x), hi_bf(wf.x), lo_bf(wf.y), hi_bf(wf.y)};
                        f32x4 f, k, q;
#pragma unroll
                        for (int e = 0; e < 4; ++e) { const float sg = sigmoidf_(xf[e]); f[e] = lb4[e] + (1.0f - lb4[e]) * sg; k[e] = (1.0f - lb4[e]) * (1.0f - sg); q[e] = siluf_(xq[e]) * 0.125f; }
                        *(LAS f32x4*)(fb + tt * 64 + d4) = f; *(LAS f32x4*)(kb + tt * 64 + d4) = k; *(LAS f32x4*)(qb + tt * 64 + d4) = q;
                        *(LAS f32x4*)(vb + tt * 64 + d4) = (f32x4){lo_bf(wv.x), hi_bf(wv.x), lo_bf(wv.y), hi_bf(wv.y)};
                    }
                }
            }
        }
    };
    prep(0, wid, 8);
    __syncthreads();
    for (int c = 0; c < nch; ++c) {
        if (is_scan) {
            const LAS float* kb = lds + (c & 1) * MIXBUF_FLOATS; const LAS float* qb = kb + TCH * 64; const LAS float* fb = qb + TCH * 64; const LAS float* vb = fb + TCH * 64; const LAS float* sc = vb + TCH * 64;
            const int ntok = (L - c * TCH) < TCH ? (L - c * TCH) : TCH;
            bf16_t* op = oraw + (size_t)(tokbase + c * TCH) * 768 + MIX * 256 + h * 64 + col;
            const LAS float* kp = kb + ksl * 8; const LAS float* qp = qb + ksl * 8; const LAS float* fp = fb + ksl * 8; const LAS float* vp = vb + col;
            f32x4 k0 = *(const LAS f32x4*)kp, k1 = *(const LAS f32x4*)(kp + 4), q0 = *(const LAS f32x4*)qp, q1 = *(const LAS f32x4*)(qp + 4);
            f32x4 f0 = (f32x4){0.f, 0.f, 0.f, 0.f}, f1 = f0, scv = f0;
            if (MIX == 0) scv = *(const LAS f32x4*)sc; else { f0 = *(const LAS f32x4*)fp; f1 = *(const LAS f32x4*)(fp + 4); }
            float v = vp[0];
#pragma unroll 2
            for (int tt = 0; tt < ntok; ++tt) {
                const int tn = (tt + 1 < TCH) ? tt + 1 : tt;
                const f32x4 nk0 = *(const LAS f32x4*)(kp + tn * 64), nk1 = *(const LAS f32x4*)(kp + tn * 64 + 4), nq0 = *(const LAS f32x4*)(qp + tn * 64), nq1 = *(const LAS f32x4*)(qp + tn * 64 + 4);
                f32x4 nf0 = f0, nf1 = f1, nsc = scv;
                if (MIX == 0) nsc = *(const LAS f32x4*)(sc + tn * 4); else { nf0 = *(const LAS f32x4*)(fp + tn * 64); nf1 = *(const LAS f32x4*)(fp + tn * 64 + 4); }
                const float nv = vp[tn * 64];
                float o;
                if (MIX == 0) {
                    const float eg = scv[0], beta = scv[1], kq = scv[2];
                    float dk = (S[0] * k0[0] + S[1] * k0[1]) + (S[2] * k0[2] + S[3] * k0[3]) + (S[4] * k1[0] + S[5] * k1[1]) + (S[6] * k1[2] + S[7] * k1[3]);
                    float dq = (S[0] * q0[0] + S[1] * q0[1]) + (S[2] * q0[2] + S[3] * q0[3]) + (S[4] * q1[0] + S[5] * q1[1]) + (S[6] * q1[2] + S[7] * q1[3]);
                    dk = red8(dk); dq = red8(dq);
                    const float delta = beta * (v - eg * dk);
#pragma unroll
                    for (int i = 0; i < 4; ++i) { S[i] = eg * S[i] + k0[i] * delta; S[4 + i] = eg * S[4 + i] + k1[i] * delta; }
                    o = eg * dq + kq * delta;
                } else {
#pragma unroll
                    for (int i = 0; i < 4; ++i) { S[i] = f0[i] * S[i] + k0[i] * v; S[4 + i] = f1[i] * S[4 + i] + k1[i] * v; }
                    float dq = (S[0] * q0[0] + S[1] * q0[1]) + (S[2] * q0[2] + S[3] * q0[3]) + (S[4] * q1[0] + S[5] * q1[1]) + (S[6] * q1[2] + S[7] * q1[3]);
                    o = red8(dq);
                }
                if (ksl == 0) op[(size_t)tt * 768] = f2bf(o);
                k0 = nk0; k1 = nk1; q0 = nq0; q1 = nq1; f0 = nf0; f1 = nf1; scv = nsc; v = nv;
            }
        } else if (c + 1 < nch) prep(c + 1, wid - (nscan >> 6), 8 - (nscan >> 6));
        __syncthreads();
    }
    if (is_scan) {
#pragma unroll
        for (int i = 0; i < 8; ++i) s_out[(ksl * 8 + i) * 64 + col] = S[i];
    }
}

constexpr int S5_BU_LD = 132, S5_XB_LD = 136, S5_WAVE_BYTES = 16 * S5_BU_LD * 4 + 16 * S5_XB_LD * 2;
template <bool SAMPLE>
__device__ __forceinline__ void s5_wave_item(KPR p, int layer, LAS unsigned char* wl, int g, int tokbase, int L, int seq0) {
    const int lane = otid() & 63, col = lane & 15, quad = lane >> 4;
    const bf16_t* pm = (const bf16_t*)(p.ws + OFF_PM); bf16_t* yg = (bf16_t*)(p.ws + OFF_YG);
    LAS float* bu = (LAS float*)wl; LAS bf16_t* xb = (LAS bf16_t*)(wl + 16 * S5_BU_LD * 4);
    const int lg = layer * 16 + g;
    float ar, ai, zr, zi;
    { const float lr = fminf(p.in[17][lg * 64 + lane], -1e-4f), li = p.in[18][lg * 64 + lane], dt = __expf(p.in[24][lg]);
      const float mag = __expf(lr * dt); float rev = li * dt * 0.15915494309f; rev -= rintf(rev);
      const float sn = __builtin_amdgcn_sinf(rev), cs = __builtin_amdgcn_cosf(rev); ar = mag * cs; ai = mag * sn;
      const float den = lr * lr + li * li; zr = ((ar - 1.0f) * lr + ai * li) / den; zi = (ai * lr - (ar - 1.0f) * li) / den; }
    bf16x8 Bf[8], Cf[4];
#pragma unroll
    for (int tt = 0; tt < 4; ++tt) {
        const int pp = tt * 16 + col; const float zr2 = __shfl(zr, pp), zi2 = __shfl(zi, pp);
        float bre[8], bim[8];
#pragma unroll
        for (int j = 0; j < 8; ++j) { bre[j] = 0.f; bim[j] = 0.f; }
        if (quad < 2) {
            const float* br_ = p.in[19] + ((size_t)lg * 64 + pp) * 16 + quad * 8; const float* bi_ = p.in[20] + ((size_t)lg * 64 + pp) * 16 + quad * 8;
#pragma unroll
            for (int j = 0; j < 8; ++j) { const float r = br_[j], i = bi_[j]; bre[j] = zr2 * r - zi2 * i; bim[j] = zr2 * i + zi2 * r; }
        }
        u32x4 wr_, wi_;
        wr_.x = cvt_pk_bf16(bre[0], bre[1]); wr_.y = cvt_pk_bf16(bre[2], bre[3]); wr_.z = cvt_pk_bf16(bre[4], bre[5]); wr_.w = cvt_pk_bf16(bre[6], bre[7]);
        wi_.x = cvt_pk_bf16(bim[0], bim[1]); wi_.y = cvt_pk_bf16(bim[2], bim[3]); wi_.z = cvt_pk_bf16(bim[4], bim[5]); wi_.w = cvt_pk_bf16(bim[6], bim[7]);
        Bf[tt] = __builtin_bit_cast(bf16x8, wr_); Bf[4 + tt] = __builtin_bit_cast(bf16x8, wi_);
    }
#pragma unroll
    for (int kb = 0; kb < 4; ++kb) {
        const int k0 = (kb & 1) * 32 + quad * 8; const float sgn = kb < 2 ? 1.0f : -1.0f;
        const float* cp = (kb < 2 ? p.in[21] : p.in[22]) + ((size_t)lg * 16 + col) * 64 + k0;
        u32x4 w; w.x = cvt_pk_bf16(sgn * cp[0], sgn * cp[1]); w.y = cvt_pk_bf16(sgn * cp[2], sgn * cp[3]); w.z = cvt_pk_bf16(sgn * cp[4], sgn * cp[5]); w.w = cvt_pk_bf16(sgn * cp[6], sgn * cp[7]);
        Cf[kb] = __builtin_bit_cast(bf16x8, w);
    }
    const float dcoef = p.in[23][layer * 256 + g * 16 + col];
    float xr = 0.f, xi = 0.f;
    const int nch = SAMPLE ? 1 : (L + 15) / 16;
    u32x4 awn = (u32x4){0u, 0u, 0u, 0u}; bf16_t un[4] = {0, 0, 0, 0};
    auto pf = [&](int cc) {
        const int t0 = cc * 16; const int nrow = SAMPLE ? 16 : ((L - t0) < 16 ? (L - t0) : 16);
        awn = (u32x4){0u, 0u, 0u, 0u};
        if (quad < 2 && col < nrow) awn = *(const u32x4*)(pm + (size_t)(tokbase + t0 + col) * NPM + C_U + g * 16 + quad * 8);
#pragma unroll
        for (int i = 0; i < 4; ++i) { const int r = quad * 4 + i; un[i] = (r < nrow) ? pm[(size_t)(tokbase + t0 + r) * NPM + C_U + g * 16 + col] : (bf16_t)0; }
    };
    pf(0);
    for (int c = 0; c < nch; ++c) {
        const int t0 = c * 16; const int nrow = SAMPLE ? 16 : ((L - t0) < 16 ? (L - t0) : 16);
        const u32x4 aw = awn; bf16_t uc[4];
#pragma unroll
        for (int i = 0; i < 4; ++i) uc[i] = un[i];
        if (c + 1 < nch) pf(c + 1);
        const bf16x8 af = __builtin_bit_cast(bf16x8, aw);
#pragma unroll
        for (int tile = 0; tile < 8; ++tile) {
            const f32x4 d = __builtin_amdgcn_mfma_f32_16x16x32_bf16(af, Bf[tile], (f32x4){0.f, 0.f, 0.f, 0.f}, 0, 0, 0);
#pragma unroll
            for (int i = 0; i < 4; ++i) bu[(quad * 4 + i) * S5_BU_LD + tile * 16 + col] = d[i];
        }
        __builtin_amdgcn_fence(__ATOMIC_RELEASE, "wavefront"); __builtin_amdgcn_wave_barrier(); __builtin_amdgcn_fence(__ATOMIC_ACQUIRE, "wavefront");
        for (int r = 0; r < 16; ++r) {
            float nr = 0.f, ni = 0.f;
            if (r < nrow) {
                if (SAMPLE) { const size_t si = ((size_t)(layer * NDEC + seq0 + r) * 16 + g) * 64 + lane; xr = p.in[5][si]; xi = p.in[6][si]; }
                const float br_ = bu[r * S5_BU_LD + lane], bi_ = bu[r * S5_BU_LD + 64 + lane];
                nr = ar * xr - ai * xi + br_; ni = ar * xi + ai * xr + bi_; xr = nr; xi = ni;
                if (SAMPLE) { const size_t so = ((size_t)(layer * NDEC + seq0 + r) * 16 + g) * 64 + lane; p.out[O_SS5R + so] = nr; p.out[O_SS5I + so] = ni; }
            }
            xb[r * S5_XB_LD + lane] = f2bf(nr); xb[r * S5_XB_LD + 64 + lane] = f2bf(ni);
        }
        __builtin_amdgcn_fence(__ATOMIC_RELEASE, "wavefront"); __builtin_amdgcn_wave_barrier(); __builtin_amdgcn_fence(__ATOMIC_ACQUIRE, "wavefront");
        f32x4 ya = (f32x4){0.f, 0.f, 0.f, 0.f};
#pragma unroll
        for (int kb = 0; kb < 4; ++kb) { const bf16x8 xf = *(const LAS bf16x8*)(xb + col * S5_XB_LD + kb * 32 + quad * 8); ya = __builtin_amdgcn_mfma_f32_16x16x32_bf16(xf, Cf[kb], ya, 0, 0, 0); }
#pragma unroll
        for (int i = 0; i < 4; ++i) { const int r = quad * 4 + i;
            if (r < nrow) { const size_t tok = (size_t)(tokbase + t0 + r); const float uu = bf2f(uc[i]);
                const float y = ya[i] + dcoef * uu; const float ge = y * __builtin_amdgcn_rcpf(1.0f + __expf(-1.5957691216f * (y + 0.044715f * y * y * y)));
                yg[tok * 256 + g * 16 + col] = f2bf(ge); } }
        __builtin_amdgcn_fence(__ATOMIC_RELEASE, "wavefront"); __builtin_amdgcn_wave_barrier(); __builtin_amdgcn_fence(__ATOMIC_ACQUIRE, "wavefront");
    }
    if (!SAMPLE) { const size_t so = ((size_t)(layer * NBATCH + seq0) * 16 + g) * 64 + lane; p.out[O_PS5R + so] = xr; p.out[O_PS5I + so] = xi; }
}

__device__ __forceinline__ void phase_mix(KPR p, int layer, LAS unsigned char* ldsb, int bid, int G) {
    LAS float* lds = (LAS float*)ldsb;
    const int wid = __builtin_amdgcn_readfirstlane(otid() >> 6);
    constexpr int NLONG = 208, NSHORT = 16 + 1536;
    for (int it = bid; it < NLONG; it += G) {
        if (it < 192) {
            const int mix = it >> 6, r = it & 63, b = r >> 3, hh = (r >> 1) & 3, half = r & 1;
            const size_t so = ((size_t)(layer * NBATCH + b) * 4 + hh) * 4096;
            if (mix == 0) mix_item<0>(p, layer, lds, b * SEQ, SEQ, hh, half * 32, 32, nullptr, p.out + O_PGDN + so, nullptr, p.out + O_PCONV + (size_t)(layer * NBATCH + b) * 2304);
            else if (mix == 1) mix_item<1>(p, layer, lds, b * SEQ, SEQ, hh, half * 32, 32, nullptr, p.out + O_PGLA + so, nullptr, nullptr);
            else mix_item<2>(p, layer, lds, b * SEQ, SEQ, hh, half * 32, 32, nullptr, p.out + O_PHG + so, nullptr, nullptr);
        } else {
            __syncthreads();
            const int j = (it - 192) * 8 + wid, b = j >> 4, g = j & 15;
            s5_wave_item<false>(p, layer, ldsb + wid * S5_WAVE_BYTES, g, b * SEQ, SEQ, b);
        }
    }
    const int w0 = (G >= 256) ? 192 : 0, nw = G - w0;
    if (bid >= w0) for (int j = bid - w0; j < NSHORT; j += nw) {
        if (j < 16) {
            __syncthreads();
            const int jj = j * 8 + wid, g = jj & 15, s0 = (jj >> 4) * 16;
            s5_wave_item<true>(p, layer, ldsb + wid * S5_WAVE_BYTES, g, MPROMPT + s0, 16, s0);
        } else {
            const int jj = j - 16, mix = jj >> 9, s = (jj & 511) >> 2, hh = jj & 3;
            const size_t so = ((size_t)(layer * NDEC + s) * 4 + hh) * 4096;
            if (mix == 0) mix_item<0>(p, layer, lds, MPROMPT + s, 1, hh, 0, 64, p.in[3] + so, p.out + O_SGDN + so, p.in[2] + (size_t)(layer * NDEC + s) * 2304, p.out + O_SCONV + (size_t)(layer * NDEC + s) * 2304);
            else if (mix == 1) mix_item<1>(p, layer, lds, MPROMPT + s, 1, hh, 0, 64, p.in[4] + so, p.out + O_SGLA + so, nullptr, nullptr);
            else mix_item<2>(p, layer, lds, MPROMPT + s, 1, hh, 0, 64, p.in[7] + so, p.out + O_SHG + so, nullptr, nullptr);
        }
    }
    __syncthreads();
}

__device__ __forceinline__ void phase_headnorm(KPR p, int layer, int bid, int G) {
    const int tid_ = otid(); const int wid = __builtin_amdgcn_readfirstlane(tid_ >> 6), lane = tid_ & 63;
    const bf16_t* pm = (const bf16_t*)(p.ws + OFF_PM); const bf16_t* oraw = (const bf16_t*)(p.ws + OFF_ORAW); bf16_t* br = (bf16_t*)(p.ws + OFF_BR);
    for (int j = bid * 8 + wid; j < MTOK * 3; j += G * 8) {
        const int tok = j / 3, mix = j - tok * 3;
        const int gcol = mix == 0 ? A_GATE : (mix == 1 ? B_GATE : D_GATE), slot = mix == 2 ? 3 : mix;
        const float* nw = (mix == 0 ? p.in[13] : (mix == 1 ? p.in[16] : p.in[27])) + layer * 256 + lane * 4;
        const u32x2 ow = *(const u32x2*)(oraw + (size_t)tok * 768 + mix * 256 + lane * 4);
        const u32x2 gw = *(const u32x2*)(pm + (size_t)tok * NPM + gcol + lane * 4);
        const float o0 = lo_bf(ow.x), o1 = hi_bf(ow.x), o2 = lo_bf(ow.y), o3 = hi_bf(ow.y);
        float ss = o0 * o0 + o1 * o1 + o2 * o2 + o3 * o3;
        ss += __shfl_xor(ss, 1); ss += __shfl_xor(ss, 2); ss += __shfl_xor(ss, 4); ss += __shfl_xor(ss, 8);
        const float rs = rsqrtf(ss * (1.0f / 64.0f) + EPS);
        const f32x4 w = *(const f32x4*)nw;
        u32x2 r; r.x = cvt_pk_bf16(o0 * rs * w[0] * siluf_(lo_bf(gw.x)), o1 * rs * w[1] * siluf_(hi_bf(gw.x)));
        r.y = cvt_pk_bf16(o2 * rs * w[2] * siluf_(lo_bf(gw.y)), o3 * rs * w[3] * siluf_(hi_bf(gw.y)));
        *(u32x2*)(br + (size_t)tok * 1024 + slot * 256 + lane * 4) = r;
    }
}

constexpr int PH_PER_LAYER = 9, N_PHASES = 4 * PH_PER_LAYER + 1;
__device__ __forceinline__ void run_phase(KPR p, int ph, LAS unsigned char* lds, int bid, int G) {
    unsigned char* ws = p.ws;
    if (ph == N_PHASES - 1) { phase_norm(p, p.in[34], 2, bid, G); return; }
    const int layer = ph / PH_PER_LAYER, s = ph - layer * PH_PER_LAYER;
    pg8::Sched S; pg8::Gemm g;
    switch (s) {
    case 0: phase_convert(p, layer, (LAS float*)lds, bid, G); phase_norm(p, p.in[8] + layer * 1024, layer == 0 ? 0 : 1, bid, G); break;
    case 1: { S.init(65, 30, 1, G, bid); g = pg8::Gemm{(const bf16_t*)(ws + OFF_XN), (const bf16_t*)(ws + OFF_WIN), 1024, 1024, 16, 0, 0};
              pg8::gemm_phase(lds, g, S, EpiIn{(bf16_t*)(ws + OFF_PM), (bf16_t*)(ws + OFF_GATES)}); } break;
    case 2: phase_mix(p, layer, lds, bid, G); break;
    case 3: { S.init(65, 2, 1, G, bid); g = pg8::Gemm{(const bf16_t*)(ws + OFF_YG), (const bf16_t*)(ws + OFF_WGLU), 256, 256, 4, 0, 0};
              pg8::gemm_phase(lds, g, S, EpiGlu{(bf16_t*)(ws + OFF_BR)}); phase_headnorm(p, layer, bid, G); } break;
    case 4: { S.init(65, 4, 4, G, bid); g = pg8::Gemm{(const bf16_t*)(ws + OFF_BR), (const bf16_t*)(ws + OFF_WBR), 1024, 256, 4, 256, (size_t)1024 * 256};
              pg8::gemm_phase(lds, g, S, EpiBr{(const bf16_t*)(ws + OFF_GATES), (bf16_t*)(ws + OFF_PM)}); } break;
    case 5: { S.init(65, 4, 1, G, bid); g = pg8::Gemm{(const bf16_t*)(ws + OFF_PM), (const bf16_t*)(ws + OFF_WOUT), 1024, 1024, 16, 0, 0};
              pg8::gemm_phase(lds, g, S, EpiRes{(float*)(ws + OFF_H)}); } break;
    case 6: phase_norm(p, p.in[30] + layer * 1024, 1, bid, G); break;
    case 7: { S.init(65, 22, 1, G, bid); g = pg8::Gemm{(const bf16_t*)(ws + OFF_XN), (const bf16_t*)(ws + OFF_WGU), 1024, 1024, 16, 0, 0};
              pg8::gemm_phase(lds, g, S, EpiGU{(bf16_t*)(ws + OFF_PM)}); } break;
    case 8: { S.init(65, 4, 1, G, bid); g = pg8::Gemm{(const bf16_t*)(ws + OFF_PM), (const bf16_t*)(ws + OFF_WDN), DFF, DFF, 44, 0, 0};
              pg8::gemm_phase(lds, g, S, EpiRes{(float*)(ws + OFF_H)}); } break;
    }
}

extern __shared__ __attribute__((aligned(16))) unsigned char dyn_smem[];
#if MULTI_LAUNCH
__global__ void __launch_bounds__(512) k_phase(KP parg, int ph) {
    KPR p = *(const CAS KP*)__builtin_amdgcn_kernarg_segment_ptr();
    run_phase(p, ph, (LAS unsigned char*)dyn_smem, blockIdx.x, gridDim.x);
}
#else
__device__ __forceinline__ void grid_bar(unsigned* bar, unsigned k, int bid, int G) {
    asm volatile("s_waitcnt vmcnt(0)" ::: "memory");
    __syncthreads();
    if (otid() == 0) {
        __builtin_amdgcn_fence(__ATOMIC_RELEASE, "agent");
        asm volatile("s_waitcnt vmcnt(0)" ::: "memory");
        const unsigned per = (unsigned)G >> 3;
        const unsigned old = __hip_atomic_fetch_add(bar + 64 * (1 + (bid & 7)), 1u, __ATOMIC_RELAXED, __HIP_MEMORY_SCOPE_AGENT);
        if (old == per * k - 1u) __hip_atomic_fetch_add(bar, 1u, __ATOMIC_RELAXED, __HIP_MEMORY_SCOPE_AGENT);
        while (__hip_atomic_load(bar, __ATOMIC_RELAXED, __HIP_MEMORY_SCOPE_AGENT) < 8u * k) __builtin_amdgcn_s_sleep(1);
    }
    __syncthreads();
    __builtin_amdgcn_fence(__ATOMIC_ACQUIRE, "agent");
    asm volatile("s_waitcnt vmcnt(0)" ::: "memory");
}
template <int PH> __device__ __forceinline__ void run_from(KPR p, cg::grid_group& grid) {
    const CAS KP* pp = &p; asm volatile("" : "+s"(pp));
    int bid = blockIdx.x, G = gridDim.x; asm volatile("" : "+s"(bid), "+s"(G));
    run_phase(*pp, PH, (LAS unsigned char*)dyn_smem, bid, G);
    if constexpr (PH + 1 < N_PHASES) {
        if constexpr (PH == 0) grid.sync();
        else grid_bar((unsigned*)(pp->ws + OFF_BAR), (unsigned)PH, bid, G);
        run_from<PH + 1>(p, grid);
    }
}
__global__ void __launch_bounds__(512) k_mega(KP parg) {
    cg::grid_group grid = cg::this_grid();
    KPR p = *(const CAS KP*)__builtin_amdgcn_kernarg_segment_ptr();
    run_from<0>(p, grid);
}
#endif

extern "C" void kernel_launch(void* const* d_in, const int* in_sizes, int n_in, void* d_out, int out_size, void* d_ws, size_t ws_size, hipStream_t stream) {
    if (ws_size < WS_NEED || n_in < 35) { fprintf(stderr, "workspace too small: %zu < %zu\n", ws_size, (size_t)WS_NEED); return; }
    KP p{};
    for (int i = 0; i < 35; ++i) p.in[i] = (const float*)d_in[i];
    p.out = (float*)d_out; p.ws = (unsigned char*)d_ws;
    constexpr size_t kDynLds = pg8::STAGE_BYTES;
#if MULTI_LAUNCH
    static bool once = false;
    if (!once) { hipFuncSetAttribute((const void*)k_phase, hipFuncAttributeMaxDynamicSharedMemorySize, (int)kDynLds); once = true; }
    for (int ph = 0; ph < N_PHASES; ++ph) hipLaunchKernelGGL(k_phase, dim3(256), dim3(512), kDynLds, stream, p, ph);
#else
    static int grid_blocks = 0;
    if (!grid_blocks) {
        hipFuncSetAttribute((const void*)k_mega, hipFuncAttributeMaxDynamicSharedMemorySize, (int)kDynLds);
        int dev = 0, cus = 0, per_cu = 0;
        hipGetDevice(&dev);
        hipDeviceGetAttribute(&cus, hipDeviceAttributeMultiprocessorCount, dev);
        hipOccupancyMaxActiveBlocksPerMultiprocessor(&per_cu, k_mega, 512, kDynLds);
        if (per_cu < 1) per_cu = 1;
        grid_blocks = cus * per_cu; if (grid_blocks > 256) grid_blocks = 256;
    }
    hipMemsetAsync((unsigned char*)d_ws + OFF_BAR, 0, 4096, stream);
    void* args[] = {&p};
    hipError_t e = hipLaunchCooperativeKernel((void*)k_mega, dim3(grid_blocks), dim3(512), args, kDynLds, stream);
    if (e != hipSuccess) fprintf(stderr, "cooperative launch failed: %s (grid %d)\n", hipGetErrorString(e), grid_blocks);
#endif
}
```

```cpp
#include <hip/hip_runtime.h>
#include <hip/hip_cooperative_groups.h>
#include <cstdio>
namespace cg = cooperative_groups;

#ifndef MULTI_LAUNCH
#define MULTI_LAUNCH 0
#endif

#define LAS __attribute__((address_space(3)))
typedef unsigned short bf16_t;
typedef short bf16x8 __attribute__((ext_vector_type(8)));
typedef float f32x4 __attribute__((ext_vector_type(4)));
typedef float f32x2 __attribute__((ext_vector_type(2)));
typedef unsigned u32x2 __attribute__((ext_vector_type(2)));
typedef unsigned u32x4 __attribute__((ext_vector_type(4)));

constexpr int DM = 1024, SEQ = 2048, NBATCH = 8, NDEC = 128;
constexpr int MPROMPT = NBATCH * SEQ;
constexpr int MTOK = MPROMPT + NDEC;
constexpr int MP = 16640;
constexpr int NPM = 3584, NGATE = 4096, NIN = 7448, DFF = 2816;
constexpr int A_QKV = 0, A_GATE = 768, B_Q = 1024, B_K = 1280, B_V = 1536, B_GATE = 1792, C_U = 2048, D_Q = 2304, D_F = 2560, D_I = 2816, D_GATE = 3072,
              A_ALPHA = 3328, A_BETA = 3332, B_GK = 3336;
constexpr float EPS = 1e-6f;

constexpr size_t SZ_WIN = (size_t)7680 * 1024 * 2, SZ_WGU = (size_t)5632 * 1024 * 2, SZ_WDN = (size_t)1024 * 2816 * 2, SZ_WOUT = (size_t)1024 * 1024 * 2,
                 SZ_WBR = (size_t)4096 * 256 * 2, SZ_WGLU = (size_t)512 * 256 * 2;
constexpr size_t OFF_WIN = 0, OFF_WGU = OFF_WIN + SZ_WIN, OFF_WDN = OFF_WGU + SZ_WGU, OFF_WOUT = OFF_WDN + SZ_WDN, OFF_WBR = OFF_WOUT + SZ_WOUT,
                 OFF_WGLU = OFF_WBR + SZ_WBR, OFF_H = OFF_WGLU + SZ_WGLU, OFF_XN = OFF_H + (size_t)MP * 1024 * 4, OFF_BR = OFF_XN + (size_t)MP * 1024 * 2,
                 OFF_PM = OFF_BR + (size_t)MP * 1024 * 2, OFF_GATES = OFF_PM + (size_t)MP * NPM * 2, OFF_ORAW = OFF_GATES + (size_t)MP * NGATE * 2,
                 OFF_YG = OFF_ORAW + (size_t)MP * 768 * 2, OFF_BAR = OFF_YG + (size_t)MP * 256 * 2, WS_NEED = OFF_BAR + 4096;
constexpr size_t O_PCONV = 16908288, O_PGDN = 16982016, O_PGLA = 17506304, O_PS5R = 18030592, O_PS5I = 18063360, O_PHG = 18096128,
                 O_SCONV = 18620416, O_SGDN = 19800064, O_SGLA = 28188672, O_SS5R = 36577280, O_SS5I = 37101568, O_SHG = 37625856;

struct KP { const float* in[35]; float* out; unsigned char* ws; };
#define CAS __attribute__((address_space(4)))
typedef const CAS KP& KPR;

__device__ __forceinline__ int otid() { return threadIdx.x; }
__device__ __forceinline__ float bf2f(bf16_t b) { return __uint_as_float(((unsigned)b) << 16); }
typedef __bf16 bf16x2_t __attribute__((ext_vector_type(2)));
__device__ __forceinline__ unsigned cvt_pk_bf16(float lo, float hi) { const f32x2 f = {lo, hi}; const bf16x2_t v = __builtin_convertvector(f, bf16x2_t); return __builtin_bit_cast(unsigned, v); }
__device__ __forceinline__ bf16_t f2bf(float f) { return (bf16_t)(cvt_pk_bf16(f, 0.f) & 0xffffu); }
__device__ __forceinline__ float lo_bf(unsigned w) { return __uint_as_float(w << 16); }
__device__ __forceinline__ float hi_bf(unsigned w) { return __uint_as_float(w & 0xffff0000u); }
__device__ __forceinline__ float sigmoidf_(float x) { return __builtin_amdgcn_rcpf(1.0f + __expf(-x)); }
__device__ __forceinline__ float siluf_(float x) { return x * __builtin_amdgcn_rcpf(1.0f + __expf(-x)); }
__device__ __forceinline__ float wave_sum(float v) {
#pragma unroll
    for (int o = 32; o >= 1; o >>= 1) v += __shfl_xor(v, o);
    return v;
}
template <int CTRL> __device__ __forceinline__ float dpp_f(float v) { return __int_as_float(__builtin_amdgcn_update_dpp(0, __float_as_int(v), CTRL, 0xf, 0xf, true)); }
__device__ __forceinline__ float red16(float v) { v += dpp_f<0xB1>(v); v += dpp_f<0x4E>(v); v += dpp_f<0x141>(v); v += dpp_f<0x140>(v); return v; }
__device__ __forceinline__ float red8(float v) { v += dpp_f<0xB1>(v); v += dpp_f<0x4E>(v); v += dpp_f<0x141>(v); return v; }

namespace pg8 {
constexpr int BM = 256, BK = 64, HALF = 128, HTB = HALF * BK * 2, STAGE_BYTES = 8 * HTB, NXCD = 8, WGM = 8;
__device__ __forceinline__ int lds_byte(int r, int c) { const int st = (r >> 4) * 2 + (c >> 5), rr = r & 15, cc = c & 31, ob = rr * 64 + cc * 2; return st * 1024 + (ob ^ (((ob >> 9) & 1) << 5)); }
__device__ __forceinline__ void stage_rc(int b, int& R, int& C) { const int st = b / 1024, sb = b % 1024, swz = sb ^ (((sb >> 9) & 1) << 5); R = (st >> 1) * 16 + swz / 64; C = (st & 1) * 32 + (swz % 64) / 2; }

struct Unit { int pm, pn, kk, k0, nt; };
struct Gemm { const bf16_t* A; const bf16_t* Bt; int lda, ldb, nt; size_t a_kk, b_kk; };
struct Sched {
    int nM, nN, nKK, nwg, G, c, ntf, nts, nextra;
    __device__ void init(int nM_, int nN_, int nKK_, int G_, int c_, int ntf_, int nts_ = 0) { nM = nM_; nN = nN_; nKK = nKK_; nwg = nM * nN; G = G_; c = c_; ntf = ntf_; nts = nts_; nextra = nts_ ? nN_ * (ntf_ / nts_) : 0; }
    __device__ bool next(int i, Unit& u) const {
        const int it = i / nKK; u.kk = i - it * nKK; u.k0 = 0; u.nt = ntf;
        const long L = (long)it * G + c;
        if (L >= nwg) { const int e = (int)(L - nwg); if (e >= nextra) return false; u.pm = nM; u.pn = e % nN; u.k0 = (e / nN) * nts; u.nt = nts; return true; }
        int wgid = (int)L; { const int q = nwg / NXCD, r = nwg % NXCD, xcd = wgid % NXCD, off = wgid / NXCD; wgid = (xcd < r ? xcd * (q + 1) : r * (q + 1) + (xcd - r) * q) + off; }
        const int nig = WGM * nN, gid = wgid / nig, fm = gid * WGM, gsz = (nM - fm) < WGM ? (nM - fm) : WGM;
        u.pm = fm + ((wgid % nig) % gsz); u.pn = (wgid % nig) / gsz; return true;
    }
};

template <class Epi>
__device__ __forceinline__ void gemm_phase(LAS unsigned char* lds, const Gemm g, const Sched& S, const Epi& E) {
    const int tid = otid(), wid = __builtin_amdgcn_readfirstlane(tid >> 6), lane = tid & 63, wr = wid >> 2, wc = wid & 3, fr = lane & 15, fq = lane >> 4;
    unsigned voffA[2], voffB[2];
#pragma unroll
    for (int i = 0; i < 2; ++i) { int R, C; stage_rc(tid * 16 + i * 8192, R, C); voffA[i] = (unsigned)(R * g.lda + C) * 2u; voffB[i] = (unsigned)(R * g.ldb + C) * 2u; }
    const size_t kstep = (size_t)(BK * 2);
    const size_t hstepA = (size_t)HALF * g.lda * 2, hstepB = (size_t)HALF * g.ldb * 2;
    const size_t tstepA = 2 * hstepA, tstepB = 2 * hstepB;
    const unsigned ldsw = (unsigned)wid * 1024u;
    const int aoff = lds_byte(wr * 64 + fr, fq * 8), boff = lds_byte(wc * 32 + fr, fq * 8);
#define PG8_SA(b, h) (((b) * 2 + (h)) * HTB)
#define PG8_SB(b, h) ((4 + (b) * 2 + (h)) * HTB)
#define PG8_STAGE(bufoff, gbase, voff) do { _Pragma("unroll") for (int _i = 0; _i < 2; ++_i) \
        __builtin_amdgcn_global_load_lds((const unsigned*)((const char*)(gbase) + (voff)[_i]), (LAS unsigned*)(lds + (bufoff) + ldsw + _i * 8192), 16, 0, 0); } while (0)
#define PG8_LDA(dst, b, h) do { _Pragma("unroll") for (int m = 0; m < 4; ++m) _Pragma("unroll") for (int k = 0; k < 2; ++k) dst[m][k] = *(const LAS bf16x8*)(lds + PG8_SA(b, h) + aoff + m * 2048 + k * 1024); } while (0)
#define PG8_LDB(dst, b, h) do { _Pragma("unroll") for (int n = 0; n < 2; ++n) _Pragma("unroll") for (int k = 0; k < 2; ++k) dst[n][k] = *(const LAS bf16x8*)(lds + PG8_SB(b, h) + boff + n * 2048 + k * 1024); } while (0)
#define PG8_MMA(ai, bj, At, Bt) do { __builtin_amdgcn_s_setprio(1); _Pragma("unroll") for (int m = 0; m < 4; ++m) _Pragma("unroll") for (int n = 0; n < 2; ++n) _Pragma("unroll") for (int k = 0; k < 2; ++k) \
        acc[ai][bj][m][n] = __builtin_amdgcn_mfma_f32_16x16x32_bf16(Bt[n][k], At[m][k], acc[ai][bj][m][n], 0, 0, 0); __builtin_amdgcn_s_setprio(0); } while (0)
#define PG8_WAIT_V(n) asm volatile("s_waitcnt vmcnt(" #n ")" ::: "memory")
#define PG8_WAIT_L(n) asm volatile("s_waitcnt lgkmcnt(" #n ")" ::: "memory")
#define PG8_BAR __builtin_amdgcn_s_barrier()
#define PG8_SCHED __builtin_amdgcn_sched_barrier(0)
    Unit cur, nxt; int ui = 0;
    if (!S.next(0, cur)) return;
    f32x4 acc[2][2][4][2];
#pragma unroll
    for (int a = 0; a < 2; ++a)
#pragma unroll
        for (int b = 0; b < 2; ++b)
#pragma unroll
            for (int m = 0; m < 4; ++m)
#pragma unroll
                for (int n = 0; n < 2; ++n) acc[a][b][m][n] = (f32x4){0.f, 0.f, 0.f, 0.f};
    bf16x8 At[4][2], B0[2][2], B1[2][2];
    const char* cA = (const char*)(g.A + (size_t)cur.kk * g.a_kk) + (size_t)cur.pm * tstepA + (size_t)cur.k0 * kstep; const char* cB = (const char*)(g.Bt + (size_t)cur.kk * g.b_kk) + (size_t)cur.pn * tstepB + (size_t)cur.k0 * kstep;
    PG8_STAGE(PG8_SB(0, 0), cB, voffB); PG8_STAGE(PG8_SA(0, 0), cA, voffA); PG8_STAGE(PG8_SB(0, 1), cB + hstepB, voffB); PG8_STAGE(PG8_SA(0, 1), cA + hstepA, voffA);
    if (wr == 1) PG8_BAR;
    PG8_WAIT_V(4); PG8_BAR;
    PG8_STAGE(PG8_SB(1, 0), cB + kstep, voffB); PG8_STAGE(PG8_SA(1, 0), cA + kstep, voffA); PG8_STAGE(PG8_SB(1, 1), cB + hstepB + kstep, voffB);
    PG8_WAIT_V(6); PG8_BAR;
    for (;;) {
        const bool has_next = S.next(ui + 1, nxt);
        const char* nA = has_next ? (const char*)(g.A + (size_t)nxt.kk * g.a_kk) + (size_t)nxt.pm * tstepA + (size_t)nxt.k0 * kstep : cA;
        const char* nB = has_next ? (const char*)(g.Bt + (size_t)nxt.kk * g.b_kk) + (size_t)nxt.pn * tstepB + (size_t)nxt.k0 * kstep : cB;
        int nt = cur.nt; asm volatile("" : "+s"(nt));
        for (int t = 0; t < nt; t += 2) {
            const bool last = (t == nt - 2);
            const char* a1 = cA + (size_t)(t + 1) * kstep;
            const char* a2 = last ? nA : cA + (size_t)(t + 2) * kstep; const char* b2 = last ? nB : cB + (size_t)(t + 2) * kstep;
            const char* a3 = a2 + kstep; const char* b3 = b2 + kstep;
            PG8_LDB(B0, 0, 0); PG8_SCHED; PG8_LDA(At, 0, 0); PG8_STAGE(PG8_SA(1, 1), a1 + hstepA, voffA);
            PG8_WAIT_L(8); PG8_BAR; PG8_WAIT_L(0); PG8_MMA(0, 0, At, B0); PG8_BAR; PG8_SCHED;
            PG8_LDB(B1, 0, 1); PG8_STAGE(PG8_SB(0, 0), b2, voffB);
            PG8_BAR; PG8_WAIT_L(0); PG8_MMA(0, 1, At, B1); PG8_BAR;
            PG8_LDA(At, 0, 1); PG8_STAGE(PG8_SA(0, 0), a2, voffA);
            PG8_BAR; PG8_WAIT_L(0); PG8_MMA(1, 0, At, B0); PG8_BAR; PG8_SCHED;
            PG8_STAGE(PG8_SB(0, 1), b2 + hstepB, voffB);
            PG8_WAIT_V(6); PG8_BAR; PG8_MMA(1, 1, At, B1); PG8_BAR;
            PG8_LDB(B0, 1, 0); PG8_SCHED; PG8_LDA(At, 1, 0); PG8_STAGE(PG8_SA(0, 1), a2 + hstepA, voffA);
            PG8_WAIT_L(8); PG8_BAR; PG8_WAIT_L(0); PG8_MMA(0, 0, At, B0); PG8_BAR; PG8_SCHED;
            PG8_LDB(B1, 1, 1); PG8_STAGE(PG8_SB(1, 0), b3, voffB);
            PG8_BAR; PG8_WAIT_L(0); PG8_MMA(0, 1, At, B1); PG8_BAR;
            PG8_LDA(At, 1, 1); PG8_STAGE(PG8_SA(1, 0), a3, voffA);
            PG8_BAR; PG8_WAIT_L(0); PG8_MMA(1, 0, At, B0); PG8_BAR; PG8_SCHED;
            PG8_STAGE(PG8_SB(1, 1), b3 + hstepB, voffB);
            PG8_WAIT_V(6); PG8_BAR; PG8_MMA(1, 1, At, B1); PG8_BAR;
        }
        E(acc, cur, wr, wc, fr, fq);
        if (!has_next) break;
#pragma unroll
        for (int a = 0; a < 2; ++a)
#pragma unroll
            for (int b = 0; b < 2; ++b)
#pragma unroll
                for (int m = 0; m < 4; ++m)
#pragma unroll
                    for (int n = 0; n < 2; ++n) acc[a][b][m][n] = (f32x4){0.f, 0.f, 0.f, 0.f};
        cur = nxt; cA = nA; cB = nB; ++ui;
    }
    PG8_WAIT_V(0);
    if (wr == 0) PG8_BAR;
    PG8_BAR;
    __builtin_amdgcn_s_waitcnt(0);
#undef PG8_SA
#undef PG8_SB
#undef PG8_STAGE
#undef PG8_LDA
#undef PG8_LDB
#undef PG8_MMA
#undef PG8_WAIT_V
#undef PG8_WAIT_L
#undef PG8_BAR
#undef PG8_SCHED
}
}
using pg8::Unit;

#define EPI_LOOP_BEGIN _Pragma("unroll") for (int ai = 0; ai < 2; ++ai) _Pragma("unroll") for (int m = 0; m < 4; ++m) { const size_t row = (size_t)(u.pm * 256 + ai * 128 + wr * 64 + m * 16 + fr); \
        _Pragma("unroll") for (int bj = 0; bj < 2; ++bj) {
#define EPI_LOOP_END } }
struct EpiIn {
    bf16_t* pm; bf16_t* gates;
    __device__ __forceinline__ void operator()(const f32x4 (&acc)[2][2][4][2], const Unit& u, int wr, int wc, int fr, int fq) const {
        const bool main_ = u.pn < 14;
        EPI_LOOP_BEGIN
#pragma unroll
            for (int n = 0; n < 2; ++n) { const int col = u.pn * 256 + bj * 128 + wc * 32 + n * 16 + fq * 4; f32x4 v = acc[ai][bj][m][n]; u32x2 w;
                if (main_) { w.x = cvt_pk_bf16(v[0], v[1]); w.y = cvt_pk_bf16(v[2], v[3]); *(u32x2*)(pm + row * NPM + col) = w; }
                else { w.x = cvt_pk_bf16(sigmoidf_(v[0]), sigmoidf_(v[1])); w.y = cvt_pk_bf16(sigmoidf_(v[2]), sigmoidf_(v[3])); *(u32x2*)(gates + row * NGATE + (col - NPM)) = w; } }
        EPI_LOOP_END
    }
};
struct EpiGlu {
    bf16_t* br;
    __device__ __forceinline__ void operator()(const f32x4 (&acc)[2][2][4][2], const Unit& u, int wr, int wc, int fr, int fq) const {
        EPI_LOOP_BEGIN
            const int j = u.pn * 128 + bj * 64 + wc * 16 + fq * 4; const f32x4 a = acc[ai][bj][m][0], b = acc[ai][bj][m][1]; u32x2 w;
            w.x = cvt_pk_bf16(a[0] * sigmoidf_(b[0]), a[1] * sigmoidf_(b[1])); w.y = cvt_pk_bf16(a[2] * sigmoidf_(b[2]), a[3] * sigmoidf_(b[3]));
            *(u32x2*)(br + row * 1024 + 512 + j) = w;
        EPI_LOOP_END
    }
};
struct EpiGU {
    bf16_t* a;
    __device__ __forceinline__ void operator()(const f32x4 (&acc)[2][2][4][2], const Unit& u, int wr, int wc, int fr, int fq) const {
        EPI_LOOP_BEGIN
            const int j = u.pn * 128 + bj * 64 + wc * 16 + fq * 4; const f32x4 g = acc[ai][bj][m][0], b = acc[ai][bj][m][1]; u32x2 w;
            w.x = cvt_pk_bf16(siluf_(g[0]) * b[0], siluf_(g[1]) * b[1]); w.y = cvt_pk_bf16(siluf_(g[2]) * b[2], siluf_(g[3]) * b[3]);
            *(u32x2*)(a + row * DFF + j) = w;
        EPI_LOOP_END
    }
};
struct EpiBr {
    const bf16_t* gates; bf16_t* mm;
    __device__ __forceinline__ void operator()(const f32x4 (&acc)[2][2][4][2], const Unit& u, int wr, int wc, int fr, int fq) const {
        const int col0 = u.pn * 256 + wc * 32 + fq * 4;
#pragma unroll
        for (int ai = 0; ai < 2; ++ai) {
            const size_t row0 = (size_t)(u.pm * 256 + ai * 128 + wr * 64 + fr);
            u32x2 gw[4][2][2], pw[4][2][2];
#pragma unroll
            for (int m = 0; m < 4; ++m)
#pragma unroll
                for (int bj = 0; bj < 2; ++bj)
#pragma unroll
                    for (int n = 0; n < 2; ++n) { const size_t row = row0 + m * 16; const int col = col0 + bj * 128 + n * 16;
                        gw[m][bj][n] = *(const u32x2*)(gates + row * NGATE + u.kk * 1024 + col);
                        pw[m][bj][n] = (u32x2){0u, 0u}; if (u.kk > 0) pw[m][bj][n] = *(const u32x2*)(mm + row * 1024 + col); }
#pragma unroll
            for (int m = 0; m < 4; ++m)
#pragma unroll
                for (int bj = 0; bj < 2; ++bj)
#pragma unroll
                    for (int n = 0; n < 2; ++n) { const size_t row = row0 + m * 16; const int col = col0 + bj * 128 + n * 16; const f32x4 v = acc[ai][bj][m][n]; const u32x2 g = gw[m][bj][n], q = pw[m][bj][n];
                        u32x2 w; w.x = cvt_pk_bf16(lo_bf(g.x) * v[0] + lo_bf(q.x), hi_bf(g.x) * v[1] + hi_bf(q.x)); w.y = cvt_pk_bf16(lo_bf(g.y) * v[2] + lo_bf(q.y), hi_bf(g.y) * v[3] + hi_bf(q.y));
                        *(u32x2*)(mm + row * 1024 + col) = w; }
        }
    }
};
struct EpiRes {
    float* h;
    __device__ __forceinline__ void operator()(const f32x4 (&acc)[2][2][4][2], const Unit& u, int wr, int wc, int fr, int fq) const {
        const bool split = u.pm == 64;
        EPI_LOOP_BEGIN
#pragma unroll
            for (int n = 0; n < 2; ++n) { const int col = u.pn * 256 + bj * 128 + wc * 32 + n * 16 + fq * 4; float* ptr = h + row * 1024 + col;
                if (split) {
#pragma unroll
                    for (int e = 0; e < 4; ++e) __hip_atomic_fetch_add(ptr + e, acc[ai][bj][m][n][e], __ATOMIC_RELAXED, __HIP_MEMORY_SCOPE_AGENT);
                } else { const f32x4 o = *(const f32x4*)ptr; *(f32x4*)ptr = o + acc[ai][bj][m][n]; } }
        EPI_LOOP_END
    }
};

__device__ __forceinline__ int win_src_col(int n) {
    if (n < 768) return n;
    if (n < 1024) return 776 + (n - 768);
    if (n < 1792) return 1032 + (n - 1024);
    if (n < 2048) return 1816 + (n - 1792);
    if (n < 2304) return 2072 + (n - 2048);
    if (n < 3072) return 2328 + (n - 2304);
    if (n < 3328) return 3096 + (n - 3072);
    if (n < 3336) return 768 + (n - 3328);
    if (n < 3352) return 1800 + (n - 3336);
    if (n < 3584) return -1;
    return 3352 + (n - 3584);
}
__device__ __forceinline__ void phase_convert(KPR p, int layer, LAS float* tile, int bid, int G) {
    const int tid = otid(), tn = tid & 63, tk = __builtin_amdgcn_readfirstlane(tid >> 6);
    constexpr int T0 = 120 * 16, T1 = T0 + 88 * 16, T2 = T1 + 16 * 44, T3 = T2 + 16 * 16, T4 = T3 + 64 * 4, T5 = T4 + 8 * 4;
    for (int j = bid; j < T5; j += G) {
        int n0, k0, K, ld; bf16_t* dst; const float* cp = nullptr;
        if (j < T0) { const int q = j; n0 = (q >> 4) * 64; k0 = (q & 15) * 64; K = 1024; ld = NIN; dst = (bf16_t*)(p.ws + OFF_WIN);
            const int sc = win_src_col(n0 + tn); if (sc >= 0) cp = p.in[9] + (size_t)layer * 1024 * NIN + sc; }
        else if (j < T1) { const int q = j - T0; n0 = (q >> 4) * 64; k0 = (q & 15) * 64; K = 1024; ld = DFF; dst = (bf16_t*)(p.ws + OFF_WGU);
            const int n = n0 + tn, g32 = n >> 5, w = n & 31, jj = g32 * 16 + (w & 15); cp = (w < 16 ? p.in[31] : p.in[32]) + (size_t)layer * 1024 * DFF + jj; }
        else if (j < T2) { const int q = j - T1; n0 = (q / 44) * 64; k0 = (q % 44) * 64; K = DFF; ld = 1024; dst = (bf16_t*)(p.ws + OFF_WDN);
            cp = p.in[33] + (size_t)layer * DFF * 1024 + (n0 + tn); }
        else if (j < T3) { const int q = j - T2; n0 = (q >> 4) * 64; k0 = (q & 15) * 64; K = 1024; ld = 1024; dst = (bf16_t*)(p.ws + OFF_WOUT);
            cp = p.in[29] + (size_t)layer * 1024 * 1024 + (n0 + tn); }
        else if (j < T4) { const int q = j - T3; n0 = (q >> 2) * 64; k0 = (q & 3) * 64; K = 256; ld = 1024; dst = (bf16_t*)(p.ws + OFF_WBR);
            const int n = n0 + tn, kk = n >> 10, d = n & 1023; cp = p.in[28] + ((size_t)(layer * 4 + kk) * 256) * 1024 + d; }
        else { const int q = j - T4; n0 = (q >> 2) * 64; k0 = (q & 3) * 64; K = 256; ld = 512; dst = (bf16_t*)(p.ws + OFF_WGLU);
            const int n = n0 + tn, g32 = n >> 5, w = n & 31, jj = g32 * 16 + (w & 15); cp = p.in[25] + (size_t)layer * 256 * 512 + (w < 16 ? jj : 256 + jj); }
        __syncthreads();
#pragma unroll
        for (int e = 0; e < 8; ++e) { const int k = k0 + tk * 8 + e; tile[tn * 65 + tk * 8 + e] = cp ? cp[(size_t)k * ld] : 0.f; }
        __syncthreads();
        { const int n = tid >> 3, ks = tid & 7; const LAS float* tp = tile + n * 65 + ks * 8; u32x4 w;
          w.x = cvt_pk_bf16(tp[0], tp[1]); w.y = cvt_pk_bf16(tp[2], tp[3]); w.z = cvt_pk_bf16(tp[4], tp[5]); w.w = cvt_pk_bf16(tp[6], tp[7]);
          *(u32x4*)(dst + (size_t)(n0 + n) * K + k0 + ks * 8) = w; }
    }
    __syncthreads();
}

__device__ __forceinline__ void phase_norm(KPR p, const float* w, int mode, int bid, int G) {
    const int tid_ = otid(); const int wid = __builtin_amdgcn_readfirstlane(tid_ >> 6), lane = tid_ & 63;
    float* h = (float*)(p.ws + OFF_H); bf16_t* xn = (bf16_t*)(p.ws + OFF_XN);
    f32x4 wv[4];
#pragma unroll
    for (int i = 0; i < 4; ++i) wv[i] = *(const f32x4*)(w + i * 256 + lane * 4);
    for (int r = bid * 8 + wid; r < MTOK; r += G * 8) {
        const float* src = (mode == 0) ? (r < MPROMPT ? p.in[0] + (size_t)r * 1024 : p.in[1] + (size_t)(r - MPROMPT) * 1024) : h + (size_t)r * 1024;
        f32x4 v[4]; float ss = 0.f;
#pragma unroll
        for (int i = 0; i < 4; ++i) { v[i] = *(const f32x4*)(src + i * 256 + lane * 4); ss += v[i][0] * v[i][0] + v[i][1] * v[i][1] + v[i][2] * v[i][2] + v[i][3] * v[i][3]; }
        ss = wave_sum(ss);
        const float rs = rsqrtf(ss * (1.0f / 1024.0f) + EPS);
#pragma unroll
        for (int i = 0; i < 4; ++i) {
            const f32x4 y = v[i] * rs * wv[i];
            if (mode == 2) *(f32x4*)(p.out + (size_t)r * 1024 + i * 256 + lane * 4) = y;
            else { u32x2 o; o.x = cvt_pk_bf16(y[0], y[1]); o.y = cvt_pk_bf16(y[2], y[3]); *(u32x2*)(xn + (size_t)r * 1024 + i * 256 + lane * 4) = o;
                   if (mode == 0) *(f32x4*)(h + (size_t)r * 1024 + i * 256 + lane * 4) = v[i]; }
        }
    }
}

constexpr int TCH = 32;
constexpr int MIXBUF_FLOATS = 4 * TCH * 64 + TCH * 4;
template <int MIX>
__device__ __forceinline__ void mix_item(KPR p, int layer, LAS float* lds, int tokbase, int L, int h, int col0, int ncols,
                         const float* s_in, float* s_out, const float* conv_in, float* conv_out) {
    const int tid = otid(), wid = __builtin_amdgcn_readfirstlane(tid >> 6), lane = tid & 63;
    const int nscan = ncols * 8; const bool is_scan = wid < (nscan >> 6);
    const int ksl = lane & 7, cl = wid * 8 + (lane >> 3), col = col0 + cl;
    const bf16_t* pm = (const bf16_t*)(p.ws + OFF_PM);
    bf16_t* oraw = (bf16_t*)(p.ws + OFF_ORAW);
    __syncthreads();
    float S[8];
#pragma unroll
    for (int i = 0; i < 8; ++i) S[i] = (is_scan && s_in) ? s_in[(ksl * 8 + i) * 64 + col] : 0.f;
    const int tl = lane >> 4, d4 = (lane & 15) * 4, hd4 = h * 64 + d4;
    f32x4 cw[3][4]; float c_a = 0.f, c_dt = 0.f; f32x4 gkw[16]; f32x4 gkb = (f32x4){0.f, 0.f, 0.f, 0.f}, lb4 = (f32x4){0.f, 0.f, 0.f, 0.f};
    if (MIX == 0) {
        const float* cwp = p.in[10] + (size_t)layer * 4 * 768;
#pragma unroll
        for (int s = 0; s < 3; ++s)
#pragma unroll
            for (int j = 0; j < 4; ++j) cw[s][j] = *(const f32x4*)(cwp + j * 768 + s * 256 + hd4);
        c_a = -__expf(p.in[11][layer * 4 + h]); c_dt = p.in[12][layer * 4 + h];
        if (conv_out && col0 == 0 && h == 0) {
            for (int idx = tid; idx < 3 * 768; idx += 512) { const int i = idx / 768, c = idx - i * 768, ti = L - 3 + i;
                conv_out[idx] = ti >= 0 ? bf2f(pm[(size_t)(tokbase + ti) * NPM + A_QKV + c]) : (conv_in ? conv_in[(3 + ti) * 768 + c] : 0.f); }
        }
    } else if (MIX == 1) {
#pragma unroll
        for (int r = 0; r < 16; ++r) gkw[r] = *(const f32x4*)(p.in[14] + ((size_t)layer * 16 + r) * 256 + hd4);
        gkb = *(const f32x4*)(p.in[15] + layer * 256 + hd4);
    } else {
        const float* lg = p.in[26] + hd4; const f32x4 a0 = *(const f32x4*)lg, a1 = *(const f32x4*)(lg + 256), a2 = *(const f32x4*)(lg + 512), a3 = *(const f32x4*)(lg + 768);
#pragma unroll
        for (int e = 0; e < 4; ++e) {
            const float mx = fmaxf(fmaxf(a0[e], a1[e]), fmaxf(a2[e], a3[e])); const float l0 = __expf(a0[e] - mx), l1 = __expf(a1[e] - mx), l2 = __expf(a2[e] - mx), l3 = __expf(a3[e] - mx);
            const float inv = 1.0f / (l0 + l1 + l2 + l3);
            lb4[e] = (layer == 0) ? 0.f : (layer == 1) ? l1 * inv : (layer == 2) ? (l1 + l2) * inv : (l1 + l2 + l3) * inv;
        }
    }
    const int nch = (L + TCH - 1) / TCH;
    auto prep = [&](int c, int pw, int npw) {
        LAS float* kb = lds + (c & 1) * MIXBUF_FLOATS; LAS float* qb = kb + TCH * 64; LAS float* fb = qb + TCH * 64; LAS float* vb = fb + TCH * 64; LAS float* sc = vb + TCH * 64;
#pragma unroll
        for (int pass = 0; pass < 2; ++pass) {
            const int tt0 = (pass * npw + pw) * 4;
            if (tt0 < TCH) {
                const int tt = tt0 + tl, t = c * TCH + tt;
                if (t < L) {
                    const bf16_t* row = pm + (size_t)(tokbase + t) * NPM;
                    if (MIX == 0) {
                        f32x4 y[3];
#pragma unroll
                        for (int s = 0; s < 3; ++s) { f32x4 a = (f32x4){0.f, 0.f, 0.f, 0.f};
#pragma unroll
                            for (int j = 0; j < 4; ++j) { const int ti = t - 3 + j; f32x4 xv = (f32x4){0.f, 0.f, 0.f, 0.f};
                                if (ti >= 0) { const u32x2 w = *(const u32x2*)(pm + (size_t)(tokbase + ti) * NPM + A_QKV + s * 256 + hd4); xv = (f32x4){lo_bf(w.x), hi_bf(w.x), lo_bf(w.y), hi_bf(w.y)}; }
                                else if (conv_in) xv = *(const f32x4*)(conv_in + (3 + ti) * 768 + s * 256 + hd4);
                                a += xv * cw[s][j]; }
                            y[s] = (f32x4){siluf_(a[0]), siluf_(a[1]), siluf_(a[2]), siluf_(a[3])}; }
                        const float qq = red16(y[0][0] * y[0][0] + y[0][1] * y[0][1] + y[0][2] * y[0][2] + y[0][3] * y[0][3]);
                        const float kk2 = red16(y[1][0] * y[1][0] + y[1][1] * y[1][1] + y[1][2] * y[1][2] + y[1][3] * y[1][3]);
                        const f32x4 qn = y[0] * (rsqrtf(qq + EPS) * 0.125f), kn = y[1] * rsqrtf(kk2 + EPS);
                        const float kq = red16(qn[0] * kn[0] + qn[1] * kn[1] + qn[2] * kn[2] + qn[3] * kn[3]);
                        *(LAS f32x4*)(kb + tt * 64 + d4) = kn; *(LAS f32x4*)(qb + tt * 64 + d4) = qn; *(LAS f32x4*)(vb + tt * 64 + d4) = y[2];
                        if ((lane & 15) == 0) { const float al = bf2f(row[A_ALPHA + h]) + c_dt; const float sp = fmaxf(al, 0.f) + __logf(1.0f + __expf(-fabsf(al)));
                            *(LAS f32x4*)(sc + tt * 4) = (f32x4){__expf(c_a * sp), sigmoidf_(bf2f(row[A_BETA + h])), kq, 0.f}; }
                    } else if (MIX == 1) {
                        const u32x4 g0 = *(const u32x4*)(row + B_GK), g1 = *(const u32x4*)(row + B_GK + 8);
                        const u32x2 wq = *(const u32x2*)(row + B_Q + hd4), wk = *(const u32x2*)(row + B_K + hd4), wv = *(const u32x2*)(row + B_V + hd4);
                        f32x4 z = gkb;
                        z += lo_bf(g0.x) * gkw[0] + hi_bf(g0.x) * gkw[1] + lo_bf(g0.y) * gkw[2] + hi_bf(g0.y) * gkw[3] + lo_bf(g0.z) * gkw[4] + hi_bf(g0.z) * gkw[5] + lo_bf(g0.w) * gkw[6] + hi_bf(g0.w) * gkw[7];
                        z += lo_bf(g1.x) * gkw[8] + hi_bf(g1.x) * gkw[9] + lo_bf(g1.y) * gkw[10] + hi_bf(g1.y) * gkw[11] + lo_bf(g1.z) * gkw[12] + hi_bf(g1.z) * gkw[13] + lo_bf(g1.w) * gkw[14] + hi_bf(g1.w) * gkw[15];
                        f32x4 f;
#pragma unroll
                        for (int e = 0; e < 4; ++e) { const float sp = fmaxf(-z[e], 0.f) + __logf(1.0f + __expf(-fabsf(z[e]))); f[e] = __expf(-sp * (1.0f / 16.0f)); }
                        *(LAS f32x4*)(fb + tt * 64 + d4) = f;
                        *(LAS f32x4*)(qb + tt * 64 + d4) = (f32x4){lo_bf(wq.x), hi_bf(wq.x), lo_bf(wq.y), hi_bf(wq.y)} * 0.125f;
                        *(LAS f32x4*)(kb + tt * 64 + d4) = (f32x4){lo_bf(wk.x), hi_bf(wk.x), lo_bf(wk.y), hi_bf(wk.y)};
                        *(LAS f32x4*)(vb + tt * 64 + d4) = (f32x4){lo_bf(wv.x), hi_bf(wv.x), lo_bf(wv.y), hi_bf(wv.y)};
                    } else {
                        const u32x2 wq = *(const u32x2*)(row + D_Q + hd4), wf = *(const u32x2*)(row + D_F + hd4), wv = *(const u32x2*)(row + D_I + hd4);
                        const f32x4 xq = (f32x4){lo_bf(wq.x), hi_bf(wq.x), lo_bf(wq.y), hi_bf(wq.y)}, xf = (f32x4){lo_bf(wf.x), hi_bf(wf.x), lo_bf(wf.y), hi_bf(wf.y)};
                        f32x4 f, k, q;
#pragma unroll
                        for (int e = 0; e < 4; ++e) { const float sg = sigmoidf_(xf[e]); f[e] = lb4[e] + (1.0f - lb4[e]) * sg; k[e] = (1.0f - lb4[e]) * (1.0f - sg); q[e] = siluf_(xq[e]) * 0.125f; }
                        *(LAS f32x4*)(fb + tt * 64 + d4) = f; *(LAS f32x4*)(kb + tt * 64 + d4) = k; *(LAS f32x4*)(qb + tt * 64 + d4) = q;
                        *(LAS f32x4*)(vb + tt * 64 + d4) = (f32x4){lo_bf(wv.x), hi_bf(wv.x), lo_bf(wv.y), hi_bf(wv.y)};
                    }
                }
            }
        }
    };
    prep(0, wid, 8);
    __syncthreads();
    for (int c = 0; c < nch; ++c) {
        if (is_scan) {
            const LAS float* kb = lds + (c & 1) * MIXBUF_FLOATS; const LAS float* qb = kb + TCH * 64; const LAS float* fb = qb + TCH * 64; const LAS float* vb = fb + TCH * 64; const LAS float* sc = vb + TCH * 64;
            const int ntok = (L - c * TCH) < TCH ? (L - c * TCH) : TCH;
            bf16_t* op = oraw + (size_t)(tokbase + c * TCH) * 768 + MIX * 256 + h * 64 + col;
            const LAS float* kp = kb + ksl * 8; const LAS float* qp = qb + ksl * 8; const LAS float* fp = fb + ksl * 8; const LAS float* vp = vb + col;
            f32x4 k0 = *(const LAS f32x4*)kp, k1 = *(const LAS f32x4*)(kp + 4), q0 = *(const LAS f32x4*)qp, q1 = *(const LAS f32x4*)(qp + 4);
            f32x4 f0 = (f32x4){0.f, 0.f, 0.f, 0.f}, f1 = f0, scv = f0;
            if (MIX == 0) scv = *(const LAS f32x4*)sc; else { f0 = *(const LAS f32x4*)fp; f1 = *(const LAS f32x4*)(fp + 4); }
            float v = vp[0];
#pragma unroll 2
            for (int tt = 0; tt < ntok; ++tt) {
                const int tn = (tt + 1 < TCH) ? tt + 1 : tt;
                const f32x4 nk0 = *(const LAS f32x4*)(kp + tn * 64), nk1 = *(const LAS f32x4*)(kp + tn * 64 + 4), nq0 = *(const LAS f32x4*)(qp + tn * 64), nq1 = *(const LAS f32x4*)(qp + tn * 64 + 4);
                f32x4 nf0 = f0, nf1 = f1, nsc = scv;
                if (MIX == 0) nsc = *(const LAS f32x4*)(sc + tn * 4); else { nf0 = *(const LAS f32x4*)(fp + tn * 64); nf1 = *(const LAS f32x4*)(fp + tn * 64 + 4); }
                const float nv = vp[tn * 64];
                float o;
                if (MIX == 0) {
                    const float eg = scv[0], beta = scv[1], kq = scv[2];
                    float dk = (S[0] * k0[0] + S[1] * k0[1]) + (S[2] * k0[2] + S[3] * k0[3]) + (S[4] * k1[0] + S[5] * k1[1]) + (S[6] * k1[2] + S[7] * k1[3]);
                    float dq = (S[0] * q0[0] + S[1] * q0[1]) + (S[2] * q0[2] + S[3] * q0[3]) + (S[4] * q1[0] + S[5] * q1[1]) + (S[6] * q1[2] + S[7] * q1[3]);
                    dk = red8(dk); dq = red8(dq);
                    const float delta = beta * (v - eg * dk);
#pragma unroll
                    for (int i = 0; i < 4; ++i) { S[i] = eg * S[i] + k0[i] * delta; S[4 + i] = eg * S[4 + i] + k1[i] * delta; }
                    o = eg * dq + kq * delta;
                } else {
#pragma unroll
                    for (int i = 0; i < 4; ++i) { S[i] = f0[i] * S[i] + k0[i] * v; S[4 + i] = f1[i] * S[4 + i] + k1[i] * v; }
                    float dq = (S[0] * q0[0] + S[1] * q0[1]) + (S[2] * q0[2] + S[3] * q0[3]) + (S[4] * q1[0] + S[5] * q1[1]) + (S[6] * q1[2] + S[7] * q1[3]);
                    o = red8(dq);
                }
                if (ksl == 0) op[(size_t)tt * 768] = f2bf(o);
                k0 = nk0; k1 = nk1; q0 = nq0; q1 = nq1; f0 = nf0; f1 = nf1; scv = nsc; v = nv;
            }
        } else if (c + 1 < nch) prep(c + 1, wid - (nscan >> 6), 8 - (nscan >> 6));
        __syncthreads();
    }
    if (is_scan) {
#pragma unroll
        for (int i = 0; i < 8; ++i) s_out[(ksl * 8 + i) * 64 + col] = S[i];
    }
}

constexpr int S5_BU_LD = 132, S5_XB_LD = 136, S5_WAVE_BYTES = 16 * S5_BU_LD * 4 + 16 * S5_XB_LD * 2;
template <bool SAMPLE>
__device__ __forceinline__ void s5_wave_item(KPR p, int layer, LAS unsigned char* wl, int g, int tokbase, int L, int seq0) {
    const int lane = otid() & 63, col = lane & 15, quad = lane >> 4;
    const bf16_t* pm = (const bf16_t*)(p.ws + OFF_PM); bf16_t* yg = (bf16_t*)(p.ws + OFF_YG);
    LAS float* bu = (LAS float*)wl; LAS bf16_t* xb = (LAS bf16_t*)(wl + 16 * S5_BU_LD * 4);
    const int lg = layer * 16 + g;
    float ar, ai, zr, zi;
    { const float lr = fminf(p.in[17][lg * 64 + lane], -1e-4f), li = p.in[18][lg * 64 + lane], dt = __expf(p.in[24][lg]);
      const float mag = __expf(lr * dt); float rev = li * dt * 0.15915494309f; rev -= rintf(rev);
      const float sn = __builtin_amdgcn_sinf(rev), cs = __builtin_amdgcn_cosf(rev); ar = mag * cs; ai = mag * sn;
      const float den = lr * lr + li * li; zr = ((ar - 1.0f) * lr + ai * li) / den; zi = (ai * lr - (ar - 1.0f) * li) / den; }
    bf16x8 Bf[8], Cf[4];
#pragma unroll
    for (int tt = 0; tt < 4; ++tt) {
        const int pp = tt * 16 + col; const float zr2 = __shfl(zr, pp), zi2 = __shfl(zi, pp);
        float bre[8], bim[8];
#pragma unroll
        for (int j = 0; j < 8; ++j) { bre[j] = 0.f; bim[j] = 0.f; }
        if (quad < 2) {
            const float* br_ = p.in[19] + ((size_t)lg * 64 + pp) * 16 + quad * 8; const float* bi_ = p.in[20] + ((size_t)lg * 64 + pp) * 16 + quad * 8;
#pragma unroll
            for (int j = 0; j < 8; ++j) { const float r = br_[j], i = bi_[j]; bre[j] = zr2 * r - zi2 * i; bim[j] = zr2 * i + zi2 * r; }
        }
        u32x4 wr_, wi_;
        wr_.x = cvt_pk_bf16(bre[0], bre[1]); wr_.y = cvt_pk_bf16(bre[2], bre[3]); wr_.z = cvt_pk_bf16(bre[4], bre[5]); wr_.w = cvt_pk_bf16(bre[6], bre[7]);
        wi_.x = cvt_pk_bf16(bim[0], bim[1]); wi_.y = cvt_pk_bf16(bim[2], bim[3]); wi_.z = cvt_pk_bf16(bim[4], bim[5]); wi_.w = cvt_pk_bf16(bim[6], bim[7]);
        Bf[tt] = __builtin_bit_cast(bf16x8, wr_); Bf[4 + tt] = __builtin_bit_cast(bf16x8, wi_);
    }
#pragma unroll
    for (int kb = 0; kb < 4; ++kb) {
        const int k0 = (kb & 1) * 32 + quad * 8; const float sgn = kb < 2 ? 1.0f : -1.0f;
        const float* cp = (kb < 2 ? p.in[21] : p.in[22]) + ((size_t)lg * 16 + col) * 64 + k0;
        u32x4 w; w.x = cvt_pk_bf16(sgn * cp[0], sgn * cp[1]); w.y = cvt_pk_bf16(sgn * cp[2], sgn * cp[3]); w.z = cvt_pk_bf16(sgn * cp[4], sgn * cp[5]); w.w = cvt_pk_bf16(sgn * cp[6], sgn * cp[7]);
        Cf[kb] = __builtin_bit_cast(bf16x8, w);
    }
    const float dcoef = p.in[23][layer * 256 + g * 16 + col];
    float xr = 0.f, xi = 0.f;
    const int nch = SAMPLE ? 1 : (L + 15) / 16;
    u32x4 awn = (u32x4){0u, 0u, 0u, 0u}; bf16_t un[4] = {0, 0, 0, 0};
    auto pf = [&](int cc) {
        const int t0 = cc * 16; const int nrow = SAMPLE ? 16 : ((L - t0) < 16 ? (L - t0) : 16);
        awn = (u32x4){0u, 0u, 0u, 0u};
        if (quad < 2 && col < nrow) awn = *(const u32x4*)(pm + (size_t)(tokbase + t0 + col) * NPM + C_U + g * 16 + quad * 8);
#pragma unroll
        for (int i = 0; i < 4; ++i) { const int r = quad * 4 + i; un[i] = (r < nrow) ? pm[(size_t)(tokbase + t0 + r) * NPM + C_U + g * 16 + col] : (bf16_t)0; }
    };
    pf(0);
    for (int c = 0; c < nch; ++c) {
        const int t0 = c * 16; const int nrow = SAMPLE ? 16 : ((L - t0) < 16 ? (L - t0) : 16);
        const u32x4 aw = awn; bf16_t uc[4];
#pragma unroll
        for (int i = 0; i < 4; ++i) uc[i] = un[i];
        if (c + 1 < nch) pf(c + 1);
        const bf16x8 af = __builtin_bit_cast(bf16x8, aw);
#pragma unroll
        for (int tile = 0; tile < 8; ++tile) {
            const f32x4 d = __builtin_amdgcn_mfma_f32_16x16x32_bf16(af, Bf[tile], (f32x4){0.f, 0.f, 0.f, 0.f}, 0, 0, 0);
#pragma unroll
            for (int i = 0; i < 4; ++i) bu[(quad * 4 + i) * S5_BU_LD + tile * 16 + col] = d[i];
        }
        __builtin_amdgcn_fence(__ATOMIC_RELEASE, "wavefront"); __builtin_amdgcn_wave_barrier(); __builtin_amdgcn_fence(__ATOMIC_ACQUIRE, "wavefront");
        for (int r = 0; r < 16; ++r) {
            float nr = 0.f, ni = 0.f;
            if (r < nrow) {
                if (SAMPLE) { const size_t si = ((size_t)(layer * NDEC + seq0 + r) * 16 + g) * 64 + lane; xr = p.in[5][si]; xi = p.in[6][si]; }
                const float br_ = bu[r * S5_BU_LD + lane], bi_ = bu[r * S5_BU_LD + 64 + lane];
                nr = ar * xr - ai * xi + br_; ni = ar * xi + ai * xr + bi_; xr = nr; xi = ni;
                if (SAMPLE) { const size_t so = ((size_t)(layer * NDEC + seq0 + r) * 16 + g) * 64 + lane; p.out[O_SS5R + so] = nr; p.out[O_SS5I + so] = ni; }
            }
            xb[r * S5_XB_LD + lane] = f2bf(nr); xb[r * S5_XB_LD + 64 + lane] = f2bf(ni);
        }
        __builtin_amdgcn_fence(__ATOMIC_RELEASE, "wavefront"); __builtin_amdgcn_wave_barrier(); __builtin_amdgcn_fence(__ATOMIC_ACQUIRE, "wavefront");
        f32x4 ya = (f32x4){0.f, 0.f, 0.f, 0.f};
#pragma unroll
        for (int kb = 0; kb < 4; ++kb) { const bf16x8 xf = *(const LAS bf16x8*)(xb + col * S5_XB_LD + kb * 32 + quad * 8); ya = __builtin_amdgcn_mfma_f32_16x16x32_bf16(xf, Cf[kb], ya, 0, 0, 0); }
#pragma unroll
        for (int i = 0; i < 4; ++i) { const int r = quad * 4 + i;
            if (r < nrow) { const size_t tok = (size_t)(tokbase + t0 + r); const float uu = bf2f(uc[i]);
                const float y = ya[i] + dcoef * uu; const float ge = y * __builtin_amdgcn_rcpf(1.0f + __expf(-1.5957691216f * (y + 0.044715f * y * y * y)));
                yg[tok * 256 + g * 16 + col] = f2bf(ge); } }
        __builtin_amdgcn_fence(__ATOMIC_RELEASE, "wavefront"); __builtin_amdgcn_wave_barrier(); __builtin_amdgcn_fence(__ATOMIC_ACQUIRE, "wavefront");
    }
    if (!SAMPLE) { const size_t so = ((size_t)(layer * NBATCH + seq0) * 16 + g) * 64 + lane; p.out[O_PS5R + so] = xr; p.out[O_PS5I + so] = xi; }
}

__device__ __forceinline__ void phase_mix(KPR p, int layer, LAS unsigned char* ldsb, int bid, int G) {
    LAS float* lds = (LAS float*)ldsb;
    const int wid = __builtin_amdgcn_readfirstlane(otid() >> 6);
    constexpr int NLONG = 208, NSHORT = 16 + 1536;
    for (int it = bid; it < NLONG; it += G) {
        if (it < 192) {
            const int mix = it >> 6, r = it & 63, b = r >> 3, hh = (r >> 1) & 3, half = r & 1;
            const size_t so = ((size_t)(layer * NBATCH + b) * 4 + hh) * 4096;
            if (mix == 0) mix_item<0>(p, layer, lds, b * SEQ, SEQ, hh, half * 32, 32, nullptr, p.out + O_PGDN + so, nullptr, p.out + O_PCONV + (size_t)(layer * NBATCH + b) * 2304);
            else if (mix == 1) mix_item<1>(p, layer, lds, b * SEQ, SEQ, hh, half * 32, 32, nullptr, p.out + O_PGLA + so, nullptr, nullptr);
            else mix_item<2>(p, layer, lds, b * SEQ, SEQ, hh, half * 32, 32, nullptr, p.out + O_PHG + so, nullptr, nullptr);
        } else {
            __syncthreads();
            const int j = (it - 192) * 8 + wid, b = j >> 4, g = j & 15;
            s5_wave_item<false>(p, layer, ldsb + wid * S5_WAVE_BYTES, g, b * SEQ, SEQ, b);
        }
    }
    const int w0 = (G >= 256) ? 192 : 0, nw = G - w0;
    if (bid >= w0) for (int j = bid - w0; j < NSHORT; j += nw) {
        if (j < 16) {
            __syncthreads();
            const int jj = j * 8 + wid, g = jj & 15, s0 = (jj >> 4) * 16;
            s5_wave_item<true>(p, layer, ldsb + wid * S5_WAVE_BYTES, g, MPROMPT + s0, 16, s0);
        } else {
            const int jj = j - 16, mix = jj >> 9, s = (jj & 511) >> 2, hh = jj & 3;
            const size_t so = ((size_t)(layer * NDEC + s) * 4 + hh) * 4096;
            if (mix == 0) mix_item<0>(p, layer, lds, MPROMPT + s, 1, hh, 0, 64, p.in[3] + so, p.out + O_SGDN + so, p.in[2] + (size_t)(layer * NDEC + s) * 2304, p.out + O_SCONV + (size_t)(layer * NDEC + s) * 2304);
            else if (mix == 1) mix_item<1>(p, layer, lds, MPROMPT + s, 1, hh, 0, 64, p.in[4] + so, p.out + O_SGLA + so, nullptr, nullptr);
            else mix_item<2>(p, layer, lds, MPROMPT + s, 1, hh, 0, 64, p.in[7] + so, p.out + O_SHG + so, nullptr, nullptr);
        }
    }
    __syncthreads();
}

__device__ __forceinline__ void phase_headnorm(KPR p, int layer, int bid, int G) {
    const int tid_ = otid(); const int wid = __builtin_amdgcn_readfirstlane(tid_ >> 6), lane = tid_ & 63;
    const bf16_t* pm = (const bf16_t*)(p.ws + OFF_PM); const bf16_t* oraw = (const bf16_t*)(p.ws + OFF_ORAW); bf16_t* br = (bf16_t*)(p.ws + OFF_BR);
    for (int j = bid * 8 + wid; j < MTOK * 3; j += G * 8) {
        const int tok = j / 3, mix = j - tok * 3;
        const int gcol = mix == 0 ? A_GATE : (mix == 1 ? B_GATE : D_GATE), slot = mix == 2 ? 3 : mix;
        const float* nw = (mix == 0 ? p.in[13] : (mix == 1 ? p.in[16] : p.in[27])) + layer * 256 + lane * 4;
        const u32x2 ow = *(const u32x2*)(oraw + (size_t)tok * 768 + mix * 256 + lane * 4);
        const u32x2 gw = *(const u32x2*)(pm + (size_t)tok * NPM + gcol + lane * 4);
        const float o0 = lo_bf(ow.x), o1 = hi_bf(ow.x), o2 = lo_bf(ow.y), o3 = hi_bf(ow.y);
        float ss = o0 * o0 + o1 * o1 + o2 * o2 + o3 * o3;
        ss += __shfl_xor(ss, 1); ss += __shfl_xor(ss, 2); ss += __shfl_xor(ss, 4); ss += __shfl_xor(ss, 8);
        const float rs = rsqrtf(ss * (1.0f / 64.0f) + EPS);
        const f32x4 w = *(const f32x4*)nw;
        u32x2 r; r.x = cvt_pk_bf16(o0 * rs * w[0] * siluf_(lo_bf(gw.x)), o1 * rs * w[1] * siluf_(hi_bf(gw.x)));
        r.y = cvt_pk_bf16(o2 * rs * w[2] * siluf_(lo_bf(gw.y)), o3 * rs * w[3] * siluf_(hi_bf(gw.y)));
        *(u32x2*)(br + (size_t)tok * 1024 + slot * 256 + lane * 4) = r;
    }
}

constexpr int PH_PER_LAYER = 9, N_PHASES = 4 * PH_PER_LAYER + 1;
__device__ __forceinline__ void run_phase(KPR p, int ph, LAS unsigned char* lds, int bid, int G) {
    unsigned char* ws = p.ws;
    if (ph == N_PHASES - 1) { phase_norm(p, p.in[34], 2, bid, G); return; }
    const int layer = ph / PH_PER_LAYER, s = ph - layer * PH_PER_LAYER;
    pg8::Sched S; pg8::Gemm g;
    switch (s) {
    case 0: phase_convert(p, layer, (LAS float*)lds, bid, G); phase_norm(p, p.in[8] + layer * 1024, layer == 0 ? 0 : 1, bid, G); break;
    case 1: { S.init(65, 30, 1, G, bid, 16); g = pg8::Gemm{(const bf16_t*)(ws + OFF_XN), (const bf16_t*)(ws + OFF_WIN), 1024, 1024, 16, 0, 0};
              pg8::gemm_phase(lds, g, S, EpiIn{(bf16_t*)(ws + OFF_PM), (bf16_t*)(ws + OFF_GATES)}); } break;
    case 2: phase_mix(p, layer, lds, bid, G); break;
    case 3: { S.init(65, 2, 1, G, bid, 4); g = pg8::Gemm{(const bf16_t*)(ws + OFF_YG), (const bf16_t*)(ws + OFF_WGLU), 256, 256, 4, 0, 0};
              pg8::gemm_phase(lds, g, S, EpiGlu{(bf16_t*)(ws + OFF_BR)}); phase_headnorm(p, layer, bid, G); } break;
    case 4: { S.init(65, 4, 4, G, bid, 4); g = pg8::Gemm{(const bf16_t*)(ws + OFF_BR), (const bf16_t*)(ws + OFF_WBR), 1024, 256, 4, 256, (size_t)1024 * 256};
              pg8::gemm_phase(lds, g, S, EpiBr{(const bf16_t*)(ws + OFF_GATES), (bf16_t*)(ws + OFF_PM)}); } break;
    case 5: { S.init(64, 4, 1, G, bid, 16, 4); g = pg8::Gemm{(const bf16_t*)(ws + OFF_PM), (const bf16_t*)(ws + OFF_WOUT), 1024, 1024, 16, 0, 0};
              pg8::gemm_phase(lds, g, S, EpiRes{(float*)(ws + OFF_H)}); } break;
    case 6: phase_norm(p, p.in[30] + layer * 1024, 1, bid, G); break;
    case 7: { S.init(65, 22, 1, G, bid, 16); g = pg8::Gemm{(const bf16_t*)(ws + OFF_XN), (const bf16_t*)(ws + OFF_WGU), 1024, 1024, 16, 0, 0};
              pg8::gemm_phase(lds, g, S, EpiGU{(bf16_t*)(ws + OFF_PM)}); } break;
    case 8: { S.init(64, 4, 1, G, bid, 44, 4); g = pg8::Gemm{(const bf16_t*)(ws + OFF_PM), (const bf16_t*)(ws + OFF_WDN), DFF, DFF, 44, 0, 0};
              pg8::gemm_phase(lds, g, S, EpiRes{(float*)(ws + OFF_H)}); } break;
    }
}

extern __shared__ __attribute__((aligned(16))) unsigned char dyn_smem[];
#if MULTI_LAUNCH
__global__ void __launch_bounds__(512) k_phase(KP parg, int ph) {
    KPR p = *(const CAS KP*)__builtin_amdgcn_kernarg_segment_ptr();
    run_phase(p, ph, (LAS unsigned char*)dyn_smem, blockIdx.x, gridDim.x);
}
#else
__device__ __forceinline__ void grid_bar(unsigned* bar, unsigned k, int bid, int G) {
    asm volatile("s_waitcnt vmcnt(0)" ::: "memory");
    __syncthreads();
    if (otid() == 0) {
        __builtin_amdgcn_fence(__ATOMIC_RELEASE, "agent");
        asm volatile("s_waitcnt vmcnt(0)" ::: "memory");
        const unsigned per = (unsigned)G >> 3;
        const unsigned old = __hip_atomic_fetch_add(bar + 64 * (1 + (bid & 7)), 1u, __ATOMIC_RELAXED, __HIP_MEMORY_SCOPE_AGENT);
        if (old == per * k - 1u) __hip_atomic_fetch_add(bar, 1u, __ATOMIC_RELAXED, __HIP_MEMORY_SCOPE_AGENT);
        while (__hip_atomic_load(bar, __ATOMIC_RELAXED, __HIP_MEMORY_SCOPE_AGENT) < 8u * k) __builtin_amdgcn_s_sleep(1);
    }
    __syncthreads();
    __builtin_amdgcn_fence(__ATOMIC_ACQUIRE, "agent");
    asm volatile("s_waitcnt vmcnt(0)" ::: "memory");
}
template <int PH> __device__ __forceinline__ void run_from(KPR p, cg::grid_group& grid) {
    const CAS KP* pp = &p; asm volatile("" : "+s"(pp));
    int bid = blockIdx.x, G = gridDim.x; asm volatile("" : "+s"(bid), "+s"(G));
    run_phase(*pp, PH, (LAS unsigned char*)dyn_smem, bid, G);
    if constexpr (PH + 1 < N_PHASES) {
        if constexpr (PH == 0) grid.sync();
        else grid_bar((unsigned*)(pp->ws + OFF_BAR), (unsigned)PH, bid, G);
        run_from<PH + 1>(p, grid);
    }
}
__global__ void __launch_bounds__(512) k_mega(KP parg) {
    cg::grid_group grid = cg::this_grid();
    KPR p = *(const CAS KP*)__builtin_amdgcn_kernarg_segment_ptr();
    run_from<0>(p, grid);
}
#endif

extern "C" void kernel_launch(void* const* d_in, const int* in_sizes, int n_in, void* d_out, int out_size, void* d_ws, size_t ws_size, hipStream_t stream) {
    if (ws_size < WS_NEED || n_in < 35) { fprintf(stderr, "workspace too small: %zu < %zu\n", ws_size, (size_t)WS_NEED); return; }
    KP p{};
    for (int i = 0; i < 35; ++i) p.in[i] = (const float*)d_in[i];
    p.out = (float*)d_out; p.ws = (unsigned char*)d_ws;
    constexpr size_t kDynLds = pg8::STAGE_BYTES;
#if MULTI_LAUNCH
    static bool once = false;
    if (!once) { hipFuncSetAttribute((const void*)k_phase, hipFuncAttributeMaxDynamicSharedMemorySize, (int)kDynLds); once = true; }
    for (int ph = 0; ph < N_PHASES; ++ph) hipLaunchKernelGGL(k_phase, dim3(256), dim3(512), kDynLds, stream, p, ph);
#else
    static int grid_blocks = 0;
    if (!grid_blocks) {
        hipFuncSetAttribute((const void*)k_mega, hipFuncAttributeMaxDynamicSharedMemorySize, (int)kDynLds);
        int dev = 0, cus = 0, per_cu = 0;
        hipGetDevice(&dev);
        hipDeviceGetAttribute(&cus, hipDeviceAttributeMultiprocessorCount, dev);
        hipOccupancyMaxActiveBlocksPerMultiprocessor(&per_cu, k_mega, 512, kDynLds);
        if (per_cu < 1) per_cu = 1;
        grid_blocks = cus * per_cu; if (grid_blocks > 256) grid_blocks = 256;
    }
    hipMemsetAsync((unsigned char*)d_ws + OFF_BAR, 0, 4096, stream);
    void* args[] = {&p};
    hipError_t e = hipLaunchCooperativeKernel((void*)k_mega, dim3(grid_blocks), dim3(512), args, kDynLds, stream);
    if (e != hipSuccess) fprintf(stderr, "cooperative launch failed: %s (grid %d)\n", hipGetErrorString(e), grid_blocks);
#endif
}
```

```cpp
#include <hip/hip_runtime.h>
#include <hip/hip_cooperative_groups.h>
#include <cstdio>
namespace cg = cooperative_groups;

#ifndef MULTI_LAUNCH
#define MULTI_LAUNCH 0
#endif

#define LAS __attribute__((address_space(3)))
typedef unsigned short bf16_t;
typedef short bf16x8 __attribute__((ext_vector_type(8)));
typedef float f32x4 __attribute__((ext_vector_type(4)));
typedef float f32x2 __attribute__((ext_vector_type(2)));
typedef unsigned u32x2 __attribute__((ext_vector_type(2)));
typedef unsigned u32x4 __attribute__((ext_vector_type(4)));

constexpr int DM = 1024, SEQ = 2048, NBATCH = 8, NDEC = 128;
constexpr int MPROMPT = NBATCH * SEQ;
constexpr int MTOK = MPROMPT + NDEC;
constexpr int MP = 16640;
constexpr int NPM = 3584, NGATE = 4096, NIN = 7448, DFF = 2816;
constexpr int A_QKV = 0, A_GATE = 768, B_Q = 1024, B_K = 1280, B_V = 1536, B_GATE = 1792, C_U = 2048, D_Q = 2304, D_F = 2560, D_I = 2816, D_GATE = 3072,
              A_ALPHA = 3328, A_BETA = 3332, B_GK = 3336;
constexpr float EPS = 1e-6f;

constexpr size_t SZ_WIN = (size_t)7680 * 1024 * 2, SZ_WGU = (size_t)5632 * 1024 * 2, SZ_WDN = (size_t)1024 * 2816 * 2, SZ_WOUT = (size_t)1024 * 1024 * 2,
                 SZ_WBR = (size_t)4096 * 256 * 2, SZ_WGLU = (size_t)512 * 256 * 2;
constexpr size_t OFF_WIN = 0, OFF_WGU = OFF_WIN + SZ_WIN, OFF_WDN = OFF_WGU + SZ_WGU, OFF_WOUT = OFF_WDN + SZ_WDN, OFF_WBR = OFF_WOUT + SZ_WOUT,
                 OFF_WGLU = OFF_WBR + SZ_WBR, OFF_H = OFF_WGLU + SZ_WGLU, OFF_XN = OFF_H + (size_t)MP * 1024 * 4, OFF_BR = OFF_XN + (size_t)MP * 1024 * 2,
                 OFF_PM = OFF_BR + (size_t)MP * 1024 * 2, OFF_GATES = OFF_PM + (size_t)MP * NPM * 2, OFF_ORAW = OFF_GATES + (size_t)MP * NGATE * 2,
                 OFF_YG = OFF_ORAW + (size_t)MP * 768 * 2, OFF_BAR = OFF_YG + (size_t)MP * 256 * 2, WS_NEED = OFF_BAR + 4096;
constexpr size_t O_PCONV = 16908288, O_PGDN = 16982016, O_PGLA = 17506304, O_PS5R = 18030592, O_PS5I = 18063360, O_PHG = 18096128,
                 O_SCONV = 18620416, O_SGDN = 19800064, O_SGLA = 28188672, O_SS5R = 36577280, O_SS5I = 37101568, O_SHG = 37625856;

struct KP { const float* in[35]; float* out; unsigned char* ws; };
#define CAS __attribute__((address_space(4)))
typedef const CAS KP& KPR;

__device__ __forceinline__ int otid() { return threadIdx.x; }
__device__ __forceinline__ float bf2f(bf16_t b) { return __uint_as_float(((unsigned)b) << 16); }
typedef __bf16 bf16x2_t __attribute__((ext_vector_type(2)));
__device__ __forceinline__ unsigned cvt_pk_bf16(float lo, float hi) { const f32x2 f = {lo, hi}; const bf16x2_t v = __builtin_convertvector(f, bf16x2_t); return __builtin_bit_cast(unsigned, v); }
__device__ __forceinline__ bf16_t f2bf(float f) { return (bf16_t)(cvt_pk_bf16(f, 0.f) & 0xffffu); }
__device__ __forceinline__ float lo_bf(unsigned w) { return __uint_as_float(w << 16); }
__device__ __forceinline__ float hi_bf(unsigned w) { return __uint_as_float(w & 0xffff0000u); }
__device__ __forceinline__ float sigmoidf_(float x) { return __builtin_amdgcn_rcpf(1.0f + __expf(-x)); }
__device__ __forceinline__ float siluf_(float x) { return x * __builtin_amdgcn_rcpf(1.0f + __expf(-x)); }
__device__ __forceinline__ float wave_sum(float v) {
#pragma unroll
    for (int o = 32; o >= 1; o >>= 1) v += __shfl_xor(v, o);
    return v;
}
template <int CTRL> __device__ __forceinline__ float dpp_f(float v) { return __int_as_float(__builtin_amdgcn_update_dpp(0, __float_as_int(v), CTRL, 0xf, 0xf, true)); }
__device__ __forceinline__ float red16(float v) { v += dpp_f<0xB1>(v); v += dpp_f<0x4E>(v); v += dpp_f<0x141>(v); v += dpp_f<0x140>(v); return v; }
__device__ __forceinline__ float red8(float v) { v += dpp_f<0xB1>(v); v += dpp_f<0x4E>(v); v += dpp_f<0x141>(v); return v; }

namespace pg8 {
constexpr int BM = 256, BK = 64, HALF = 128, HTB = HALF * BK * 2, STAGE_BYTES = 8 * HTB, NXCD = 8, WGM = 8;
__device__ __forceinline__ int lds_byte(int r, int c) { const int st = (r >> 4) * 2 + (c >> 5), rr = r & 15, cc = c & 31, ob = rr * 64 + cc * 2; return st * 1024 + (ob ^ (((ob >> 9) & 1) << 5)); }
__device__ __forceinline__ void stage_rc(int b, int& R, int& C) { const int st = b / 1024, sb = b % 1024, swz = sb ^ (((sb >> 9) & 1) << 5); R = (st >> 1) * 16 + swz / 64; C = (st & 1) * 32 + (swz % 64) / 2; }

struct Unit { int pm, pn, kk, k0, nt; };
struct Gemm { const bf16_t* A; const bf16_t* Bt; int lda, ldb, nt; size_t a_kk, b_kk; };
struct Sched {
    int nM, nN, nKK, nwg, G, c, ntf, nts, nextra;
    __device__ void init(int nM_, int nN_, int nKK_, int G_, int c_, int ntf_, int nts_ = 0) { nM = nM_; nN = nN_; nKK = nKK_; nwg = nM * nN; G = G_; c = c_; ntf = ntf_; nts = nts_; nextra = nts_ ? nN_ * (ntf_ / nts_) : 0; }
    __device__ bool next(int i, Unit& u) const {
        const int it = i / nKK; u.kk = i - it * nKK; u.k0 = 0; u.nt = ntf;
        const long L = (long)it * G + c;
        if (L >= nwg) { const int e = (int)(L - nwg); if (e >= nextra) return false; u.pm = nM; u.pn = e % nN; u.k0 = (e / nN) * nts; u.nt = nts; return true; }
        int wgid = (int)L; { const int q = nwg / NXCD, r = nwg % NXCD, xcd = wgid % NXCD, off = wgid / NXCD; wgid = (xcd < r ? xcd * (q + 1) : r * (q + 1) + (xcd - r) * q) + off; }
        const int nig = WGM * nN, gid = wgid / nig, fm = gid * WGM, gsz = (nM - fm) < WGM ? (nM - fm) : WGM;
        u.pm = fm + ((wgid % nig) % gsz); u.pn = (wgid % nig) / gsz; return true;
    }
};

template <class Epi>
__device__ __forceinline__ void gemm_phase(LAS unsigned char* lds, const Gemm g, const Sched& S, const Epi& E) {
    const int tid = otid(), wid = __builtin_amdgcn_readfirstlane(tid >> 6), lane = tid & 63, wr = wid >> 2, wc = wid & 3, fr = lane & 15, fq = lane >> 4;
    unsigned voffA[2], voffB[2];
#pragma unroll
    for (int i = 0; i < 2; ++i) { int R, C; stage_rc(tid * 16 + i * 8192, R, C); voffA[i] = (unsigned)(R * g.lda + C) * 2u; voffB[i] = (unsigned)(R * g.ldb + C) * 2u; }
    const size_t kstep = (size_t)(BK * 2);
    const size_t hstepA = (size_t)HALF * g.lda * 2, hstepB = (size_t)HALF * g.ldb * 2;
    const size_t tstepA = 2 * hstepA, tstepB = 2 * hstepB;
    const unsigned ldsw = (unsigned)wid * 1024u;
    const int aoff = lds_byte(wr * 64 + fr, fq * 8), boff = lds_byte(wc * 32 + fr, fq * 8);
#define PG8_SA(b, h) (((b) * 2 + (h)) * HTB)
#define PG8_SB(b, h) ((4 + (b) * 2 + (h)) * HTB)
#define PG8_STAGE(bufoff, gbase, voff) do { _Pragma("unroll") for (int _i = 0; _i < 2; ++_i) \
        __builtin_amdgcn_global_load_lds((const unsigned*)((const char*)(gbase) + (voff)[_i]), (LAS unsigned*)(lds + (bufoff) + ldsw + _i * 8192), 16, 0, 0); } while (0)
#define PG8_LDA(dst, b, h) do { _Pragma("unroll") for (int m = 0; m < 4; ++m) _Pragma("unroll") for (int k = 0; k < 2; ++k) dst[m][k] = *(const LAS bf16x8*)(lds + PG8_SA(b, h) + aoff + m * 2048 + k * 1024); } while (0)
#define PG8_LDB(dst, b, h) do { _Pragma("unroll") for (int n = 0; n < 2; ++n) _Pragma("unroll") for (int k = 0; k < 2; ++k) dst[n][k] = *(const LAS bf16x8*)(lds + PG8_SB(b, h) + boff + n * 2048 + k * 1024); } while (0)
#define PG8_MMA(ai, bj, At, Bt) do { __builtin_amdgcn_s_setprio(1); _Pragma("unroll") for (int m = 0; m < 4; ++m) _Pragma("unroll") for (int n = 0; n < 2; ++n) _Pragma("unroll") for (int k = 0; k < 2; ++k) \
        acc[ai][bj][m][n] = __builtin_amdgcn_mfma_f32_16x16x32_bf16(Bt[n][k], At[m][k], acc[ai][bj][m][n], 0, 0, 0); __builtin_amdgcn_s_setprio(0); } while (0)
#define PG8_WAIT_V(n) asm volatile("s_waitcnt vmcnt(" #n ")" ::: "memory")
#define PG8_WAIT_L(n) asm volatile("s_waitcnt lgkmcnt(" #n ")" ::: "memory")
#define PG8_BAR __builtin_amdgcn_s_barrier()
#define PG8_SCHED __builtin_amdgcn_sched_barrier(0)
    Unit cur, nxt; int ui = 0;
    if (!S.next(0, cur)) return;
    f32x4 acc[2][2][4][2];
#pragma unroll
    for (int a = 0; a < 2; ++a)
#pragma unroll
        for (int b = 0; b < 2; ++b)
#pragma unroll
            for (int m = 0; m < 4; ++m)
#pragma unroll
                for (int n = 0; n < 2; ++n) acc[a][b][m][n] = (f32x4){0.f, 0.f, 0.f, 0.f};
    bf16x8 At[4][2], B0[2][2], B1[2][2];
    const char* cA = (const char*)(g.A + (size_t)cur.kk * g.a_kk) + (size_t)cur.pm * tstepA + (size_t)cur.k0 * kstep; const char* cB = (const char*)(g.Bt + (size_t)cur.kk * g.b_kk) + (size_t)cur.pn * tstepB + (size_t)cur.k0 * kstep;
    PG8_STAGE(PG8_SB(0, 0), cB, voffB); PG8_STAGE(PG8_SA(0, 0), cA, voffA); PG8_STAGE(PG8_SB(0, 1), cB + hstepB, voffB); PG8_STAGE(PG8_SA(0, 1), cA + hstepA, voffA);
    if (wr == 1) PG8_BAR;
    PG8_WAIT_V(4); PG8_BAR;
    PG8_STAGE(PG8_SB(1, 0), cB + kstep, voffB); PG8_STAGE(PG8_SA(1, 0), cA + kstep, voffA); PG8_STAGE(PG8_SB(1, 1), cB + hstepB + kstep, voffB);
    PG8_WAIT_V(6); PG8_BAR;
    for (;;) {
        const bool has_next = S.next(ui + 1, nxt);
        const char* nA = has_next ? (const char*)(g.A + (size_t)nxt.kk * g.a_kk) + (size_t)nxt.pm * tstepA + (size_t)nxt.k0 * kstep : cA;
        const char* nB = has_next ? (const char*)(g.Bt + (size_t)nxt.kk * g.b_kk) + (size_t)nxt.pn * tstepB + (size_t)nxt.k0 * kstep : cB;
        int nt = cur.nt; asm volatile("" : "+s"(nt));
        for (int t = 0; t < nt; t += 2) {
            const bool last = (t == nt - 2);
            const char* a1 = cA + (size_t)(t + 1) * kstep;
            const char* a2 = last ? nA : cA + (size_t)(t + 2) * kstep; const char* b2 = last ? nB : cB + (size_t)(t + 2) * kstep;
            const char* a3 = a2 + kstep; const char* b3 = b2 + kstep;
            PG8_LDB(B0, 0, 0); PG8_SCHED; PG8_LDA(At, 0, 0); PG8_STAGE(PG8_SA(1, 1), a1 + hstepA, voffA);
            PG8_WAIT_L(8); PG8_BAR; PG8_WAIT_L(0); PG8_MMA(0, 0, At, B0); PG8_BAR; PG8_SCHED;
            PG8_LDB(B1, 0, 1); PG8_STAGE(PG8_SB(0, 0), b2, voffB);
            PG8_BAR; PG8_WAIT_L(0); PG8_MMA(0, 1, At, B1); PG8_BAR;
            PG8_LDA(At, 0, 1); PG8_STAGE(PG8_SA(0, 0), a2, voffA);
            PG8_BAR; PG8_WAIT_L(0); PG8_MMA(1, 0, At, B0); PG8_BAR; PG8_SCHED;
            PG8_STAGE(PG8_SB(0, 1), b2 + hstepB, voffB);
            PG8_WAIT_V(6); PG8_BAR; PG8_MMA(1, 1, At, B1); PG8_BAR;
            PG8_LDB(B0, 1, 0); PG8_SCHED; PG8_LDA(At, 1, 0); PG8_STAGE(PG8_SA(0, 1), a2 + hstepA, voffA);
            PG8_WAIT_L(8); PG8_BAR; PG8_WAIT_L(0); PG8_MMA(0, 0, At, B0); PG8_BAR; PG8_SCHED;
            PG8_LDB(B1, 1, 1); PG8_STAGE(PG8_SB(1, 0), b3, voffB);
            PG8_BAR; PG8_WAIT_L(0); PG8_MMA(0, 1, At, B1); PG8_BAR;
            PG8_LDA(At, 1, 1); PG8_STAGE(PG8_SA(1, 0), a3, voffA);
            PG8_BAR; PG8_WAIT_L(0); PG8_MMA(1, 0, At, B0); PG8_BAR; PG8_SCHED;
            PG8_STAGE(PG8_SB(1, 1), b3 + hstepB, voffB);
            PG8_WAIT_V(6); PG8_BAR; PG8_MMA(1, 1, At, B1); PG8_BAR;
        }
        E(acc, cur, wr, wc, fr, fq);
        if (!has_next) break;
#pragma unroll
        for (int a = 0; a < 2; ++a)
#pragma unroll
            for (int b = 0; b < 2; ++b)
#pragma unroll
                for (int m = 0; m < 4; ++m)
#pragma unroll
                    for (int n = 0; n < 2; ++n) acc[a][b][m][n] = (f32x4){0.f, 0.f, 0.f, 0.f};
        cur = nxt; cA = nA; cB = nB; ++ui;
    }
    PG8_WAIT_V(0);
    if (wr == 0) PG8_BAR;
    PG8_BAR;
    __builtin_amdgcn_s_waitcnt(0);
#undef PG8_SA
#undef PG8_SB
#undef PG8_STAGE
#undef PG8_LDA
#undef PG8_LDB
#undef PG8_MMA
#undef PG8_WAIT_V
#undef PG8_WAIT_L
#undef PG8_BAR
#undef PG8_SCHED
}
}
using pg8::Unit;

#define EPI_LOOP_BEGIN _Pragma("unroll") for (int ai = 0; ai < 2; ++ai) _Pragma("unroll") for (int m = 0; m < 4; ++m) { const size_t row = (size_t)(u.pm * 256 + ai * 128 + wr * 64 + m * 16 + fr); \
        _Pragma("unroll") for (int bj = 0; bj < 2; ++bj) {
#define EPI_LOOP_END } }
struct EpiIn {
    bf16_t* pm; bf16_t* gates;
    __device__ __forceinline__ void operator()(const f32x4 (&acc)[2][2][4][2], const Unit& u, int wr, int wc, int fr, int fq) const {
        const bool main_ = u.pn < 14;
        EPI_LOOP_BEGIN
#pragma unroll
            for (int n = 0; n < 2; ++n) { const int col = u.pn * 256 + bj * 128 + wc * 32 + n * 16 + fq * 4; f32x4 v = acc[ai][bj][m][n]; u32x2 w;
                if (main_) { w.x = cvt_pk_bf16(v[0], v[1]); w.y = cvt_pk_bf16(v[2], v[3]); *(u32x2*)(pm + row * NPM + col) = w; }
                else { w.x = cvt_pk_bf16(sigmoidf_(v[0]), sigmoidf_(v[1])); w.y = cvt_pk_bf16(sigmoidf_(v[2]), sigmoidf_(v[3])); *(u32x2*)(gates + row * NGATE + (col - NPM)) = w; } }
        EPI_LOOP_END
    }
};
struct EpiGlu {
    bf16_t* br;
    __device__ __forceinline__ void operator()(const f32x4 (&acc)[2][2][4][2], const Unit& u, int wr, int wc, int fr, int fq) const {
        EPI_LOOP_BEGIN
            const int j = u.pn * 128 + bj * 64 + wc * 16 + fq * 4; const f32x4 a = acc[ai][bj][m][0], b = acc[ai][bj][m][1]; u32x2 w;
            w.x = cvt_pk_bf16(a[0] * sigmoidf_(b[0]), a[1] * sigmoidf_(b[1])); w.y = cvt_pk_bf16(a[2] * sigmoidf_(b[2]), a[3] * sigmoidf_(b[3]));
            *(u32x2*)(br + row * 1024 + 512 + j) = w;
        EPI_LOOP_END
    }
};
struct EpiGU {
    bf16_t* a;
    __device__ __forceinline__ void operator()(const f32x4 (&acc)[2][2][4][2], const Unit& u, int wr, int wc, int fr, int fq) const {
        EPI_LOOP_BEGIN
            const int j = u.pn * 128 + bj * 64 + wc * 16 + fq * 4; const f32x4 g = acc[ai][bj][m][0], b = acc[ai][bj][m][1]; u32x2 w;
            w.x = cvt_pk_bf16(siluf_(g[0]) * b[0], siluf_(g[1]) * b[1]); w.y = cvt_pk_bf16(siluf_(g[2]) * b[2], siluf_(g[3]) * b[3]);
            *(u32x2*)(a + row * DFF + j) = w;
        EPI_LOOP_END
    }
};
struct EpiBr {
    const bf16_t* gates; bf16_t* mm;
    __device__ __forceinline__ void operator()(const f32x4 (&acc)[2][2][4][2], const Unit& u, int wr, int wc, int fr, int fq) const {
        const int col0 = u.pn * 256 + wc * 32 + fq * 4;
#pragma unroll
        for (int ai = 0; ai < 2; ++ai) {
            if (ai == 1 && u.pm == 64) break;
            const size_t row0 = (size_t)(u.pm * 256 + ai * 128 + wr * 64 + fr);
            u32x2 gw[4][2][2], pw[4][2][2];
#pragma unroll
            for (int m = 0; m < 4; ++m)
#pragma unroll
                for (int bj = 0; bj < 2; ++bj)
#pragma unroll
                    for (int n = 0; n < 2; ++n) { const size_t row = row0 + m * 16; const int col = col0 + bj * 128 + n * 16;
                        gw[m][bj][n] = *(const u32x2*)(gates + row * NGATE + u.kk * 1024 + col);
                        pw[m][bj][n] = (u32x2){0u, 0u}; if (u.kk > 0) pw[m][bj][n] = *(const u32x2*)(mm + row * 1024 + col); }
#pragma unroll
            for (int m = 0; m < 4; ++m)
#pragma unroll
                for (int bj = 0; bj < 2; ++bj)
#pragma unroll
                    for (int n = 0; n < 2; ++n) { const size_t row = row0 + m * 16; const int col = col0 + bj * 128 + n * 16; const f32x4 v = acc[ai][bj][m][n]; const u32x2 g = gw[m][bj][n], q = pw[m][bj][n];
                        u32x2 w; w.x = cvt_pk_bf16(lo_bf(g.x) * v[0] + lo_bf(q.x), hi_bf(g.x) * v[1] + hi_bf(q.x)); w.y = cvt_pk_bf16(lo_bf(g.y) * v[2] + lo_bf(q.y), hi_bf(g.y) * v[3] + hi_bf(q.y));
                        *(u32x2*)(mm + row * 1024 + col) = w; }
        }
    }
};
struct EpiRes {
    float* h;
    __device__ __forceinline__ void operator()(const f32x4 (&acc)[2][2][4][2], const Unit& u, int wr, int wc, int fr, int fq) const {
        const bool split = u.pm == 64;
        EPI_LOOP_BEGIN
#pragma unroll
            for (int n = 0; n < 2; ++n) { const int col = u.pn * 256 + bj * 128 + wc * 32 + n * 16 + fq * 4; float* ptr = h + row * 1024 + col;
                if (split) {
#pragma unroll
                    for (int e = 0; e < 4; ++e) __hip_atomic_fetch_add(ptr + e, acc[ai][bj][m][n][e], __ATOMIC_RELAXED, __HIP_MEMORY_SCOPE_AGENT);
                } else { const f32x4 o = *(const f32x4*)ptr; *(f32x4*)ptr = o + acc[ai][bj][m][n]; } }
        EPI_LOOP_END
    }
};

__device__ __forceinline__ int win_src_col(int n) {
    if (n < 768) return n;
    if (n < 1024) return 776 + (n - 768);
    if (n < 1792) return 1032 + (n - 1024);
    if (n < 2048) return 1816 + (n - 1792);
    if (n < 2304) return 2072 + (n - 2048);
    if (n < 3072) return 2328 + (n - 2304);
    if (n < 3328) return 3096 + (n - 3072);
    if (n < 3336) return 768 + (n - 3328);
    if (n < 3352) return 1800 + (n - 3336);
    if (n < 3584) return -1;
    return 3352 + (n - 3584);
}
__device__ __forceinline__ void phase_convert(KPR p, int layer, LAS float* tile, int bid, int G) {
    const int tid = otid(), tn = tid & 63, tk = __builtin_amdgcn_readfirstlane(tid >> 6);
    constexpr int T0 = 120 * 16, T1 = T0 + 88 * 16, T2 = T1 + 16 * 44, T3 = T2 + 16 * 16, T4 = T3 + 64 * 4, T5 = T4 + 8 * 4;
    for (int j = bid; j < T5; j += G) {
        int n0, k0, K, ld; bf16_t* dst; const float* cp = nullptr;
        if (j < T0) { const int q = j; n0 = (q >> 4) * 64; k0 = (q & 15) * 64; K = 1024; ld = NIN; dst = (bf16_t*)(p.ws + OFF_WIN);
            const int sc = win_src_col(n0 + tn); if (sc >= 0) cp = p.in[9] + (size_t)layer * 1024 * NIN + sc; }
        else if (j < T1) { const int q = j - T0; n0 = (q >> 4) * 64; k0 = (q & 15) * 64; K = 1024; ld = DFF; dst = (bf16_t*)(p.ws + OFF_WGU);
            const int n = n0 + tn, g32 = n >> 5, w = n & 31, jj = g32 * 16 + (w & 15); cp = (w < 16 ? p.in[31] : p.in[32]) + (size_t)layer * 1024 * DFF + jj; }
        else if (j < T2) { const int q = j - T1; n0 = (q / 44) * 64; k0 = (q % 44) * 64; K = DFF; ld = 1024; dst = (bf16_t*)(p.ws + OFF_WDN);
            cp = p.in[33] + (size_t)layer * DFF * 1024 + (n0 + tn); }
        else if (j < T3) { const int q = j - T2; n0 = (q >> 4) * 64; k0 = (q & 15) * 64; K = 1024; ld = 1024; dst = (bf16_t*)(p.ws + OFF_WOUT);
            cp = p.in[29] + (size_t)layer * 1024 * 1024 + (n0 + tn); }
        else if (j < T4) { const int q = j - T3; n0 = (q >> 2) * 64; k0 = (q & 3) * 64; K = 256; ld = 1024; dst = (bf16_t*)(p.ws + OFF_WBR);
            const int n = n0 + tn, kk = n >> 10, d = n & 1023; cp = p.in[28] + ((size_t)(layer * 4 + kk) * 256) * 1024 + d; }
        else { const int q = j - T4; n0 = (q >> 2) * 64; k0 = (q & 3) * 64; K = 256; ld = 512; dst = (bf16_t*)(p.ws + OFF_WGLU);
            const int n = n0 + tn, g32 = n >> 5, w = n & 31, jj = g32 * 16 + (w & 15); cp = p.in[25] + (size_t)layer * 256 * 512 + (w < 16 ? jj : 256 + jj); }
        __syncthreads();
#pragma unroll
        for (int e = 0; e < 8; ++e) { const int k = k0 + tk * 8 + e; tile[tn * 65 + tk * 8 + e] = cp ? cp[(size_t)k * ld] : 0.f; }
        __syncthreads();
        { const int n = tid >> 3, ks = tid & 7; const LAS float* tp = tile + n * 65 + ks * 8; u32x4 w;
          w.x = cvt_pk_bf16(tp[0], tp[1]); w.y = cvt_pk_bf16(tp[2], tp[3]); w.z = cvt_pk_bf16(tp[4], tp[5]); w.w = cvt_pk_bf16(tp[6], tp[7]);
          *(u32x4*)(dst + (size_t)(n0 + n) * K + k0 + ks * 8) = w; }
    }
    __syncthreads();
}

__device__ __forceinline__ void phase_norm(KPR p, const float* w, int mode, int bid, int G) {
    const int tid_ = otid(); const int wid = __builtin_amdgcn_readfirstlane(tid_ >> 6), lane = tid_ & 63;
    float* h = (float*)(p.ws + OFF_H); bf16_t* xn = (bf16_t*)(p.ws + OFF_XN);
    f32x4 wv[4];
#pragma unroll
    for (int i = 0; i < 4; ++i) wv[i] = *(const f32x4*)(w + i * 256 + lane * 4);
    for (int r = bid * 8 + wid; r < MTOK; r += G * 8) {
        const float* src = (mode == 0) ? (r < MPROMPT ? p.in[0] + (size_t)r * 1024 : p.in[1] + (size_t)(r - MPROMPT) * 1024) : h + (size_t)r * 1024;
        f32x4 v[4]; float ss = 0.f;
#pragma unroll
        for (int i = 0; i < 4; ++i) { v[i] = *(const f32x4*)(src + i * 256 + lane * 4); ss += v[i][0] * v[i][0] + v[i][1] * v[i][1] + v[i][2] * v[i][2] + v[i][3] * v[i][3]; }
        ss = wave_sum(ss);
        const float rs = rsqrtf(ss * (1.0f / 1024.0f) + EPS);
#pragma unroll
        for (int i = 0; i < 4; ++i) {
            const f32x4 y = v[i] * rs * wv[i];
            if (mode == 2) *(f32x4*)(p.out + (size_t)r * 1024 + i * 256 + lane * 4) = y;
            else { u32x2 o; o.x = cvt_pk_bf16(y[0], y[1]); o.y = cvt_pk_bf16(y[2], y[3]); *(u32x2*)(xn + (size_t)r * 1024 + i * 256 + lane * 4) = o;
                   if (mode == 0) *(f32x4*)(h + (size_t)r * 1024 + i * 256 + lane * 4) = v[i]; }
        }
    }
}

constexpr int TCH = 32;
constexpr int MIXBUF_FLOATS = 4 * TCH * 64 + TCH * 4;
template <int MIX>
__device__ __forceinline__ void mix_item(KPR p, int layer, LAS float* lds, int tokbase, int L, int h, int col0, int ncols,
                         const float* s_in, float* s_out, const float* conv_in, float* conv_out) {
    const int tid = otid(), wid = __builtin_amdgcn_readfirstlane(tid >> 6), lane = tid & 63;
    const int nscan = ncols * 8; const bool is_scan = wid < (nscan >> 6);
    const int ksl = lane & 7, cl = wid * 8 + (lane >> 3), col = col0 + cl;
    const bf16_t* pm = (const bf16_t*)(p.ws + OFF_PM);
    bf16_t* oraw = (bf16_t*)(p.ws + OFF_ORAW);
    __syncthreads();
    float S[8];
#pragma unroll
    for (int i = 0; i < 8; ++i) S[i] = (is_scan && s_in) ? s_in[(ksl * 8 + i) * 64 + col] : 0.f;
    const int tl = lane >> 4, d4 = (lane & 15) * 4, hd4 = h * 64 + d4;
    f32x4 cw[3][4]; float c_a = 0.f, c_dt = 0.f; f32x4 gkw[16]; f32x4 gkb = (f32x4){0.f, 0.f, 0.f, 0.f}, lb4 = (f32x4){0.f, 0.f, 0.f, 0.f};
    if (MIX == 0) {
        const float* cwp = p.in[10] + (size_t)layer * 4 * 768;
#pragma unroll
        for (int s = 0; s < 3; ++s)
#pragma unroll
            for (int j = 0; j < 4; ++j) cw[s][j] = *(const f32x4*)(cwp + j * 768 + s * 256 + hd4);
        c_a = -__expf(p.in[11][layer * 4 + h]); c_dt = p.in[12][layer * 4 + h];
        if (conv_out && col0 == 0 && h == 0) {
            for (int idx = tid; idx < 3 * 768; idx += 512) { const int i = idx / 768, c = idx - i * 768, ti = L - 3 + i;
                conv_out[idx] = ti >= 0 ? bf2f(pm[(size_t)(tokbase + ti) * NPM + A_QKV + c]) : (conv_in ? conv_in[(3 + ti) * 768 + c] : 0.f); }
        }
    } else if (MIX == 1) {
#pragma unroll
        for (int r = 0; r < 16; ++r) gkw[r] = *(const f32x4*)(p.in[14] + ((size_t)layer * 16 + r) * 256 + hd4);
        gkb = *(const f32x4*)(p.in[15] + layer * 256 + hd4);
    } else {
        const float* lg = p.in[26] + hd4; const f32x4 a0 = *(const f32x4*)lg, a1 = *(const f32x4*)(lg + 256), a2 = *(const f32x4*)(lg + 512), a3 = *(const f32x4*)(lg + 768);
#pragma unroll
        for (int e = 0; e < 4; ++e) {
            const float mx = fmaxf(fmaxf(a0[e], a1[e]), fmaxf(a2[e], a3[e])); const float l0 = __expf(a0[e] - mx), l1 = __expf(a1[e] - mx), l2 = __expf(a2[e] - mx), l3 = __expf(a3[e] - mx);
            const float inv = 1.0f / (l0 + l1 + l2 + l3);
            lb4[e] = (layer == 0) ? 0.f : (layer == 1) ? l1 * inv : (layer == 2) ? (l1 + l2) * inv : (l1 + l2 + l3) * inv;
        }
    }
    const int nch = (L + TCH - 1) / TCH;
    auto prep = [&](int c, int pw, int npw) {
        LAS float* kb = lds + (c & 1) * MIXBUF_FLOATS; LAS float* qb = kb + TCH * 64; LAS float* fb = qb + TCH * 64; LAS float* vb = fb + TCH * 64; LAS float* sc = vb + TCH * 64;
#pragma unroll
        for (int pass = 0; pass < 2; ++pass) {
            const int tt0 = (pass * npw + pw) * 4;
            if (tt0 < TCH) {
                const int tt = tt0 + tl, t = c * TCH + tt;
                if (t < L) {
                    const bf16_t* row = pm + (size_t)(tokbase + t) * NPM;
                    if (MIX == 0) {
                        f32x4 y[3];
#pragma unroll
                        for (int s = 0; s < 3; ++s) { f32x4 a = (f32x4){0.f, 0.f, 0.f, 0.f};
#pragma unroll
                            for (int j = 0; j < 4; ++j) { const int ti = t - 3 + j; f32x4 xv = (f32x4){0.f, 0.f, 0.f, 0.f};
                                if (ti >= 0) { const u32x2 w = *(const u32x2*)(pm + (size_t)(tokbase + ti) * NPM + A_QKV + s * 256 + hd4); xv = (f32x4){lo_bf(w.x), hi_bf(w.x), lo_bf(w.y), hi_bf(w.y)}; }
                                else if (conv_in) xv = *(const f32x4*)(conv_in + (3 + ti) * 768 + s * 256 + hd4);
                                a += xv * cw[s][j]; }
                            y[s] = (f32x4){siluf_(a[0]), siluf_(a[1]), siluf_(a[2]), siluf_(a[3])}; }
                        const float qq = red16(y[0][0] * y[0][0] + y[0][1] * y[0][1] + y[0][2] * y[0][2] + y[0][3] * y[0][3]);
                        const float kk2 = red16(y[1][0] * y[1][0] + y[1][1] * y[1][1] + y[1][2] * y[1][2] + y[1][3] * y[1][3]);
                        const f32x4 qn = y[0] * (rsqrtf(qq + EPS) * 0.125f), kn = y[1] * rsqrtf(kk2 + EPS);
                        const float kq = red16(qn[0] * kn[0] + qn[1] * kn[1] + qn[2] * kn[2] + qn[3] * kn[3]);
                        *(LAS f32x4*)(kb + tt * 64 + d4) = kn; *(LAS f32x4*)(qb + tt * 64 + d4) = qn; *(LAS f32x4*)(vb + tt * 64 + d4) = y[2];
                        if ((lane & 15) == 0) { const float al = bf2f(row[A_ALPHA + h]) + c_dt; const float sp = fmaxf(al, 0.f) + __logf(1.0f + __expf(-fabsf(al)));
                            *(LAS f32x4*)(sc + tt * 4) = (f32x4){__expf(c_a * sp), sigmoidf_(bf2f(row[A_BETA + h])), kq, 0.f}; }
                    } else if (MIX == 1) {
                        const u32x4 g0 = *(const u32x4*)(row + B_GK), g1 = *(const u32x4*)(row + B_GK + 8);
                        const u32x2 wq = *(const u32x2*)(row + B_Q + hd4), wk = *(const u32x2*)(row + B_K + hd4), wv = *(const u32x2*)(row + B_V + hd4);
                        f32x4 z = gkb;
                        z += lo_bf(g0.x) * gkw[0] + hi_bf(g0.x) * gkw[1] + lo_bf(g0.y) * gkw[2] + hi_bf(g0.y) * gkw[3] + lo_bf(g0.z) * gkw[4] + hi_bf(g0.z) * gkw[5] + lo_bf(g0.w) * gkw[6] + hi_bf(g0.w) * gkw[7];
                        z += lo_bf(g1.x) * gkw[8] + hi_bf(g1.x) * gkw[9] + lo_bf(g1.y) * gkw[10] + hi_bf(g1.y) * gkw[11] + lo_bf(g1.z) * gkw[12] + hi_bf(g1.z) * gkw[13] + lo_bf(g1.w) * gkw[14] + hi_bf(g1.w) * gkw[15];
                        f32x4 f;
#pragma unroll
                        for (int e = 0; e < 4; ++e) { const float sp = fmaxf(-z[e], 0.f) + __logf(1.0f + __expf(-fabsf(z[e]))); f[e] = __expf(-sp * (1.0f / 16.0f)); }
                        *(LAS f32x4*)(fb + tt * 64 + d4) = f;
                        *(LAS f32x4*)(qb + tt * 64 + d4) = (f32x4){lo_bf(wq.x), hi_bf(wq.x), lo_bf(wq.y), hi_bf(wq.y)} * 0.125f;
                        *(LAS f32x4*)(kb + tt * 64 + d4) = (f32x4){lo_bf(wk.x), hi_bf(wk.x), lo_bf(wk.y), hi_bf(wk.y)};
                        *(LAS f32x4*)(vb + tt * 64 + d4) = (f32x4){lo_bf(wv.x), hi_bf(wv.x), lo_bf(wv.y), hi_bf(wv.y)};
                    } else {
                        const u32x2 wq = *(const u32x2*)(row + D_Q + hd4), wf = *(const u32x2*)(row + D_F + hd4), wv = *(const u32x2*)(row + D_I + hd4);
                        const f32x4 xq = (f32x4){lo_bf(wq.x), hi_bf(wq.x), lo_bf(wq.y), hi_bf(wq.y)}, xf = (f32x4){lo_bf(wf.x), hi_bf(wf.x), lo_bf(wf.y), hi_bf(wf.y)};
                        f32x4 f, k, q;
#pragma unroll
                        for (int e = 0; e < 4; ++e) { const float sg = sigmoidf_(xf[e]); f[e] = lb4[e] + (1.0f - lb4[e]) * sg; k[e] = (1.0f - lb4[e]) * (1.0f - sg); q[e] = siluf_(xq[e]) * 0.125f; }
                        *(LAS f32x4*)(fb + tt * 64 + d4) = f; *(LAS f32x4*)(kb + tt * 64 + d4) = k; *(LAS f32x4*)(qb + tt * 64 + d4) = q;
                        *(LAS f32x4*)(vb + tt * 64 + d4) = (f32x4){lo_bf(wv.x), hi_bf(wv.x), lo_bf(wv.y), hi_bf(wv.y)};
                    }
                }
            }
        }
    };
    prep(0, wid, 8);
    __syncthreads();
    for (int c = 0; c < nch; ++c) {
        if (is_scan) {
            const LAS float* kb = lds + (c & 1) * MIXBUF_FLOATS; const LAS float* qb = kb + TCH * 64; const LAS float* fb = qb + TCH * 64; const LAS float* vb = fb + TCH * 64; const LAS float* sc = vb + TCH * 64;
            const int ntok = (L - c * TCH) < TCH ? (L - c * TCH) : TCH;
            bf16_t* op = oraw + (size_t)(tokbase + c * TCH) * 768 + MIX * 256 + h * 64 + col;
            const LAS float* kp = kb + ksl * 8; const LAS float* qp = qb + ksl * 8; const LAS float* fp = fb + ksl * 8; const LAS float* vp = vb + col;
            f32x4 k0 = *(const LAS f32x4*)kp, k1 = *(const LAS f32x4*)(kp + 4), q0 = *(const LAS f32x4*)qp, q1 = *(const LAS f32x4*)(qp + 4);
            f32x4 f0 = (f32x4){0.f, 0.f, 0.f, 0.f}, f1 = f0, scv = f0;
            if (MIX == 0) scv = *(const LAS f32x4*)sc; else { f0 = *(const LAS f32x4*)fp; f1 = *(const LAS f32x4*)(fp + 4); }
            float v = vp[0];
            __builtin_amdgcn_s_setprio(3);
#pragma unroll 2
            for (int tt = 0; tt < ntok; ++tt) {
                const int tn = (tt + 1 < TCH) ? tt + 1 : tt;
                const f32x4 nk0 = *(const LAS f32x4*)(kp + tn * 64), nk1 = *(const LAS f32x4*)(kp + tn * 64 + 4), nq0 = *(const LAS f32x4*)(qp + tn * 64), nq1 = *(const LAS f32x4*)(qp + tn * 64 + 4);
                f32x4 nf0 = f0, nf1 = f1, nsc = scv;
                if (MIX == 0) nsc = *(const LAS f32x4*)(sc + tn * 4); else { nf0 = *(const LAS f32x4*)(fp + tn * 64); nf1 = *(const LAS f32x4*)(fp + tn * 64 + 4); }
                const float nv = vp[tn * 64];
                float o;
                if (MIX == 0) {
                    const float eg = scv[0], beta = scv[1], kq = scv[2];
                    float dk = (S[0] * k0[0] + S[1] * k0[1]) + (S[2] * k0[2] + S[3] * k0[3]) + (S[4] * k1[0] + S[5] * k1[1]) + (S[6] * k1[2] + S[7] * k1[3]);
                    float dq = (S[0] * q0[0] + S[1] * q0[1]) + (S[2] * q0[2] + S[3] * q0[3]) + (S[4] * q1[0] + S[5] * q1[1]) + (S[6] * q1[2] + S[7] * q1[3]);
                    dk = red8(dk); dq = red8(dq);
                    const float delta = beta * (v - eg * dk);
#pragma unroll
                    for (int i = 0; i < 4; ++i) { S[i] = eg * S[i] + k0[i] * delta; S[4 + i] = eg * S[4 + i] + k1[i] * delta; }
                    o = eg * dq + kq * delta;
                } else {
#pragma unroll
                    for (int i = 0; i < 4; ++i) { S[i] = f0[i] * S[i] + k0[i] * v; S[4 + i] = f1[i] * S[4 + i] + k1[i] * v; }
                    float dq = (S[0] * q0[0] + S[1] * q0[1]) + (S[2] * q0[2] + S[3] * q0[3]) + (S[4] * q1[0] + S[5] * q1[1]) + (S[6] * q1[2] + S[7] * q1[3]);
                    o = red8(dq);
                }
                if (ksl == 0) op[(size_t)tt * 768] = f2bf(o);
                k0 = nk0; k1 = nk1; q0 = nq0; q1 = nq1; f0 = nf0; f1 = nf1; scv = nsc; v = nv;
            }
            __builtin_amdgcn_s_setprio(0);
        } else if (c + 1 < nch) prep(c + 1, wid - (nscan >> 6), 8 - (nscan >> 6));
        __syncthreads();
    }
    if (is_scan) {
#pragma unroll
        for (int i = 0; i < 8; ++i) s_out[(ksl * 8 + i) * 64 + col] = S[i];
    }
}

constexpr int S5_BU_LD = 132, S5_XB_LD = 136, S5_WAVE_BYTES = 16 * S5_BU_LD * 4 + 16 * S5_XB_LD * 2;
template <bool SAMPLE>
__device__ __forceinline__ void s5_wave_item(KPR p, int layer, LAS unsigned char* wl, int g, int tokbase, int L, int seq0) {
    const int lane = otid() & 63, col = lane & 15, quad = lane >> 4;
    const bf16_t* pm = (const bf16_t*)(p.ws + OFF_PM); bf16_t* yg = (bf16_t*)(p.ws + OFF_YG);
    LAS float* bu = (LAS float*)wl; LAS bf16_t* xb = (LAS bf16_t*)(wl + 16 * S5_BU_LD * 4);
    const int lg = layer * 16 + g;
    float ar, ai, zr, zi;
    { const float lr = fminf(p.in[17][lg * 64 + lane], -1e-4f), li = p.in[18][lg * 64 + lane], dt = __expf(p.in[24][lg]);
      const float mag = __expf(lr * dt); float rev = li * dt * 0.15915494309f; rev -= rintf(rev);
      const float sn = __builtin_amdgcn_sinf(rev), cs = __builtin_amdgcn_cosf(rev); ar = mag * cs; ai = mag * sn;
      const float den = lr * lr + li * li; zr = ((ar - 1.0f) * lr + ai * li) / den; zi = (ai * lr - (ar - 1.0f) * li) / den; }
    bf16x8 Bf[8], Cf[4];
#pragma unroll
    for (int tt = 0; tt < 4; ++tt) {
        const int pp = tt * 16 + col; const float zr2 = __shfl(zr, pp), zi2 = __shfl(zi, pp);
        float bre[8], bim[8];
#pragma unroll
        for (int j = 0; j < 8; ++j) { bre[j] = 0.f; bim[j] = 0.f; }
        if (quad < 2) {
            const float* br_ = p.in[19] + ((size_t)lg * 64 + pp) * 16 + quad * 8; const float* bi_ = p.in[20] + ((size_t)lg * 64 + pp) * 16 + quad * 8;
#pragma unroll
            for (int j = 0; j < 8; ++j) { const float r = br_[j], i = bi_[j]; bre[j] = zr2 * r - zi2 * i; bim[j] = zr2 * i + zi2 * r; }
        }
        u32x4 wr_, wi_;
        wr_.x = cvt_pk_bf16(bre[0], bre[1]); wr_.y = cvt_pk_bf16(bre[2], bre[3]); wr_.z = cvt_pk_bf16(bre[4], bre[5]); wr_.w = cvt_pk_bf16(bre[6], bre[7]);
        wi_.x = cvt_pk_bf16(bim[0], bim[1]); wi_.y = cvt_pk_bf16(bim[2], bim[3]); wi_.z = cvt_pk_bf16(bim[4], bim[5]); wi_.w = cvt_pk_bf16(bim[6], bim[7]);
        Bf[tt] = __builtin_bit_cast(bf16x8, wr_); Bf[4 + tt] = __builtin_bit_cast(bf16x8, wi_);
    }
#pragma unroll
    for (int kb = 0; kb < 4; ++kb) {
        const int k0 = (kb & 1) * 32 + quad * 8; const float sgn = kb < 2 ? 1.0f : -1.0f;
        const float* cp = (kb < 2 ? p.in[21] : p.in[22]) + ((size_t)lg * 16 + col) * 64 + k0;
        u32x4 w; w.x = cvt_pk_bf16(sgn * cp[0], sgn * cp[1]); w.y = cvt_pk_bf16(sgn * cp[2], sgn * cp[3]); w.z = cvt_pk_bf16(sgn * cp[4], sgn * cp[5]); w.w = cvt_pk_bf16(sgn * cp[6], sgn * cp[7]);
        Cf[kb] = __builtin_bit_cast(bf16x8, w);
    }
    const float dcoef = p.in[23][layer * 256 + g * 16 + col];
    float xr = 0.f, xi = 0.f;
    const int nch = SAMPLE ? 1 : (L + 15) / 16;
    u32x4 awn = (u32x4){0u, 0u, 0u, 0u}; bf16_t un[4] = {0, 0, 0, 0};
    auto pf = [&](int cc) {
        const int t0 = cc * 16; const int nrow = SAMPLE ? 16 : ((L - t0) < 16 ? (L - t0) : 16);
        awn = (u32x4){0u, 0u, 0u, 0u};
        if (quad < 2 && col < nrow) awn = *(const u32x4*)(pm + (size_t)(tokbase + t0 + col) * NPM + C_U + g * 16 + quad * 8);
#pragma unroll
        for (int i = 0; i < 4; ++i) { const int r = quad * 4 + i; un[i] = (r < nrow) ? pm[(size_t)(tokbase + t0 + r) * NPM + C_U + g * 16 + col] : (bf16_t)0; }
    };
    pf(0);
    for (int c = 0; c < nch; ++c) {
        const int t0 = c * 16; const int nrow = SAMPLE ? 16 : ((L - t0) < 16 ? (L - t0) : 16);
        const u32x4 aw = awn; bf16_t uc[4];
#pragma unroll
        for (int i = 0; i < 4; ++i) uc[i] = un[i];
        if (c + 1 < nch) pf(c + 1);
        const bf16x8 af = __builtin_bit_cast(bf16x8, aw);
#pragma unroll
        for (int tile = 0; tile < 8; ++tile) {
            const f32x4 d = __builtin_amdgcn_mfma_f32_16x16x32_bf16(af, Bf[tile], (f32x4){0.f, 0.f, 0.f, 0.f}, 0, 0, 0);
#pragma unroll
            for (int i = 0; i < 4; ++i) bu[(quad * 4 + i) * S5_BU_LD + tile * 16 + col] = d[i];
        }
        __builtin_amdgcn_fence(__ATOMIC_RELEASE, "wavefront"); __builtin_amdgcn_wave_barrier(); __builtin_amdgcn_fence(__ATOMIC_ACQUIRE, "wavefront");
        for (int r = 0; r < 16; ++r) {
            float nr = 0.f, ni = 0.f;
            if (r < nrow) {
                if (SAMPLE) { const size_t si = ((size_t)(layer * NDEC + seq0 + r) * 16 + g) * 64 + lane; xr = p.in[5][si]; xi = p.in[6][si]; }
                const float br_ = bu[r * S5_BU_LD + lane], bi_ = bu[r * S5_BU_LD + 64 + lane];
                nr = ar * xr - ai * xi + br_; ni = ar * xi + ai * xr + bi_; xr = nr; xi = ni;
                if (SAMPLE) { const size_t so = ((size_t)(layer * NDEC + seq0 + r) * 16 + g) * 64 + lane; p.out[O_SS5R + so] = nr; p.out[O_SS5I + so] = ni; }
            }
            xb[r * S5_XB_LD + lane] = f2bf(nr); xb[r * S5_XB_LD + 64 + lane] = f2bf(ni);
        }
        __builtin_amdgcn_fence(__ATOMIC_RELEASE, "wavefront"); __builtin_amdgcn_wave_barrier(); __builtin_amdgcn_fence(__ATOMIC_ACQUIRE, "wavefront");
        f32x4 ya = (f32x4){0.f, 0.f, 0.f, 0.f};
#pragma unroll
        for (int kb = 0; kb < 4; ++kb) { const bf16x8 xf = *(const LAS bf16x8*)(xb + col * S5_XB_LD + kb * 32 + quad * 8); ya = __builtin_amdgcn_mfma_f32_16x16x32_bf16(xf, Cf[kb], ya, 0, 0, 0); }
#pragma unroll
        for (int i = 0; i < 4; ++i) { const int r = quad * 4 + i;
            if (r < nrow) { const size_t tok = (size_t)(tokbase + t0 + r); const float uu = bf2f(uc[i]);
                const float y = ya[i] + dcoef * uu; const float ge = y * __builtin_amdgcn_rcpf(1.0f + __expf(-1.5957691216f * (y + 0.044715f * y * y * y)));
                yg[tok * 256 + g * 16 + col] = f2bf(ge); } }
        __builtin_amdgcn_fence(__ATOMIC_RELEASE, "wavefront"); __builtin_amdgcn_wave_barrier(); __builtin_amdgcn_fence(__ATOMIC_ACQUIRE, "wavefront");
    }
    if (!SAMPLE) { const size_t so = ((size_t)(layer * NBATCH + seq0) * 16 + g) * 64 + lane; p.out[O_PS5R + so] = xr; p.out[O_PS5I + so] = xi; }
}

__device__ __forceinline__ void phase_mix(KPR p, int layer, LAS unsigned char* ldsb, int bid, int G) {
    LAS float* lds = (LAS float*)ldsb;
    const int wid = __builtin_amdgcn_readfirstlane(otid() >> 6);
    constexpr int NLONG = 208, NSHORT = 16 + 1536;
    for (int it = bid; it < NLONG; it += G) {
        if (it < 192) {
            const int mix = it >> 6, r = it & 63, b = r >> 3, hh = (r >> 1) & 3, half = r & 1;
            const size_t so = ((size_t)(layer * NBATCH + b) * 4 + hh) * 4096;
            if (mix == 0) mix_item<0>(p, layer, lds, b * SEQ, SEQ, hh, half * 32, 32, nullptr, p.out + O_PGDN + so, nullptr, p.out + O_PCONV + (size_t)(layer * NBATCH + b) * 2304);
            else if (mix == 1) mix_item<1>(p, layer, lds, b * SEQ, SEQ, hh, half * 32, 32, nullptr, p.out + O_PGLA + so, nullptr, nullptr);
            else mix_item<2>(p, layer, lds, b * SEQ, SEQ, hh, half * 32, 32, nullptr, p.out + O_PHG + so, nullptr, nullptr);
        } else {
            __syncthreads();
            const int j = (it - 192) * 8 + wid, b = j >> 4, g = j & 15;
            s5_wave_item<false>(p, layer, ldsb + wid * S5_WAVE_BYTES, g, b * SEQ, SEQ, b);
        }
    }
    const int w0 = (G >= 256) ? 192 : 0, nw = G - w0;
    if (bid >= w0) for (int j = bid - w0; j < NSHORT; j += nw) {
        if (j < 16) {
            __syncthreads();
            const int jj = j * 8 + wid, g = jj & 15, s0 = (jj >> 4) * 16;
            s5_wave_item<true>(p, layer, ldsb + wid * S5_WAVE_BYTES, g, MPROMPT + s0, 16, s0);
        } else {
            const int jj = j - 16, mix = jj >> 9, s = (jj & 511) >> 2, hh = jj & 3;
            const size_t so = ((size_t)(layer * NDEC + s) * 4 + hh) * 4096;
            if (mix == 0) mix_item<0>(p, layer, lds, MPROMPT + s, 1, hh, 0, 64, p.in[3] + so, p.out + O_SGDN + so, p.in[2] + (size_t)(layer * NDEC + s) * 2304, p.out + O_SCONV + (size_t)(layer * NDEC + s) * 2304);
            else if (mix == 1) mix_item<1>(p, layer, lds, MPROMPT + s, 1, hh, 0, 64, p.in[4] + so, p.out + O_SGLA + so, nullptr, nullptr);
            else mix_item<2>(p, layer, lds, MPROMPT + s, 1, hh, 0, 64, p.in[7] + so, p.out + O_SHG + so, nullptr, nullptr);
        }
    }
    __syncthreads();
}

__device__ __forceinline__ void phase_headnorm(KPR p, int layer, int bid, int G) {
    const int tid_ = otid(); const int wid = __builtin_amdgcn_readfirstlane(tid_ >> 6), lane = tid_ & 63;
    const bf16_t* pm = (const bf16_t*)(p.ws + OFF_PM); const bf16_t* oraw = (const bf16_t*)(p.ws + OFF_ORAW); bf16_t* br = (bf16_t*)(p.ws + OFF_BR);
    for (int j = bid * 8 + wid; j < MTOK * 3; j += G * 8) {
        const int tok = j / 3, mix = j - tok * 3;
        const int gcol = mix == 0 ? A_GATE : (mix == 1 ? B_GATE : D_GATE), slot = mix == 2 ? 3 : mix;
        const float* nw = (mix == 0 ? p.in[13] : (mix == 1 ? p.in[16] : p.in[27])) + layer * 256 + lane * 4;
        const u32x2 ow = *(const u32x2*)(oraw + (size_t)tok * 768 + mix * 256 + lane * 4);
        const u32x2 gw = *(const u32x2*)(pm + (size_t)tok * NPM + gcol + lane * 4);
        const float o0 = lo_bf(ow.x), o1 = hi_bf(ow.x), o2 = lo_bf(ow.y), o3 = hi_bf(ow.y);
        float ss = o0 * o0 + o1 * o1 + o2 * o2 + o3 * o3;
        ss += __shfl_xor(ss, 1); ss += __shfl_xor(ss, 2); ss += __shfl_xor(ss, 4); ss += __shfl_xor(ss, 8);
        const float rs = rsqrtf(ss * (1.0f / 64.0f) + EPS);
        const f32x4 w = *(const f32x4*)nw;
        u32x2 r; r.x = cvt_pk_bf16(o0 * rs * w[0] * siluf_(lo_bf(gw.x)), o1 * rs * w[1] * siluf_(hi_bf(gw.x)));
        r.y = cvt_pk_bf16(o2 * rs * w[2] * siluf_(lo_bf(gw.y)), o3 * rs * w[3] * siluf_(hi_bf(gw.y)));
        *(u32x2*)(br + (size_t)tok * 1024 + slot * 256 + lane * 4) = r;
    }
}

constexpr int PH_PER_LAYER = 9, N_PHASES = 4 * PH_PER_LAYER + 1;
__device__ __forceinline__ void run_phase(KPR p, int ph, LAS unsigned char* lds, int bid, int G) {
    unsigned char* ws = p.ws;
    if (ph == N_PHASES - 1) { phase_norm(p, p.in[34], 2, bid, G); return; }
    const int layer = ph / PH_PER_LAYER, s = ph - layer * PH_PER_LAYER;
    pg8::Sched S; pg8::Gemm g;
    switch (s) {
    case 0: phase_convert(p, layer, (LAS float*)lds, bid, G); phase_norm(p, p.in[8] + layer * 1024, layer == 0 ? 0 : 1, bid, G); break;
    case 1: { S.init(65, 30, 1, G, bid, 16); g = pg8::Gemm{(const bf16_t*)(ws + OFF_XN), (const bf16_t*)(ws + OFF_WIN), 1024, 1024, 16, 0, 0};
              pg8::gemm_phase(lds, g, S, EpiIn{(bf16_t*)(ws + OFF_PM), (bf16_t*)(ws + OFF_GATES)}); } break;
    case 2: phase_mix(p, layer, lds, bid, G); break;
    case 3: { S.init(65, 2, 1, G, bid, 4); g = pg8::Gemm{(const bf16_t*)(ws + OFF_YG), (const bf16_t*)(ws + OFF_WGLU), 256, 256, 4, 0, 0};
              pg8::gemm_phase(lds, g, S, EpiGlu{(bf16_t*)(ws + OFF_BR)}); phase_headnorm(p, layer, bid, G); } break;
    case 4: { S.init(65, 4, 4, G, bid, 4); g = pg8::Gemm{(const bf16_t*)(ws + OFF_BR), (const bf16_t*)(ws + OFF_WBR), 1024, 256, 4, 256, (size_t)1024 * 256};
              pg8::gemm_phase(lds, g, S, EpiBr{(const bf16_t*)(ws + OFF_GATES), (bf16_t*)(ws + OFF_PM)}); } break;
    case 5: { S.init(64, 4, 1, G, bid, 16, 4); g = pg8::Gemm{(const bf16_t*)(ws + OFF_PM), (const bf16_t*)(ws + OFF_WOUT), 1024, 1024, 16, 0, 0};
              pg8::gemm_phase(lds, g, S, EpiRes{(float*)(ws + OFF_H)}); } break;
    case 6: phase_norm(p, p.in[30] + layer * 1024, 1, bid, G); break;
    case 7: { S.init(65, 22, 1, G, bid, 16); g = pg8::Gemm{(const bf16_t*)(ws + OFF_XN), (const bf16_t*)(ws + OFF_WGU), 1024, 1024, 16, 0, 0};
              pg8::gemm_phase(lds, g, S, EpiGU{(bf16_t*)(ws + OFF_PM)}); } break;
    case 8: { S.init(64, 4, 1, G, bid, 44, 4); g = pg8::Gemm{(const bf16_t*)(ws + OFF_PM), (const bf16_t*)(ws + OFF_WDN), DFF, DFF, 44, 0, 0};
              pg8::gemm_phase(lds, g, S, EpiRes{(float*)(ws + OFF_H)}); } break;
    }
}

extern __shared__ __attribute__((aligned(16))) unsigned char dyn_smem[];
#if MULTI_LAUNCH
__global__ void __launch_bounds__(512) k_phase(KP parg, int ph) {
    KPR p = *(const CAS KP*)__builtin_amdgcn_kernarg_segment_ptr();
    run_phase(p, ph, (LAS unsigned char*)dyn_smem, blockIdx.x, gridDim.x);
}
#else
__device__ __forceinline__ void grid_bar(unsigned* bar, unsigned k, int bid, int G) {
    asm volatile("s_waitcnt vmcnt(0)" ::: "memory");
    __syncthreads();
    if (otid() == 0) {
        __builtin_amdgcn_fence(__ATOMIC_RELEASE, "agent");
        asm volatile("s_waitcnt vmcnt(0)" ::: "memory");
        const unsigned per = (unsigned)(G - (bid & 7) + 7) >> 3;
        const unsigned old = __hip_atomic_fetch_add(bar + 64 * (1 + (bid & 7)), 1u, __ATOMIC_RELAXED, __HIP_MEMORY_SCOPE_AGENT);
        if (old == per * k - 1u) __hip_atomic_fetch_add(bar, 1u, __ATOMIC_RELAXED, __HIP_MEMORY_SCOPE_AGENT);
        const unsigned ngrp = G < 8 ? (unsigned)G : 8u;
        while (__hip_atomic_load(bar, __ATOMIC_RELAXED, __HIP_MEMORY_SCOPE_AGENT) < ngrp * k) __builtin_amdgcn_s_sleep(1);
    }
    __syncthreads();
    __builtin_amdgcn_fence(__ATOMIC_ACQUIRE, "agent");
    asm volatile("s_waitcnt vmcnt(0)" ::: "memory");
}
template <int PH> __device__ __forceinline__ void run_from(KPR p, cg::grid_group& grid) {
    const CAS KP* pp = &p; asm volatile("" : "+s"(pp));
    int bid = blockIdx.x, G = gridDim.x; asm volatile("" : "+s"(bid), "+s"(G));
    run_phase(*pp, PH, (LAS unsigned char*)dyn_smem, bid, G);
    if constexpr (PH + 1 < N_PHASES) {
        if constexpr (PH == 0) grid.sync();
        else grid_bar((unsigned*)(pp->ws + OFF_BAR), (unsigned)PH, bid, G);
        run_from<PH + 1>(p, grid);
    }
}
__global__ void __launch_bounds__(512) k_mega(KP parg) {
    cg::grid_group grid = cg::this_grid();
    KPR p = *(const CAS KP*)__builtin_amdgcn_kernarg_segment_ptr();
    run_from<0>(p, grid);
}
#endif

extern "C" void kernel_launch(void* const* d_in, const int* in_sizes, int n_in, void* d_out, int out_size, void* d_ws, size_t ws_size, hipStream_t stream) {
    if (ws_size < WS_NEED || n_in < 35) { fprintf(stderr, "workspace too small: %zu < %zu\n", ws_size, (size_t)WS_NEED); return; }
    KP p{};
    for (int i = 0; i < 35; ++i) p.in[i] = (const float*)d_in[i];
    p.out = (float*)d_out; p.ws = (unsigned char*)d_ws;
    constexpr size_t kDynLds = pg8::STAGE_BYTES;
#if MULTI_LAUNCH
    static bool once = false;
    if (!once) { hipFuncSetAttribute((const void*)k_phase, hipFuncAttributeMaxDynamicSharedMemorySize, (int)kDynLds); once = true; }
    for (int ph = 0; ph < N_PHASES; ++ph) hipLaunchKernelGGL(k_phase, dim3(256), dim3(512), kDynLds, stream, p, ph);
#else
    static int grid_blocks = 0;
    if (!grid_blocks) {
        hipFuncSetAttribute((const void*)k_mega, hipFuncAttributeMaxDynamicSharedMemorySize, (int)kDynLds);
        int dev = 0, cus = 0, per_cu = 0;
        hipGetDevice(&dev);
        hipDeviceGetAttribute(&cus, hipDeviceAttributeMultiprocessorCount, dev);
        hipOccupancyMaxActiveBlocksPerMultiprocessor(&per_cu, k_mega, 512, kDynLds);
        if (per_cu < 1) per_cu = 1;
        grid_blocks = cus * per_cu; if (grid_blocks > 256) grid_blocks = 256;
    }
    hipMemsetAsync((unsigned char*)d_ws + OFF_BAR, 0, 4096, stream);
    void* args[] = {&p};
    hipError_t e = hipLaunchCooperativeKernel((void*)k_mega, dim3(grid_blocks), dim3(512), args, kDynLds, stream);
    if (e != hipSuccess) fprintf(stderr, "cooperative launch failed: %s (grid %d)\n", hipGetErrorString(e), grid_blocks);
#endif
}
```

```cpp
#include <hip/hip_runtime.h>
#include <hip/hip_cooperative_groups.h>
#include <cstdio>
namespace cg = cooperative_groups;

#ifndef MULTI_LAUNCH
#define MULTI_LAUNCH 0
#endif

#define LAS __attribute__((address_space(3)))
typedef unsigned short bf16_t;
typedef short bf16x8 __attribute__((ext_vector_type(8)));
typedef float f32x4 __attribute__((ext_vector_type(4)));
typedef float f32x2 __attribute__((ext_vector_type(2)));
typedef unsigned u32x2 __attribute__((ext_vector_type(2)));
typedef unsigned u32x4 __attribute__((ext_vector_type(4)));

constexpr int DM = 1024, SEQ = 2048, NBATCH = 8, NDEC = 128;
constexpr int MPROMPT = NBATCH * SEQ;
constexpr int MTOK = MPROMPT + NDEC;
constexpr int MP = 16640;
constexpr int NPM = 3584, NGATE = 4096, NIN = 7448, DFF = 2816;
constexpr int A_QKV = 0, A_GATE = 768, B_Q = 1024, B_K = 1280, B_V = 1536, B_GATE = 1792, C_U = 2048, D_Q = 2304, D_F = 2560, D_I = 2816, D_GATE = 3072,
              A_ALPHA = 3328, A_BETA = 3332, B_GK = 3336;
constexpr float EPS = 1e-6f;

constexpr size_t SZ_WIN = (size_t)7680 * 1024 * 2, SZ_WGU = (size_t)5632 * 1024 * 2, SZ_WDN = (size_t)1024 * 2816 * 2, SZ_WOUT = (size_t)1024 * 1024 * 2,
                 SZ_WBR = (size_t)4096 * 256 * 2, SZ_WGLU = (size_t)512 * 256 * 2;
constexpr size_t OFF_WIN = 0, OFF_WGU = OFF_WIN + SZ_WIN, OFF_WDN = OFF_WGU + SZ_WGU, OFF_WOUT = OFF_WDN + SZ_WDN, OFF_WBR = OFF_WOUT + SZ_WOUT,
                 OFF_WGLU = OFF_WBR + SZ_WBR, OFF_H = OFF_WGLU + SZ_WGLU, OFF_XN = OFF_H + (size_t)MP * 1024 * 4, OFF_BR = OFF_XN + (size_t)MP * 1024 * 2,
                 OFF_PM = OFF_BR + (size_t)MP * 1024 * 2, OFF_GATES = OFF_PM + (size_t)MP * NPM * 2, OFF_ORAW = OFF_GATES + (size_t)MP * NGATE * 2,
                 OFF_YG = OFF_ORAW + (size_t)MP * 768 * 2, OFF_BAR = OFF_YG + (size_t)MP * 256 * 2, WS_NEED = OFF_BAR + 4096;
constexpr size_t O_PCONV = 16908288, O_PGDN = 16982016, O_PGLA = 17506304, O_PS5R = 18030592, O_PS5I = 18063360, O_PHG = 18096128,
                 O_SCONV = 18620416, O_SGDN = 19800064, O_SGLA = 28188672, O_SS5R = 36577280, O_SS5I = 37101568, O_SHG = 37625856;

struct KP { const float* in[35]; float* out; unsigned char* ws; };
#define CAS __attribute__((address_space(4)))
typedef const CAS KP& KPR;

__device__ __forceinline__ int otid() { int t = threadIdx.x; asm volatile("" : "+v"(t)); return t & 511; }
__device__ __forceinline__ float bf2f(bf16_t b) { return __uint_as_float(((unsigned)b) << 16); }
typedef __bf16 bf16x2_t __attribute__((ext_vector_type(2)));
__device__ __forceinline__ unsigned cvt_pk_bf16(float lo, float hi) { const f32x2 f = {lo, hi}; const bf16x2_t v = __builtin_convertvector(f, bf16x2_t); return __builtin_bit_cast(unsigned, v); }
__device__ __forceinline__ bf16_t f2bf(float f) { return (bf16_t)(cvt_pk_bf16(f, 0.f) & 0xffffu); }
__device__ __forceinline__ float lo_bf(unsigned w) { return __uint_as_float(w << 16); }
__device__ __forceinline__ float hi_bf(unsigned w) { return __uint_as_float(w & 0xffff0000u); }
__device__ __forceinline__ float sigmoidf_(float x) { return __builtin_amdgcn_rcpf(1.0f + __expf(-x)); }
__device__ __forceinline__ float siluf_(float x) { return x * __builtin_amdgcn_rcpf(1.0f + __expf(-x)); }
__device__ __forceinline__ float wave_sum(float v) {
#pragma unroll
    for (int o = 32; o >= 1; o >>= 1) v += __shfl_xor(v, o);
    return v;
}
template <int CTRL> __device__ __forceinline__ float dpp_f(float v) { return __int_as_float(__builtin_amdgcn_update_dpp(0, __float_as_int(v), CTRL, 0xf, 0xf, true)); }
__device__ __forceinline__ float red16(float v) { v += dpp_f<0xB1>(v); v += dpp_f<0x4E>(v); v += dpp_f<0x141>(v); v += dpp_f<0x140>(v); return v; }
__device__ __forceinline__ float red8(float v) { v += dpp_f<0xB1>(v); v += dpp_f<0x4E>(v); v += dpp_f<0x141>(v); return v; }

namespace pg8 {
constexpr int BM = 256, BK = 64, HALF = 128, HTB = HALF * BK * 2, STAGE_BYTES = 8 * HTB, NXCD = 8, WGM = 8;
__device__ __forceinline__ int lds_byte(int r, int c) { const int st = (r >> 4) * 2 + (c >> 5), rr = r & 15, cc = c & 31, ob = rr * 64 + cc * 2; return st * 1024 + (ob ^ (((ob >> 9) & 1) << 5)); }
__device__ __forceinline__ void stage_rc(int b, int& R, int& C) { const int st = b / 1024, sb = b % 1024, swz = sb ^ (((sb >> 9) & 1) << 5); R = (st >> 1) * 16 + swz / 64; C = (st & 1) * 32 + (swz % 64) / 2; }

struct Unit { int pm, pn, kk, k0, nt; };
struct Gemm { const bf16_t* A; const bf16_t* Bt; int lda, ldb, nt; size_t a_kk, b_kk; };
struct Sched {
    int nM, nN, nKK, nwg, G, c, ntf, nts, nextra;
    __device__ void init(int nM_, int nN_, int nKK_, int G_, int c_, int ntf_, int nts_ = 0) { nM = nM_; nN = nN_; nKK = nKK_; nwg = nM * nN; G = G_; c = c_; ntf = ntf_; nts = nts_; nextra = nts_ ? nN_ * (ntf_ / nts_) : 0; }
    __device__ bool next(int i, Unit& u) const {
        const int it = i / nKK; u.kk = i - it * nKK; u.k0 = 0; u.nt = ntf;
        const long L = (long)it * G + c;
        if (L >= nwg) { const int e = (int)(L - nwg); if (e >= nextra) return false; u.pm = nM; u.pn = e % nN; u.k0 = (e / nN) * nts; u.nt = nts; return true; }
        int wgid = (int)L; { const int q = nwg / NXCD, r = nwg % NXCD, xcd = wgid % NXCD, off = wgid / NXCD; wgid = (xcd < r ? xcd * (q + 1) : r * (q + 1) + (xcd - r) * q) + off; }
        const int nig = WGM * nN, gid = wgid / nig, fm = gid * WGM, gsz = (nM - fm) < WGM ? (nM - fm) : WGM;
        u.pm = fm + ((wgid % nig) % gsz); u.pn = (wgid % nig) / gsz; return true;
    }
};

template <class Epi>
__device__ __forceinline__ void gemm_phase(LAS unsigned char* lds, const Gemm g, const Sched& S, const Epi& E) {
    const int tid = otid(), wid = __builtin_amdgcn_readfirstlane(tid >> 6), lane = tid & 63, wr = wid >> 2, wc = wid & 3, fr = lane & 15, fq = lane >> 4;
    unsigned voffA[2], voffB[2];
#pragma unroll
    for (int i = 0; i < 2; ++i) { int R, C; stage_rc(tid * 16 + i * 8192, R, C); voffA[i] = (unsigned)(R * g.lda + C) * 2u; voffB[i] = (unsigned)(R * g.ldb + C) * 2u; }
    const size_t kstep = (size_t)(BK * 2);
    const size_t hstepA = (size_t)HALF * g.lda * 2, hstepB = (size_t)HALF * g.ldb * 2;
    const size_t tstepA = 2 * hstepA, tstepB = 2 * hstepB;
    const unsigned ldsw = (unsigned)wid * 1024u;
    const int aoff = lds_byte(wr * 64 + fr, fq * 8), boff = lds_byte(wc * 32 + fr, fq * 8);
#define PG8_SA(b, h) (((b) * 2 + (h)) * HTB)
#define PG8_SB(b, h) ((4 + (b) * 2 + (h)) * HTB)
#define PG8_STAGE(bufoff, gbase, voff) do { _Pragma("unroll") for (int _i = 0; _i < 2; ++_i) \
        __builtin_amdgcn_global_load_lds((const unsigned*)((const char*)(gbase) + (voff)[_i]), (LAS unsigned*)(lds + (bufoff) + ldsw + _i * 8192), 16, 0, 0); } while (0)
#define PG8_LDA(dst, b, h) do { _Pragma("unroll") for (int m = 0; m < 4; ++m) _Pragma("unroll") for (int k = 0; k < 2; ++k) dst[m][k] = *(const LAS bf16x8*)(lds + PG8_SA(b, h) + aoff + m * 2048 + k * 1024); } while (0)
#define PG8_LDB(dst, b, h) do { _Pragma("unroll") for (int n = 0; n < 2; ++n) _Pragma("unroll") for (int k = 0; k < 2; ++k) dst[n][k] = *(const LAS bf16x8*)(lds + PG8_SB(b, h) + boff + n * 2048 + k * 1024); } while (0)
#define PG8_MMA(ai, bj, At, Bt) do { __builtin_amdgcn_s_setprio(1); _Pragma("unroll") for (int m = 0; m < 4; ++m) _Pragma("unroll") for (int n = 0; n < 2; ++n) _Pragma("unroll") for (int k = 0; k < 2; ++k) \
        acc[ai][bj][m][n] = __builtin_amdgcn_mfma_f32_16x16x32_bf16(Bt[n][k], At[m][k], acc[ai][bj][m][n], 0, 0, 0); __builtin_amdgcn_s_setprio(0); } while (0)
#define PG8_WAIT_V(n) asm volatile("s_waitcnt vmcnt(" #n ")" ::: "memory")
#define PG8_WAIT_L(n) asm volatile("s_waitcnt lgkmcnt(" #n ")" ::: "memory")
#define PG8_BAR __builtin_amdgcn_s_barrier()
#define PG8_SCHED __builtin_amdgcn_sched_barrier(0)
    Unit cur, nxt; int ui = 0;
    if (!S.next(0, cur)) return;
    f32x4 acc[2][2][4][2];
#pragma unroll
    for (int a = 0; a < 2; ++a)
#pragma unroll
        for (int b = 0; b < 2; ++b)
#pragma unroll
            for (int m = 0; m < 4; ++m)
#pragma unroll
                for (int n = 0; n < 2; ++n) acc[a][b][m][n] = (f32x4){0.f, 0.f, 0.f, 0.f};
    bf16x8 At[4][2], B0[2][2], B1[2][2];
    const char* cA = (const char*)(g.A + (size_t)cur.kk * g.a_kk) + (size_t)cur.pm * tstepA + (size_t)cur.k0 * kstep; const char* cB = (const char*)(g.Bt + (size_t)cur.kk * g.b_kk) + (size_t)cur.pn * tstepB + (size_t)cur.k0 * kstep;
    PG8_STAGE(PG8_SB(0, 0), cB, voffB); PG8_STAGE(PG8_SA(0, 0), cA, voffA); PG8_STAGE(PG8_SB(0, 1), cB + hstepB, voffB); PG8_STAGE(PG8_SA(0, 1), cA + hstepA, voffA);
    if (wr == 1) PG8_BAR;
    PG8_WAIT_V(4); PG8_BAR;
    PG8_STAGE(PG8_SB(1, 0), cB + kstep, voffB); PG8_STAGE(PG8_SA(1, 0), cA + kstep, voffA); PG8_STAGE(PG8_SB(1, 1), cB + hstepB + kstep, voffB);
    PG8_WAIT_V(6); PG8_BAR;
    for (;;) {
        const bool has_next = S.next(ui + 1, nxt);
        const char* nA = has_next ? (const char*)(g.A + (size_t)nxt.kk * g.a_kk) + (size_t)nxt.pm * tstepA + (size_t)nxt.k0 * kstep : cA;
        const char* nB = has_next ? (const char*)(g.Bt + (size_t)nxt.kk * g.b_kk) + (size_t)nxt.pn * tstepB + (size_t)nxt.k0 * kstep : cB;
        int nt = cur.nt; asm volatile("" : "+s"(nt));
        for (int t = 0; t < nt; t += 2) {
            const bool last = (t == nt - 2);
            const char* a1 = cA + (size_t)(t + 1) * kstep;
            const char* a2 = last ? nA : cA + (size_t)(t + 2) * kstep; const char* b2 = last ? nB : cB + (size_t)(t + 2) * kstep;
            const char* a3 = a2 + kstep; const char* b3 = b2 + kstep;
            PG8_LDB(B0, 0, 0); PG8_SCHED; PG8_LDA(At, 0, 0); PG8_STAGE(PG8_SA(1, 1), a1 + hstepA, voffA);
            PG8_WAIT_L(8); PG8_BAR; PG8_WAIT_L(0); PG8_MMA(0, 0, At, B0); PG8_BAR; PG8_SCHED;
            PG8_LDB(B1, 0, 1); PG8_STAGE(PG8_SB(0, 0), b2, voffB);
            PG8_BAR; PG8_WAIT_L(0); PG8_MMA(0, 1, At, B1); PG8_BAR;
            PG8_LDA(At, 0, 1); PG8_STAGE(PG8_SA(0, 0), a2, voffA);
            PG8_BAR; PG8_WAIT_L(0); PG8_MMA(1, 0, At, B0); PG8_BAR; PG8_SCHED;
            PG8_STAGE(PG8_SB(0, 1), b2 + hstepB, voffB);
            PG8_WAIT_V(6); PG8_BAR; PG8_MMA(1, 1, At, B1); PG8_BAR;
            PG8_LDB(B0, 1, 0); PG8_SCHED; PG8_LDA(At, 1, 0); PG8_STAGE(PG8_SA(0, 1), a2 + hstepA, voffA);
            PG8_WAIT_L(8); PG8_BAR; PG8_WAIT_L(0); PG8_MMA(0, 0, At, B0); PG8_BAR; PG8_SCHED;
            PG8_LDB(B1, 1, 1); PG8_STAGE(PG8_SB(1, 0), b3, voffB);
            PG8_BAR; PG8_WAIT_L(0); PG8_MMA(0, 1, At, B1); PG8_BAR;
            PG8_LDA(At, 1, 1); PG8_STAGE(PG8_SA(1, 0), a3, voffA);
            PG8_BAR; PG8_WAIT_L(0); PG8_MMA(1, 0, At, B0); PG8_BAR; PG8_SCHED;
            PG8_STAGE(PG8_SB(1, 1), b3 + hstepB, voffB);
            PG8_WAIT_V(6); PG8_BAR; PG8_MMA(1, 1, At, B1); PG8_BAR;
        }
        E(acc, cur, wr, wc, fr, fq);
        if (!has_next) break;
#pragma unroll
        for (int a = 0; a < 2; ++a)
#pragma unroll
            for (int b = 0; b < 2; ++b)
#pragma unroll
                for (int m = 0; m < 4; ++m)
#pragma unroll
                    for (int n = 0; n < 2; ++n) acc[a][b][m][n] = (f32x4){0.f, 0.f, 0.f, 0.f};
        cur = nxt; cA = nA; cB = nB; ++ui;
    }
    PG8_WAIT_V(0);
    if (wr == 0) PG8_BAR;
    PG8_BAR;
    __builtin_amdgcn_s_waitcnt(0);
#undef PG8_SA
#undef PG8_SB
#undef PG8_STAGE
#undef PG8_LDA
#undef PG8_LDB
#undef PG8_MMA
#undef PG8_WAIT_V
#undef PG8_WAIT_L
#undef PG8_BAR
#undef PG8_SCHED
}
}
using pg8::Unit;

#define EPI_LOOP_BEGIN _Pragma("unroll") for (int ai = 0; ai < 2; ++ai) _Pragma("unroll") for (int m = 0; m < 4; ++m) { const size_t row = (size_t)(u.pm * 256 + ai * 128 + wr * 64 + m * 16 + fr); \
        _Pragma("unroll") for (int bj = 0; bj < 2; ++bj) {
#define EPI_LOOP_END } }
struct EpiIn {
    bf16_t* pm; bf16_t* gates;
    __device__ __forceinline__ void operator()(const f32x4 (&acc)[2][2][4][2], const Unit& u, int wr, int wc, int fr, int fq) const {
        const bool main_ = u.pn < 14;
        EPI_LOOP_BEGIN
#pragma unroll
            for (int n = 0; n < 2; ++n) { const int col = u.pn * 256 + bj * 128 + wc * 32 + n * 16 + fq * 4; f32x4 v = acc[ai][bj][m][n]; u32x2 w;
                if (main_) { w.x = cvt_pk_bf16(v[0], v[1]); w.y = cvt_pk_bf16(v[2], v[3]); *(u32x2*)(pm + row * NPM + col) = w; }
                else { w.x = cvt_pk_bf16(sigmoidf_(v[0]), sigmoidf_(v[1])); w.y = cvt_pk_bf16(sigmoidf_(v[2]), sigmoidf_(v[3])); *(u32x2*)(gates + row * NGATE + (col - NPM)) = w; } }
        EPI_LOOP_END
    }
};
struct EpiGlu {
    bf16_t* br;
    __device__ __forceinline__ void operator()(const f32x4 (&acc)[2][2][4][2], const Unit& u, int wr, int wc, int fr, int fq) const {
        EPI_LOOP_BEGIN
            const int j = u.pn * 128 + bj * 64 + wc * 16 + fq * 4; const f32x4 a = acc[ai][bj][m][0], b = acc[ai][bj][m][1]; u32x2 w;
            w.x = cvt_pk_bf16(a[0] * sigmoidf_(b[0]), a[1] * sigmoidf_(b[1])); w.y = cvt_pk_bf16(a[2] * sigmoidf_(b[2]), a[3] * sigmoidf_(b[3]));
            *(u32x2*)(br + row * 1024 + 512 + j) = w;
        EPI_LOOP_END
    }
};
struct EpiGU {
    bf16_t* a;
    __device__ __forceinline__ void operator()(const f32x4 (&acc)[2][2][4][2], const Unit& u, int wr, int wc, int fr, int fq) const {
        EPI_LOOP_BEGIN
            const int j = u.pn * 128 + bj * 64 + wc * 16 + fq * 4; const f32x4 g = acc[ai][bj][m][0], b = acc[ai][bj][m][1]; u32x2 w;
            w.x = cvt_pk_bf16(siluf_(g[0]) * b[0], siluf_(g[1]) * b[1]); w.y = cvt_pk_bf16(siluf_(g[2]) * b[2], siluf_(g[3]) * b[3]);
            *(u32x2*)(a + row * DFF + j) = w;
        EPI_LOOP_END
    }
};
struct EpiBr {
    const bf16_t* gates; bf16_t* mm;
    __device__ __forceinline__ void operator()(const f32x4 (&acc)[2][2][4][2], const Unit& u, int wr, int wc, int fr, int fq) const {
        const int col0 = u.pn * 256 + wc * 32 + fq * 4;
#pragma unroll
        for (int ai = 0; ai < 2; ++ai) {
            if (ai == 1 && u.pm == 64) break;
            const size_t row0 = (size_t)(u.pm * 256 + ai * 128 + wr * 64 + fr);
            u32x2 gw[4][2][2], pw[4][2][2];
#pragma unroll
            for (int m = 0; m < 4; ++m)
#pragma unroll
                for (int bj = 0; bj < 2; ++bj)
#pragma unroll
                    for (int n = 0; n < 2; ++n) { const size_t row = row0 + m * 16; const int col = col0 + bj * 128 + n * 16;
                        gw[m][bj][n] = *(const u32x2*)(gates + row * NGATE + u.kk * 1024 + col);
                        pw[m][bj][n] = (u32x2){0u, 0u}; if (u.kk > 0) pw[m][bj][n] = *(const u32x2*)(mm + row * 1024 + col); }
#pragma unroll
            for (int m = 0; m < 4; ++m)
#pragma unroll
                for (int bj = 0; bj < 2; ++bj)
#pragma unroll
                    for (int n = 0; n < 2; ++n) { const size_t row = row0 + m * 16; const int col = col0 + bj * 128 + n * 16; const f32x4 v = acc[ai][bj][m][n]; const u32x2 g = gw[m][bj][n], q = pw[m][bj][n];
                        u32x2 w; w.x = cvt_pk_bf16(lo_bf(g.x) * v[0] + lo_bf(q.x), hi_bf(g.x) * v[1] + hi_bf(q.x)); w.y = cvt_pk_bf16(lo_bf(g.y) * v[2] + lo_bf(q.y), hi_bf(g.y) * v[3] + hi_bf(q.y));
                        *(u32x2*)(mm + row * 1024 + col) = w; }
        }
    }
};
struct EpiRes {
    float* h;
    __device__ __forceinline__ void operator()(const f32x4 (&acc)[2][2][4][2], const Unit& u, int wr, int wc, int fr, int fq) const {
        const bool split = u.pm == 64;
        EPI_LOOP_BEGIN
#pragma unroll
            for (int n = 0; n < 2; ++n) { const int col = u.pn * 256 + bj * 128 + wc * 32 + n * 16 + fq * 4; float* ptr = h + row * 1024 + col;
                if (split) {
#pragma unroll
                    for (int e = 0; e < 4; ++e) __hip_atomic_fetch_add(ptr + e, acc[ai][bj][m][n][e], __ATOMIC_RELAXED, __HIP_MEMORY_SCOPE_AGENT);
                } else { const f32x4 o = *(const f32x4*)ptr; *(f32x4*)ptr = o + acc[ai][bj][m][n]; } }
        EPI_LOOP_END
    }
};

__device__ __forceinline__ int win_src_col(int n) {
    if (n < 768) return n;
    if (n < 1024) return 776 + (n - 768);
    if (n < 1792) return 1032 + (n - 1024);
    if (n < 2048) return 1816 + (n - 1792);
    if (n < 2304) return 2072 + (n - 2048);
    if (n < 3072) return 2328 + (n - 2304);
    if (n < 3328) return 3096 + (n - 3072);
    if (n < 3336) return 768 + (n - 3328);
    if (n < 3352) return 1800 + (n - 3336);
    if (n < 3584) return -1;
    return 3352 + (n - 3584);
}
__device__ __forceinline__ void phase_convert(KPR p, int layer, LAS float* tile, int bid, int G) {
    const int tid = otid(), tn = tid & 63, tk = __builtin_amdgcn_readfirstlane(tid >> 6);
    constexpr int T0 = 120 * 16, T1 = T0 + 88 * 16, T2 = T1 + 16 * 44, T3 = T2 + 16 * 16, T4 = T3 + 64 * 4, T5 = T4 + 8 * 4;
    for (int j = bid; j < T5; j += G) {
        int n0, k0, K, ld; bf16_t* dst; const float* cp = nullptr;
        if (j < T0) { const int q = j; n0 = (q >> 4) * 64; k0 = (q & 15) * 64; K = 1024; ld = NIN; dst = (bf16_t*)(p.ws + OFF_WIN);
            const int sc = win_src_col(n0 + tn); if (sc >= 0) cp = p.in[9] + (size_t)layer * 1024 * NIN + sc; }
        else if (j < T1) { const int q = j - T0; n0 = (q >> 4) * 64; k0 = (q & 15) * 64; K = 1024; ld = DFF; dst = (bf16_t*)(p.ws + OFF_WGU);
            const int n = n0 + tn, g32 = n >> 5, w = n & 31, jj = g32 * 16 + (w & 15); cp = (w < 16 ? p.in[31] : p.in[32]) + (size_t)layer * 1024 * DFF + jj; }
        else if (j < T2) { const int q = j - T1; n0 = (q / 44) * 64; k0 = (q % 44) * 64; K = DFF; ld = 1024; dst = (bf16_t*)(p.ws + OFF_WDN);
            cp = p.in[33] + (size_t)layer * DFF * 1024 + (n0 + tn); }
        else if (j < T3) { const int q = j - T2; n0 = (q >> 4) * 64; k0 = (q & 15) * 64; K = 1024; ld = 1024; dst = (bf16_t*)(p.ws + OFF_WOUT);
            cp = p.in[29] + (size_t)layer * 1024 * 1024 + (n0 + tn); }
        else if (j < T4) { const int q = j - T3; n0 = (q >> 2) * 64; k0 = (q & 3) * 64; K = 256; ld = 1024; dst = (bf16_t*)(p.ws + OFF_WBR);
            const int n = n0 + tn, kk = n >> 10, d = n & 1023; cp = p.in[28] + ((size_t)(layer * 4 + kk) * 256) * 1024 + d; }
        else { const int q = j - T4; n0 = (q >> 2) * 64; k0 = (q & 3) * 64; K = 256; ld = 512; dst = (bf16_t*)(p.ws + OFF_WGLU);
            const int n = n0 + tn, g32 = n >> 5, w = n & 31, jj = g32 * 16 + (w & 15); cp = p.in[25] + (size_t)layer * 256 * 512 + (w < 16 ? jj : 256 + jj); }
        __syncthreads();
#pragma unroll
        for (int e = 0; e < 8; ++e) { const int k = k0 + tk * 8 + e; tile[tn * 65 + tk * 8 + e] = cp ? cp[(size_t)k * ld] : 0.f; }
        __syncthreads();
        { const int n = tid >> 3, ks = tid & 7; const LAS float* tp = tile + n * 65 + ks * 8; u32x4 w;
          w.x = cvt_pk_bf16(tp[0], tp[1]); w.y = cvt_pk_bf16(tp[2], tp[3]); w.z = cvt_pk_bf16(tp[4], tp[5]); w.w = cvt_pk_bf16(tp[6], tp[7]);
          *(u32x4*)(dst + (size_t)(n0 + n) * K + k0 + ks * 8) = w; }
    }
    __syncthreads();
}

__device__ __forceinline__ void phase_norm(KPR p, const float* w, int mode, int bid, int G) {
    const int tid_ = otid(); const int wid = __builtin_amdgcn_readfirstlane(tid_ >> 6), lane = tid_ & 63;
    float* h = (float*)(p.ws + OFF_H); bf16_t* xn = (bf16_t*)(p.ws + OFF_XN);
    f32x4 wv[4];
#pragma unroll
    for (int i = 0; i < 4; ++i) wv[i] = *(const f32x4*)(w + i * 256 + lane * 4);
    for (int r = bid * 8 + wid; r < MTOK; r += G * 8) {
        const float* src = (mode == 0) ? (r < MPROMPT ? p.in[0] + (size_t)r * 1024 : p.in[1] + (size_t)(r - MPROMPT) * 1024) : h + (size_t)r * 1024;
        f32x4 v[4]; float ss = 0.f;
#pragma unroll
        for (int i = 0; i < 4; ++i) { v[i] = *(const f32x4*)(src + i * 256 + lane * 4); ss += v[i][0] * v[i][0] + v[i][1] * v[i][1] + v[i][2] * v[i][2] + v[i][3] * v[i][3]; }
        ss = wave_sum(ss);
        const float rs = rsqrtf(ss * (1.0f / 1024.0f) + EPS);
#pragma unroll
        for (int i = 0; i < 4; ++i) {
            const f32x4 y = v[i] * rs * wv[i];
            if (mode == 2) *(f32x4*)(p.out + (size_t)r * 1024 + i * 256 + lane * 4) = y;
            else { u32x2 o; o.x = cvt_pk_bf16(y[0], y[1]); o.y = cvt_pk_bf16(y[2], y[3]); *(u32x2*)(xn + (size_t)r * 1024 + i * 256 + lane * 4) = o;
                   if (mode == 0) *(f32x4*)(h + (size_t)r * 1024 + i * 256 + lane * 4) = v[i]; }
        }
    }
}

constexpr int TCH = 32;
constexpr int MIXBUF_FLOATS = 4 * TCH * 64 + TCH * 4;
template <int MIX>
__device__ __forceinline__ void mix_item(KPR p, int layer, LAS float* lds, int tokbase, int L, int h, int col0, int ncols,
                         const float* s_in, float* s_out, const float* conv_in, float* conv_out) {
    const int tid = otid(), wid = __builtin_amdgcn_readfirstlane(tid >> 6), lane = tid & 63;
    const int nscan = ncols * 8; const bool is_scan = wid < (nscan >> 6);
    const int ksl = lane & 7, cl = wid * 8 + (lane >> 3), col = col0 + cl;
    const bf16_t* pm = (const bf16_t*)(p.ws + OFF_PM);
    bf16_t* oraw = (bf16_t*)(p.ws + OFF_ORAW);
    __syncthreads();
    float S[8];
#pragma unroll
    for (int i = 0; i < 8; ++i) S[i] = (is_scan && s_in) ? s_in[(ksl * 8 + i) * 64 + col] : 0.f;
    const int tl = lane >> 4, d4 = (lane & 15) * 4, hd4 = h * 64 + d4;
    f32x4 cw[3][4]; float c_a = 0.f, c_dt = 0.f; f32x4 gkw[16]; f32x4 gkb = (f32x4){0.f, 0.f, 0.f, 0.f}, lb4 = (f32x4){0.f, 0.f, 0.f, 0.f};
    if (MIX == 0) {
        const float* cwp = p.in[10] + (size_t)layer * 4 * 768;
#pragma unroll
        for (int s = 0; s < 3; ++s)
#pragma unroll
            for (int j = 0; j < 4; ++j) cw[s][j] = *(const f32x4*)(cwp + j * 768 + s * 256 + hd4);
        c_a = -__expf(p.in[11][layer * 4 + h]); c_dt = p.in[12][layer * 4 + h];
        if (conv_out && col0 == 0 && h == 0) {
            for (int idx = tid; idx < 3 * 768; idx += 512) { const int i = idx / 768, c = idx - i * 768, ti = L - 3 + i;
                conv_out[idx] = ti >= 0 ? bf2f(pm[(size_t)(tokbase + ti) * NPM + A_QKV + c]) : (conv_in ? conv_in[(3 + ti) * 768 + c] : 0.f); }
        }
    } else if (MIX == 1) {
#pragma unroll
        for (int r = 0; r < 16; ++r) gkw[r] = *(const f32x4*)(p.in[14] + ((size_t)layer * 16 + r) * 256 + hd4);
        gkb = *(const f32x4*)(p.in[15] + layer * 256 + hd4);
    } else {
        const float* lg = p.in[26] + hd4; const f32x4 a0 = *(const f32x4*)lg, a1 = *(const f32x4*)(lg + 256), a2 = *(const f32x4*)(lg + 512), a3 = *(const f32x4*)(lg + 768);
#pragma unroll
        for (int e = 0; e < 4; ++e) {
            const float mx = fmaxf(fmaxf(a0[e], a1[e]), fmaxf(a2[e], a3[e])); const float l0 = __expf(a0[e] - mx), l1 = __expf(a1[e] - mx), l2 = __expf(a2[e] - mx), l3 = __expf(a3[e] - mx);
            const float inv = 1.0f / (l0 + l1 + l2 + l3);
            lb4[e] = (layer == 0) ? 0.f : (layer == 1) ? l1 * inv : (layer == 2) ? (l1 + l2) * inv : (l1 + l2 + l3) * inv;
        }
    }
    const int nch = (L + TCH - 1) / TCH;
    auto prep = [&](int c, int pw, int npw) {
        LAS float* kb = lds + (c & 1) * MIXBUF_FLOATS; LAS float* qb = kb + TCH * 64; LAS float* fb = qb + TCH * 64; LAS float* vb = fb + TCH * 64; LAS float* sc = vb + TCH * 64;
#pragma unroll
        for (int pass = 0; pass < 2; ++pass) {
            const int tt0 = (pass * npw + pw) * 4;
            if (tt0 < TCH) {
                const int tt = tt0 + tl, t = c * TCH + tt;
                if (t < L) {
                    const bf16_t* row = pm + (size_t)(tokbase + t) * NPM;
                    if (MIX == 0) {
                        f32x4 y[3];
#pragma unroll
                        for (int s = 0; s < 3; ++s) { f32x4 a = (f32x4){0.f, 0.f, 0.f, 0.f};
#pragma unroll
                            for (int j = 0; j < 4; ++j) { const int ti = t - 3 + j; f32x4 xv = (f32x4){0.f, 0.f, 0.f, 0.f};
                                if (ti >= 0) { const u32x2 w = *(const u32x2*)(pm + (size_t)(tokbase + ti) * NPM + A_QKV + s * 256 + hd4); xv = (f32x4){lo_bf(w.x), hi_bf(w.x), lo_bf(w.y), hi_bf(w.y)}; }
                                else if (conv_in) xv = *(const f32x4*)(conv_in + (3 + ti) * 768 + s * 256 + hd4);
                                a += xv * cw[s][j]; }
                            y[s] = (f32x4){siluf_(a[0]), siluf_(a[1]), siluf_(a[2]), siluf_(a[3])}; }
                        const float qq = red16(y[0][0] * y[0][0] + y[0][1] * y[0][1] + y[0][2] * y[0][2] + y[0][3] * y[0][3]);
                        const float kk2 = red16(y[1][0] * y[1][0] + y[1][1] * y[1][1] + y[1][2] * y[1][2] + y[1][3] * y[1][3]);
                        const f32x4 qn = y[0] * (rsqrtf(qq + EPS) * 0.125f), kn = y[1] * rsqrtf(kk2 + EPS);
                        const float kq = red16(qn[0] * kn[0] + qn[1] * kn[1] + qn[2] * kn[2] + qn[3] * kn[3]);
                        *(LAS f32x4*)(kb + tt * 64 + d4) = kn; *(LAS f32x4*)(qb + tt * 64 + d4) = qn; *(LAS f32x4*)(vb + tt * 64 + d4) = y[2];
                        if ((lane & 15) == 0) { const float al = bf2f(row[A_ALPHA + h]) + c_dt; const float sp = fmaxf(al, 0.f) + __logf(1.0f + __expf(-fabsf(al)));
                            *(LAS f32x4*)(sc + tt * 4) = (f32x4){__expf(c_a * sp), sigmoidf_(bf2f(row[A_BETA + h])), kq, 0.f}; }
                    } else if (MIX == 1) {
                        const u32x4 g0 = *(const u32x4*)(row + B_GK), g1 = *(const u32x4*)(row + B_GK + 8);
                        const u32x2 wq = *(const u32x2*)(row + B_Q + hd4), wk = *(const u32x2*)(row + B_K + hd4), wv = *(const u32x2*)(row + B_V + hd4);
                        f32x4 z = gkb;
                        z += lo_bf(g0.x) * gkw[0] + hi_bf(g0.x) * gkw[1] + lo_bf(g0.y) * gkw[2] + hi_bf(g0.y) * gkw[3] + lo_bf(g0.z) * gkw[4] + hi_bf(g0.z) * gkw[5] + lo_bf(g0.w) * gkw[6] + hi_bf(g0.w) * gkw[7];
                        z += lo_bf(g1.x) * gkw[8] + hi_bf(g1.x) * gkw[9] + lo_bf(g1.y) * gkw[10] + hi_bf(g1.y) * gkw[11] + lo_bf(g1.z) * gkw[12] + hi_bf(g1.z) * gkw[13] + lo_bf(g1.w) * gkw[14] + hi_bf(g1.w) * gkw[15];
                        f32x4 f;
#pragma unroll
                        for (int e = 0; e < 4; ++e) { const float sp = fmaxf(-z[e], 0.f) + __logf(1.0f + __expf(-fabsf(z[e]))); f[e] = __expf(-sp * (1.0f / 16.0f)); }
                        *(LAS f32x4*)(fb + tt * 64 + d4) = f;
                        *(LAS f32x4*)(qb + tt * 64 + d4) = (f32x4){lo_bf(wq.x), hi_bf(wq.x), lo_bf(wq.y), hi_bf(wq.y)} * 0.125f;
                        *(LAS f32x4*)(kb + tt * 64 + d4) = (f32x4){lo_bf(wk.x), hi_bf(wk.x), lo_bf(wk.y), hi_bf(wk.y)};
                        *(LAS f32x4*)(vb + tt * 64 + d4) = (f32x4){lo_bf(wv.x), hi_bf(wv.x), lo_bf(wv.y), hi_bf(wv.y)};
                    } else {
                        const u32x2 wq = *(const u32x2*)(row + D_Q + hd4), wf = *(const u32x2*)(row + D_F + hd4), wv = *(const u32x2*)(row + D_I + hd4);
                        const f32x4 xq = (f32x4){lo_bf(wq.x), hi_bf(wq.x), lo_bf(wq.y), hi_bf(wq.y)}, xf = (f32x4){lo_bf(wf.x), hi_bf(wf.x), lo_bf(wf.y), hi_bf(wf.y)};
                        f32x4 f, k, q;
#pragma unroll
                        for (int e = 0; e < 4; ++e) { const float sg = sigmoidf_(xf[e]); f[e] = lb4[e] + (1.0f - lb4[e]) * sg; k[e] = (1.0f - lb4[e]) * (1.0f - sg); q[e] = siluf_(xq[e]) * 0.125f; }
                        *(LAS f32x4*)(fb + tt * 64 + d4) = f; *(LAS f32x4*)(kb + tt * 64 + d4) = k; *(LAS f32x4*)(qb + tt * 64 + d4) = q;
                        *(LAS f32x4*)(vb + tt * 64 + d4) = (f32x4){lo_bf(wv.x), hi_bf(wv.x), lo_bf(wv.y), hi_bf(wv.y)};
                    }
                }
            }
        }
    };
    prep(0, wid, 8);
    __syncthreads();
    for (int c = 0; c < nch; ++c) {
        if (is_scan) {
            const LAS float* kb = lds + (c & 1) * MIXBUF_FLOATS; const LAS float* qb = kb + TCH * 64; const LAS float* fb = qb + TCH * 64; const LAS float* vb = fb + TCH * 64; const LAS float* sc = vb + TCH * 64;
            const int ntok = (L - c * TCH) < TCH ? (L - c * TCH) : TCH;
            bf16_t* op = oraw + (size_t)(tokbase + c * TCH) * 768 + MIX * 256 + h * 64 + col;
            const LAS float* kp = kb + ksl * 8; const LAS float* qp = qb + ksl * 8; const LAS float* fp = fb + ksl * 8; const LAS float* vp = vb + col;
            f32x4 k0 = *(const LAS f32x4*)kp, k1 = *(const LAS f32x4*)(kp + 4), q0 = *(const LAS f32x4*)qp, q1 = *(const LAS f32x4*)(qp + 4);
            f32x4 f0 = (f32x4){0.f, 0.f, 0.f, 0.f}, f1 = f0, scv = f0;
            if (MIX == 0) scv = *(const LAS f32x4*)sc; else { f0 = *(const LAS f32x4*)fp; f1 = *(const LAS f32x4*)(fp + 4); }
            float v = vp[0];
            __builtin_amdgcn_s_setprio(3);
#pragma unroll 2
            for (int tt = 0; tt < ntok; ++tt) {
                const int tn = (tt + 1 < TCH) ? tt + 1 : tt;
                const f32x4 nk0 = *(const LAS f32x4*)(kp + tn * 64), nk1 = *(const LAS f32x4*)(kp + tn * 64 + 4), nq0 = *(const LAS f32x4*)(qp + tn * 64), nq1 = *(const LAS f32x4*)(qp + tn * 64 + 4);
                f32x4 nf0 = f0, nf1 = f1, nsc = scv;
                if (MIX == 0) nsc = *(const LAS f32x4*)(sc + tn * 4); else { nf0 = *(const LAS f32x4*)(fp + tn * 64); nf1 = *(const LAS f32x4*)(fp + tn * 64 + 4); }
                const float nv = vp[tn * 64];
                float o;
                if (MIX == 0) {
                    const float eg = scv[0], beta = scv[1], kq = scv[2];
                    float dk = (S[0] * k0[0] + S[1] * k0[1]) + (S[2] * k0[2] + S[3] * k0[3]) + (S[4] * k1[0] + S[5] * k1[1]) + (S[6] * k1[2] + S[7] * k1[3]);
                    float dq = (S[0] * q0[0] + S[1] * q0[1]) + (S[2] * q0[2] + S[3] * q0[3]) + (S[4] * q1[0] + S[5] * q1[1]) + (S[6] * q1[2] + S[7] * q1[3]);
                    dk = red8(dk); dq = red8(dq);
                    const float delta = beta * (v - eg * dk);
#pragma unroll
                    for (int i = 0; i < 4; ++i) { S[i] = eg * S[i] + k0[i] * delta; S[4 + i] = eg * S[4 + i] + k1[i] * delta; }
                    o = eg * dq + kq * delta;
                } else {
#pragma unroll
                    for (int i = 0; i < 4; ++i) { S[i] = f0[i] * S[i] + k0[i] * v; S[4 + i] = f1[i] * S[4 + i] + k1[i] * v; }
                    float dq = (S[0] * q0[0] + S[1] * q0[1]) + (S[2] * q0[2] + S[3] * q0[3]) + (S[4] * q1[0] + S[5] * q1[1]) + (S[6] * q1[2] + S[7] * q1[3]);
                    o = red8(dq);
                }
                if (ksl == 0) op[(size_t)tt * 768] = f2bf(o);
                k0 = nk0; k1 = nk1; q0 = nq0; q1 = nq1; f0 = nf0; f1 = nf1; scv = nsc; v = nv;
            }
            __builtin_amdgcn_s_setprio(0);
        } else if (c + 1 < nch) prep(c + 1, wid - (nscan >> 6), 8 - (nscan >> 6));
        __syncthreads();
    }
    if (is_scan) {
#pragma unroll
        for (int i = 0; i < 8; ++i) s_out[(ksl * 8 + i) * 64 + col] = S[i];
    }
}

constexpr int S5_BU_LD = 132, S5_XB_LD = 136, S5_WAVE_BYTES = 16 * S5_BU_LD * 4 + 16 * S5_XB_LD * 2;
template <bool SAMPLE>
__device__ __forceinline__ void s5_wave_item(KPR p, int layer, LAS unsigned char* wl, int g, int tokbase, int L, int seq0) {
    const int lane = otid() & 63, col = lane & 15, quad = lane >> 4;
    const bf16_t* pm = (const bf16_t*)(p.ws + OFF_PM); bf16_t* yg = (bf16_t*)(p.ws + OFF_YG);
    LAS float* bu = (LAS float*)wl; LAS bf16_t* xb = (LAS bf16_t*)(wl + 16 * S5_BU_LD * 4);
    const int lg = layer * 16 + g;
    float ar, ai, zr, zi;
    { const float lr = fminf(p.in[17][lg * 64 + lane], -1e-4f), li = p.in[18][lg * 64 + lane], dt = __expf(p.in[24][lg]);
      const float mag = __expf(lr * dt); float rev = li * dt * 0.15915494309f; rev -= rintf(rev);
      const float sn = __builtin_amdgcn_sinf(rev), cs = __builtin_amdgcn_cosf(rev); ar = mag * cs; ai = mag * sn;
      const float den = lr * lr + li * li; zr = ((ar - 1.0f) * lr + ai * li) / den; zi = (ai * lr - (ar - 1.0f) * li) / den; }
    bf16x8 Bf[8], Cf[4];
#pragma unroll
    for (int tt = 0; tt < 4; ++tt) {
        const int pp = tt * 16 + col; const float zr2 = __shfl(zr, pp), zi2 = __shfl(zi, pp);
        float bre[8], bim[8];
#pragma unroll
        for (int j = 0; j < 8; ++j) { bre[j] = 0.f; bim[j] = 0.f; }
        if (quad < 2) {
            const float* br_ = p.in[19] + ((size_t)lg * 64 + pp) * 16 + quad * 8; const float* bi_ = p.in[20] + ((size_t)lg * 64 + pp) * 16 + quad * 8;
#pragma unroll
            for (int j = 0; j < 8; ++j) { const float r = br_[j], i = bi_[j]; bre[j] = zr2 * r - zi2 * i; bim[j] = zr2 * i + zi2 * r; }
        }
        u32x4 wr_, wi_;
        wr_.x = cvt_pk_bf16(bre[0], bre[1]); wr_.y = cvt_pk_bf16(bre[2], bre[3]); wr_.z = cvt_pk_bf16(bre[4], bre[5]); wr_.w = cvt_pk_bf16(bre[6], bre[7]);
        wi_.x = cvt_pk_bf16(bim[0], bim[1]); wi_.y = cvt_pk_bf16(bim[2], bim[3]); wi_.z = cvt_pk_bf16(bim[4], bim[5]); wi_.w = cvt_pk_bf16(bim[6], bim[7]);
        Bf[tt] = __builtin_bit_cast(bf16x8, wr_); Bf[4 + tt] = __builtin_bit_cast(bf16x8, wi_);
    }
#pragma unroll
    for (int kb = 0; kb < 4; ++kb) {
        const int k0 = (kb & 1) * 32 + quad * 8; const float sgn = kb < 2 ? 1.0f : -1.0f;
        const float* cp = (kb < 2 ? p.in[21] : p.in[22]) + ((size_t)lg * 16 + col) * 64 + k0;
        u32x4 w; w.x = cvt_pk_bf16(sgn * cp[0], sgn * cp[1]); w.y = cvt_pk_bf16(sgn * cp[2], sgn * cp[3]); w.z = cvt_pk_bf16(sgn * cp[4], sgn * cp[5]); w.w = cvt_pk_bf16(sgn * cp[6], sgn * cp[7]);
        Cf[kb] = __builtin_bit_cast(bf16x8, w);
    }
    const float dcoef = p.in[23][layer * 256 + g * 16 + col];
    float xr = 0.f, xi = 0.f;
    const int nch = SAMPLE ? 1 : (L + 15) / 16;
    u32x4 awn = (u32x4){0u, 0u, 0u, 0u}; bf16_t un[4] = {0, 0, 0, 0};
    auto pf = [&](int cc) {
        const int t0 = cc * 16; const int nrow = SAMPLE ? 16 : ((L - t0) < 16 ? (L - t0) : 16);
        awn = (u32x4){0u, 0u, 0u, 0u};
        if (quad < 2 && col < nrow) awn = *(const u32x4*)(pm + (size_t)(tokbase + t0 + col) * NPM + C_U + g * 16 + quad * 8);
#pragma unroll
        for (int i = 0; i < 4; ++i) { const int r = quad * 4 + i; un[i] = (r < nrow) ? pm[(size_t)(tokbase + t0 + r) * NPM + C_U + g * 16 + col] : (bf16_t)0; }
    };
    pf(0);
    for (int c = 0; c < nch; ++c) {
        const int t0 = c * 16; const int nrow = SAMPLE ? 16 : ((L - t0) < 16 ? (L - t0) : 16);
        const u32x4 aw = awn; bf16_t uc[4];
#pragma unroll
        for (int i = 0; i < 4; ++i) uc[i] = un[i];
        if (c + 1 < nch) pf(c + 1);
        const bf16x8 af = __builtin_bit_cast(bf16x8, aw);
#pragma unroll
        for (int tile = 0; tile < 8; ++tile) {
            const f32x4 d = __builtin_amdgcn_mfma_f32_16x16x32_bf16(af, Bf[tile], (f32x4){0.f, 0.f, 0.f, 0.f}, 0, 0, 0);
#pragma unroll
            for (int i = 0; i < 4; ++i) bu[(quad * 4 + i) * S5_BU_LD + tile * 16 + col] = d[i];
        }
        __builtin_amdgcn_fence(__ATOMIC_RELEASE, "wavefront"); __builtin_amdgcn_wave_barrier(); __builtin_amdgcn_fence(__ATOMIC_ACQUIRE, "wavefront");
        for (int r = 0; r < 16; ++r) {
            float nr = 0.f, ni = 0.f;
            if (r < nrow) {
                if (SAMPLE) { const size_t si = ((size_t)(layer * NDEC + seq0 + r) * 16 + g) * 64 + lane; xr = p.in[5][si]; xi = p.in[6][si]; }
                const float br_ = bu[r * S5_BU_LD + lane], bi_ = bu[r * S5_BU_LD + 64 + lane];
                nr = ar * xr - ai * xi + br_; ni = ar * xi + ai * xr + bi_; xr = nr; xi = ni;
                if (SAMPLE) { const size_t so = ((size_t)(layer * NDEC + seq0 + r) * 16 + g) * 64 + lane; p.out[O_SS5R + so] = nr; p.out[O_SS5I + so] = ni; }
            }
            xb[r * S5_XB_LD + lane] = f2bf(nr); xb[r * S5_XB_LD + 64 + lane] = f2bf(ni);
        }
        __builtin_amdgcn_fence(__ATOMIC_RELEASE, "wavefront"); __builtin_amdgcn_wave_barrier(); __builtin_amdgcn_fence(__ATOMIC_ACQUIRE, "wavefront");
        f32x4 ya = (f32x4){0.f, 0.f, 0.f, 0.f};
#pragma unroll
        for (int kb = 0; kb < 4; ++kb) { const bf16x8 xf = *(const LAS bf16x8*)(xb + col * S5_XB_LD + kb * 32 + quad * 8); ya = __builtin_amdgcn_mfma_f32_16x16x32_bf16(xf, Cf[kb], ya, 0, 0, 0); }
#pragma unroll
        for (int i = 0; i < 4; ++i) { const int r = quad * 4 + i;
            if (r < nrow) { const size_t tok = (size_t)(tokbase + t0 + r); const float uu = bf2f(uc[i]);
                const float y = ya[i] + dcoef * uu; const float ge = y * __builtin_amdgcn_rcpf(1.0f + __expf(-1.5957691216f * (y + 0.044715f * y * y * y)));
                yg[tok * 256 + g * 16 + col] = f2bf(ge); } }
        __builtin_amdgcn_fence(__ATOMIC_RELEASE, "wavefront"); __builtin_amdgcn_wave_barrier(); __builtin_amdgcn_fence(__ATOMIC_ACQUIRE, "wavefront");
    }
    if (!SAMPLE) { const size_t so = ((size_t)(layer * NBATCH + seq0) * 16 + g) * 64 + lane; p.out[O_PS5R + so] = xr; p.out[O_PS5I + so] = xi; }
}

__device__ __forceinline__ void phase_mix(KPR p, int layer, LAS unsigned char* ldsb, int bid, int G) {
    LAS float* lds = (LAS float*)ldsb;
    const int wid = __builtin_amdgcn_readfirstlane(otid() >> 6);
    constexpr int NLONG = 208, NSHORT = 16 + 1536;
    for (int it = bid; it < NLONG; it += G) {
        if (it < 192) {
            const int mix = it >> 6, r = it & 63, b = r >> 3, hh = (r >> 1) & 3, half = r & 1;
            const size_t so = ((size_t)(layer * NBATCH + b) * 4 + hh) * 4096;
            if (mix == 0) mix_item<0>(p, layer, lds, b * SEQ, SEQ, hh, half * 32, 32, nullptr, p.out + O_PGDN + so, nullptr, p.out + O_PCONV + (size_t)(layer * NBATCH + b) * 2304);
            else if (mix == 1) mix_item<1>(p, layer, lds, b * SEQ, SEQ, hh, half * 32, 32, nullptr, p.out + O_PGLA + so, nullptr, nullptr);
            else mix_item<2>(p, layer, lds, b * SEQ, SEQ, hh, half * 32, 32, nullptr, p.out + O_PHG + so, nullptr, nullptr);
        } else {
            __syncthreads();
            const int j = (it - 192) * 8 + wid, b = j >> 4, g = j & 15;
            s5_wave_item<false>(p, layer, ldsb + wid * S5_WAVE_BYTES, g, b * SEQ, SEQ, b);
        }
    }
    int js = bid, jstep = G, jend = NSHORT;
    if (G >= 256) { if (bid >= 192) { js = bid - 192; jstep = 64; jend = 1040; } else if (bid >= 64) { js = 1040 + (bid - 64) * 4; jstep = 1; jend = js + 4; } else { js = 0; jend = 0; } }
    for (int j = js; j < jend; j += jstep) {
        if (j < 16) {
            __syncthreads();
            const int jj = j * 8 + wid, g = jj & 15, s0 = (jj >> 4) * 16;
            s5_wave_item<true>(p, layer, ldsb + wid * S5_WAVE_BYTES, g, MPROMPT + s0, 16, s0);
        } else {
            const int jj = j - 16, mix = jj >> 9, s = (jj & 511) >> 2, hh = jj & 3;
            const size_t so = ((size_t)(layer * NDEC + s) * 4 + hh) * 4096;
            if (mix == 0) mix_item<0>(p, layer, lds, MPROMPT + s, 1, hh, 0, 64, p.in[3] + so, p.out + O_SGDN + so, p.in[2] + (size_t)(layer * NDEC + s) * 2304, p.out + O_SCONV + (size_t)(layer * NDEC + s) * 2304);
            else if (mix == 1) mix_item<1>(p, layer, lds, MPROMPT + s, 1, hh, 0, 64, p.in[4] + so, p.out + O_SGLA + so, nullptr, nullptr);
            else mix_item<2>(p, layer, lds, MPROMPT + s, 1, hh, 0, 64, p.in[7] + so, p.out + O_SHG + so, nullptr, nullptr);
        }
    }
    __syncthreads();
}

__device__ __forceinline__ void phase_headnorm(KPR p, int layer, int bid, int G) {
    const int tid_ = otid(); const int wid = __builtin_amdgcn_readfirstlane(tid_ >> 6), lane = tid_ & 63;
    const bf16_t* pm = (const bf16_t*)(p.ws + OFF_PM); const bf16_t* oraw = (const bf16_t*)(p.ws + OFF_ORAW); bf16_t* br = (bf16_t*)(p.ws + OFF_BR);
    for (int j = bid * 8 + wid; j < MTOK * 3; j += G * 8) {
        const int tok = j / 3, mix = j - tok * 3;
        const int gcol = mix == 0 ? A_GATE : (mix == 1 ? B_GATE : D_GATE), slot = mix == 2 ? 3 : mix;
        const float* nw = (mix == 0 ? p.in[13] : (mix == 1 ? p.in[16] : p.in[27])) + layer * 256 + lane * 4;
        const u32x2 ow = *(const u32x2*)(oraw + (size_t)tok * 768 + mix * 256 + lane * 4);
        const u32x2 gw = *(const u32x2*)(pm + (size_t)tok * NPM + gcol + lane * 4);
        const float o0 = lo_bf(ow.x), o1 = hi_bf(ow.x), o2 = lo_bf(ow.y), o3 = hi_bf(ow.y);
        float ss = o0 * o0 + o1 * o1 + o2 * o2 + o3 * o3;
        ss += __shfl_xor(ss, 1); ss += __shfl_xor(ss, 2); ss += __shfl_xor(ss, 4); ss += __shfl_xor(ss, 8);
        const float rs = rsqrtf(ss * (1.0f / 64.0f) + EPS);
        const f32x4 w = *(const f32x4*)nw;
        u32x2 r; r.x = cvt_pk_bf16(o0 * rs * w[0] * siluf_(lo_bf(gw.x)), o1 * rs * w[1] * siluf_(hi_bf(gw.x)));
        r.y = cvt_pk_bf16(o2 * rs * w[2] * siluf_(lo_bf(gw.y)), o3 * rs * w[3] * siluf_(hi_bf(gw.y)));
        *(u32x2*)(br + (size_t)tok * 1024 + slot * 256 + lane * 4) = r;
    }
}

constexpr int PH_PER_LAYER = 9, N_PHASES = 4 * PH_PER_LAYER + 1;
__device__ __forceinline__ void run_phase(KPR p, int ph, LAS unsigned char* lds, int bid, int G) {
    unsigned char* ws = p.ws;
    if (ph == N_PHASES - 1) { phase_norm(p, p.in[34], 2, bid, G); return; }
    const int layer = ph / PH_PER_LAYER, s = ph - layer * PH_PER_LAYER;
    pg8::Sched S; pg8::Gemm g;
    switch (s) {
    case 0: phase_convert(p, layer, (LAS float*)lds, bid, G); phase_norm(p, p.in[8] + layer * 1024, layer == 0 ? 0 : 1, bid, G); break;
    case 1: { S.init(65, 30, 1, G, bid, 16); g = pg8::Gemm{(const bf16_t*)(ws + OFF_XN), (const bf16_t*)(ws + OFF_WIN), 1024, 1024, 16, 0, 0};
              pg8::gemm_phase(lds, g, S, EpiIn{(bf16_t*)(ws + OFF_PM), (bf16_t*)(ws + OFF_GATES)}); } break;
    case 2: phase_mix(p, layer, lds, bid, G); break;
    case 3: { S.init(65, 2, 1, G, bid, 4); g = pg8::Gemm{(const bf16_t*)(ws + OFF_YG), (const bf16_t*)(ws + OFF_WGLU), 256, 256, 4, 0, 0};
              pg8::gemm_phase(lds, g, S, EpiGlu{(bf16_t*)(ws + OFF_BR)}); phase_headnorm(p, layer, bid, G); } break;
    case 4: { S.init(65, 4, 4, G, bid, 4); g = pg8::Gemm{(const bf16_t*)(ws + OFF_BR), (const bf16_t*)(ws + OFF_WBR), 1024, 256, 4, 256, (size_t)1024 * 256};
              pg8::gemm_phase(lds, g, S, EpiBr{(const bf16_t*)(ws + OFF_GATES), (bf16_t*)(ws + OFF_PM)}); } break;
    case 5: { S.init(64, 4, 1, G, bid, 16, 4); g = pg8::Gemm{(const bf16_t*)(ws + OFF_PM), (const bf16_t*)(ws + OFF_WOUT), 1024, 1024, 16, 0, 0};
              pg8::gemm_phase(lds, g, S, EpiRes{(float*)(ws + OFF_H)}); } break;
    case 6: phase_norm(p, p.in[30] + layer * 1024, 1, bid, G); break;
    case 7: { S.init(65, 22, 1, G, bid, 16); g = pg8::Gemm{(const bf16_t*)(ws + OFF_XN), (const bf16_t*)(ws + OFF_WGU), 1024, 1024, 16, 0, 0};
              pg8::gemm_phase(lds, g, S, EpiGU{(bf16_t*)(ws + OFF_PM)}); } break;
    case 8: { S.init(64, 4, 1, G, bid, 44, 4); g = pg8::Gemm{(const bf16_t*)(ws + OFF_PM), (const bf16_t*)(ws + OFF_WDN), DFF, DFF, 44, 0, 0};
              pg8::gemm_phase(lds, g, S, EpiRes{(float*)(ws + OFF_H)}); } break;
    }
}

extern __shared__ __attribute__((aligned(16))) unsigned char dyn_smem[];
#if MULTI_LAUNCH
__global__ void __launch_bounds__(512) k_phase(KP parg, int ph) {
    KPR p = *(const CAS KP*)__builtin_amdgcn_kernarg_segment_ptr();
    run_phase(p, ph, (LAS unsigned char*)dyn_smem, blockIdx.x, gridDim.x);
}
#else
__device__ __forceinline__ void grid_bar(unsigned* bar, unsigned k, int bid, int G) {
    asm volatile("s_waitcnt vmcnt(0)" ::: "memory");
    __syncthreads();
    if (otid() == 0) {
        __builtin_amdgcn_fence(__ATOMIC_RELEASE, "agent");
        asm volatile("s_waitcnt vmcnt(0)" ::: "memory");
        const unsigned per = (unsigned)(G - (bid & 7) + 7) >> 3;
        const unsigned old = __hip_atomic_fetch_add(bar + 64 * (1 + (bid & 7)), 1u, __ATOMIC_RELAXED, __HIP_MEMORY_SCOPE_AGENT);
        if (old == per * k - 1u) __hip_atomic_fetch_add(bar, 1u, __ATOMIC_RELAXED, __HIP_MEMORY_SCOPE_AGENT);
        const unsigned ngrp = G < 8 ? (unsigned)G : 8u;
        while (__hip_atomic_load(bar, __ATOMIC_RELAXED, __HIP_MEMORY_SCOPE_AGENT) < ngrp * k) __builtin_amdgcn_s_sleep(1);
    }
    __syncthreads();
    __builtin_amdgcn_fence(__ATOMIC_ACQUIRE, "agent");
    asm volatile("s_waitcnt vmcnt(0)" ::: "memory");
}
template <int PH> __device__ __forceinline__ void run_from(KPR p, cg::grid_group& grid) {
    const CAS KP* pp = &p; asm volatile("" : "+s"(pp));
    int bid = blockIdx.x, G = gridDim.x; asm volatile("" : "+s"(bid), "+s"(G));
    run_phase(*pp, PH, (LAS unsigned char*)dyn_smem, bid, G);
    if constexpr (PH + 1 < N_PHASES) {
        if constexpr (PH == 0) grid.sync();
        else grid_bar((unsigned*)(pp->ws + OFF_BAR), (unsigned)PH, bid, G);
        run_from<PH + 1>(p, grid);
    }
}
__global__ void __launch_bounds__(512) k_mega(KP parg) {
    cg::grid_group grid = cg::this_grid();
    KPR p = *(const CAS KP*)__builtin_amdgcn_kernarg_segment_ptr();
    run_from<0>(p, grid);
}
#endif

extern "C" void kernel_launch(void* const* d_in, const int* in_sizes, int n_in, void* d_out, int out_size, void* d_ws, size_t ws_size, hipStream_t stream) {
    if (ws_size < WS_NEED || n_in < 35) { fprintf(stderr, "workspace too small: %zu < %zu\n", ws_size, (size_t)WS_NEED); return; }
    KP p{};
    for (int i = 0; i < 35; ++i) p.in[i] = (const float*)d_in[i];
    p.out = (float*)d_out; p.ws = (unsigned char*)d_ws;
    constexpr size_t kDynLds = pg8::STAGE_BYTES;
#if MULTI_LAUNCH
    static bool once = false;
    if (!once) { hipFuncSetAttribute((const void*)k_phase, hipFuncAttributeMaxDynamicSharedMemorySize, (int)kDynLds); once = true; }
    for (int ph = 0; ph < N_PHASES; ++ph) hipLaunchKernelGGL(k_phase, dim3(256), dim3(512), kDynLds, stream, p, ph);
#else
    static int grid_blocks = 0;
    if (!grid_blocks) {
        hipFuncSetAttribute((const void*)k_mega, hipFuncAttributeMaxDynamicSharedMemorySize, (int)kDynLds);
        int dev = 0, cus = 0, per_cu = 0;
        hipGetDevice(&dev);
        hipDeviceGetAttribute(&cus, hipDeviceAttributeMultiprocessorCount, dev);
        hipOccupancyMaxActiveBlocksPerMultiprocessor(&per_cu, k_mega, 512, kDynLds);
        if (per_cu < 1) per_cu = 1;
        grid_blocks = cus * per_cu; if (grid_blocks > 256) grid_blocks = 256;
    }
    hipMemsetAsync((unsigned char*)d_ws + OFF_BAR, 0, 4096, stream);
    void* args[] = {&p};
    hipError_t e = hipLaunchCooperativeKernel((void*)k_mega, dim3(grid_blocks), dim3(512), args, kDynLds, stream);
    if (e != hipSuccess) fprintf(stderr, "cooperative launch failed: %s (grid %d)\n", hipGetErrorString(e), grid_blocks);
#endif
}
```

```cpp
#include <hip/hip_runtime.h>
#include <hip/hip_cooperative_groups.h>
#include <cstdio>
namespace cg = cooperative_groups;

#ifndef MULTI_LAUNCH
#define MULTI_LAUNCH 0
#endif

#define LAS __attribute__((address_space(3)))
typedef unsigned short bf16_t;
typedef short bf16x8 __attribute__((ext_vector_type(8)));
typedef float f32x4 __attribute__((ext_vector_type(4)));
typedef float f32x2 __attribute__((ext_vector_type(2)));
typedef unsigned u32x2 __attribute__((ext_vector_type(2)));
typedef unsigned u32x4 __attribute__((ext_vector_type(4)));

constexpr int DM = 1024, SEQ = 2048, NBATCH = 8, NDEC = 128;
constexpr int MPROMPT = NBATCH * SEQ;
constexpr int MTOK = MPROMPT + NDEC;
constexpr int MP = 16640;
constexpr int NPM = 3584, NGATE = 4096, NIN = 7448, DFF = 2816;
constexpr int A_QKV = 0, A_GATE = 768, B_Q = 1024, B_K = 1280, B_V = 1536, B_GATE = 1792, C_U = 2048, D_Q = 2304, D_F = 2560, D_I = 2816, D_GATE = 3072,
              A_ALPHA = 3328, A_BETA = 3332, B_GK = 3336;
constexpr float EPS = 1e-6f;

constexpr size_t SZ_WIN = (size_t)7680 * 1024 * 2, SZ_WGU = (size_t)5632 * 1024 * 2, SZ_WDN = (size_t)1024 * 2816 * 2, SZ_WOUT = (size_t)1024 * 1024 * 2,
                 SZ_WBR = (size_t)4096 * 256 * 2, SZ_WGLU = (size_t)512 * 256 * 2;
constexpr size_t OFF_WIN = 0, OFF_WGU = OFF_WIN + SZ_WIN, OFF_WDN = OFF_WGU + SZ_WGU, OFF_WOUT = OFF_WDN + SZ_WDN, OFF_WBR = OFF_WOUT + SZ_WOUT,
                 OFF_WGLU = OFF_WBR + SZ_WBR, OFF_H = OFF_WGLU + SZ_WGLU, OFF_XN = OFF_H + (size_t)MP * 1024 * 4, OFF_BR = OFF_XN + (size_t)MP * 1024 * 2,
                 OFF_PM = OFF_BR + (size_t)MP * 1024 * 2, OFF_GATES = OFF_PM + (size_t)MP * NPM * 2, OFF_ORAW = OFF_GATES + (size_t)MP * NGATE * 2,
                 OFF_YG = OFF_ORAW + (size_t)MP * 768 * 2, OFF_BAR = OFF_YG + (size_t)MP * 256 * 2, WS_NEED = OFF_BAR + 16384;
constexpr size_t O_PCONV = 16908288, O_PGDN = 16982016, O_PGLA = 17506304, O_PS5R = 18030592, O_PS5I = 18063360, O_PHG = 18096128,
                 O_SCONV = 18620416, O_SGDN = 19800064, O_SGLA = 28188672, O_SS5R = 36577280, O_SS5I = 37101568, O_SHG = 37625856;

struct KP { const float* in[35]; float* out; unsigned char* ws; };
#define CAS __attribute__((address_space(4)))
typedef const CAS KP& KPR;

__device__ __forceinline__ int otid() { int t = threadIdx.x; asm volatile("" : "+v"(t)); return t & 511; }
__device__ __forceinline__ float bf2f(bf16_t b) { return __uint_as_float(((unsigned)b) << 16); }
typedef __bf16 bf16x2_t __attribute__((ext_vector_type(2)));
__device__ __forceinline__ unsigned cvt_pk_bf16(float lo, float hi) { const f32x2 f = {lo, hi}; const bf16x2_t v = __builtin_convertvector(f, bf16x2_t); return __builtin_bit_cast(unsigned, v); }
__device__ __forceinline__ bf16_t f2bf(float f) { return (bf16_t)(cvt_pk_bf16(f, 0.f) & 0xffffu); }
__device__ __forceinline__ float lo_bf(unsigned w) { return __uint_as_float(w << 16); }
__device__ __forceinline__ float hi_bf(unsigned w) { return __uint_as_float(w & 0xffff0000u); }
__device__ __forceinline__ float sigmoidf_(float x) { return __builtin_amdgcn_rcpf(1.0f + __expf(-x)); }
__device__ __forceinline__ float siluf_(float x) { return x * __builtin_amdgcn_rcpf(1.0f + __expf(-x)); }
__device__ __forceinline__ float wave_sum(float v) {
#pragma unroll
    for (int o = 32; o >= 1; o >>= 1) v += __shfl_xor(v, o);
    return v;
}
template <int CTRL> __device__ __forceinline__ float dpp_f(float v) { return __int_as_float(__builtin_amdgcn_update_dpp(0, __float_as_int(v), CTRL, 0xf, 0xf, true)); }
__device__ __forceinline__ float red16(float v) { v += dpp_f<0xB1>(v); v += dpp_f<0x4E>(v); v += dpp_f<0x141>(v); v += dpp_f<0x140>(v); return v; }
__device__ __forceinline__ float red8(float v) { v += dpp_f<0xB1>(v); v += dpp_f<0x4E>(v); v += dpp_f<0x141>(v); return v; }

namespace pg8 {
constexpr int BM = 256, BK = 64, HALF = 128, HTB = HALF * BK * 2, STAGE_BYTES = 8 * HTB, NXCD = 8, WGM = 8;
__device__ __forceinline__ int lds_byte(int r, int c) { const int st = (r >> 4) * 2 + (c >> 5), rr = r & 15, cc = c & 31, ob = rr * 64 + cc * 2; return st * 1024 + (ob ^ (((ob >> 9) & 1) << 5)); }
__device__ __forceinline__ void stage_rc(int b, int& R, int& C) { const int st = b / 1024, sb = b % 1024, swz = sb ^ (((sb >> 9) & 1) << 5); R = (st >> 1) * 16 + swz / 64; C = (st & 1) * 32 + (swz % 64) / 2; }

struct Unit { int pm, pn, kk, k0, nt; };
struct Gemm { const bf16_t* A; const bf16_t* Bt; int lda, ldb, nt; size_t a_kk, b_kk; };
struct Sched {
    int nM, nN, nKK, nwg, G, c, ntf, nts, nextra;
    __device__ void init(int nM_, int nN_, int nKK_, int G_, int c_, int ntf_, int nts_ = 0) { nM = nM_; nN = nN_; nKK = nKK_; nwg = nM * nN; G = G_; c = c_; ntf = ntf_; nts = nts_; nextra = nts_ ? nN_ * (ntf_ / nts_) : 0; }
    __device__ bool next(int i, Unit& u) const {
        const int it = i / nKK; u.kk = i - it * nKK; u.k0 = 0; u.nt = ntf;
        const long L = (long)it * G + c;
        if (L >= nwg) { const int e = (int)(L - nwg); if (e >= nextra) return false; u.pm = nM; u.pn = e % nN; u.k0 = (e / nN) * nts; u.nt = nts; return true; }
        int wgid = (int)L; { const int q = nwg / NXCD, r = nwg % NXCD, xcd = wgid % NXCD, off = wgid / NXCD; wgid = (xcd < r ? xcd * (q + 1) : r * (q + 1) + (xcd - r) * q) + off; }
        const int nig = WGM * nN, gid = wgid / nig, fm = gid * WGM, gsz = (nM - fm) < WGM ? (nM - fm) : WGM;
        u.pm = fm + ((wgid % nig) % gsz); u.pn = (wgid % nig) / gsz; return true;
    }
};

template <class Epi>
__device__ __forceinline__ void gemm_phase(LAS unsigned char* lds, const Gemm g, const Sched& S, const Epi& E) {
    const int tid = otid(), wid = __builtin_amdgcn_readfirstlane(tid >> 6), lane = tid & 63, wr = wid >> 2, wc = wid & 3, fr = lane & 15, fq = lane >> 4;
    unsigned voffA[2], voffB[2];
#pragma unroll
    for (int i = 0; i < 2; ++i) { int R, C; stage_rc(tid * 16 + i * 8192, R, C); voffA[i] = (unsigned)(R * g.lda + C) * 2u; voffB[i] = (unsigned)(R * g.ldb + C) * 2u; }
    const size_t kstep = (size_t)(BK * 2);
    const size_t hstepA = (size_t)HALF * g.lda * 2, hstepB = (size_t)HALF * g.ldb * 2;
    const size_t tstepA = 2 * hstepA, tstepB = 2 * hstepB;
    const unsigned ldsw = (unsigned)wid * 1024u;
    const int aoff = lds_byte(wr * 64 + fr, fq * 8), boff = lds_byte(wc * 32 + fr, fq * 8);
#define PG8_SA(b, h) (((b) * 2 + (h)) * HTB)
#define PG8_SB(b, h) ((4 + (b) * 2 + (h)) * HTB)
#define PG8_STAGE(bufoff, gbase, voff) do { _Pragma("unroll") for (int _i = 0; _i < 2; ++_i) \
        __builtin_amdgcn_global_load_lds((const unsigned*)((const char*)(gbase) + (voff)[_i]), (LAS unsigned*)(lds + (bufoff) + ldsw + _i * 8192), 16, 0, 0); } while (0)
#define PG8_LDA(dst, b, h) do { _Pragma("unroll") for (int m = 0; m < 4; ++m) _Pragma("unroll") for (int k = 0; k < 2; ++k) dst[m][k] = *(const LAS bf16x8*)(lds + PG8_SA(b, h) + aoff + m * 2048 + k * 1024); } while (0)
#define PG8_LDB(dst, b, h) do { _Pragma("unroll") for (int n = 0; n < 2; ++n) _Pragma("unroll") for (int k = 0; k < 2; ++k) dst[n][k] = *(const LAS bf16x8*)(lds + PG8_SB(b, h) + boff + n * 2048 + k * 1024); } while (0)
#define PG8_MMA(ai, bj, At, Bt) do { __builtin_amdgcn_s_setprio(1); _Pragma("unroll") for (int m = 0; m < 4; ++m) _Pragma("unroll") for (int n = 0; n < 2; ++n) _Pragma("unroll") for (int k = 0; k < 2; ++k) \
        acc[ai][bj][m][n] = __builtin_amdgcn_mfma_f32_16x16x32_bf16(Bt[n][k], At[m][k], acc[ai][bj][m][n], 0, 0, 0); __builtin_amdgcn_s_setprio(0); } while (0)
#define PG8_WAIT_V(n) asm volatile("s_waitcnt vmcnt(" #n ")" ::: "memory")
#define PG8_WAIT_L(n) asm volatile("s_waitcnt lgkmcnt(" #n ")" ::: "memory")
#define PG8_BAR __builtin_amdgcn_s_barrier()
#define PG8_SCHED __builtin_amdgcn_sched_barrier(0)
    Unit cur, nxt; int ui = 0;
    if (!S.next(0, cur)) return;
    f32x4 acc[2][2][4][2];
#pragma unroll
    for (int a = 0; a < 2; ++a)
#pragma unroll
        for (int b = 0; b < 2; ++b)
#pragma unroll
            for (int m = 0; m < 4; ++m)
#pragma unroll
                for (int n = 0; n < 2; ++n) acc[a][b][m][n] = (f32x4){0.f, 0.f, 0.f, 0.f};
    bf16x8 At[4][2], B0[2][2], B1[2][2];
    const char* cA = (const char*)(g.A + (size_t)cur.kk * g.a_kk) + (size_t)cur.pm * tstepA + (size_t)cur.k0 * kstep; const char* cB = (const char*)(g.Bt + (size_t)cur.kk * g.b_kk) + (size_t)cur.pn * tstepB + (size_t)cur.k0 * kstep;
    PG8_STAGE(PG8_SB(0, 0), cB, voffB); PG8_STAGE(PG8_SA(0, 0), cA, voffA); PG8_STAGE(PG8_SB(0, 1), cB + hstepB, voffB); PG8_STAGE(PG8_SA(0, 1), cA + hstepA, voffA);
    if (wr == 1) PG8_BAR;
    PG8_WAIT_V(4); PG8_BAR;
    PG8_STAGE(PG8_SB(1, 0), cB + kstep, voffB); PG8_STAGE(PG8_SA(1, 0), cA + kstep, voffA); PG8_STAGE(PG8_SB(1, 1), cB + hstepB + kstep, voffB);
    PG8_WAIT_V(6); PG8_BAR;
    for (;;) {
        const bool has_next = S.next(ui + 1, nxt);
        const char* nA = has_next ? (const char*)(g.A + (size_t)nxt.kk * g.a_kk) + (size_t)nxt.pm * tstepA + (size_t)nxt.k0 * kstep : cA;
        const char* nB = has_next ? (const char*)(g.Bt + (size_t)nxt.kk * g.b_kk) + (size_t)nxt.pn * tstepB + (size_t)nxt.k0 * kstep : cB;
        int nt = cur.nt; asm volatile("" : "+s"(nt));
        for (int t = 0; t < nt; t += 2) {
            const bool last = (t == nt - 2);
            const char* a1 = cA + (size_t)(t + 1) * kstep;
            const char* a2 = last ? nA : cA + (size_t)(t + 2) * kstep; const char* b2 = last ? nB : cB + (size_t)(t + 2) * kstep;
            const char* a3 = a2 + kstep; const char* b3 = b2 + kstep;
            PG8_LDB(B0, 0, 0); PG8_SCHED; PG8_LDA(At, 0, 0); PG8_STAGE(PG8_SA(1, 1), a1 + hstepA, voffA);
            PG8_WAIT_L(8); PG8_BAR; PG8_WAIT_L(0); PG8_MMA(0, 0, At, B0); PG8_BAR; PG8_SCHED;
            PG8_LDB(B1, 0, 1); PG8_STAGE(PG8_SB(0, 0), b2, voffB);
            PG8_BAR; PG8_WAIT_L(0); PG8_MMA(0, 1, At, B1); PG8_BAR;
            PG8_LDA(At, 0, 1); PG8_STAGE(PG8_SA(0, 0), a2, voffA);
            PG8_BAR; PG8_WAIT_L(0); PG8_MMA(1, 0, At, B0); PG8_BAR; PG8_SCHED;
            PG8_STAGE(PG8_SB(0, 1), b2 + hstepB, voffB);
            PG8_WAIT_V(6); PG8_BAR; PG8_MMA(1, 1, At, B1); PG8_BAR;
            PG8_LDB(B0, 1, 0); PG8_SCHED; PG8_LDA(At, 1, 0); PG8_STAGE(PG8_SA(0, 1), a2 + hstepA, voffA);
            PG8_WAIT_L(8); PG8_BAR; PG8_WAIT_L(0); PG8_MMA(0, 0, At, B0); PG8_BAR; PG8_SCHED;
            PG8_LDB(B1, 1, 1); PG8_STAGE(PG8_SB(1, 0), b3, voffB);
            PG8_BAR; PG8_WAIT_L(0); PG8_MMA(0, 1, At, B1); PG8_BAR;
            PG8_LDA(At, 1, 1); PG8_STAGE(PG8_SA(1, 0), a3, voffA);
            PG8_BAR; PG8_WAIT_L(0); PG8_MMA(1, 0, At, B0); PG8_BAR; PG8_SCHED;
            PG8_STAGE(PG8_SB(1, 1), b3 + hstepB, voffB);
            PG8_WAIT_V(6); PG8_BAR; PG8_MMA(1, 1, At, B1); PG8_BAR;
        }
        E(acc, cur, wr, wc, fr, fq);
        if (!has_next) break;
#pragma unroll
        for (int a = 0; a < 2; ++a)
#pragma unroll
            for (int b = 0; b < 2; ++b)
#pragma unroll
                for (int m = 0; m < 4; ++m)
#pragma unroll
                    for (int n = 0; n < 2; ++n) acc[a][b][m][n] = (f32x4){0.f, 0.f, 0.f, 0.f};
        cur = nxt; cA = nA; cB = nB; ++ui;
    }
    PG8_WAIT_V(0);
    if (wr == 0) PG8_BAR;
    PG8_BAR;
    __builtin_amdgcn_s_waitcnt(0);
#undef PG8_SA
#undef PG8_SB
#undef PG8_STAGE
#undef PG8_LDA
#undef PG8_LDB
#undef PG8_MMA
#undef PG8_WAIT_V
#undef PG8_WAIT_L
#undef PG8_BAR
#undef PG8_SCHED
}
}
using pg8::Unit;

#define EPI_LOOP_BEGIN _Pragma("unroll") for (int ai = 0; ai < 2; ++ai) _Pragma("unroll") for (int m = 0; m < 4; ++m) { const size_t row = (size_t)(u.pm * 256 + ai * 128 + wr * 64 + m * 16 + fr); \
        _Pragma("unroll") for (int bj = 0; bj < 2; ++bj) {
#define EPI_LOOP_END } }
struct EpiIn {
    bf16_t* pm; bf16_t* gates;
    __device__ __forceinline__ void operator()(const f32x4 (&acc)[2][2][4][2], const Unit& u, int wr, int wc, int fr, int fq) const {
        const bool main_ = u.pn < 14;
        EPI_LOOP_BEGIN
#pragma unroll
            for (int n = 0; n < 2; ++n) { const int col = u.pn * 256 + bj * 128 + wc * 32 + n * 16 + fq * 4; f32x4 v = acc[ai][bj][m][n]; u32x2 w;
                if (main_) { w.x = cvt_pk_bf16(v[0], v[1]); w.y = cvt_pk_bf16(v[2], v[3]); *(u32x2*)(pm + row * NPM + col) = w; }
                else { w.x = cvt_pk_bf16(sigmoidf_(v[0]), sigmoidf_(v[1])); w.y = cvt_pk_bf16(sigmoidf_(v[2]), sigmoidf_(v[3])); *(u32x2*)(gates + row * NGATE + (col - NPM)) = w; } }
        EPI_LOOP_END
    }
};
struct EpiGlu {
    bf16_t* br;
    __device__ __forceinline__ void operator()(const f32x4 (&acc)[2][2][4][2], const Unit& u, int wr, int wc, int fr, int fq) const {
        EPI_LOOP_BEGIN
            const int j = u.pn * 128 + bj * 64 + wc * 16 + fq * 4; const f32x4 a = acc[ai][bj][m][0], b = acc[ai][bj][m][1]; u32x2 w;
            w.x = cvt_pk_bf16(a[0] * sigmoidf_(b[0]), a[1] * sigmoidf_(b[1])); w.y = cvt_pk_bf16(a[2] * sigmoidf_(b[2]), a[3] * sigmoidf_(b[3]));
            *(u32x2*)(br + row * 1024 + 512 + j) = w;
        EPI_LOOP_END
    }
};
struct EpiGU {
    bf16_t* a;
    __device__ __forceinline__ void operator()(const f32x4 (&acc)[2][2][4][2], const Unit& u, int wr, int wc, int fr, int fq) const {
        EPI_LOOP_BEGIN
            const int j = u.pn * 128 + bj * 64 + wc * 16 + fq * 4; const f32x4 g = acc[ai][bj][m][0], b = acc[ai][bj][m][1]; u32x2 w;
            w.x = cvt_pk_bf16(siluf_(g[0]) * b[0], siluf_(g[1]) * b[1]); w.y = cvt_pk_bf16(siluf_(g[2]) * b[2], siluf_(g[3]) * b[3]);
            *(u32x2*)(a + row * DFF + j) = w;
        EPI_LOOP_END
    }
};
struct EpiBr {
    const bf16_t* gates; bf16_t* mm;
    __device__ __forceinline__ void operator()(const f32x4 (&acc)[2][2][4][2], const Unit& u, int wr, int wc, int fr, int fq) const {
        const int col0 = u.pn * 256 + wc * 32 + fq * 4;
#pragma unroll
        for (int ai = 0; ai < 2; ++ai) {
            if (ai == 1 && u.pm == 64) break;
            const size_t row0 = (size_t)(u.pm * 256 + ai * 128 + wr * 64 + fr);
            u32x2 gw[4][2][2], pw[4][2][2];
#pragma unroll
            for (int m = 0; m < 4; ++m)
#pragma unroll
                for (int bj = 0; bj < 2; ++bj)
#pragma unroll
                    for (int n = 0; n < 2; ++n) { const size_t row = row0 + m * 16; const int col = col0 + bj * 128 + n * 16;
                        gw[m][bj][n] = *(const u32x2*)(gates + row * NGATE + u.kk * 1024 + col);
                        pw[m][bj][n] = (u32x2){0u, 0u}; if (u.kk > 0) pw[m][bj][n] = *(const u32x2*)(mm + row * 1024 + col); }
#pragma unroll
            for (int m = 0; m < 4; ++m)
#pragma unroll
                for (int bj = 0; bj < 2; ++bj)
#pragma unroll
                    for (int n = 0; n < 2; ++n) { const size_t row = row0 + m * 16; const int col = col0 + bj * 128 + n * 16; const f32x4 v = acc[ai][bj][m][n]; const u32x2 g = gw[m][bj][n], q = pw[m][bj][n];
                        u32x2 w; w.x = cvt_pk_bf16(lo_bf(g.x) * v[0] + lo_bf(q.x), hi_bf(g.x) * v[1] + hi_bf(q.x)); w.y = cvt_pk_bf16(lo_bf(g.y) * v[2] + lo_bf(q.y), hi_bf(g.y) * v[3] + hi_bf(q.y));
                        *(u32x2*)(mm + row * 1024 + col) = w; }
        }
    }
};
struct EpiRes {
    float* h;
    __device__ __forceinline__ void operator()(const f32x4 (&acc)[2][2][4][2], const Unit& u, int wr, int wc, int fr, int fq) const {
        const bool split = u.pm == 64;
        EPI_LOOP_BEGIN
#pragma unroll
            for (int n = 0; n < 2; ++n) { const int col = u.pn * 256 + bj * 128 + wc * 32 + n * 16 + fq * 4; float* ptr = h + row * 1024 + col;
                if (split) {
#pragma unroll
                    for (int e = 0; e < 4; ++e) __hip_atomic_fetch_add(ptr + e, acc[ai][bj][m][n][e], __ATOMIC_RELAXED, __HIP_MEMORY_SCOPE_AGENT);
                } else { const f32x4 o = *(const f32x4*)ptr; *(f32x4*)ptr = o + acc[ai][bj][m][n]; } }
        EPI_LOOP_END
    }
};

__device__ __forceinline__ int win_src_col(int n) {
    if (n < 768) return n;
    if (n < 1024) return 776 + (n - 768);
    if (n < 1792) return 1032 + (n - 1024);
    if (n < 2048) return 1816 + (n - 1792);
    if (n < 2304) return 2072 + (n - 2048);
    if (n < 3072) return 2328 + (n - 2304);
    if (n < 3328) return 3096 + (n - 3072);
    if (n < 3336) return 768 + (n - 3328);
    if (n < 3352) return 1800 + (n - 3336);
    if (n < 3584) return -1;
    return 3352 + (n - 3584);
}
__device__ __forceinline__ void phase_convert(KPR p, int layer, LAS float* tile, int bid, int G) {
    const int tid = otid(), tn = tid & 63, tk = __builtin_amdgcn_readfirstlane(tid >> 6);
    constexpr int T0 = 120 * 16, T1 = T0 + 88 * 16, T2 = T1 + 16 * 44, T3 = T2 + 16 * 16, T4 = T3 + 64 * 4, T5 = T4 + 8 * 4;
    for (int j = bid; j < T5; j += G) {
        int n0, k0, K, ld; bf16_t* dst; const float* cp = nullptr;
        if (j < T0) { const int q = j; n0 = (q >> 4) * 64; k0 = (q & 15) * 64; K = 1024; ld = NIN; dst = (bf16_t*)(p.ws + OFF_WIN);
            const int sc = win_src_col(n0 + tn); if (sc >= 0) cp = p.in[9] + (size_t)layer * 1024 * NIN + sc; }
        else if (j < T1) { const int q = j - T0; n0 = (q >> 4) * 64; k0 = (q & 15) * 64; K = 1024; ld = DFF; dst = (bf16_t*)(p.ws + OFF_WGU);
            const int n = n0 + tn, g32 = n >> 5, w = n & 31, jj = g32 * 16 + (w & 15); cp = (w < 16 ? p.in[31] : p.in[32]) + (size_t)layer * 1024 * DFF + jj; }
        else if (j < T2) { const int q = j - T1; n0 = (q / 44) * 64; k0 = (q % 44) * 64; K = DFF; ld = 1024; dst = (bf16_t*)(p.ws + OFF_WDN);
            cp = p.in[33] + (size_t)layer * DFF * 1024 + (n0 + tn); }
        else if (j < T3) { const int q = j - T2; n0 = (q >> 4) * 64; k0 = (q & 15) * 64; K = 1024; ld = 1024; dst = (bf16_t*)(p.ws + OFF_WOUT);
            cp = p.in[29] + (size_t)layer * 1024 * 1024 + (n0 + tn); }
        else if (j < T4) { const int q = j - T3; n0 = (q >> 2) * 64; k0 = (q & 3) * 64; K = 256; ld = 1024; dst = (bf16_t*)(p.ws + OFF_WBR);
            const int n = n0 + tn, kk = n >> 10, d = n & 1023; cp = p.in[28] + ((size_t)(layer * 4 + kk) * 256) * 1024 + d; }
        else { const int q = j - T4; n0 = (q >> 2) * 64; k0 = (q & 3) * 64; K = 256; ld = 512; dst = (bf16_t*)(p.ws + OFF_WGLU);
            const int n = n0 + tn, g32 = n >> 5, w = n & 31, jj = g32 * 16 + (w & 15); cp = p.in[25] + (size_t)layer * 256 * 512 + (w < 16 ? jj : 256 + jj); }
        __syncthreads();
#pragma unroll
        for (int e = 0; e < 8; ++e) { const int k = k0 + tk * 8 + e; tile[tn * 65 + tk * 8 + e] = cp ? cp[(size_t)k * ld] : 0.f; }
        __syncthreads();
        { const int n = tid >> 3, ks = tid & 7; const LAS float* tp = tile + n * 65 + ks * 8; u32x4 w;
          w.x = cvt_pk_bf16(tp[0], tp[1]); w.y = cvt_pk_bf16(tp[2], tp[3]); w.z = cvt_pk_bf16(tp[4], tp[5]); w.w = cvt_pk_bf16(tp[6], tp[7]);
          *(u32x4*)(dst + (size_t)(n0 + n) * K + k0 + ks * 8) = w; }
    }
    __syncthreads();
}

__device__ __forceinline__ void phase_norm(KPR p, const float* w, int mode, int bid, int G) {
    const int tid_ = otid(); const int wid = __builtin_amdgcn_readfirstlane(tid_ >> 6), lane = tid_ & 63;
    float* h = (float*)(p.ws + OFF_H); bf16_t* xn = (bf16_t*)(p.ws + OFF_XN);
    f32x4 wv[4];
#pragma unroll
    for (int i = 0; i < 4; ++i) wv[i] = *(const f32x4*)(w + i * 256 + lane * 4);
    for (int r = bid * 8 + wid; r < MTOK; r += G * 8) {
        const float* src = (mode == 0) ? (r < MPROMPT ? p.in[0] + (size_t)r * 1024 : p.in[1] + (size_t)(r - MPROMPT) * 1024) : h + (size_t)r * 1024;
        f32x4 v[4]; float ss = 0.f;
#pragma unroll
        for (int i = 0; i < 4; ++i) { v[i] = *(const f32x4*)(src + i * 256 + lane * 4); ss += v[i][0] * v[i][0] + v[i][1] * v[i][1] + v[i][2] * v[i][2] + v[i][3] * v[i][3]; }
        ss = wave_sum(ss);
        const float rs = rsqrtf(ss * (1.0f / 1024.0f) + EPS);
#pragma unroll
        for (int i = 0; i < 4; ++i) {
            const f32x4 y = v[i] * rs * wv[i];
            if (mode == 2) *(f32x4*)(p.out + (size_t)r * 1024 + i * 256 + lane * 4) = y;
            else { u32x2 o; o.x = cvt_pk_bf16(y[0], y[1]); o.y = cvt_pk_bf16(y[2], y[3]); *(u32x2*)(xn + (size_t)r * 1024 + i * 256 + lane * 4) = o;
                   if (mode == 0) *(f32x4*)(h + (size_t)r * 1024 + i * 256 + lane * 4) = v[i]; }
        }
    }
}

constexpr int TCH = 32;
constexpr int MIXBUF_FLOATS = 4 * TCH * 64 + TCH * 4;
template <int MIX>
__device__ __forceinline__ void mix_item(KPR p, int layer, LAS float* lds, int tokbase, int L, int h, int col0, int ncols,
                         const float* s_in, float* s_out, const float* conv_in, float* conv_out) {
    const int tid = otid(), wid = __builtin_amdgcn_readfirstlane(tid >> 6), lane = tid & 63;
    const int nscan = ncols * 8; const bool is_scan = wid < (nscan >> 6);
    const int ksl = lane & 7, cl = wid * 8 + (lane >> 3), col = col0 + cl;
    const bf16_t* pm = (const bf16_t*)(p.ws + OFF_PM);
    bf16_t* oraw = (bf16_t*)(p.ws + OFF_ORAW);
    __syncthreads();
    float S[8];
#pragma unroll
    for (int i = 0; i < 8; ++i) S[i] = (is_scan && s_in) ? s_in[(ksl * 8 + i) * 64 + col] : 0.f;
    const int tl = lane >> 4, d4 = (lane & 15) * 4, hd4 = h * 64 + d4;
    f32x4 cw[3][4]; float c_a = 0.f, c_dt = 0.f; f32x4 gkw[16]; f32x4 gkb = (f32x4){0.f, 0.f, 0.f, 0.f}, lb4 = (f32x4){0.f, 0.f, 0.f, 0.f};
    if (MIX == 0) {
        const float* cwp = p.in[10] + (size_t)layer * 4 * 768;
#pragma unroll
        for (int s = 0; s < 3; ++s)
#pragma unroll
            for (int j = 0; j < 4; ++j) cw[s][j] = *(const f32x4*)(cwp + j * 768 + s * 256 + hd4);
        c_a = -__expf(p.in[11][layer * 4 + h]); c_dt = p.in[12][layer * 4 + h];
        if (conv_out && col0 == 0 && h == 0) {
            for (int idx = tid; idx < 3 * 768; idx += 512) { const int i = idx / 768, c = idx - i * 768, ti = L - 3 + i;
                conv_out[idx] = ti >= 0 ? bf2f(pm[(size_t)(tokbase + ti) * NPM + A_QKV + c]) : (conv_in ? conv_in[(3 + ti) * 768 + c] : 0.f); }
        }
    } else if (MIX == 1) {
#pragma unroll
        for (int r = 0; r < 16; ++r) gkw[r] = *(const f32x4*)(p.in[14] + ((size_t)layer * 16 + r) * 256 + hd4);
        gkb = *(const f32x4*)(p.in[15] + layer * 256 + hd4);
    } else {
        const float* lg = p.in[26] + hd4; const f32x4 a0 = *(const f32x4*)lg, a1 = *(const f32x4*)(lg + 256), a2 = *(const f32x4*)(lg + 512), a3 = *(const f32x4*)(lg + 768);
#pragma unroll
        for (int e = 0; e < 4; ++e) {
            const float mx = fmaxf(fmaxf(a0[e], a1[e]), fmaxf(a2[e], a3[e])); const float l0 = __expf(a0[e] - mx), l1 = __expf(a1[e] - mx), l2 = __expf(a2[e] - mx), l3 = __expf(a3[e] - mx);
            const float inv = 1.0f / (l0 + l1 + l2 + l3);
            lb4[e] = (layer == 0) ? 0.f : (layer == 1) ? l1 * inv : (layer == 2) ? (l1 + l2) * inv : (l1 + l2 + l3) * inv;
        }
    }
    const int nch = (L + TCH - 1) / TCH;
    auto prep = [&](int c, int pw, int npw) {
        LAS float* kb = lds + (c & 1) * MIXBUF_FLOATS; LAS float* qb = kb + TCH * 64; LAS float* fb = qb + TCH * 64; LAS float* vb = fb + TCH * 64; LAS float* sc = vb + TCH * 64;
#pragma unroll
        for (int pass = 0; pass < 2; ++pass) {
            const int tt0 = (pass * npw + pw) * 4;
            if (tt0 < TCH) {
                const int tt = tt0 + tl, t = c * TCH + tt;
                if (t < L) {
                    const bf16_t* row = pm + (size_t)(tokbase + t) * NPM;
                    if (MIX == 0) {
                        f32x4 y[3];
#pragma unroll
                        for (int s = 0; s < 3; ++s) { f32x4 a = (f32x4){0.f, 0.f, 0.f, 0.f};
#pragma unroll
                            for (int j = 0; j < 4; ++j) { const int ti = t - 3 + j; f32x4 xv = (f32x4){0.f, 0.f, 0.f, 0.f};
                                if (ti >= 0) { const u32x2 w = *(const u32x2*)(pm + (size_t)(tokbase + ti) * NPM + A_QKV + s * 256 + hd4); xv = (f32x4){lo_bf(w.x), hi_bf(w.x), lo_bf(w.y), hi_bf(w.y)}; }
                                else if (conv_in) xv = *(const f32x4*)(conv_in + (3 + ti) * 768 + s * 256 + hd4);
                                a += xv * cw[s][j]; }
                            y[s] = (f32x4){siluf_(a[0]), siluf_(a[1]), siluf_(a[2]), siluf_(a[3])}; }
                        const float qq = red16(y[0][0] * y[0][0] + y[0][1] * y[0][1] + y[0][2] * y[0][2] + y[0][3] * y[0][3]);
                        const float kk2 = red16(y[1][0] * y[1][0] + y[1][1] * y[1][1] + y[1][2] * y[1][2] + y[1][3] * y[1][3]);
                        const f32x4 qn = y[0] * (rsqrtf(qq + EPS) * 0.125f), kn = y[1] * rsqrtf(kk2 + EPS);
                        const float kq = red16(qn[0] * kn[0] + qn[1] * kn[1] + qn[2] * kn[2] + qn[3] * kn[3]);
                        *(LAS f32x4*)(kb + tt * 64 + d4) = kn; *(LAS f32x4*)(qb + tt * 64 + d4) = qn; *(LAS f32x4*)(vb + tt * 64 + d4) = y[2];
                        if ((lane & 15) == 0) { const float al = bf2f(row[A_ALPHA + h]) + c_dt; const float sp = fmaxf(al, 0.f) + __logf(1.0f + __expf(-fabsf(al)));
                            *(LAS f32x4*)(sc + tt * 4) = (f32x4){__expf(c_a * sp), sigmoidf_(bf2f(row[A_BETA + h])), kq, 0.f}; }
                    } else if (MIX == 1) {
                        const u32x4 g0 = *(const u32x4*)(row + B_GK), g1 = *(const u32x4*)(row + B_GK + 8);
                        const u32x2 wq = *(const u32x2*)(row + B_Q + hd4), wk = *(const u32x2*)(row + B_K + hd4), wv = *(const u32x2*)(row + B_V + hd4);
                        f32x4 z = gkb;
                        z += lo_bf(g0.x) * gkw[0] + hi_bf(g0.x) * gkw[1] + lo_bf(g0.y) * gkw[2] + hi_bf(g0.y) * gkw[3] + lo_bf(g0.z) * gkw[4] + hi_bf(g0.z) * gkw[5] + lo_bf(g0.w) * gkw[6] + hi_bf(g0.w) * gkw[7];
                        z += lo_bf(g1.x) * gkw[8] + hi_bf(g1.x) * gkw[9] + lo_bf(g1.y) * gkw[10] + hi_bf(g1.y) * gkw[11] + lo_bf(g1.z) * gkw[12] + hi_bf(g1.z) * gkw[13] + lo_bf(g1.w) * gkw[14] + hi_bf(g1.w) * gkw[15];
                        f32x4 f;
#pragma unroll
                        for (int e = 0; e < 4; ++e) { const float sp = fmaxf(-z[e], 0.f) + __logf(1.0f + __expf(-fabsf(z[e]))); f[e] = __expf(-sp * (1.0f / 16.0f)); }
                        *(LAS f32x4*)(fb + tt * 64 + d4) = f;
                        *(LAS f32x4*)(qb + tt * 64 + d4) = (f32x4){lo_bf(wq.x), hi_bf(wq.x), lo_bf(wq.y), hi_bf(wq.y)} * 0.125f;
                        *(LAS f32x4*)(kb + tt * 64 + d4) = (f32x4){lo_bf(wk.x), hi_bf(wk.x), lo_bf(wk.y), hi_bf(wk.y)};
                        *(LAS f32x4*)(vb + tt * 64 + d4) = (f32x4){lo_bf(wv.x), hi_bf(wv.x), lo_bf(wv.y), hi_bf(wv.y)};
                    } else {
                        const u32x2 wq = *(const u32x2*)(row + D_Q + hd4), wf = *(const u32x2*)(row + D_F + hd4), wv = *(const u32x2*)(row + D_I + hd4);
                        const f32x4 xq = (f32x4){lo_bf(wq.x), hi_bf(wq.x), lo_bf(wq.y), hi_bf(wq.y)}, xf = (f32x4){lo_bf(wf.x), hi_bf(wf.x), lo_bf(wf.y), hi_bf(wf.y)};
                        f32x4 f, k, q;
#pragma unroll
                        for (int e = 0; e < 4; ++e) { const float sg = sigmoidf_(xf[e]); f[e] = lb4[e] + (1.0f - lb4[e]) * sg; k[e] = (1.0f - lb4[e]) * (1.0f - sg); q[e] = siluf_(xq[e]) * 0.125f; }
                        *(LAS f32x4*)(fb + tt * 64 + d4) = f; *(LAS f32x4*)(kb + tt * 64 + d4) = k; *(LAS f32x4*)(qb + tt * 64 + d4) = q;
                        *(LAS f32x4*)(vb + tt * 64 + d4) = (f32x4){lo_bf(wv.x), hi_bf(wv.x), lo_bf(wv.y), hi_bf(wv.y)};
                    }
                }
            }
        }
    };
    prep(0, wid, 8);
    __syncthreads();
    for (int c = 0; c < nch; ++c) {
        if (is_scan) {
            const LAS float* kb = lds + (c & 1) * MIXBUF_FLOATS; const LAS float* qb = kb + TCH * 64; const LAS float* fb = qb + TCH * 64; const LAS float* vb = fb + TCH * 64; const LAS float* sc = vb + TCH * 64;
            const int ntok = (L - c * TCH) < TCH ? (L - c * TCH) : TCH;
            bf16_t* op = oraw + (size_t)(tokbase + c * TCH) * 768 + MIX * 256 + h * 64 + col;
            const LAS float* kp = kb + ksl * 8; const LAS float* qp = qb + ksl * 8; const LAS float* fp = fb + ksl * 8; const LAS float* vp = vb + col;
            f32x4 k0 = *(const LAS f32x4*)kp, k1 = *(const LAS f32x4*)(kp + 4), q0 = *(const LAS f32x4*)qp, q1 = *(const LAS f32x4*)(qp + 4);
            f32x4 f0 = (f32x4){0.f, 0.f, 0.f, 0.f}, f1 = f0, scv = f0;
            if (MIX == 0) scv = *(const LAS f32x4*)sc; else { f0 = *(const LAS f32x4*)fp; f1 = *(const LAS f32x4*)(fp + 4); }
            float v = vp[0];
            __builtin_amdgcn_s_setprio(3);
#pragma unroll 2
            for (int tt = 0; tt < ntok; ++tt) {
                const int tn = (tt + 1 < TCH) ? tt + 1 : tt;
                const f32x4 nk0 = *(const LAS f32x4*)(kp + tn * 64), nk1 = *(const LAS f32x4*)(kp + tn * 64 + 4), nq0 = *(const LAS f32x4*)(qp + tn * 64), nq1 = *(const LAS f32x4*)(qp + tn * 64 + 4);
                f32x4 nf0 = f0, nf1 = f1, nsc = scv;
                if (MIX == 0) nsc = *(const LAS f32x4*)(sc + tn * 4); else { nf0 = *(const LAS f32x4*)(fp + tn * 64); nf1 = *(const LAS f32x4*)(fp + tn * 64 + 4); }
                const float nv = vp[tn * 64];
                float o;
                if (MIX == 0) {
                    const float eg = scv[0], beta = scv[1], kq = scv[2];
                    float dk = (S[0] * k0[0] + S[1] * k0[1]) + (S[2] * k0[2] + S[3] * k0[3]) + (S[4] * k1[0] + S[5] * k1[1]) + (S[6] * k1[2] + S[7] * k1[3]);
                    float dq = (S[0] * q0[0] + S[1] * q0[1]) + (S[2] * q0[2] + S[3] * q0[3]) + (S[4] * q1[0] + S[5] * q1[1]) + (S[6] * q1[2] + S[7] * q1[3]);
                    dk = red8(dk); dq = red8(dq);
                    const float delta = beta * (v - eg * dk);
#pragma unroll
                    for (int i = 0; i < 4; ++i) { S[i] = eg * S[i] + k0[i] * delta; S[4 + i] = eg * S[4 + i] + k1[i] * delta; }
                    o = eg * dq + kq * delta;
                } else {
#pragma unroll
                    for (int i = 0; i < 4; ++i) { S[i] = f0[i] * S[i] + k0[i] * v; S[4 + i] = f1[i] * S[4 + i] + k1[i] * v; }
                    float dq = (S[0] * q0[0] + S[1] * q0[1]) + (S[2] * q0[2] + S[3] * q0[3]) + (S[4] * q1[0] + S[5] * q1[1]) + (S[6] * q1[2] + S[7] * q1[3]);
                    o = red8(dq);
                }
                if (ksl == 0) op[(size_t)tt * 768] = f2bf(o);
                k0 = nk0; k1 = nk1; q0 = nq0; q1 = nq1; f0 = nf0; f1 = nf1; scv = nsc; v = nv;
            }
            __builtin_amdgcn_s_setprio(0);
        } else if (c + 1 < nch) prep(c + 1, wid - (nscan >> 6), 8 - (nscan >> 6));
        __syncthreads();
    }
    if (is_scan) {
#pragma unroll
        for (int i = 0; i < 8; ++i) s_out[(ksl * 8 + i) * 64 + col] = S[i];
    }
}

constexpr int S5_BU_LD = 132, S5_XB_LD = 136, S5_WAVE_BYTES = 16 * S5_BU_LD * 4 + 16 * S5_XB_LD * 2;
template <bool SAMPLE>
__device__ __forceinline__ void s5_wave_item(KPR p, int layer, LAS unsigned char* wl, int g, int tokbase, int L, int seq0) {
    const int lane = otid() & 63, col = lane & 15, quad = lane >> 4;
    const bf16_t* pm = (const bf16_t*)(p.ws + OFF_PM); bf16_t* yg = (bf16_t*)(p.ws + OFF_YG);
    LAS float* bu = (LAS float*)wl; LAS bf16_t* xb = (LAS bf16_t*)(wl + 16 * S5_BU_LD * 4);
    const int lg = layer * 16 + g;
    float ar, ai, zr, zi;
    { const float lr = fminf(p.in[17][lg * 64 + lane], -1e-4f), li = p.in[18][lg * 64 + lane], dt = __expf(p.in[24][lg]);
      const float mag = __expf(lr * dt); float rev = li * dt * 0.15915494309f; rev -= rintf(rev);
      const float sn = __builtin_amdgcn_sinf(rev), cs = __builtin_amdgcn_cosf(rev); ar = mag * cs; ai = mag * sn;
      const float den = lr * lr + li * li; zr = ((ar - 1.0f) * lr + ai * li) / den; zi = (ai * lr - (ar - 1.0f) * li) / den; }
    bf16x8 Bf[8], Cf[4];
#pragma unroll
    for (int tt = 0; tt < 4; ++tt) {
        const int pp = tt * 16 + col; const float zr2 = __shfl(zr, pp), zi2 = __shfl(zi, pp);
        float bre[8], bim[8];
#pragma unroll
        for (int j = 0; j < 8; ++j) { bre[j] = 0.f; bim[j] = 0.f; }
        if (quad < 2) {
            const float* br_ = p.in[19] + ((size_t)lg * 64 + pp) * 16 + quad * 8; const float* bi_ = p.in[20] + ((size_t)lg * 64 + pp) * 16 + quad * 8;
#pragma unroll
            for (int j = 0; j < 8; ++j) { const float r = br_[j], i = bi_[j]; bre[j] = zr2 * r - zi2 * i; bim[j] = zr2 * i + zi2 * r; }
        }
        u32x4 wr_, wi_;
        wr_.x = cvt_pk_bf16(bre[0], bre[1]); wr_.y = cvt_pk_bf16(bre[2], bre[3]); wr_.z = cvt_pk_bf16(bre[4], bre[5]); wr_.w = cvt_pk_bf16(bre[6], bre[7]);
        wi_.x = cvt_pk_bf16(bim[0], bim[1]); wi_.y = cvt_pk_bf16(bim[2], bim[3]); wi_.z = cvt_pk_bf16(bim[4], bim[5]); wi_.w = cvt_pk_bf16(bim[6], bim[7]);
        Bf[tt] = __builtin_bit_cast(bf16x8, wr_); Bf[4 + tt] = __builtin_bit_cast(bf16x8, wi_);
    }
#pragma unroll
    for (int kb = 0; kb < 4; ++kb) {
        const int k0 = (kb & 1) * 32 + quad * 8; const float sgn = kb < 2 ? 1.0f : -1.0f;
        const float* cp = (kb < 2 ? p.in[21] : p.in[22]) + ((size_t)lg * 16 + col) * 64 + k0;
        u32x4 w; w.x = cvt_pk_bf16(sgn * cp[0], sgn * cp[1]); w.y = cvt_pk_bf16(sgn * cp[2], sgn * cp[3]); w.z = cvt_pk_bf16(sgn * cp[4], sgn * cp[5]); w.w = cvt_pk_bf16(sgn * cp[6], sgn * cp[7]);
        Cf[kb] = __builtin_bit_cast(bf16x8, w);
    }
    const float dcoef = p.in[23][layer * 256 + g * 16 + col];
    float xr = 0.f, xi = 0.f;
    const int nch = SAMPLE ? 1 : (L + 15) / 16;
    u32x4 awn = (u32x4){0u, 0u, 0u, 0u}; bf16_t un[4] = {0, 0, 0, 0};
    auto pf = [&](int cc) {
        const int t0 = cc * 16; const int nrow = SAMPLE ? 16 : ((L - t0) < 16 ? (L - t0) : 16);
        awn = (u32x4){0u, 0u, 0u, 0u};
        if (quad < 2 && col < nrow) awn = *(const u32x4*)(pm + (size_t)(tokbase + t0 + col) * NPM + C_U + g * 16 + quad * 8);
#pragma unroll
        for (int i = 0; i < 4; ++i) { const int r = quad * 4 + i; un[i] = (r < nrow) ? pm[(size_t)(tokbase + t0 + r) * NPM + C_U + g * 16 + col] : (bf16_t)0; }
    };
    pf(0);
    for (int c = 0; c < nch; ++c) {
        const int t0 = c * 16; const int nrow = SAMPLE ? 16 : ((L - t0) < 16 ? (L - t0) : 16);
        const u32x4 aw = awn; bf16_t uc[4];
#pragma unroll
        for (int i = 0; i < 4; ++i) uc[i] = un[i];
        if (c + 1 < nch) pf(c + 1);
        const bf16x8 af = __builtin_bit_cast(bf16x8, aw);
#pragma unroll
        for (int tile = 0; tile < 8; ++tile) {
            const f32x4 d = __builtin_amdgcn_mfma_f32_16x16x32_bf16(af, Bf[tile], (f32x4){0.f, 0.f, 0.f, 0.f}, 0, 0, 0);
#pragma unroll
            for (int i = 0; i < 4; ++i) bu[(quad * 4 + i) * S5_BU_LD + tile * 16 + col] = d[i];
        }
        __builtin_amdgcn_fence(__ATOMIC_RELEASE, "wavefront"); __builtin_amdgcn_wave_barrier(); __builtin_amdgcn_fence(__ATOMIC_ACQUIRE, "wavefront");
        for (int r = 0; r < 16; ++r) {
            float nr = 0.f, ni = 0.f;
            if (r < nrow) {
                if (SAMPLE) { const size_t si = ((size_t)(layer * NDEC + seq0 + r) * 16 + g) * 64 + lane; xr = p.in[5][si]; xi = p.in[6][si]; }
                const float br_ = bu[r * S5_BU_LD + lane], bi_ = bu[r * S5_BU_LD + 64 + lane];
                nr = ar * xr - ai * xi + br_; ni = ar * xi + ai * xr + bi_; xr = nr; xi = ni;
                if (SAMPLE) { const size_t so = ((size_t)(layer * NDEC + seq0 + r) * 16 + g) * 64 + lane; p.out[O_SS5R + so] = nr; p.out[O_SS5I + so] = ni; }
            }
            xb[r * S5_XB_LD + lane] = f2bf(nr); xb[r * S5_XB_LD + 64 + lane] = f2bf(ni);
        }
        __builtin_amdgcn_fence(__ATOMIC_RELEASE, "wavefront"); __builtin_amdgcn_wave_barrier(); __builtin_amdgcn_fence(__ATOMIC_ACQUIRE, "wavefront");
        f32x4 ya = (f32x4){0.f, 0.f, 0.f, 0.f};
#pragma unroll
        for (int kb = 0; kb < 4; ++kb) { const bf16x8 xf = *(const LAS bf16x8*)(xb + col * S5_XB_LD + kb * 32 + quad * 8); ya = __builtin_amdgcn_mfma_f32_16x16x32_bf16(xf, Cf[kb], ya, 0, 0, 0); }
#pragma unroll
        for (int i = 0; i < 4; ++i) { const int r = quad * 4 + i;
            if (r < nrow) { const size_t tok = (size_t)(tokbase + t0 + r); const float uu = bf2f(uc[i]);
                const float y = ya[i] + dcoef * uu; const float ge = y * __builtin_amdgcn_rcpf(1.0f + __expf(-1.5957691216f * (y + 0.044715f * y * y * y)));
                yg[tok * 256 + g * 16 + col] = f2bf(ge); } }
        __builtin_amdgcn_fence(__ATOMIC_RELEASE, "wavefront"); __builtin_amdgcn_wave_barrier(); __builtin_amdgcn_fence(__ATOMIC_ACQUIRE, "wavefront");
    }
    if (!SAMPLE) { const size_t so = ((size_t)(layer * NBATCH + seq0) * 16 + g) * 64 + lane; p.out[O_PS5R + so] = xr; p.out[O_PS5I + so] = xi; }
}

__device__ __forceinline__ void phase_mix(KPR p, int layer, LAS unsigned char* ldsb, int bid, int G) {
    LAS float* lds = (LAS float*)ldsb;
    const int wid = __builtin_amdgcn_readfirstlane(otid() >> 6);
    constexpr int NLONG = 208, NSHORT = 16 + 1536;
    for (int it = bid; it < NLONG; it += G) {
        if (it < 192) {
            const int mix = it >> 6, r = it & 63, b = r >> 3, hh = (r >> 1) & 3, half = r & 1;
            const size_t so = ((size_t)(layer * NBATCH + b) * 4 + hh) * 4096;
            if (mix == 0) mix_item<0>(p, layer, lds, b * SEQ, SEQ, hh, half * 32, 32, nullptr, p.out + O_PGDN + so, nullptr, p.out + O_PCONV + (size_t)(layer * NBATCH + b) * 2304);
            else if (mix == 1) mix_item<1>(p, layer, lds, b * SEQ, SEQ, hh, half * 32, 32, nullptr, p.out + O_PGLA + so, nullptr, nullptr);
            else mix_item<2>(p, layer, lds, b * SEQ, SEQ, hh, half * 32, 32, nullptr, p.out + O_PHG + so, nullptr, nullptr);
        } else {
            __syncthreads();
            const int j = (it - 192) * 8 + wid, b = j >> 4, g = j & 15;
            s5_wave_item<false>(p, layer, ldsb + wid * S5_WAVE_BYTES, g, b * SEQ, SEQ, b);
        }
    }
    int js = bid, jstep = G, jend = NSHORT;
    if (G >= 256) { if (bid >= 192) { js = bid - 192; jstep = 64; jend = 1040; } else if (bid >= 64) { js = 1040 + (bid - 64) * 4; jstep = 1; jend = js + 4; } else { js = 0; jend = 0; } }
    for (int j = js; j < jend; j += jstep) {
        if (j < 16) {
            __syncthreads();
            const int jj = j * 8 + wid, g = jj & 15, s0 = (jj >> 4) * 16;
            s5_wave_item<true>(p, layer, ldsb + wid * S5_WAVE_BYTES, g, MPROMPT + s0, 16, s0);
        } else {
            const int jj = j - 16, mix = jj >> 9, s = (jj & 511) >> 2, hh = jj & 3;
            const size_t so = ((size_t)(layer * NDEC + s) * 4 + hh) * 4096;
            if (mix == 0) mix_item<0>(p, layer, lds, MPROMPT + s, 1, hh, 0, 64, p.in[3] + so, p.out + O_SGDN + so, p.in[2] + (size_t)(layer * NDEC + s) * 2304, p.out + O_SCONV + (size_t)(layer * NDEC + s) * 2304);
            else if (mix == 1) mix_item<1>(p, layer, lds, MPROMPT + s, 1, hh, 0, 64, p.in[4] + so, p.out + O_SGLA + so, nullptr, nullptr);
            else mix_item<2>(p, layer, lds, MPROMPT + s, 1, hh, 0, 64, p.in[7] + so, p.out + O_SHG + so, nullptr, nullptr);
        }
    }
    __syncthreads();
}

__device__ __forceinline__ void phase_headnorm(KPR p, int layer, int bid, int G) {
    const int tid_ = otid(); const int wid = __builtin_amdgcn_readfirstlane(tid_ >> 6), lane = tid_ & 63;
    const bf16_t* pm = (const bf16_t*)(p.ws + OFF_PM); const bf16_t* oraw = (const bf16_t*)(p.ws + OFF_ORAW); bf16_t* br = (bf16_t*)(p.ws + OFF_BR);
    for (int j = bid * 8 + wid; j < MTOK * 3; j += G * 8) {
        const int tok = j / 3, mix = j - tok * 3;
        const int gcol = mix == 0 ? A_GATE : (mix == 1 ? B_GATE : D_GATE), slot = mix == 2 ? 3 : mix;
        const float* nw = (mix == 0 ? p.in[13] : (mix == 1 ? p.in[16] : p.in[27])) + layer * 256 + lane * 4;
        const u32x2 ow = *(const u32x2*)(oraw + (size_t)tok * 768 + mix * 256 + lane * 4);
        const u32x2 gw = *(const u32x2*)(pm + (size_t)tok * NPM + gcol + lane * 4);
        const float o0 = lo_bf(ow.x), o1 = hi_bf(ow.x), o2 = lo_bf(ow.y), o3 = hi_bf(ow.y);
        float ss = o0 * o0 + o1 * o1 + o2 * o2 + o3 * o3;
        ss += __shfl_xor(ss, 1); ss += __shfl_xor(ss, 2); ss += __shfl_xor(ss, 4); ss += __shfl_xor(ss, 8);
        const float rs = rsqrtf(ss * (1.0f / 64.0f) + EPS);
        const f32x4 w = *(const f32x4*)nw;
        u32x2 r; r.x = cvt_pk_bf16(o0 * rs * w[0] * siluf_(lo_bf(gw.x)), o1 * rs * w[1] * siluf_(hi_bf(gw.x)));
        r.y = cvt_pk_bf16(o2 * rs * w[2] * siluf_(lo_bf(gw.y)), o3 * rs * w[3] * siluf_(hi_bf(gw.y)));
        *(u32x2*)(br + (size_t)tok * 1024 + slot * 256 + lane * 4) = r;
    }
}

constexpr int PH_PER_LAYER = 9, N_PHASES = 4 * PH_PER_LAYER + 1;
__device__ __forceinline__ void run_phase(KPR p, int ph, LAS unsigned char* lds, int bid, int G) {
    unsigned char* ws = p.ws;
    if (ph == N_PHASES - 1) { phase_norm(p, p.in[34], 2, bid, G); return; }
    const int layer = ph / PH_PER_LAYER, s = ph - layer * PH_PER_LAYER;
    pg8::Sched S; pg8::Gemm g;
    switch (s) {
    case 0: phase_convert(p, layer, (LAS float*)lds, bid, G); phase_norm(p, p.in[8] + layer * 1024, layer == 0 ? 0 : 1, bid, G); break;
    case 1: { S.init(65, 30, 1, G, bid, 16); g = pg8::Gemm{(const bf16_t*)(ws + OFF_XN), (const bf16_t*)(ws + OFF_WIN), 1024, 1024, 16, 0, 0};
              pg8::gemm_phase(lds, g, S, EpiIn{(bf16_t*)(ws + OFF_PM), (bf16_t*)(ws + OFF_GATES)}); } break;
    case 2: phase_mix(p, layer, lds, bid, G); break;
    case 3: { S.init(65, 2, 1, G, bid, 4); g = pg8::Gemm{(const bf16_t*)(ws + OFF_YG), (const bf16_t*)(ws + OFF_WGLU), 256, 256, 4, 0, 0};
              pg8::gemm_phase(lds, g, S, EpiGlu{(bf16_t*)(ws + OFF_BR)}); phase_headnorm(p, layer, bid, G); } break;
    case 4: { S.init(65, 4, 4, G, bid, 4); g = pg8::Gemm{(const bf16_t*)(ws + OFF_BR), (const bf16_t*)(ws + OFF_WBR), 1024, 256, 4, 256, (size_t)1024 * 256};
              pg8::gemm_phase(lds, g, S, EpiBr{(const bf16_t*)(ws + OFF_GATES), (bf16_t*)(ws + OFF_PM)}); } break;
    case 5: { S.init(64, 4, 1, G, bid, 16, 4); g = pg8::Gemm{(const bf16_t*)(ws + OFF_PM), (const bf16_t*)(ws + OFF_WOUT), 1024, 1024, 16, 0, 0};
              pg8::gemm_phase(lds, g, S, EpiRes{(float*)(ws + OFF_H)}); } break;
    case 6: phase_norm(p, p.in[30] + layer * 1024, 1, bid, G); break;
    case 7: { S.init(65, 22, 1, G, bid, 16); g = pg8::Gemm{(const bf16_t*)(ws + OFF_XN), (const bf16_t*)(ws + OFF_WGU), 1024, 1024, 16, 0, 0};
              pg8::gemm_phase(lds, g, S, EpiGU{(bf16_t*)(ws + OFF_PM)}); } break;
    case 8: { S.init(64, 4, 1, G, bid, 44, 4); g = pg8::Gemm{(const bf16_t*)(ws + OFF_PM), (const bf16_t*)(ws + OFF_WDN), DFF, DFF, 44, 0, 0};
              pg8::gemm_phase(lds, g, S, EpiRes{(float*)(ws + OFF_H)}); } break;
    }
}

extern __shared__ __attribute__((aligned(16))) unsigned char dyn_smem[];
#if MULTI_LAUNCH
__global__ void __launch_bounds__(512) k_phase(KP parg, int ph) {
    KPR p = *(const CAS KP*)__builtin_amdgcn_kernarg_segment_ptr();
    run_phase(p, ph, (LAS unsigned char*)dyn_smem, blockIdx.x, gridDim.x);
}
#else
#define XB_TMO      128
#define XB_XCNT(j)  (256  + 64 * (j))
#define XB_XSUB(j)  (1280 + 64 * (j))
#define XB_XGEN(j)  (2304 + 64 * (j))
#define XB_TOP      3328
#define XB_TOPGEN   3392
#define XCD_BAR_WORDS 3456
#define XB_SPIN_CAP (1u << 22)
__device__ __forceinline__ unsigned xb_ld(unsigned* q)              { return __hip_atomic_load(q, __ATOMIC_RELAXED, __HIP_MEMORY_SCOPE_AGENT); }
__device__ __forceinline__ unsigned xb_add(unsigned* q, unsigned v) { return __hip_atomic_fetch_add(q, v, __ATOMIC_RELAXED, __HIP_MEMORY_SCOPE_AGENT); }
__device__ __forceinline__ unsigned xb_xcc_id() { return (unsigned)__builtin_amdgcn_s_getreg((3 << 11) | 20) & 0xFu; }
#define XB_SPIN(cond, bar) do { unsigned _sp = 0; while (cond) { __builtin_amdgcn_s_sleep(1); \
    if ((++_sp & 255u) == 0u) { if (xb_ld(&(bar)[XB_TMO])) break; if (_sp > XB_SPIN_CAP) { atomicAdd(&(bar)[XB_TMO], 1u); break; } } } } while (0)
__device__ __forceinline__ void xcd_barrier_complete(unsigned* bar, unsigned x, unsigned G, unsigned& nloc, unsigned& nx) {
    unsigned sum, cnt, mine, sp = 0u;
    for (;;) {
        sum = 0u; cnt = 0u; mine = 0u;
#pragma unroll
        for (unsigned j = 0; j < 16; ++j) { const unsigned c = xb_ld(&bar[XB_XCNT(j)]); sum += c; cnt += (c > 0u) ? 1u : 0u; mine = (j == x) ? c : mine; }
        if (sum == G) break;
        __builtin_amdgcn_s_sleep(1);
        if ((++sp & 255u) == 0u) { if (xb_ld(&bar[XB_TMO])) break; if (sp > XB_SPIN_CAP) { atomicAdd(&bar[XB_TMO], 1u); break; } }
    }
    nloc = mine > 0u ? mine : 1u; nx = cnt > 0u ? cnt : 1u;
}
__device__ __forceinline__ void grid_bar(unsigned* bar, volatile LAS unsigned* st, int G) {
    asm volatile("s_waitcnt vmcnt(0)" ::: "memory");
    __syncthreads();
    if (otid() == 0) {
        __builtin_amdgcn_s_waitcnt(0);
        const unsigned x = xb_xcc_id();
        unsigned nloc = st[0], nx = st[1];
        if (nloc == 0u) { xcd_barrier_complete(bar, x, (unsigned)G, nloc, nx); st[0] = nloc; st[1] = nx; }
        const unsigned old = xb_add(&bar[XB_XSUB(x)], 1u);
        const unsigned gen = old / nloc;
        if (old + 1u == (gen + 1u) * nloc) {
            __builtin_amdgcn_fence(__ATOMIC_RELEASE, "agent");
            asm volatile("s_waitcnt vmcnt(0)" ::: "memory");
            const unsigned og = xb_add(&bar[XB_TOP], 1u);
            const unsigned tg = og / nx;
            if (og + 1u == (tg + 1u) * nx) xb_add(&bar[XB_TOPGEN], 1u);
            else XB_SPIN(xb_ld(&bar[XB_TOPGEN]) == tg, bar);
            __builtin_amdgcn_fence(__ATOMIC_ACQUIRE, "agent");
            xb_add(&bar[XB_XGEN(x)], 1u);
            asm volatile("s_waitcnt vmcnt(0)" ::: "memory");
        } else {
            XB_SPIN(xb_ld(&bar[XB_XGEN(x)]) == gen, bar);
            __builtin_amdgcn_fence(__ATOMIC_ACQUIRE, "agent");
            asm volatile("s_waitcnt vmcnt(0)" ::: "memory");
        }
    }
    __syncthreads();
}
template <int PH> __device__ __forceinline__ void run_from(KPR p, cg::grid_group& grid) {
    const CAS KP* pp = &p; asm volatile("" : "+s"(pp));
    int bid = blockIdx.x, G = gridDim.x; asm volatile("" : "+s"(bid), "+s"(G));
    run_phase(*pp, PH, (LAS unsigned char*)dyn_smem, bid, G);
    if constexpr (PH + 1 < N_PHASES) {
        if constexpr (PH == 0) grid.sync();
        else grid_bar((unsigned*)(pp->ws + OFF_BAR), (volatile LAS unsigned*)((LAS unsigned char*)dyn_smem + pg8::STAGE_BYTES), G);
        run_from<PH + 1>(p, grid);
    }
}
__global__ void __launch_bounds__(512) k_mega(KP parg) {
    cg::grid_group grid = cg::this_grid();
    KPR p = *(const CAS KP*)__builtin_amdgcn_kernarg_segment_ptr();
    if (threadIdx.x == 0) { volatile LAS unsigned* st = (volatile LAS unsigned*)((LAS unsigned char*)dyn_smem + pg8::STAGE_BYTES); st[0] = 0u; st[1] = 0u;
        (void)xb_add(&((unsigned*)(p.ws + OFF_BAR))[XB_XCNT(xb_xcc_id())], 1u); }
    __syncthreads();
    run_from<0>(p, grid);
}
#endif

extern "C" void kernel_launch(void* const* d_in, const int* in_sizes, int n_in, void* d_out, int out_size, void* d_ws, size_t ws_size, hipStream_t stream) {
    if (ws_size < WS_NEED || n_in < 35) { fprintf(stderr, "workspace too small: %zu < %zu\n", ws_size, (size_t)WS_NEED); return; }
    KP p{};
    for (int i = 0; i < 35; ++i) p.in[i] = (const float*)d_in[i];
    p.out = (float*)d_out; p.ws = (unsigned char*)d_ws;
    constexpr size_t kDynLds = pg8::STAGE_BYTES + 16;
#if MULTI_LAUNCH
    static bool once = false;
    if (!once) { hipFuncSetAttribute((const void*)k_phase, hipFuncAttributeMaxDynamicSharedMemorySize, (int)kDynLds); once = true; }
    for (int ph = 0; ph < N_PHASES; ++ph) hipLaunchKernelGGL(k_phase, dim3(256), dim3(512), kDynLds, stream, p, ph);
#else
    static int grid_blocks = 0;
    if (!grid_blocks) {
        hipFuncSetAttribute((const void*)k_mega, hipFuncAttributeMaxDynamicSharedMemorySize, (int)kDynLds);
        int dev = 0, cus = 0, per_cu = 0;
        hipGetDevice(&dev);
        hipDeviceGetAttribute(&cus, hipDeviceAttributeMultiprocessorCount, dev);
        hipOccupancyMaxActiveBlocksPerMultiprocessor(&per_cu, k_mega, 512, kDynLds);
        if (per_cu < 1) per_cu = 1;
        grid_blocks = cus * per_cu; if (grid_blocks > 256) grid_blocks = 256;
    }
    hipMemsetAsync((unsigned char*)d_ws + OFF_BAR, 0, 16384, stream);
    void* args[] = {&p};
    hipError_t e = hipLaunchCooperativeKernel((void*)k_mega, dim3(grid_blocks), dim3(512), args, kDynLds, stream);
    if (e != hipSuccess) fprintf(stderr, "cooperative launch failed: %s (grid %d)\n", hipGetErrorString(e), grid_blocks);
#endif
}
```

```cpp
#include <hip/hip_runtime.h>
#include <hip/hip_cooperative_groups.h>
#include <cstdio>
namespace cg = cooperative_groups;

#ifndef MULTI_LAUNCH
#define MULTI_LAUNCH 0
#endif

#define LAS __attribute__((address_space(3)))
typedef unsigned short bf16_t;
typedef short bf16x8 __attribute__((ext_vector_type(8)));
typedef float f32x4 __attribute__((ext_vector_type(4)));
typedef float f32x2 __attribute__((ext_vector_type(2)));
typedef unsigned u32x2 __attribute__((ext_vector_type(2)));
typedef unsigned u32x4 __attribute__((ext_vector_type(4)));

constexpr int DM = 1024, SEQ = 2048, NBATCH = 8, NDEC = 128;
constexpr int MPROMPT = NBATCH * SEQ;
constexpr int MTOK = MPROMPT + NDEC;
constexpr int MP = 16640;
constexpr int NPM = 3584, NGATE = 4096, NIN = 7448, DFF = 2816;
constexpr int A_QKV = 0, A_GATE = 768, B_Q = 1024, B_K = 1280, B_V = 1536, B_GATE = 1792, C_U = 2048, D_Q = 2304, D_F = 2560, D_I = 2816, D_GATE = 3072,
              A_ALPHA = 3328, A_BETA = 3332, B_GK = 3336;
constexpr float EPS = 1e-6f;

constexpr size_t SZ_WIN = (size_t)7680 * 1024 * 2, SZ_WGU = (size_t)5632 * 1024 * 2, SZ_WDN = (size_t)1024 * 2816 * 2, SZ_WOUT = (size_t)1024 * 1024 * 2,
                 SZ_WBR = (size_t)4096 * 256 * 2, SZ_WGLU = (size_t)512 * 256 * 2;
constexpr size_t OFF_WIN = 0, OFF_WGU = OFF_WIN + SZ_WIN, OFF_WDN = OFF_WGU + SZ_WGU, OFF_WOUT = OFF_WDN + SZ_WDN, OFF_WBR = OFF_WOUT + SZ_WOUT,
                 OFF_WGLU = OFF_WBR + SZ_WBR, OFF_H = OFF_WGLU + SZ_WGLU, OFF_XN = OFF_H + (size_t)MP * 1024 * 4, OFF_BR = OFF_XN + (size_t)MP * 1024 * 2,
                 OFF_PM = OFF_BR + (size_t)MP * 1024 * 2, OFF_GATES = OFF_PM + (size_t)MP * NPM * 2, OFF_ORAW = OFF_GATES + (size_t)MP * NGATE * 2,
                 OFF_YG = OFF_ORAW + (size_t)MP * 768 * 2, OFF_BAR = OFF_YG + (size_t)MP * 256 * 2, WS_NEED = OFF_BAR + 16384;
constexpr size_t O_PCONV = 16908288, O_PGDN = 16982016, O_PGLA = 17506304, O_PS5R = 18030592, O_PS5I = 18063360, O_PHG = 18096128,
                 O_SCONV = 18620416, O_SGDN = 19800064, O_SGLA = 28188672, O_SS5R = 36577280, O_SS5I = 37101568, O_SHG = 37625856;

struct KP { const float* in[35]; float* out; unsigned char* ws; };
#define CAS __attribute__((address_space(4)))
typedef const CAS KP& KPR;

__device__ __forceinline__ int otid() { int t = threadIdx.x; asm volatile("" : "+v"(t)); return t & 511; }
__device__ __forceinline__ float bf2f(bf16_t b) { return __uint_as_float(((unsigned)b) << 16); }
typedef __bf16 bf16x2_t __attribute__((ext_vector_type(2)));
__device__ __forceinline__ unsigned cvt_pk_bf16(float lo, float hi) { const f32x2 f = {lo, hi}; const bf16x2_t v = __builtin_convertvector(f, bf16x2_t); return __builtin_bit_cast(unsigned, v); }
__device__ __forceinline__ bf16_t f2bf(float f) { return (bf16_t)(cvt_pk_bf16(f, 0.f) & 0xffffu); }
__device__ __forceinline__ float lo_bf(unsigned w) { return __uint_as_float(w << 16); }
__device__ __forceinline__ float hi_bf(unsigned w) { return __uint_as_float(w & 0xffff0000u); }
__device__ __forceinline__ float sigmoidf_(float x) { return __builtin_amdgcn_rcpf(1.0f + __expf(-x)); }
__device__ __forceinline__ float siluf_(float x) { return x * __builtin_amdgcn_rcpf(1.0f + __expf(-x)); }
__device__ __forceinline__ float wave_sum(float v) {
#pragma unroll
    for (int o = 32; o >= 1; o >>= 1) v += __shfl_xor(v, o);
    return v;
}
template <int CTRL> __device__ __forceinline__ float dpp_f(float v) { return __int_as_float(__builtin_amdgcn_update_dpp(0, __float_as_int(v), CTRL, 0xf, 0xf, true)); }
__device__ __forceinline__ float red16(float v) { v += dpp_f<0xB1>(v); v += dpp_f<0x4E>(v); v += dpp_f<0x141>(v); v += dpp_f<0x140>(v); return v; }
__device__ __forceinline__ float red8(float v) { v += dpp_f<0xB1>(v); v += dpp_f<0x4E>(v); v += dpp_f<0x141>(v); return v; }

namespace pg8 {
constexpr int BM = 256, BK = 64, HALF = 128, HTB = HALF * BK * 2, STAGE_BYTES = 8 * HTB, NXCD = 8, WGM = 8;
__device__ __forceinline__ int lds_byte(int r, int c) { const int st = (r >> 4) * 2 + (c >> 5), rr = r & 15, cc = c & 31, ob = rr * 64 + cc * 2; return st * 1024 + (ob ^ (((ob >> 9) & 1) << 5)); }
__device__ __forceinline__ void stage_rc(int b, int& R, int& C) { const int st = b / 1024, sb = b % 1024, swz = sb ^ (((sb >> 9) & 1) << 5); R = (st >> 1) * 16 + swz / 64; C = (st & 1) * 32 + (swz % 64) / 2; }

struct Unit { int pm, pn, kk, k0, nt; };
struct Gemm { const bf16_t* A; const bf16_t* Bt; int lda, ldb, nt; size_t a_kk, b_kk; };
struct Sched {
    int nM, nN, nKK, nwg, G, c, ntf, nts, nextra;
    __device__ void init(int nM_, int nN_, int nKK_, int G_, int c_, int ntf_, int nts_ = 0) { nM = nM_; nN = nN_; nKK = nKK_; nwg = nM * nN; G = G_; c = c_; ntf = ntf_; nts = nts_; nextra = nts_ ? nN_ * (ntf_ / nts_) : 0; }
    __device__ bool next(int i, Unit& u) const {
        const int it = i / nKK; u.kk = i - it * nKK; u.k0 = 0; u.nt = ntf;
        const long L = (long)it * G + c;
        if (L >= nwg) { const int e = (int)(L - nwg); if (e >= nextra) return false; u.pm = nM; u.pn = e % nN; u.k0 = (e / nN) * nts; u.nt = nts; return true; }
        int wgid = (int)L; { const int q = nwg / NXCD, r = nwg % NXCD, xcd = wgid % NXCD, off = wgid / NXCD; wgid = (xcd < r ? xcd * (q + 1) : r * (q + 1) + (xcd - r) * q) + off; }
        const int nig = WGM * nN, gid = wgid / nig, fm = gid * WGM, gsz = (nM - fm) < WGM ? (nM - fm) : WGM;
        u.pm = fm + ((wgid % nig) % gsz); u.pn = (wgid % nig) / gsz; return true;
    }
};

template <class Epi>
__device__ __forceinline__ void gemm_phase(LAS unsigned char* lds, const Gemm g, const Sched& S, const Epi& E) {
    const int tid = otid(), wid = __builtin_amdgcn_readfirstlane(tid >> 6), lane = tid & 63, wr = wid >> 2, wc = wid & 3, fr = lane & 15, fq = lane >> 4;
    unsigned voffA[2], voffB[2];
#pragma unroll
    for (int i = 0; i < 2; ++i) { int R, C; stage_rc(tid * 16 + i * 8192, R, C); voffA[i] = (unsigned)(R * g.lda + C) * 2u; voffB[i] = (unsigned)(R * g.ldb + C) * 2u; }
    const size_t kstep = (size_t)(BK * 2);
    const size_t hstepA = (size_t)HALF * g.lda * 2, hstepB = (size_t)HALF * g.ldb * 2;
    const size_t tstepA = 2 * hstepA, tstepB = 2 * hstepB;
    const unsigned ldsw = (unsigned)wid * 1024u;
    const int aoff = lds_byte(wr * 64 + fr, fq * 8), boff = lds_byte(wc * 32 + fr, fq * 8);
#define PG8_SA(b, h) (((b) * 2 + (h)) * HTB)
#define PG8_SB(b, h) ((4 + (b) * 2 + (h)) * HTB)
#define PG8_STAGE(bufoff, gbase, voff) do { _Pragma("unroll") for (int _i = 0; _i < 2; ++_i) \
        __builtin_amdgcn_global_load_lds((const unsigned*)((const char*)(gbase) + (voff)[_i]), (LAS unsigned*)(lds + (bufoff) + ldsw + _i * 8192), 16, 0, 0); } while (0)
#define PG8_LDA(dst, b, h) do { _Pragma("unroll") for (int m = 0; m < 4; ++m) _Pragma("unroll") for (int k = 0; k < 2; ++k) dst[m][k] = *(const LAS bf16x8*)(lds + PG8_SA(b, h) + aoff + m * 2048 + k * 1024); } while (0)
#define PG8_LDB(dst, b, h) do { _Pragma("unroll") for (int n = 0; n < 2; ++n) _Pragma("unroll") for (int k = 0; k < 2; ++k) dst[n][k] = *(const LAS bf16x8*)(lds + PG8_SB(b, h) + boff + n * 2048 + k * 1024); } while (0)
#define PG8_MMA(ai, bj, At, Bt) do { __builtin_amdgcn_s_setprio(1); _Pragma("unroll") for (int m = 0; m < 4; ++m) _Pragma("unroll") for (int n = 0; n < 2; ++n) _Pragma("unroll") for (int k = 0; k < 2; ++k) \
        acc[ai][bj][m][n] = __builtin_amdgcn_mfma_f32_16x16x32_bf16(Bt[n][k], At[m][k], acc[ai][bj][m][n], 0, 0, 0); __builtin_amdgcn_s_setprio(0); } while (0)
#define PG8_WAIT_V(n) asm volatile("s_waitcnt vmcnt(" #n ")" ::: "memory")
#define PG8_WAIT_L(n) asm volatile("s_waitcnt lgkmcnt(" #n ")" ::: "memory")
#define PG8_BAR __builtin_amdgcn_s_barrier()
#define PG8_SCHED __builtin_amdgcn_sched_barrier(0)
    Unit cur, nxt; int ui = 0;
    if (!S.next(0, cur)) return;
    f32x4 acc[2][2][4][2];
#pragma unroll
    for (int a = 0; a < 2; ++a)
#pragma unroll
        for (int b = 0; b < 2; ++b)
#pragma unroll
            for (int m = 0; m < 4; ++m)
#pragma unroll
                for (int n = 0; n < 2; ++n) acc[a][b][m][n] = (f32x4){0.f, 0.f, 0.f, 0.f};
    bf16x8 At[4][2], B0[2][2], B1[2][2];
    const char* cA = (const char*)(g.A + (size_t)cur.kk * g.a_kk) + (size_t)cur.pm * tstepA + (size_t)cur.k0 * kstep; const char* cB = (const char*)(g.Bt + (size_t)cur.kk * g.b_kk) + (size_t)cur.pn * tstepB + (size_t)cur.k0 * kstep;
    PG8_STAGE(PG8_SB(0, 0), cB, voffB); PG8_STAGE(PG8_SA(0, 0), cA, voffA); PG8_STAGE(PG8_SB(0, 1), cB + hstepB, voffB); PG8_STAGE(PG8_SA(0, 1), cA + hstepA, voffA);
    if (wr == 1) PG8_BAR;
    PG8_WAIT_V(4); PG8_BAR;
    PG8_STAGE(PG8_SB(1, 0), cB + kstep, voffB); PG8_STAGE(PG8_SA(1, 0), cA + kstep, voffA); PG8_STAGE(PG8_SB(1, 1), cB + hstepB + kstep, voffB);
    PG8_WAIT_V(6); PG8_BAR;
    for (;;) {
        const bool has_next = S.next(ui + 1, nxt);
        const char* nA = has_next ? (const char*)(g.A + (size_t)nxt.kk * g.a_kk) + (size_t)nxt.pm * tstepA + (size_t)nxt.k0 * kstep : cA;
        const char* nB = has_next ? (const char*)(g.Bt + (size_t)nxt.kk * g.b_kk) + (size_t)nxt.pn * tstepB + (size_t)nxt.k0 * kstep : cB;
        int nt = cur.nt; asm volatile("" : "+s"(nt));
        for (int t = 0; t < nt; t += 2) {
            const bool last = (t == nt - 2);
            const char* a1 = cA + (size_t)(t + 1) * kstep;
            const char* a2 = last ? nA : cA + (size_t)(t + 2) * kstep; const char* b2 = last ? nB : cB + (size_t)(t + 2) * kstep;
            const char* a3 = a2 + kstep; const char* b3 = b2 + kstep;
            PG8_LDB(B0, 0, 0); PG8_SCHED; PG8_LDA(At, 0, 0); PG8_STAGE(PG8_SA(1, 1), a1 + hstepA, voffA);
            PG8_WAIT_L(8); PG8_BAR; PG8_WAIT_L(0); PG8_MMA(0, 0, At, B0); PG8_BAR; PG8_SCHED;
            PG8_LDB(B1, 0, 1); PG8_STAGE(PG8_SB(0, 0), b2, voffB);
            PG8_BAR; PG8_WAIT_L(0); PG8_MMA(0, 1, At, B1); PG8_BAR;
            PG8_LDA(At, 0, 1); PG8_STAGE(PG8_SA(0, 0), a2, voffA);
            PG8_BAR; PG8_WAIT_L(0); PG8_MMA(1, 0, At, B0); PG8_BAR; PG8_SCHED;
            PG8_STAGE(PG8_SB(0, 1), b2 + hstepB, voffB);
            PG8_WAIT_V(6); PG8_BAR; PG8_MMA(1, 1, At, B1); PG8_BAR;
            PG8_LDB(B0, 1, 0); PG8_SCHED; PG8_LDA(At, 1, 0); PG8_STAGE(PG8_SA(0, 1), a2 + hstepA, voffA);
            PG8_WAIT_L(8); PG8_BAR; PG8_WAIT_L(0); PG8_MMA(0, 0, At, B0); PG8_BAR; PG8_SCHED;
            PG8_LDB(B1, 1, 1); PG8_STAGE(PG8_SB(1, 0), b3, voffB);
            PG8_BAR; PG8_WAIT_L(0); PG8_MMA(0, 1, At, B1); PG8_BAR;
            PG8_LDA(At, 1, 1); PG8_STAGE(PG8_SA(1, 0), a3, voffA);
            PG8_BAR; PG8_WAIT_L(0); PG8_MMA(1, 0, At, B0); PG8_BAR; PG8_SCHED;
            PG8_STAGE(PG8_SB(1, 1), b3 + hstepB, voffB);
            PG8_WAIT_V(6); PG8_BAR; PG8_MMA(1, 1, At, B1); PG8_BAR;
        }
        E(acc, cur, wr, wc, fr, fq);
        if (!has_next) break;
#pragma unroll
        for (int a = 0; a < 2; ++a)
#pragma unroll
            for (int b = 0; b < 2; ++b)
#pragma unroll
                for (int m = 0; m < 4; ++m)
#pragma unroll
                    for (int n = 0; n < 2; ++n) acc[a][b][m][n] = (f32x4){0.f, 0.f, 0.f, 0.f};
        cur = nxt; cA = nA; cB = nB; ++ui;
    }
    PG8_WAIT_V(0);
    if (wr == 0) PG8_BAR;
    PG8_BAR;
    __builtin_amdgcn_s_waitcnt(0);
#undef PG8_SA
#undef PG8_SB
#undef PG8_STAGE
#undef PG8_LDA
#undef PG8_LDB
#undef PG8_MMA
#undef PG8_WAIT_V
#undef PG8_WAIT_L
#undef PG8_BAR
#undef PG8_SCHED
}
}
using pg8::Unit;

#define EPI_LOOP_BEGIN _Pragma("unroll") for (int ai = 0; ai < 2; ++ai) _Pragma("unroll") for (int m = 0; m < 4; ++m) { const size_t row = (size_t)(u.pm * 256 + ai * 128 + wr * 64 + m * 16 + fr); \
        _Pragma("unroll") for (int bj = 0; bj < 2; ++bj) {
#define EPI_LOOP_END } }
struct EpiIn {
    bf16_t* pm; bf16_t* gates;
    __device__ __forceinline__ void operator()(const f32x4 (&acc)[2][2][4][2], const Unit& u, int wr, int wc, int fr, int fq) const {
        const bool main_ = u.pn < 14;
        EPI_LOOP_BEGIN
#pragma unroll
            for (int n = 0; n < 2; ++n) { const int col = u.pn * 256 + bj * 128 + wc * 32 + n * 16 + fq * 4; f32x4 v = acc[ai][bj][m][n]; u32x2 w;
                if (main_) { w.x = cvt_pk_bf16(v[0], v[1]); w.y = cvt_pk_bf16(v[2], v[3]); *(u32x2*)(pm + row * NPM + col) = w; }
                else { w.x = cvt_pk_bf16(sigmoidf_(v[0]), sigmoidf_(v[1])); w.y = cvt_pk_bf16(sigmoidf_(v[2]), sigmoidf_(v[3])); *(u32x2*)(gates + row * NGATE + (col - NPM)) = w; } }
        EPI_LOOP_END
    }
};
struct EpiGlu {
    bf16_t* br;
    __device__ __forceinline__ void operator()(const f32x4 (&acc)[2][2][4][2], const Unit& u, int wr, int wc, int fr, int fq) const {
        EPI_LOOP_BEGIN
            const int j = u.pn * 128 + bj * 64 + wc * 16 + fq * 4; const f32x4 a = acc[ai][bj][m][0], b = acc[ai][bj][m][1]; u32x2 w;
            w.x = cvt_pk_bf16(a[0] * sigmoidf_(b[0]), a[1] * sigmoidf_(b[1])); w.y = cvt_pk_bf16(a[2] * sigmoidf_(b[2]), a[3] * sigmoidf_(b[3]));
            *(u32x2*)(br + row * 1024 + 512 + j) = w;
        EPI_LOOP_END
    }
};
struct EpiGU {
    bf16_t* a;
    __device__ __forceinline__ void operator()(const f32x4 (&acc)[2][2][4][2], const Unit& u, int wr, int wc, int fr, int fq) const {
        EPI_LOOP_BEGIN
            const int j = u.pn * 128 + bj * 64 + wc * 16 + fq * 4; const f32x4 g = acc[ai][bj][m][0], b = acc[ai][bj][m][1]; u32x2 w;
            w.x = cvt_pk_bf16(siluf_(g[0]) * b[0], siluf_(g[1]) * b[1]); w.y = cvt_pk_bf16(siluf_(g[2]) * b[2], siluf_(g[3]) * b[3]);
            *(u32x2*)(a + row * DFF + j) = w;
        EPI_LOOP_END
    }
};
struct EpiBr {
    const bf16_t* gates; bf16_t* mm;
    __device__ __forceinline__ void operator()(const f32x4 (&acc)[2][2][4][2], const Unit& u, int wr, int wc, int fr, int fq) const {
        const int col0 = u.pn * 256 + wc * 32 + fq * 4;
#pragma unroll
        for (int ai = 0; ai < 2; ++ai) {
            if (ai == 1 && u.pm == 64) break;
            const size_t row0 = (size_t)(u.pm * 256 + ai * 128 + wr * 64 + fr);
            u32x2 gw[4][2][2], pw[4][2][2];
#pragma unroll
            for (int m = 0; m < 4; ++m)
#pragma unroll
                for (int bj = 0; bj < 2; ++bj)
#pragma unroll
                    for (int n = 0; n < 2; ++n) { const size_t row = row0 + m * 16; const int col = col0 + bj * 128 + n * 16;
                        gw[m][bj][n] = *(const u32x2*)(gates + row * NGATE + u.kk * 1024 + col);
                        pw[m][bj][n] = (u32x2){0u, 0u}; if (u.kk > 0) pw[m][bj][n] = *(const u32x2*)(mm + row * 1024 + col); }
#pragma unroll
            for (int m = 0; m < 4; ++m)
#pragma unroll
                for (int bj = 0; bj < 2; ++bj)
#pragma unroll
                    for (int n = 0; n < 2; ++n) { const size_t row = row0 + m * 16; const int col = col0 + bj * 128 + n * 16; const f32x4 v = acc[ai][bj][m][n]; const u32x2 g = gw[m][bj][n], q = pw[m][bj][n];
                        u32x2 w; w.x = cvt_pk_bf16(lo_bf(g.x) * v[0] + lo_bf(q.x), hi_bf(g.x) * v[1] + hi_bf(q.x)); w.y = cvt_pk_bf16(lo_bf(g.y) * v[2] + lo_bf(q.y), hi_bf(g.y) * v[3] + hi_bf(q.y));
                        *(u32x2*)(mm + row * 1024 + col) = w; }
        }
    }
};
struct EpiRes {
    float* h;
    __device__ __forceinline__ void operator()(const f32x4 (&acc)[2][2][4][2], const Unit& u, int wr, int wc, int fr, int fq) const {
        const bool split = u.pm == 64;
        EPI_LOOP_BEGIN
#pragma unroll
            for (int n = 0; n < 2; ++n) { const int col = u.pn * 256 + bj * 128 + wc * 32 + n * 16 + fq * 4; float* ptr = h + row * 1024 + col;
                if (split) {
#pragma unroll
                    for (int e = 0; e < 4; ++e) __hip_atomic_fetch_add(ptr + e, acc[ai][bj][m][n][e], __ATOMIC_RELAXED, __HIP_MEMORY_SCOPE_AGENT);
                } else { const f32x4 o = *(const f32x4*)ptr; *(f32x4*)ptr = o + acc[ai][bj][m][n]; } }
        EPI_LOOP_END
    }
};

__device__ __forceinline__ int win_src_col(int n) {
    if (n < 768) return n;
    if (n < 1024) return 776 + (n - 768);
    if (n < 1792) return 1032 + (n - 1024);
    if (n < 2048) return 1816 + (n - 1792);
    if (n < 2304) return 2072 + (n - 2048);
    if (n < 3072) return 2328 + (n - 2304);
    if (n < 3328) return 3096 + (n - 3072);
    if (n < 3336) return 768 + (n - 3328);
    if (n < 3352) return 1800 + (n - 3336);
    if (n < 3584) return -1;
    return 3352 + (n - 3584);
}
__device__ __forceinline__ void phase_convert(KPR p, int layer, LAS float* tile, int bid, int G) {
    const int tid = otid(), tn = tid & 63, tk = __builtin_amdgcn_readfirstlane(tid >> 6);
    constexpr int T0 = 120 * 16, T1 = T0 + 88 * 16, T2 = T1 + 16 * 44, T3 = T2 + 16 * 16, T4 = T3 + 64 * 4, T5 = T4 + 8 * 4;
    for (int j = bid; j < T5; j += G) {
        int n0, k0, K, ld; bf16_t* dst; const float* cp = nullptr;
        if (j < T0) { const int q = j; n0 = (q >> 4) * 64; k0 = (q & 15) * 64; K = 1024; ld = NIN; dst = (bf16_t*)(p.ws + OFF_WIN);
            const int sc = win_src_col(n0 + tn); if (sc >= 0) cp = p.in[9] + (size_t)layer * 1024 * NIN + sc; }
        else if (j < T1) { const int q = j - T0; n0 = (q >> 4) * 64; k0 = (q & 15) * 64; K = 1024; ld = DFF; dst = (bf16_t*)(p.ws + OFF_WGU);
            const int n = n0 + tn, g32 = n >> 5, w = n & 31, jj = g32 * 16 + (w & 15); cp = (w < 16 ? p.in[31] : p.in[32]) + (size_t)layer * 1024 * DFF + jj; }
        else if (j < T2) { const int q = j - T1; n0 = (q / 44) * 64; k0 = (q % 44) * 64; K = DFF; ld = 1024; dst = (bf16_t*)(p.ws + OFF_WDN);
            cp = p.in[33] + (size_t)layer * DFF * 1024 + (n0 + tn); }
        else if (j < T3) { const int q = j - T2; n0 = (q >> 4) * 64; k0 = (q & 15) * 64; K = 1024; ld = 1024; dst = (bf16_t*)(p.ws + OFF_WOUT);
            cp = p.in[29] + (size_t)layer * 1024 * 1024 + (n0 + tn); }
        else if (j < T4) { const int q = j - T3; n0 = (q >> 2) * 64; k0 = (q & 3) * 64; K = 256; ld = 1024; dst = (bf16_t*)(p.ws + OFF_WBR);
            const int n = n0 + tn, kk = n >> 10, d = n & 1023; cp = p.in[28] + ((size_t)(layer * 4 + kk) * 256) * 1024 + d; }
        else { const int q = j - T4; n0 = (q >> 2) * 64; k0 = (q & 3) * 64; K = 256; ld = 512; dst = (bf16_t*)(p.ws + OFF_WGLU);
            const int n = n0 + tn, g32 = n >> 5, w = n & 31, jj = g32 * 16 + (w & 15); cp = p.in[25] + (size_t)layer * 256 * 512 + (w < 16 ? jj : 256 + jj); }
        __syncthreads();
#pragma unroll
        for (int e = 0; e < 8; ++e) { const int k = k0 + tk * 8 + e; tile[tn * 65 + tk * 8 + e] = cp ? cp[(size_t)k * ld] : 0.f; }
        __syncthreads();
        { const int n = tid >> 3, ks = tid & 7; const LAS float* tp = tile + n * 65 + ks * 8; u32x4 w;
          w.x = cvt_pk_bf16(tp[0], tp[1]); w.y = cvt_pk_bf16(tp[2], tp[3]); w.z = cvt_pk_bf16(tp[4], tp[5]); w.w = cvt_pk_bf16(tp[6], tp[7]);
          *(u32x4*)(dst + (size_t)(n0 + n) * K + k0 + ks * 8) = w; }
    }
    __syncthreads();
}

__device__ __forceinline__ void phase_norm(KPR p, const float* w, int mode, int bid, int G) {
    const int tid_ = otid(); const int wid = __builtin_amdgcn_readfirstlane(tid_ >> 6), lane = tid_ & 63;
    float* h = (float*)(p.ws + OFF_H); bf16_t* xn = (bf16_t*)(p.ws + OFF_XN);
    f32x4 wv[4];
#pragma unroll
    for (int i = 0; i < 4; ++i) wv[i] = *(const f32x4*)(w + i * 256 + lane * 4);
    for (int r = bid * 8 + wid; r < MTOK; r += G * 8) {
        const float* src = (mode == 0) ? (r < MPROMPT ? p.in[0] + (size_t)r * 1024 : p.in[1] + (size_t)(r - MPROMPT) * 1024) : h + (size_t)r * 1024;
        f32x4 v[4]; float ss = 0.f;
#pragma unroll
        for (int i = 0; i < 4; ++i) { v[i] = *(const f32x4*)(src + i * 256 + lane * 4); ss += v[i][0] * v[i][0] + v[i][1] * v[i][1] + v[i][2] * v[i][2] + v[i][3] * v[i][3]; }
        ss = wave_sum(ss);
        const float rs = rsqrtf(ss * (1.0f / 1024.0f) + EPS);
#pragma unroll
        for (int i = 0; i < 4; ++i) {
            const f32x4 y = v[i] * rs * wv[i];
            if (mode == 2) *(f32x4*)(p.out + (size_t)r * 1024 + i * 256 + lane * 4) = y;
            else { u32x2 o; o.x = cvt_pk_bf16(y[0], y[1]); o.y = cvt_pk_bf16(y[2], y[3]); *(u32x2*)(xn + (size_t)r * 1024 + i * 256 + lane * 4) = o;
                   if (mode == 0) *(f32x4*)(h + (size_t)r * 1024 + i * 256 + lane * 4) = v[i]; }
        }
    }
}

constexpr int TCH = 32;
constexpr int MIXBUF_FLOATS = 4 * TCH * 64 + TCH * 4;
template <int MIX>
__device__ __forceinline__ void mix_item(KPR p, int layer, LAS float* lds, int tokbase, int L, int h, int col0, int ncols,
                         const float* s_in, float* s_out, const float* conv_in, float* conv_out) {
    const int tid = otid(), wid = __builtin_amdgcn_readfirstlane(tid >> 6), lane = tid & 63;
    const int nscan = ncols * 8; const bool is_scan = wid < (nscan >> 6);
    const int ksl = lane & 7, cl = wid * 8 + (lane >> 3), col = col0 + cl;
    const bf16_t* pm = (const bf16_t*)(p.ws + OFF_PM);
    bf16_t* oraw = (bf16_t*)(p.ws + OFF_ORAW);
    __syncthreads();
    f32x2 S2[4];
#pragma unroll
    for (int i = 0; i < 4; ++i) { S2[i].x = (is_scan && s_in) ? s_in[(ksl * 8 + 2 * i) * 64 + col] : 0.f; S2[i].y = (is_scan && s_in) ? s_in[(ksl * 8 + 2 * i + 1) * 64 + col] : 0.f; }
    const int tl = lane >> 4, d4 = (lane & 15) * 4, hd4 = h * 64 + d4;
    f32x4 cw[3][4]; float c_a = 0.f, c_dt = 0.f; f32x4 gkw[16]; f32x4 gkb = (f32x4){0.f, 0.f, 0.f, 0.f}, lb4 = (f32x4){0.f, 0.f, 0.f, 0.f};
    if (MIX == 0) {
        const float* cwp = p.in[10] + (size_t)layer * 4 * 768;
#pragma unroll
        for (int s = 0; s < 3; ++s)
#pragma unroll
            for (int j = 0; j < 4; ++j) cw[s][j] = *(const f32x4*)(cwp + j * 768 + s * 256 + hd4);
        c_a = -__expf(p.in[11][layer * 4 + h]); c_dt = p.in[12][layer * 4 + h];
        if (conv_out && col0 == 0 && h == 0) {
            for (int idx = tid; idx < 3 * 768; idx += 512) { const int i = idx / 768, c = idx - i * 768, ti = L - 3 + i;
                conv_out[idx] = ti >= 0 ? bf2f(pm[(size_t)(tokbase + ti) * NPM + A_QKV + c]) : (conv_in ? conv_in[(3 + ti) * 768 + c] : 0.f); }
        }
    } else if (MIX == 1) {
#pragma unroll
        for (int r = 0; r < 16; ++r) gkw[r] = *(const f32x4*)(p.in[14] + ((size_t)layer * 16 + r) * 256 + hd4);
        gkb = *(const f32x4*)(p.in[15] + layer * 256 + hd4);
    } else {
        const float* lg = p.in[26] + hd4; const f32x4 a0 = *(const f32x4*)lg, a1 = *(const f32x4*)(lg + 256), a2 = *(const f32x4*)(lg + 512), a3 = *(const f32x4*)(lg + 768);
#pragma unroll
        for (int e = 0; e < 4; ++e) {
            const float mx = fmaxf(fmaxf(a0[e], a1[e]), fmaxf(a2[e], a3[e])); const float l0 = __expf(a0[e] - mx), l1 = __expf(a1[e] - mx), l2 = __expf(a2[e] - mx), l3 = __expf(a3[e] - mx);
            const float inv = 1.0f / (l0 + l1 + l2 + l3);
            lb4[e] = (layer == 0) ? 0.f : (layer == 1) ? l1 * inv : (layer == 2) ? (l1 + l2) * inv : (l1 + l2 + l3) * inv;
        }
    }
    const int nch = (L + TCH - 1) / TCH;
    auto prep = [&](int c, int pw, int npw) {
        LAS float* kb = lds + (c & 1) * MIXBUF_FLOATS; LAS float* qb = kb + TCH * 64; LAS float* fb = qb + TCH * 64; LAS float* vb = fb + TCH * 64; LAS float* sc = vb + TCH * 64;
#pragma unroll
        for (int pass = 0; pass < 2; ++pass) {
            const int tt0 = (pass * npw + pw) * 4;
            if (tt0 < TCH) {
                const int tt = tt0 + tl, t = c * TCH + tt;
                if (t < L) {
                    const bf16_t* row = pm + (size_t)(tokbase + t) * NPM;
                    if (MIX == 0) {
                        f32x4 y[3];
#pragma unroll
                        for (int s = 0; s < 3; ++s) { f32x4 a = (f32x4){0.f, 0.f, 0.f, 0.f};
#pragma unroll
                            for (int j = 0; j < 4; ++j) { const int ti = t - 3 + j; f32x4 xv = (f32x4){0.f, 0.f, 0.f, 0.f};
                                if (ti >= 0) { const u32x2 w = *(const u32x2*)(pm + (size_t)(tokbase + ti) * NPM + A_QKV + s * 256 + hd4); xv = (f32x4){lo_bf(w.x), hi_bf(w.x), lo_bf(w.y), hi_bf(w.y)}; }
                                else if (conv_in) xv = *(const f32x4*)(conv_in + (3 + ti) * 768 + s * 256 + hd4);
                                a += xv * cw[s][j]; }
                            y[s] = (f32x4){siluf_(a[0]), siluf_(a[1]), siluf_(a[2]), siluf_(a[3])}; }
                        const float qq = red16(y[0][0] * y[0][0] + y[0][1] * y[0][1] + y[0][2] * y[0][2] + y[0][3] * y[0][3]);
                        const float kk2 = red16(y[1][0] * y[1][0] + y[1][1] * y[1][1] + y[1][2] * y[1][2] + y[1][3] * y[1][3]);
                        const f32x4 qn = y[0] * (rsqrtf(qq + EPS) * 0.125f), kn = y[1] * rsqrtf(kk2 + EPS);
                        const float kq = red16(qn[0] * kn[0] + qn[1] * kn[1] + qn[2] * kn[2] + qn[3] * kn[3]);
                        *(LAS f32x4*)(kb + tt * 64 + d4) = kn; *(LAS f32x4*)(qb + tt * 64 + d4) = qn; *(LAS f32x4*)(vb + tt * 64 + d4) = y[2];
                        if ((lane & 15) == 0) { const float al = bf2f(row[A_ALPHA + h]) + c_dt; const float sp = fmaxf(al, 0.f) + __logf(1.0f + __expf(-fabsf(al)));
                            *(LAS f32x4*)(sc + tt * 4) = (f32x4){__expf(c_a * sp), sigmoidf_(bf2f(row[A_BETA + h])), kq, 0.f}; }
                    } else if (MIX == 1) {
                        const u32x4 g0 = *(const u32x4*)(row + B_GK), g1 = *(const u32x4*)(row + B_GK + 8);
                        const u32x2 wq = *(const u32x2*)(row + B_Q + hd4), wk = *(const u32x2*)(row + B_K + hd4), wv = *(const u32x2*)(row + B_V + hd4);
                        f32x4 z = gkb;
                        z += lo_bf(g0.x) * gkw[0] + hi_bf(g0.x) * gkw[1] + lo_bf(g0.y) * gkw[2] + hi_bf(g0.y) * gkw[3] + lo_bf(g0.z) * gkw[4] + hi_bf(g0.z) * gkw[5] + lo_bf(g0.w) * gkw[6] + hi_bf(g0.w) * gkw[7];
                        z += lo_bf(g1.x) * gkw[8] + hi_bf(g1.x) * gkw[9] + lo_bf(g1.y) * gkw[10] + hi_bf(g1.y) * gkw[11] + lo_bf(g1.z) * gkw[12] + hi_bf(g1.z) * gkw[13] + lo_bf(g1.w) * gkw[14] + hi_bf(g1.w) * gkw[15];
                        f32x4 f;
#pragma unroll
                        for (int e = 0; e < 4; ++e) { const float sp = fmaxf(-z[e], 0.f) + __logf(1.0f + __expf(-fabsf(z[e]))); f[e] = __expf(-sp * (1.0f / 16.0f)); }
                        *(LAS f32x4*)(fb + tt * 64 + d4) = f;
                        *(LAS f32x4*)(qb + tt * 64 + d4) = (f32x4){lo_bf(wq.x), hi_bf(wq.x), lo_bf(wq.y), hi_bf(wq.y)} * 0.125f;
                        *(LAS f32x4*)(kb + tt * 64 + d4) = (f32x4){lo_bf(wk.x), hi_bf(wk.x), lo_bf(wk.y), hi_bf(wk.y)};
                        *(LAS f32x4*)(vb + tt * 64 + d4) = (f32x4){lo_bf(wv.x), hi_bf(wv.x), lo_bf(wv.y), hi_bf(wv.y)};
                    } else {
                        const u32x2 wq = *(const u32x2*)(row + D_Q + hd4), wf = *(const u32x2*)(row + D_F + hd4), wv = *(const u32x2*)(row + D_I + hd4);
                        const f32x4 xq = (f32x4){lo_bf(wq.x), hi_bf(wq.x), lo_bf(wq.y), hi_bf(wq.y)}, xf = (f32x4){lo_bf(wf.x), hi_bf(wf.x), lo_bf(wf.y), hi_bf(wf.y)};
                        f32x4 f, k, q;
#pragma unroll
                        for (int e = 0; e < 4; ++e) { const float sg = sigmoidf_(xf[e]); f[e] = lb4[e] + (1.0f - lb4[e]) * sg; k[e] = (1.0f - lb4[e]) * (1.0f - sg); q[e] = siluf_(xq[e]) * 0.125f; }
                        *(LAS f32x4*)(fb + tt * 64 + d4) = f; *(LAS f32x4*)(kb + tt * 64 + d4) = k; *(LAS f32x4*)(qb + tt * 64 + d4) = q;
                        *(LAS f32x4*)(vb + tt * 64 + d4) = (f32x4){lo_bf(wv.x), hi_bf(wv.x), lo_bf(wv.y), hi_bf(wv.y)};
                    }
                }
            }
        }
    };
    prep(0, wid, 8);
    __syncthreads();
    for (int c = 0; c < nch; ++c) {
        if (is_scan) {
            const LAS float* kb = lds + (c & 1) * MIXBUF_FLOATS; const LAS float* qb = kb + TCH * 64; const LAS float* fb = qb + TCH * 64; const LAS float* vb = fb + TCH * 64; const LAS float* sc = vb + TCH * 64;
            const int ntok = (L - c * TCH) < TCH ? (L - c * TCH) : TCH;
            bf16_t* op = oraw + (size_t)(tokbase + c * TCH) * 768 + MIX * 256 + h * 64 + col;
            const LAS float* kp = kb + ksl * 8; const LAS float* qp = qb + ksl * 8; const LAS float* fp = fb + ksl * 8; const LAS float* vp = vb + col;
            f32x4 k0 = *(const LAS f32x4*)kp, k1 = *(const LAS f32x4*)(kp + 4), q0 = *(const LAS f32x4*)qp, q1 = *(const LAS f32x4*)(qp + 4);
            f32x4 f0 = (f32x4){0.f, 0.f, 0.f, 0.f}, f1 = f0, scv = f0;
            if (MIX == 0) scv = *(const LAS f32x4*)sc; else { f0 = *(const LAS f32x4*)fp; f1 = *(const LAS f32x4*)(fp + 4); }
            float v = vp[0];
            __builtin_amdgcn_s_setprio(3);
#pragma unroll 2
            for (int tt = 0; tt < ntok; ++tt) {
                const int tn = (tt + 1 < TCH) ? tt + 1 : tt;
                const f32x4 nk0 = *(const LAS f32x4*)(kp + tn * 64), nk1 = *(const LAS f32x4*)(kp + tn * 64 + 4), nq0 = *(const LAS f32x4*)(qp + tn * 64), nq1 = *(const LAS f32x4*)(qp + tn * 64 + 4);
                f32x4 nf0 = f0, nf1 = f1, nsc = scv;
                if (MIX == 0) nsc = *(const LAS f32x4*)(sc + tn * 4); else { nf0 = *(const LAS f32x4*)(fp + tn * 64); nf1 = *(const LAS f32x4*)(fp + tn * 64 + 4); }
                const float nv = vp[tn * 64];
                float o;
                if (MIX == 0) {
                    const float eg = scv[0], beta = scv[1], kq = scv[2];
                    const f32x2 ka = {k0[0], k0[1]}, kb2 = {k0[2], k0[3]}, kc = {k1[0], k1[1]}, kd = {k1[2], k1[3]};
                    const f32x2 qa = {q0[0], q0[1]}, qb2 = {q0[2], q0[3]}, qc = {q1[0], q1[1]}, qd = {q1[2], q1[3]};
                    f32x2 dk2 = S2[0] * ka; dk2 = S2[1] * kb2 + dk2; dk2 = S2[2] * kc + dk2; dk2 = S2[3] * kd + dk2;
                    f32x2 dq2 = S2[0] * qa; dq2 = S2[1] * qb2 + dq2; dq2 = S2[2] * qc + dq2; dq2 = S2[3] * qd + dq2;
                    const float dk = red8(dk2.x + dk2.y), dq = red8(dq2.x + dq2.y);
                    const float delta = beta * (v - eg * dk);
                    const f32x2 eg2 = {eg, eg}, de2 = {delta, delta};
                    S2[0] = ka * de2 + S2[0] * eg2; S2[1] = kb2 * de2 + S2[1] * eg2; S2[2] = kc * de2 + S2[2] * eg2; S2[3] = kd * de2 + S2[3] * eg2;
                    o = eg * dq + kq * delta;
                } else {
#pragma unroll
                    for (int i = 0; i < 1; ++i) {}
                    const f32x2 v2 = {v, v};
                    S2[0] = (f32x2){k0[0], k0[1]} * v2 + (f32x2){f0[0], f0[1]} * S2[0]; S2[1] = (f32x2){k0[2], k0[3]} * v2 + (f32x2){f0[2], f0[3]} * S2[1];
                    S2[2] = (f32x2){k1[0], k1[1]} * v2 + (f32x2){f1[0], f1[1]} * S2[2]; S2[3] = (f32x2){k1[2], k1[3]} * v2 + (f32x2){f1[2], f1[3]} * S2[3];
                    f32x2 dq2 = S2[0] * (f32x2){q0[0], q0[1]}; dq2 = S2[1] * (f32x2){q0[2], q0[3]} + dq2; dq2 = S2[2] * (f32x2){q1[0], q1[1]} + dq2; dq2 = S2[3] * (f32x2){q1[2], q1[3]} + dq2;
                    o = red8(dq2.x + dq2.y);
                }
                if (ksl == 0) op[(size_t)tt * 768] = f2bf(o);
                k0 = nk0; k1 = nk1; q0 = nq0; q1 = nq1; f0 = nf0; f1 = nf1; scv = nsc; v = nv;
            }
            __builtin_amdgcn_s_setprio(0);
        } else if (c + 1 < nch) prep(c + 1, wid - (nscan >> 6), 8 - (nscan >> 6));
        __syncthreads();
    }
    if (is_scan) {
#pragma unroll
        for (int i = 0; i < 4; ++i) { s_out[(ksl * 8 + 2 * i) * 64 + col] = S2[i].x; s_out[(ksl * 8 + 2 * i + 1) * 64 + col] = S2[i].y; }
    }
}

constexpr int S5_BU_LD = 132, S5_XB_LD = 136, S5_WAVE_BYTES = 16 * S5_BU_LD * 4 + 16 * S5_XB_LD * 2;
template <bool SAMPLE>
__device__ __forceinline__ void s5_wave_item(KPR p, int layer, LAS unsigned char* wl, int g, int tokbase, int L, int seq0) {
    const int lane = otid() & 63, col = lane & 15, quad = lane >> 4;
    const bf16_t* pm = (const bf16_t*)(p.ws + OFF_PM); bf16_t* yg = (bf16_t*)(p.ws + OFF_YG);
    LAS float* bu = (LAS float*)wl; LAS bf16_t* xb = (LAS bf16_t*)(wl + 16 * S5_BU_LD * 4);
    const int lg = layer * 16 + g;
    float ar, ai, zr, zi;
    { const float lr = fminf(p.in[17][lg * 64 + lane], -1e-4f), li = p.in[18][lg * 64 + lane], dt = __expf(p.in[24][lg]);
      const float mag = __expf(lr * dt); float rev = li * dt * 0.15915494309f; rev -= rintf(rev);
      const float sn = __builtin_amdgcn_sinf(rev), cs = __builtin_amdgcn_cosf(rev); ar = mag * cs; ai = mag * sn;
      const float den = lr * lr + li * li; zr = ((ar - 1.0f) * lr + ai * li) / den; zi = (ai * lr - (ar - 1.0f) * li) / den; }
    bf16x8 Bf[8], Cf[4];
#pragma unroll
    for (int tt = 0; tt < 4; ++tt) {
        const int pp = tt * 16 + col; const float zr2 = __shfl(zr, pp), zi2 = __shfl(zi, pp);
        float bre[8], bim[8];
#pragma unroll
        for (int j = 0; j < 8; ++j) { bre[j] = 0.f; bim[j] = 0.f; }
        if (quad < 2) {
            const float* br_ = p.in[19] + ((size_t)lg * 64 + pp) * 16 + quad * 8; const float* bi_ = p.in[20] + ((size_t)lg * 64 + pp) * 16 + quad * 8;
#pragma unroll
            for (int j = 0; j < 8; ++j) { const float r = br_[j], i = bi_[j]; bre[j] = zr2 * r - zi2 * i; bim[j] = zr2 * i + zi2 * r; }
        }
        u32x4 wr_, wi_;
        wr_.x = cvt_pk_bf16(bre[0], bre[1]); wr_.y = cvt_pk_bf16(bre[2], bre[3]); wr_.z = cvt_pk_bf16(bre[4], bre[5]); wr_.w = cvt_pk_bf16(bre[6], bre[7]);
        wi_.x = cvt_pk_bf16(bim[0], bim[1]); wi_.y = cvt_pk_bf16(bim[2], bim[3]); wi_.z = cvt_pk_bf16(bim[4], bim[5]); wi_.w = cvt_pk_bf16(bim[6], bim[7]);
        Bf[tt] = __builtin_bit_cast(bf16x8, wr_); Bf[4 + tt] = __builtin_bit_cast(bf16x8, wi_);
    }
#pragma unroll
    for (int kb = 0; kb < 4; ++kb) {
        const int k0 = (kb & 1) * 32 + quad * 8; const float sgn = kb < 2 ? 1.0f : -1.0f;
        const float* cp = (kb < 2 ? p.in[21] : p.in[22]) + ((size_t)lg * 16 + col) * 64 + k0;
        u32x4 w; w.x = cvt_pk_bf16(sgn * cp[0], sgn * cp[1]); w.y = cvt_pk_bf16(sgn * cp[2], sgn * cp[3]); w.z = cvt_pk_bf16(sgn * cp[4], sgn * cp[5]); w.w = cvt_pk_bf16(sgn * cp[6], sgn * cp[7]);
        Cf[kb] = __builtin_bit_cast(bf16x8, w);
    }
    const float dcoef = p.in[23][layer * 256 + g * 16 + col];
    float xr = 0.f, xi = 0.f;
    const int nch = SAMPLE ? 1 : (L + 15) / 16;
    u32x4 awn = (u32x4){0u, 0u, 0u, 0u}; bf16_t un[4] = {0, 0, 0, 0};
    auto pf = [&](int cc) {
        const int t0 = cc * 16; const int nrow = SAMPLE ? 16 : ((L - t0) < 16 ? (L - t0) : 16);
        awn = (u32x4){0u, 0u, 0u, 0u};
        if (quad < 2 && col < nrow) awn = *(const u32x4*)(pm + (size_t)(tokbase + t0 + col) * NPM + C_U + g * 16 + quad * 8);
#pragma unroll
        for (int i = 0; i < 4; ++i) { const int r = quad * 4 + i; un[i] = (r < nrow) ? pm[(size_t)(tokbase + t0 + r) * NPM + C_U + g * 16 + col] : (bf16_t)0; }
    };
    pf(0);
    for (int c = 0; c < nch; ++c) {
        const int t0 = c * 16; const int nrow = SAMPLE ? 16 : ((L - t0) < 16 ? (L - t0) : 16);
        const u32x4 aw = awn; bf16_t uc[4];
#pragma unroll
        for (int i = 0; i < 4; ++i) uc[i] = un[i];
        if (c + 1 < nch) pf(c + 1);
        const bf16x8 af = __builtin_bit_cast(bf16x8, aw);
#pragma unroll
        for (int tile = 0; tile < 8; ++tile) {
            const f32x4 d = __builtin_amdgcn_mfma_f32_16x16x32_bf16(af, Bf[tile], (f32x4){0.f, 0.f, 0.f, 0.f}, 0, 0, 0);
#pragma unroll
            for (int i = 0; i < 4; ++i) bu[(quad * 4 + i) * S5_BU_LD + tile * 16 + col] = d[i];
        }
        __builtin_amdgcn_fence(__ATOMIC_RELEASE, "wavefront"); __builtin_amdgcn_wave_barrier(); __builtin_amdgcn_fence(__ATOMIC_ACQUIRE, "wavefront");
        for (int r = 0; r < 16; ++r) {
            float nr = 0.f, ni = 0.f;
            if (r < nrow) {
                if (SAMPLE) { const size_t si = ((size_t)(layer * NDEC + seq0 + r) * 16 + g) * 64 + lane; xr = p.in[5][si]; xi = p.in[6][si]; }
                const float br_ = bu[r * S5_BU_LD + lane], bi_ = bu[r * S5_BU_LD + 64 + lane];
                nr = ar * xr - ai * xi + br_; ni = ar * xi + ai * xr + bi_; xr = nr; xi = ni;
                if (SAMPLE) { const size_t so = ((size_t)(layer * NDEC + seq0 + r) * 16 + g) * 64 + lane; p.out[O_SS5R + so] = nr; p.out[O_SS5I + so] = ni; }
            }
            xb[r * S5_XB_LD + lane] = f2bf(nr); xb[r * S5_XB_LD + 64 + lane] = f2bf(ni);
        }
        __builtin_amdgcn_fence(__ATOMIC_RELEASE, "wavefront"); __builtin_amdgcn_wave_barrier(); __builtin_amdgcn_fence(__ATOMIC_ACQUIRE, "wavefront");
        f32x4 ya = (f32x4){0.f, 0.f, 0.f, 0.f};
#pragma unroll
        for (int kb = 0; kb < 4; ++kb) { const bf16x8 xf = *(const LAS bf16x8*)(xb + col * S5_XB_LD + kb * 32 + quad * 8); ya = __builtin_amdgcn_mfma_f32_16x16x32_bf16(xf, Cf[kb], ya, 0, 0, 0); }
#pragma unroll
        for (int i = 0; i < 4; ++i) { const int r = quad * 4 + i;
            if (r < nrow) { const size_t tok = (size_t)(tokbase + t0 + r); const float uu = bf2f(uc[i]);
                const float y = ya[i] + dcoef * uu; const float ge = y * __builtin_amdgcn_rcpf(1.0f + __expf(-1.5957691216f * (y + 0.044715f * y * y * y)));
                yg[tok * 256 + g * 16 + col] = f2bf(ge); } }
        __builtin_amdgcn_fence(__ATOMIC_RELEASE, "wavefront"); __builtin_amdgcn_wave_barrier(); __builtin_amdgcn_fence(__ATOMIC_ACQUIRE, "wavefront");
    }
    if (!SAMPLE) { const size_t so = ((size_t)(layer * NBATCH + seq0) * 16 + g) * 64 + lane; p.out[O_PS5R + so] = xr; p.out[O_PS5I + so] = xi; }
}

__device__ __forceinline__ void phase_mix(KPR p, int layer, LAS unsigned char* ldsb, int bid, int G) {
    LAS float* lds = (LAS float*)ldsb;
    const int wid = __builtin_amdgcn_readfirstlane(otid() >> 6);
    constexpr int NLONG = 208, NSHORT = 16 + 1536;
    for (int it = bid; it < NLONG; it += G) {
        if (it < 192) {
            const int mix = it >> 6, r = it & 63, b = r >> 3, hh = (r >> 1) & 3, half = r & 1;
            const size_t so = ((size_t)(layer * NBATCH + b) * 4 + hh) * 4096;
            if (mix == 0) mix_item<0>(p, layer, lds, b * SEQ, SEQ, hh, half * 32, 32, nullptr, p.out + O_PGDN + so, nullptr, p.out + O_PCONV + (size_t)(layer * NBATCH + b) * 2304);
            else if (mix == 1) mix_item<1>(p, layer, lds, b * SEQ, SEQ, hh, half * 32, 32, nullptr, p.out + O_PGLA + so, nullptr, nullptr);
            else mix_item<2>(p, layer, lds, b * SEQ, SEQ, hh, half * 32, 32, nullptr, p.out + O_PHG + so, nullptr, nullptr);
        } else {
            __syncthreads();
            const int j = (it - 192) * 8 + wid, b = j >> 4, g = j & 15;
            s5_wave_item<false>(p, layer, ldsb + wid * S5_WAVE_BYTES, g, b * SEQ, SEQ, b);
        }
    }
    int js = bid, jstep = G, jend = NSHORT;
    if (G >= 256) { if (bid >= 192) { js = bid - 192; jstep = 64; jend = 1040; } else if (bid >= 64) { js = 1040 + (bid - 64) * 4; jstep = 1; jend = js + 4; } else { js = 0; jend = 0; } }
    for (int j = js; j < jend; j += jstep) {
        if (j < 16) {
            __syncthreads();
            const int jj = j * 8 + wid, g = jj & 15, s0 = (jj >> 4) * 16;
            s5_wave_item<true>(p, layer, ldsb + wid * S5_WAVE_BYTES, g, MPROMPT + s0, 16, s0);
        } else {
            const int jj = j - 16, mix = jj >> 9, s = (jj & 511) >> 2, hh = jj & 3;
            const size_t so = ((size_t)(layer * NDEC + s) * 4 + hh) * 4096;
            if (mix == 0) mix_item<0>(p, layer, lds, MPROMPT + s, 1, hh, 0, 64, p.in[3] + so, p.out + O_SGDN + so, p.in[2] + (size_t)(layer * NDEC + s) * 2304, p.out + O_SCONV + (size_t)(layer * NDEC + s) * 2304);
            else if (mix == 1) mix_item<1>(p, layer, lds, MPROMPT + s, 1, hh, 0, 64, p.in[4] + so, p.out + O_SGLA + so, nullptr, nullptr);
            else mix_item<2>(p, layer, lds, MPROMPT + s, 1, hh, 0, 64, p.in[7] + so, p.out + O_SHG + so, nullptr, nullptr);
        }
    }
    __syncthreads();
}

__device__ __forceinline__ void phase_headnorm(KPR p, int layer, int bid, int G) {
    const int tid_ = otid(); const int wid = __builtin_amdgcn_readfirstlane(tid_ >> 6), lane = tid_ & 63;
    const bf16_t* pm = (const bf16_t*)(p.ws + OFF_PM); const bf16_t* oraw = (const bf16_t*)(p.ws + OFF_ORAW); bf16_t* br = (bf16_t*)(p.ws + OFF_BR);
    for (int j = bid * 8 + wid; j < MTOK * 3; j += G * 8) {
        const int tok = j / 3, mix = j - tok * 3;
        const int gcol = mix == 0 ? A_GATE : (mix == 1 ? B_GATE : D_GATE), slot = mix == 2 ? 3 : mix;
        const float* nw = (mix == 0 ? p.in[13] : (mix == 1 ? p.in[16] : p.in[27])) + layer * 256 + lane * 4;
        const u32x2 ow = *(const u32x2*)(oraw + (size_t)tok * 768 + mix * 256 + lane * 4);
        const u32x2 gw = *(const u32x2*)(pm + (size_t)tok * NPM + gcol + lane * 4);
        const float o0 = lo_bf(ow.x), o1 = hi_bf(ow.x), o2 = lo_bf(ow.y), o3 = hi_bf(ow.y);
        float ss = o0 * o0 + o1 * o1 + o2 * o2 + o3 * o3;
        ss += __shfl_xor(ss, 1); ss += __shfl_xor(ss, 2); ss += __shfl_xor(ss, 4); ss += __shfl_xor(ss, 8);
        const float rs = rsqrtf(ss * (1.0f / 64.0f) + EPS);
        const f32x4 w = *(const f32x4*)nw;
        u32x2 r; r.x = cvt_pk_bf16(o0 * rs * w[0] * siluf_(lo_bf(gw.x)), o1 * rs * w[1] * siluf_(hi_bf(gw.x)));
        r.y = cvt_pk_bf16(o2 * rs * w[2] * siluf_(lo_bf(gw.y)), o3 * rs * w[3] * siluf_(hi_bf(gw.y)));
        *(u32x2*)(br + (size_t)tok * 1024 + slot * 256 + lane * 4) = r;
    }
}

constexpr int PH_PER_LAYER = 9, N_PHASES = 4 * PH_PER_LAYER + 1;
__device__ __forceinline__ void run_phase(KPR p, int ph, LAS unsigned char* lds, int bid, int G) {
    unsigned char* ws = p.ws;
    if (ph == N_PHASES - 1) { phase_norm(p, p.in[34], 2, bid, G); return; }
    const int layer = ph / PH_PER_LAYER, s = ph - layer * PH_PER_LAYER;
    pg8::Sched S; pg8::Gemm g;
    switch (s) {
    case 0: phase_convert(p, layer, (LAS float*)lds, bid, G); phase_norm(p, p.in[8] + layer * 1024, layer == 0 ? 0 : 1, bid, G); break;
    case 1: { S.init(65, 30, 1, G, bid, 16); g = pg8::Gemm{(const bf16_t*)(ws + OFF_XN), (const bf16_t*)(ws + OFF_WIN), 1024, 1024, 16, 0, 0};
              pg8::gemm_phase(lds, g, S, EpiIn{(bf16_t*)(ws + OFF_PM), (bf16_t*)(ws + OFF_GATES)}); } break;
    case 2: phase_mix(p, layer, lds, bid, G); break;
    case 3: { S.init(65, 2, 1, G, bid, 4); g = pg8::Gemm{(const bf16_t*)(ws + OFF_YG), (const bf16_t*)(ws + OFF_WGLU), 256, 256, 4, 0, 0};
              pg8::gemm_phase(lds, g, S, EpiGlu{(bf16_t*)(ws + OFF_BR)}); phase_headnorm(p, layer, bid, G); } break;
    case 4: { S.init(65, 4, 4, G, bid, 4); g = pg8::Gemm{(const bf16_t*)(ws + OFF_BR), (const bf16_t*)(ws + OFF_WBR), 1024, 256, 4, 256, (size_t)1024 * 256};
              pg8::gemm_phase(lds, g, S, EpiBr{(const bf16_t*)(ws + OFF_GATES), (bf16_t*)(ws + OFF_PM)}); } break;
    case 5: { S.init(64, 4, 1, G, bid, 16, 4); g = pg8::Gemm{(const bf16_t*)(ws + OFF_PM), (const bf16_t*)(ws + OFF_WOUT), 1024, 1024, 16, 0, 0};
              pg8::gemm_phase(lds, g, S, EpiRes{(float*)(ws + OFF_H)}); } break;
    case 6: phase_norm(p, p.in[30] + layer * 1024, 1, bid, G); break;
    case 7: { S.init(65, 22, 1, G, bid, 16); g = pg8::Gemm{(const bf16_t*)(ws + OFF_XN), (const bf16_t*)(ws + OFF_WGU), 1024, 1024, 16, 0, 0};
              pg8::gemm_phase(lds, g, S, EpiGU{(bf16_t*)(ws + OFF_PM)}); } break;
    case 8: { S.init(64, 4, 1, G, bid, 44, 4); g = pg8::Gemm{(const bf16_t*)(ws + OFF_PM), (const bf16_t*)(ws + OFF_WDN), DFF, DFF, 44, 0, 0};
              pg8::gemm_phase(lds, g, S, EpiRes{(float*)(ws + OFF_H)}); } break;
    }
}

extern __shared__ __attribute__((aligned(16))) unsigned char dyn_smem[];
#if MULTI_LAUNCH
__global__ void __launch_bounds__(512) k_phase(KP parg, int ph) {
    KPR p = *(const CAS KP*)__builtin_amdgcn_kernarg_segment_ptr();
    run_phase(p, ph, (LAS unsigned char*)dyn_smem, blockIdx.x, gridDim.x);
}
#else
#define XB_TMO      128
#define XB_XCNT(j)  (256  + 64 * (j))
#define XB_XSUB(j)  (1280 + 64 * (j))
#define XB_XGEN(j)  (2304 + 64 * (j))
#define XB_TOP      3328
#define XB_TOPGEN   3392
#define XCD_BAR_WORDS 3456
#define XB_SPIN_CAP (1u << 22)
__device__ __forceinline__ unsigned xb_ld(unsigned* q)              { return __hip_atomic_load(q, __ATOMIC_RELAXED, __HIP_MEMORY_SCOPE_AGENT); }
__device__ __forceinline__ unsigned xb_add(unsigned* q, unsigned v) { return __hip_atomic_fetch_add(q, v, __ATOMIC_RELAXED, __HIP_MEMORY_SCOPE_AGENT); }
__device__ __forceinline__ unsigned xb_xcc_id() { return (unsigned)__builtin_amdgcn_s_getreg((3 << 11) | 20) & 0xFu; }
#define XB_SPIN(cond, bar) do { unsigned _sp = 0; while (cond) { __builtin_amdgcn_s_sleep(1); \
    if ((++_sp & 255u) == 0u) { if (xb_ld(&(bar)[XB_TMO])) break; if (_sp > XB_SPIN_CAP) { atomicAdd(&(bar)[XB_TMO], 1u); break; } } } } while (0)
__device__ __forceinline__ void xcd_barrier_complete(unsigned* bar, unsigned x, unsigned G, unsigned& nloc, unsigned& nx) {
    unsigned sum, cnt, mine, sp = 0u;
    for (;;) {
        sum = 0u; cnt = 0u; mine = 0u;
#pragma unroll
        for (unsigned j = 0; j < 16; ++j) { const unsigned c = xb_ld(&bar[XB_XCNT(j)]); sum += c; cnt += (c > 0u) ? 1u : 0u; mine = (j == x) ? c : mine; }
        if (sum == G) break;
        __builtin_amdgcn_s_sleep(1);
        if ((++sp & 255u) == 0u) { if (xb_ld(&bar[XB_TMO])) break; if (sp > XB_SPIN_CAP) { atomicAdd(&bar[XB_TMO], 1u); break; } }
    }
    nloc = mine > 0u ? mine : 1u; nx = cnt > 0u ? cnt : 1u;
}
__device__ __forceinline__ void grid_bar(unsigned* bar, volatile LAS unsigned* st, int G) {
    asm volatile("s_waitcnt vmcnt(0)" ::: "memory");
    __syncthreads();
    if (otid() == 0) {
        __builtin_amdgcn_s_waitcnt(0);
        const unsigned x = xb_xcc_id();
        unsigned nloc = st[0], nx = st[1];
        if (nloc == 0u) { xcd_barrier_complete(bar, x, (unsigned)G, nloc, nx); st[0] = nloc; st[1] = nx; }
        const unsigned old = xb_add(&bar[XB_XSUB(x)], 1u);
        const unsigned gen = old / nloc;
        if (old + 1u == (gen + 1u) * nloc) {
            __builtin_amdgcn_fence(__ATOMIC_RELEASE, "agent");
            asm volatile("s_waitcnt vmcnt(0)" ::: "memory");
            const unsigned og = xb_add(&bar[XB_TOP], 1u);
            const unsigned tg = og / nx;
            if (og + 1u == (tg + 1u) * nx) xb_add(&bar[XB_TOPGEN], 1u);
            else XB_SPIN(xb_ld(&bar[XB_TOPGEN]) == tg, bar);
            __builtin_amdgcn_fence(__ATOMIC_ACQUIRE, "agent");
            xb_add(&bar[XB_XGEN(x)], 1u);
            asm volatile("s_waitcnt vmcnt(0)" ::: "memory");
        } else {
            XB_SPIN(xb_ld(&bar[XB_XGEN(x)]) == gen, bar);
            __builtin_amdgcn_fence(__ATOMIC_ACQUIRE, "agent");
            asm volatile("s_waitcnt vmcnt(0)" ::: "memory");
        }
    }
    __syncthreads();
}
template <int PH> __device__ __forceinline__ void run_from(KPR p, cg::grid_group& grid) {
    const CAS KP* pp = &p; asm volatile("" : "+s"(pp));
    int bid = blockIdx.x, G = gridDim.x; asm volatile("" : "+s"(bid), "+s"(G));
    run_phase(*pp, PH, (LAS unsigned char*)dyn_smem, bid, G);
    if constexpr (PH + 1 < N_PHASES) {
        if constexpr (PH == 0) grid.sync();
        else grid_bar((unsigned*)(pp->ws + OFF_BAR), (volatile LAS unsigned*)((LAS unsigned char*)dyn_smem + pg8::STAGE_BYTES), G);
        run_from<PH + 1>(p, grid);
    }
}
__global__ void __launch_bounds__(512) k_mega(KP parg) {
    cg::grid_group grid = cg::this_grid();
    KPR p = *(const CAS KP*)__builtin_amdgcn_kernarg_segment_ptr();
    if (threadIdx.x == 0) { volatile LAS unsigned* st = (volatile LAS unsigned*)((LAS unsigned char*)dyn_smem + pg8::STAGE_BYTES); st[0] = 0u; st[1] = 0u;
        (void)xb_add(&((unsigned*)(p.ws + OFF_BAR))[XB_XCNT(xb_xcc_id())], 1u); }
    __syncthreads();
    run_from<0>(p, grid);
}
#endif

extern "C" void kernel_launch(void* const* d_in, const int* in_sizes, int n_in, void* d_out, int out_size, void* d_ws, size_t ws_size, hipStream_t stream) {
    if (ws_size < WS_NEED || n_in < 35) { fprintf(stderr, "workspace too small: %zu < %zu\n", ws_size, (size_t)WS_NEED); return; }
    KP p{};
    for (int i = 0; i < 35; ++i) p.in[i] = (const float*)d_in[i];
    p.out = (float*)d_out; p.ws = (unsigned char*)d_ws;
    constexpr size_t kDynLds = pg8::STAGE_BYTES + 16;
#if MULTI_LAUNCH
    static bool once = false;
    if (!once) { hipFuncSetAttribute((const void*)k_phase, hipFuncAttributeMaxDynamicSharedMemorySize, (int)kDynLds); once = true; }
    for (int ph = 0; ph < N_PHASES; ++ph) hipLaunchKernelGGL(k_phase, dim3(256), dim3(512), kDynLds, stream, p, ph);
#else
    static int grid_blocks = 0;
    if (!grid_blocks) {
        hipFuncSetAttribute((const void*)k_mega, hipFuncAttributeMaxDynamicSharedMemorySize, (int)kDynLds);
        int dev = 0, cus = 0, per_cu = 0;
        hipGetDevice(&dev);
        hipDeviceGetAttribute(&cus, hipDeviceAttributeMultiprocessorCount, dev);
        hipOccupancyMaxActiveBlocksPerMultiprocessor(&per_cu, k_mega, 512, kDynLds);
        if (per_cu < 1) per_cu = 1;
        grid_blocks = cus * per_cu; if (grid_blocks > 256) grid_blocks = 256;
    }
    hipMemsetAsync((unsigned char*)d_ws + OFF_BAR, 0, 16384, stream);
    void* args[] = {&p};
    hipError_t e = hipLaunchCooperativeKernel((void*)k_mega, dim3(grid_blocks), dim3(512), args, kDynLds, stream);
    if (e != hipSuccess) fprintf(stderr, "cooperative launch failed: %s (grid %d)\n", hipGetErrorString(e), grid_blocks);
#endif
}
```

```cpp
#include <hip/hip_runtime.h>
#include <hip/hip_cooperative_groups.h>
#include <cstdio>
namespace cg = cooperative_groups;

#ifndef MULTI_LAUNCH
#define MULTI_LAUNCH 0
#endif

#define LAS __attribute__((address_space(3)))
typedef unsigned short bf16_t;
typedef short bf16x8 __attribute__((ext_vector_type(8)));
typedef float f32x4 __attribute__((ext_vector_type(4)));
typedef float f32x2 __attribute__((ext_vector_type(2)));
typedef unsigned u32x2 __attribute__((ext_vector_type(2)));
typedef unsigned u32x4 __attribute__((ext_vector_type(4)));

constexpr int DM = 1024, SEQ = 2048, NBATCH = 8, NDEC = 128;
constexpr int MPROMPT = NBATCH * SEQ;
constexpr int MTOK = MPROMPT + NDEC;
constexpr int MP = 16640;
constexpr int NPM = 3584, NGATE = 4096, NIN = 7448, DFF = 2816;
constexpr int A_QKV = 0, A_GATE = 768, B_Q = 1024, B_K = 1280, B_V = 1536, B_GATE = 1792, C_U = 2048, D_Q = 2304, D_F = 2560, D_I = 2816, D_GATE = 3072,
              A_ALPHA = 3328, A_BETA = 3332, B_GK = 3336;
constexpr float EPS = 1e-6f;

constexpr size_t SZ_WIN = (size_t)7680 * 1024 * 2, SZ_WGU = (size_t)5632 * 1024 * 2, SZ_WDN = (size_t)1024 * 2816 * 2, SZ_WOUT = (size_t)1024 * 1024 * 2,
                 SZ_WBR = (size_t)4096 * 256 * 2, SZ_WGLU = (size_t)512 * 256 * 2;
constexpr size_t OFF_WIN = 0, OFF_WGU = OFF_WIN + SZ_WIN, OFF_WDN = OFF_WGU + SZ_WGU, OFF_WOUT = OFF_WDN + SZ_WDN, OFF_WBR = OFF_WOUT + SZ_WOUT,
                 OFF_WGLU = OFF_WBR + SZ_WBR, OFF_H = OFF_WGLU + SZ_WGLU, OFF_XN = OFF_H + (size_t)MP * 1024 * 4, OFF_BR = OFF_XN + (size_t)MP * 1024 * 2,
                 OFF_PM = OFF_BR + (size_t)MP * 1024 * 2, OFF_GATES = OFF_PM + (size_t)MP * NPM * 2, OFF_ORAW = OFF_GATES + (size_t)MP * NGATE * 2,
                 OFF_YG = OFF_ORAW + (size_t)MP * 768 * 2, OFF_BAR = OFF_YG + (size_t)MP * 256 * 2, WS_NEED = OFF_BAR + 16384;
constexpr size_t O_PCONV = 16908288, O_PGDN = 16982016, O_PGLA = 17506304, O_PS5R = 18030592, O_PS5I = 18063360, O_PHG = 18096128,
                 O_SCONV = 18620416, O_SGDN = 19800064, O_SGLA = 28188672, O_SS5R = 36577280, O_SS5I = 37101568, O_SHG = 37625856;

struct KP { const float* in[35]; float* out; unsigned char* ws; };
#define CAS __attribute__((address_space(4)))
typedef const CAS KP& KPR;

__device__ __forceinline__ int otid() { int t = threadIdx.x; asm volatile("" : "+v"(t)); return t & 511; }
__device__ __forceinline__ float bf2f(bf16_t b) { return __uint_as_float(((unsigned)b) << 16); }
typedef __bf16 bf16x2_t __attribute__((ext_vector_type(2)));
__device__ __forceinline__ unsigned cvt_pk_bf16(float lo, float hi) { const f32x2 f = {lo, hi}; const bf16x2_t v = __builtin_convertvector(f, bf16x2_t); return __builtin_bit_cast(unsigned, v); }
__device__ __forceinline__ bf16_t f2bf(float f) { return (bf16_t)(cvt_pk_bf16(f, 0.f) & 0xffffu); }
__device__ __forceinline__ float lo_bf(unsigned w) { return __uint_as_float(w << 16); }
__device__ __forceinline__ float hi_bf(unsigned w) { return __uint_as_float(w & 0xffff0000u); }
__device__ __forceinline__ float sigmoidf_(float x) { return __builtin_amdgcn_rcpf(1.0f + __expf(-x)); }
__device__ __forceinline__ float siluf_(float x) { return x * __builtin_amdgcn_rcpf(1.0f + __expf(-x)); }
__device__ __forceinline__ float wave_sum(float v) {
#pragma unroll
    for (int o = 32; o >= 1; o >>= 1) v += __shfl_xor(v, o);
    return v;
}
template <int CTRL> __device__ __forceinline__ float dpp_f(float v) { return __int_as_float(__builtin_amdgcn_update_dpp(0, __float_as_int(v), CTRL, 0xf, 0xf, true)); }
__device__ __forceinline__ float red16(float v) { v += dpp_f<0xB1>(v); v += dpp_f<0x4E>(v); v += dpp_f<0x141>(v); v += dpp_f<0x140>(v); return v; }
__device__ __forceinline__ float red8(float v) { v += dpp_f<0xB1>(v); v += dpp_f<0x4E>(v); v += dpp_f<0x141>(v); return v; }

namespace pg8 {
constexpr int BM = 256, BK = 64, HALF = 128, HTB = HALF * BK * 2, STAGE_BYTES = 8 * HTB, NXCD = 8, WGM = 8;
__device__ __forceinline__ int lds_byte(int r, int c) { const int st = (r >> 4) * 2 + (c >> 5), rr = r & 15, cc = c & 31, ob = rr * 64 + cc * 2; return st * 1024 + (ob ^ (((ob >> 9) & 1) << 5)); }
__device__ __forceinline__ void stage_rc(int b, int& R, int& C) { const int st = b / 1024, sb = b % 1024, swz = sb ^ (((sb >> 9) & 1) << 5); R = (st >> 1) * 16 + swz / 64; C = (st & 1) * 32 + (swz % 64) / 2; }

struct Unit { int pm, pn, kk, k0, nt; };
struct Gemm { const bf16_t* A; const bf16_t* Bt; int lda, ldb, nt; size_t a_kk, b_kk; };
struct Sched {
    int nM, nN, nKK, nwg, G, c, ntf, nts, nextra;
    __device__ void init(int nM_, int nN_, int nKK_, int G_, int c_, int ntf_, int nts_ = 0) { nM = nM_; nN = nN_; nKK = nKK_; nwg = nM * nN; G = G_; c = c_; ntf = ntf_; nts = nts_; nextra = nts_ ? nN_ * (ntf_ / nts_) : 0; }
    __device__ bool next(int i, Unit& u) const {
        const int it = i / nKK; u.kk = i - it * nKK; u.k0 = 0; u.nt = ntf;
        const long L = (long)it * G + c;
        if (L >= nwg) { const int e = (int)(L - nwg); if (e >= nextra) return false; u.pm = nM; u.pn = e % nN; u.k0 = (e / nN) * nts; u.nt = nts; return true; }
        int wgid = (int)L; { const int q = nwg / NXCD, r = nwg % NXCD, xcd = wgid % NXCD, off = wgid / NXCD; wgid = (xcd < r ? xcd * (q + 1) : r * (q + 1) + (xcd - r) * q) + off; }
        const int nig = WGM * nN, gid = wgid / nig, fm = gid * WGM, gsz = (nM - fm) < WGM ? (nM - fm) : WGM;
        u.pm = fm + ((wgid % nig) % gsz); u.pn = (wgid % nig) / gsz; return true;
    }
};

template <class Epi>
__device__ __forceinline__ void gemm_phase(LAS unsigned char* lds, const Gemm g, const Sched& S, const Epi& E) {
    const int tid = otid(), wid = __builtin_amdgcn_readfirstlane(tid >> 6), lane = tid & 63, wr = wid >> 2, wc = wid & 3, fr = lane & 15, fq = lane >> 4;
    unsigned voffA[2], voffB[2];
#pragma unroll
    for (int i = 0; i < 2; ++i) { int R, C; stage_rc(tid * 16 + i * 8192, R, C); voffA[i] = (unsigned)(R * g.lda + C) * 2u; voffB[i] = (unsigned)(R * g.ldb + C) * 2u; }
    const size_t kstep = (size_t)(BK * 2);
    const size_t hstepA = (size_t)HALF * g.lda * 2, hstepB = (size_t)HALF * g.ldb * 2;
    const size_t tstepA = 2 * hstepA, tstepB = 2 * hstepB;
    const unsigned ldsw = (unsigned)wid * 1024u;
    const int aoff = lds_byte(wr * 64 + fr, fq * 8), boff = lds_byte(wc * 32 + fr, fq * 8);
#define PG8_SA(b, h) (((b) * 2 + (h)) * HTB)
#define PG8_SB(b, h) ((4 + (b) * 2 + (h)) * HTB)
#define PG8_STAGE(bufoff, gbase, voff) do { _Pragma("unroll") for (int _i = 0; _i < 2; ++_i) \
        __builtin_amdgcn_global_load_lds((const unsigned*)((const char*)(gbase) + (voff)[_i]), (LAS unsigned*)(lds + (bufoff) + ldsw + _i * 8192), 16, 0, 0); } while (0)
#define PG8_LDA(dst, b, h) do { _Pragma("unroll") for (int m = 0; m < 4; ++m) _Pragma("unroll") for (int k = 0; k < 2; ++k) dst[m][k] = *(const LAS bf16x8*)(lds + PG8_SA(b, h) + aoff + m * 2048 + k * 1024); } while (0)
#define PG8_LDB(dst, b, h) do { _Pragma("unroll") for (int n = 0; n < 2; ++n) _Pragma("unroll") for (int k = 0; k < 2; ++k) dst[n][k] = *(const LAS bf16x8*)(lds + PG8_SB(b, h) + boff + n * 2048 + k * 1024); } while (0)
#define PG8_MMA(ai, bj, At, Bt) do { __builtin_amdgcn_s_setprio(1); _Pragma("unroll") for (int m = 0; m < 4; ++m) _Pragma("unroll") for (int n = 0; n < 2; ++n) _Pragma("unroll") for (int k = 0; k < 2; ++k) \
        acc[ai][bj][m][n] = __builtin_amdgcn_mfma_f32_16x16x32_bf16(Bt[n][k], At[m][k], acc[ai][bj][m][n], 0, 0, 0); __builtin_amdgcn_s_setprio(0); } while (0)
#define PG8_WAIT_V(n) asm volatile("s_waitcnt vmcnt(" #n ")" ::: "memory")
#define PG8_WAIT_L(n) asm volatile("s_waitcnt lgkmcnt(" #n ")" ::: "memory")
#define PG8_BAR __builtin_amdgcn_s_barrier()
#define PG8_SCHED __builtin_amdgcn_sched_barrier(0)
    Unit cur, nxt; int ui = 0;
    if (!S.next(0, cur)) return;
    f32x4 acc[2][2][4][2];
#pragma unroll
    for (int a = 0; a < 2; ++a)
#pragma unroll
        for (int b = 0; b < 2; ++b)
#pragma unroll
            for (int m = 0; m < 4; ++m)
#pragma unroll
                for (int n = 0; n < 2; ++n) acc[a][b][m][n] = (f32x4){0.f, 0.f, 0.f, 0.f};
    bf16x8 At[4][2], B0[2][2], B1[2][2];
    const char* cA = (const char*)(g.A + (size_t)cur.kk * g.a_kk) + (size_t)cur.pm * tstepA + (size_t)cur.k0 * kstep; const char* cB = (const char*)(g.Bt + (size_t)cur.kk * g.b_kk) + (size_t)cur.pn * tstepB + (size_t)cur.k0 * kstep;
    PG8_STAGE(PG8_SB(0, 0), cB, voffB); PG8_STAGE(PG8_SA(0, 0), cA, voffA); PG8_STAGE(PG8_SB(0, 1), cB + hstepB, voffB); PG8_STAGE(PG8_SA(0, 1), cA + hstepA, voffA);
    if (wr == 1) PG8_BAR;
    PG8_WAIT_V(4); PG8_BAR;
    PG8_STAGE(PG8_SB(1, 0), cB + kstep, voffB); PG8_STAGE(PG8_SA(1, 0), cA + kstep, voffA); PG8_STAGE(PG8_SB(1, 1), cB + hstepB + kstep, voffB);
    PG8_WAIT_V(6); PG8_BAR;
    for (;;) {
        const bool has_next = S.next(ui + 1, nxt);
        const char* nA = has_next ? (const char*)(g.A + (size_t)nxt.kk * g.a_kk) + (size_t)nxt.pm * tstepA + (size_t)nxt.k0 * kstep : cA;
        const char* nB = has_next ? (const char*)(g.Bt + (size_t)nxt.kk * g.b_kk) + (size_t)nxt.pn * tstepB + (size_t)nxt.k0 * kstep : cB;
        int nt = cur.nt; asm volatile("" : "+s"(nt));
        for (int t = 0; t < nt; t += 2) {
            const bool last = (t == nt - 2);
            const char* a1 = cA + (size_t)(t + 1) * kstep;
            const char* a2 = last ? nA : cA + (size_t)(t + 2) * kstep; const char* b2 = last ? nB : cB + (size_t)(t + 2) * kstep;
            const char* a3 = a2 + kstep; const char* b3 = b2 + kstep;
            PG8_LDB(B0, 0, 0); PG8_SCHED; PG8_LDA(At, 0, 0); PG8_STAGE(PG8_SA(1, 1), a1 + hstepA, voffA);
            PG8_WAIT_L(8); PG8_BAR; PG8_WAIT_L(0); PG8_MMA(0, 0, At, B0); PG8_BAR; PG8_SCHED;
            PG8_LDB(B1, 0, 1); PG8_STAGE(PG8_SB(0, 0), b2, voffB);
            PG8_BAR; PG8_WAIT_L(0); PG8_MMA(0, 1, At, B1); PG8_BAR;
            PG8_LDA(At, 0, 1); PG8_STAGE(PG8_SA(0, 0), a2, voffA);
            PG8_BAR; PG8_WAIT_L(0); PG8_MMA(1, 0, At, B0); PG8_BAR; PG8_SCHED;
            PG8_STAGE(PG8_SB(0, 1), b2 + hstepB, voffB);
            PG8_WAIT_V(6); PG8_BAR; PG8_MMA(1, 1, At, B1); PG8_BAR;
            PG8_LDB(B0, 1, 0); PG8_SCHED; PG8_LDA(At, 1, 0); PG8_STAGE(PG8_SA(0, 1), a2 + hstepA, voffA);
            PG8_WAIT_L(8); PG8_BAR; PG8_WAIT_L(0); PG8_MMA(0, 0, At, B0); PG8_BAR; PG8_SCHED;
            PG8_LDB(B1, 1, 1); PG8_STAGE(PG8_SB(1, 0), b3, voffB);
            PG8_BAR; PG8_WAIT_L(0); PG8_MMA(0, 1, At, B1); PG8_BAR;
            PG8_LDA(At, 1, 1); PG8_STAGE(PG8_SA(1, 0), a3, voffA);
            PG8_BAR; PG8_WAIT_L(0); PG8_MMA(1, 0, At, B0); PG8_BAR; PG8_SCHED;
            PG8_STAGE(PG8_SB(1, 1), b3 + hstepB, voffB);
            PG8_WAIT_V(6); PG8_BAR; PG8_MMA(1, 1, At, B1); PG8_BAR;
        }
        E(acc, cur, wr, wc, fr, fq);
        if (!has_next) break;
#pragma unroll
        for (int a = 0; a < 2; ++a)
#pragma unroll
            for (int b = 0; b < 2; ++b)
#pragma unroll
                for (int m = 0; m < 4; ++m)
#pragma unroll
                    for (int n = 0; n < 2; ++n) acc[a][b][m][n] = (f32x4){0.f, 0.f, 0.f, 0.f};
        cur = nxt; cA = nA; cB = nB; ++ui;
    }
    PG8_WAIT_V(0);
    if (wr == 0) PG8_BAR;
    PG8_BAR;
    __builtin_amdgcn_s_waitcnt(0);
#undef PG8_SA
#undef PG8_SB
#undef PG8_STAGE
#undef PG8_LDA
#undef PG8_LDB
#undef PG8_MMA
#undef PG8_WAIT_V
#undef PG8_WAIT_L
#undef PG8_BAR
#undef PG8_SCHED
}
}
using pg8::Unit;

#define EPI_LOOP_BEGIN _Pragma("unroll") for (int ai = 0; ai < 2; ++ai) _Pragma("unroll") for (int m = 0; m < 4; ++m) { const size_t row = (size_t)(u.pm * 256 + ai * 128 + wr * 64 + m * 16 + fr); \
        _Pragma("unroll") for (int bj = 0; bj < 2; ++bj) {
#define EPI_LOOP_END } }
struct EpiIn {
    bf16_t* pm; bf16_t* gates;
    __device__ __forceinline__ void operator()(const f32x4 (&acc)[2][2][4][2], const Unit& u, int wr, int wc, int fr, int fq) const {
        const bool main_ = u.pn < 14;
        EPI_LOOP_BEGIN
#pragma unroll
            for (int n = 0; n < 2; ++n) { const int col = u.pn * 256 + bj * 128 + wc * 32 + n * 16 + fq * 4; f32x4 v = acc[ai][bj][m][n]; u32x2 w;
                if (main_) { w.x = cvt_pk_bf16(v[0], v[1]); w.y = cvt_pk_bf16(v[2], v[3]); *(u32x2*)(pm + row * NPM + col) = w; }
                else { w.x = cvt_pk_bf16(sigmoidf_(v[0]), sigmoidf_(v[1])); w.y = cvt_pk_bf16(sigmoidf_(v[2]), sigmoidf_(v[3])); *(u32x2*)(gates + row * NGATE + (col - NPM)) = w; } }
        EPI_LOOP_END
    }
};
struct EpiGlu {
    bf16_t* br;
    __device__ __forceinline__ void operator()(const f32x4 (&acc)[2][2][4][2], const Unit& u, int wr, int wc, int fr, int fq) const {
        EPI_LOOP_BEGIN
            const int j = u.pn * 128 + bj * 64 + wc * 16 + fq * 4; const f32x4 a = acc[ai][bj][m][0], b = acc[ai][bj][m][1]; u32x2 w;
            w.x = cvt_pk_bf16(a[0] * sigmoidf_(b[0]), a[1] * sigmoidf_(b[1])); w.y = cvt_pk_bf16(a[2] * sigmoidf_(b[2]), a[3] * sigmoidf_(b[3]));
            *(u32x2*)(br + row * 1024 + 512 + j) = w;
        EPI_LOOP_END
    }
};
struct EpiGU {
    bf16_t* a;
    __device__ __forceinline__ void operator()(const f32x4 (&acc)[2][2][4][2], const Unit& u, int wr, int wc, int fr, int fq) const {
        EPI_LOOP_BEGIN
            const int j = u.pn * 128 + bj * 64 + wc * 16 + fq * 4; const f32x4 g = acc[ai][bj][m][0], b = acc[ai][bj][m][1]; u32x2 w;
            w.x = cvt_pk_bf16(siluf_(g[0]) * b[0], siluf_(g[1]) * b[1]); w.y = cvt_pk_bf16(siluf_(g[2]) * b[2], siluf_(g[3]) * b[3]);
            *(u32x2*)(a + row * DFF + j) = w;
        EPI_LOOP_END
    }
};
struct EpiBr {
    const bf16_t* gates; bf16_t* mm;
    __device__ __forceinline__ void operator()(const f32x4 (&acc)[2][2][4][2], const Unit& u, int wr, int wc, int fr, int fq) const {
        const int col0 = u.pn * 256 + wc * 32 + fq * 4;
#pragma unroll
        for (int ai = 0; ai < 2; ++ai) {
            if (ai == 1 && u.pm == 64) break;
            const size_t row0 = (size_t)(u.pm * 256 + ai * 128 + wr * 64 + fr);
            u32x2 gw[4][2][2], pw[4][2][2];
#pragma unroll
            for (int m = 0; m < 4; ++m)
#pragma unroll
                for (int bj = 0; bj < 2; ++bj)
#pragma unroll
                    for (int n = 0; n < 2; ++n) { const size_t row = row0 + m * 16; const int col = col0 + bj * 128 + n * 16;
                        gw[m][bj][n] = *(const u32x2*)(gates + row * NGATE + u.kk * 1024 + col);
                        pw[m][bj][n] = (u32x2){0u, 0u}; if (u.kk > 0) pw[m][bj][n] = *(const u32x2*)(mm + row * 1024 + col); }
#pragma unroll
            for (int m = 0; m < 4; ++m)
#pragma unroll
                for (int bj = 0; bj < 2; ++bj)
#pragma unroll
                    for (int n = 0; n < 2; ++n) { const size_t row = row0 + m * 16; const int col = col0 + bj * 128 + n * 16; const f32x4 v = acc[ai][bj][m][n]; const u32x2 g = gw[m][bj][n], q = pw[m][bj][n];
                        u32x2 w; w.x = cvt_pk_bf16(lo_bf(g.x) * v[0] + lo_bf(q.x), hi_bf(g.x) * v[1] + hi_bf(q.x)); w.y = cvt_pk_bf16(lo_bf(g.y) * v[2] + lo_bf(q.y), hi_bf(g.y) * v[3] + hi_bf(q.y));
                        *(u32x2*)(mm + row * 1024 + col) = w; }
        }
    }
};
struct EpiRes {
    float* h;
    __device__ __forceinline__ void operator()(const f32x4 (&acc)[2][2][4][2], const Unit& u, int wr, int wc, int fr, int fq) const {
        const bool split = u.pm == 64;
        EPI_LOOP_BEGIN
#pragma unroll
            for (int n = 0; n < 2; ++n) { const int col = u.pn * 256 + bj * 128 + wc * 32 + n * 16 + fq * 4; float* ptr = h + row * 1024 + col;
                if (split) {
#pragma unroll
                    for (int e = 0; e < 4; ++e) __hip_atomic_fetch_add(ptr + e, acc[ai][bj][m][n][e], __ATOMIC_RELAXED, __HIP_MEMORY_SCOPE_AGENT);
                } else { const f32x4 o = *(const f32x4*)ptr; *(f32x4*)ptr = o + acc[ai][bj][m][n]; } }
        EPI_LOOP_END
    }
};

__device__ __forceinline__ int win_src_col(int n) {
    if (n < 768) return n;
    if (n < 1024) return 776 + (n - 768);
    if (n < 1792) return 1032 + (n - 1024);
    if (n < 2048) return 1816 + (n - 1792);
    if (n < 2304) return 2072 + (n - 2048);
    if (n < 3072) return 2328 + (n - 2304);
    if (n < 3328) return 3096 + (n - 3072);
    if (n < 3336) return 768 + (n - 3328);
    if (n < 3352) return 1800 + (n - 3336);
    if (n < 3584) return -1;
    return 3352 + (n - 3584);
}
__device__ __forceinline__ void phase_convert(KPR p, int layer, LAS float* tile, int bid, int G) {
    const int tid = otid(), tn = tid & 63, tk = __builtin_amdgcn_readfirstlane(tid >> 6);
    constexpr int T0 = 120 * 16, T1 = T0 + 88 * 16, T2 = T1 + 16 * 44, T3 = T2 + 16 * 16, T4 = T3 + 64 * 4, T5 = T4 + 8 * 4;
    for (int j = bid; j < T5; j += G) {
        int n0, k0, K, ld; bf16_t* dst; const float* cp = nullptr;
        if (j < T0) { const int q = j; n0 = (q >> 4) * 64; k0 = (q & 15) * 64; K = 1024; ld = NIN; dst = (bf16_t*)(p.ws + OFF_WIN);
            const int sc = win_src_col(n0 + tn); if (sc >= 0) cp = p.in[9] + (size_t)layer * 1024 * NIN + sc; }
        else if (j < T1) { const int q = j - T0; n0 = (q >> 4) * 64; k0 = (q & 15) * 64; K = 1024; ld = DFF; dst = (bf16_t*)(p.ws + OFF_WGU);
            const int n = n0 + tn, g32 = n >> 5, w = n & 31, jj = g32 * 16 + (w & 15); cp = (w < 16 ? p.in[31] : p.in[32]) + (size_t)layer * 1024 * DFF + jj; }
        else if (j < T2) { const int q = j - T1; n0 = (q / 44) * 64; k0 = (q % 44) * 64; K = DFF; ld = 1024; dst = (bf16_t*)(p.ws + OFF_WDN);
            cp = p.in[33] + (size_t)layer * DFF * 1024 + (n0 + tn); }
        else if (j < T3) { const int q = j - T2; n0 = (q >> 4) * 64; k0 = (q & 15) * 64; K = 1024; ld = 1024; dst = (bf16_t*)(p.ws + OFF_WOUT);
            cp = p.in[29] + (size_t)layer * 1024 * 1024 + (n0 + tn); }
        else if (j < T4) { const int q = j - T3; n0 = (q >> 2) * 64; k0 = (q & 3) * 64; K = 256; ld = 1024; dst = (bf16_t*)(p.ws + OFF_WBR);
            const int n = n0 + tn, kk = n >> 10, d = n & 1023; cp = p.in[28] + ((size_t)(layer * 4 + kk) * 256) * 1024 + d; }
        else { const int q = j - T4; n0 = (q >> 2) * 64; k0 = (q & 3) * 64; K = 256; ld = 512; dst = (bf16_t*)(p.ws + OFF_WGLU);
            const int n = n0 + tn, g32 = n >> 5, w = n & 31, jj = g32 * 16 + (w & 15); cp = p.in[25] + (size_t)layer * 256 * 512 + (w < 16 ? jj : 256 + jj); }
        __syncthreads();
#pragma unroll
        for (int e = 0; e < 8; ++e) { const int k = k0 + tk * 8 + e; tile[tn * 65 + tk * 8 + e] = cp ? cp[(size_t)k * ld] : 0.f; }
        __syncthreads();
        { const int n = tid >> 3, ks = tid & 7; const LAS float* tp = tile + n * 65 + ks * 8; u32x4 w;
          w.x = cvt_pk_bf16(tp[0], tp[1]); w.y = cvt_pk_bf16(tp[2], tp[3]); w.z = cvt_pk_bf16(tp[4], tp[5]); w.w = cvt_pk_bf16(tp[6], tp[7]);
          *(u32x4*)(dst + (size_t)(n0 + n) * K + k0 + ks * 8) = w; }
    }
    __syncthreads();
}

__device__ __forceinline__ void phase_norm(KPR p, const float* w, int mode, int bid, int G) {
    const int tid_ = otid(); const int wid = __builtin_amdgcn_readfirstlane(tid_ >> 6), lane = tid_ & 63;
    float* h = (float*)(p.ws + OFF_H); bf16_t* xn = (bf16_t*)(p.ws + OFF_XN);
    f32x4 wv[4];
#pragma unroll
    for (int i = 0; i < 4; ++i) wv[i] = *(const f32x4*)(w + i * 256 + lane * 4);
    for (int r = bid * 8 + wid; r < MTOK; r += G * 8) {
        const float* src = (mode == 0) ? (r < MPROMPT ? p.in[0] + (size_t)r * 1024 : p.in[1] + (size_t)(r - MPROMPT) * 1024) : h + (size_t)r * 1024;
        f32x4 v[4]; float ss = 0.f;
#pragma unroll
        for (int i = 0; i < 4; ++i) { v[i] = *(const f32x4*)(src + i * 256 + lane * 4); ss += v[i][0] * v[i][0] + v[i][1] * v[i][1] + v[i][2] * v[i][2] + v[i][3] * v[i][3]; }
        ss = wave_sum(ss);
        const float rs = rsqrtf(ss * (1.0f / 1024.0f) + EPS);
#pragma unroll
        for (int i = 0; i < 4; ++i) {
            const f32x4 y = v[i] * rs * wv[i];
            if (mode == 2) *(f32x4*)(p.out + (size_t)r * 1024 + i * 256 + lane * 4) = y;
            else { u32x2 o; o.x = cvt_pk_bf16(y[0], y[1]); o.y = cvt_pk_bf16(y[2], y[3]); *(u32x2*)(xn + (size_t)r * 1024 + i * 256 + lane * 4) = o;
                   if (mode == 0) *(f32x4*)(h + (size_t)r * 1024 + i * 256 + lane * 4) = v[i]; }
        }
    }
}

constexpr int TCH = 32;
constexpr int MIXBUF_FLOATS = 4 * TCH * 64 + TCH * 4;
template <int MIX>
__device__ __forceinline__ void mix_item(KPR p, int layer, LAS float* lds, int tokbase, int L, int h, int col0, int ncols,
                         const float* s_in, float* s_out, const float* conv_in, float* conv_out) {
    const int tid = otid(), wid = __builtin_amdgcn_readfirstlane(tid >> 6), lane = tid & 63;
    const int nscan = ncols * 8; const bool is_scan = wid < (nscan >> 6);
    const int ksl = lane & 7, cl = wid * 8 + (lane >> 3), col = col0 + cl;
    const bf16_t* pm = (const bf16_t*)(p.ws + OFF_PM);
    bf16_t* oraw = (bf16_t*)(p.ws + OFF_ORAW);
    __syncthreads();
    f32x2 S2[4];
#pragma unroll
    for (int i = 0; i < 4; ++i) { S2[i].x = (is_scan && s_in) ? s_in[(ksl * 8 + 2 * i) * 64 + col] : 0.f; S2[i].y = (is_scan && s_in) ? s_in[(ksl * 8 + 2 * i + 1) * 64 + col] : 0.f; }
    const int tl = lane >> 4, d4 = (lane & 15) * 4, hd4 = h * 64 + d4;
    f32x4 cw[3][4]; float c_a = 0.f, c_dt = 0.f; f32x4 gkw[16]; f32x4 gkb = (f32x4){0.f, 0.f, 0.f, 0.f}, lb4 = (f32x4){0.f, 0.f, 0.f, 0.f};
    if (MIX == 0) {
        const float* cwp = p.in[10] + (size_t)layer * 4 * 768;
#pragma unroll
        for (int s = 0; s < 3; ++s)
#pragma unroll
            for (int j = 0; j < 4; ++j) cw[s][j] = *(const f32x4*)(cwp + j * 768 + s * 256 + hd4);
        c_a = -__expf(p.in[11][layer * 4 + h]); c_dt = p.in[12][layer * 4 + h];
        if (conv_out && col0 == 0 && h == 0) {
            for (int idx = tid; idx < 3 * 768; idx += 512) { const int i = idx / 768, c = idx - i * 768, ti = L - 3 + i;
                conv_out[idx] = ti >= 0 ? bf2f(pm[(size_t)(tokbase + ti) * NPM + A_QKV + c]) : (conv_in ? conv_in[(3 + ti) * 768 + c] : 0.f); }
        }
    } else if (MIX == 1) {
#pragma unroll
        for (int r = 0; r < 16; ++r) gkw[r] = *(const f32x4*)(p.in[14] + ((size_t)layer * 16 + r) * 256 + hd4);
        gkb = *(const f32x4*)(p.in[15] + layer * 256 + hd4);
    } else {
        const float* lg = p.in[26] + hd4; const f32x4 a0 = *(const f32x4*)lg, a1 = *(const f32x4*)(lg + 256), a2 = *(const f32x4*)(lg + 512), a3 = *(const f32x4*)(lg + 768);
#pragma unroll
        for (int e = 0; e < 4; ++e) {
            const float mx = fmaxf(fmaxf(a0[e], a1[e]), fmaxf(a2[e], a3[e])); const float l0 = __expf(a0[e] - mx), l1 = __expf(a1[e] - mx), l2 = __expf(a2[e] - mx), l3 = __expf(a3[e] - mx);
            const float inv = 1.0f / (l0 + l1 + l2 + l3);
            lb4[e] = (layer == 0) ? 0.f : (layer == 1) ? l1 * inv : (layer == 2) ? (l1 + l2) * inv : (l1 + l2 + l3) * inv;
        }
    }
    const int nch = (L + TCH - 1) / TCH;
    auto prep = [&](int c, int pw, int npw) {
        LAS float* kb = lds + (c & 1) * MIXBUF_FLOATS; LAS float* qb = kb + TCH * 64; LAS float* fb = qb + TCH * 64; LAS float* vb = fb + TCH * 64; LAS float* sc = vb + TCH * 64;
#pragma unroll
        for (int pass = 0; pass < 2; ++pass) {
            const int tt0 = (pass * npw + pw) * 4;
            if (tt0 < TCH) {
                const int tt = tt0 + tl, t = c * TCH + tt;
                if (t < L) {
                    const bf16_t* row = pm + (size_t)(tokbase + t) * NPM;
                    if (MIX == 0) {
                        f32x4 y[3];
#pragma unroll
                        for (int s = 0; s < 3; ++s) { f32x4 a = (f32x4){0.f, 0.f, 0.f, 0.f};
#pragma unroll
                            for (int j = 0; j < 4; ++j) { const int ti = t - 3 + j; f32x4 xv = (f32x4){0.f, 0.f, 0.f, 0.f};
                                if (ti >= 0) { const u32x2 w = *(const u32x2*)(pm + (size_t)(tokbase + ti) * NPM + A_QKV + s * 256 + hd4); xv = (f32x4){lo_bf(w.x), hi_bf(w.x), lo_bf(w.y), hi_bf(w.y)}; }
                                else if (conv_in) xv = *(const f32x4*)(conv_in + (3 + ti) * 768 + s * 256 + hd4);
                                a += xv * cw[s][j]; }
                            y[s] = (f32x4){siluf_(a[0]), siluf_(a[1]), siluf_(a[2]), siluf_(a[3])}; }
                        const float qq = red16(y[0][0] * y[0][0] + y[0][1] * y[0][1] + y[0][2] * y[0][2] + y[0][3] * y[0][3]);
                        const float kk2 = red16(y[1][0] * y[1][0] + y[1][1] * y[1][1] + y[1][2] * y[1][2] + y[1][3] * y[1][3]);
                        const f32x4 qn = y[0] * (rsqrtf(qq + EPS) * 0.125f), kn = y[1] * rsqrtf(kk2 + EPS);
                        const float kq = red16(qn[0] * kn[0] + qn[1] * kn[1] + qn[2] * kn[2] + qn[3] * kn[3]);
                        *(LAS f32x4*)(kb + tt * 64 + d4) = kn; *(LAS f32x4*)(qb + tt * 64 + d4) = qn; *(LAS f32x4*)(vb + tt * 64 + d4) = y[2];
                        if ((lane & 15) == 0) { const float al = bf2f(row[A_ALPHA + h]) + c_dt; const float sp = fmaxf(al, 0.f) + __logf(1.0f + __expf(-fabsf(al)));
                            *(LAS f32x4*)(sc + tt * 4) = (f32x4){__expf(c_a * sp), sigmoidf_(bf2f(row[A_BETA + h])), kq, 0.f}; }
                    } else if (MIX == 1) {
                        const u32x4 g0 = *(const u32x4*)(row + B_GK), g1 = *(const u32x4*)(row + B_GK + 8);
                        const u32x2 wq = *(const u32x2*)(row + B_Q + hd4), wk = *(const u32x2*)(row + B_K + hd4), wv = *(const u32x2*)(row + B_V + hd4);
                        f32x4 z = gkb;
                        z += lo_bf(g0.x) * gkw[0] + hi_bf(g0.x) * gkw[1] + lo_bf(g0.y) * gkw[2] + hi_bf(g0.y) * gkw[3] + lo_bf(g0.z) * gkw[4] + hi_bf(g0.z) * gkw[5] + lo_bf(g0.w) * gkw[6] + hi_bf(g0.w) * gkw[7];
                        z += lo_bf(g1.x) * gkw[8] + hi_bf(g1.x) * gkw[9] + lo_bf(g1.y) * gkw[10] + hi_bf(g1.y) * gkw[11] + lo_bf(g1.z) * gkw[12] + hi_bf(g1.z) * gkw[13] + lo_bf(g1.w) * gkw[14] + hi_bf(g1.w) * gkw[15];
                        f32x4 f;
#pragma unroll
                        for (int e = 0; e < 4; ++e) { const float sp = fmaxf(-z[e], 0.f) + __logf(1.0f + __expf(-fabsf(z[e]))); f[e] = __expf(-sp * (1.0f / 16.0f)); }
                        *(LAS f32x4*)(fb + tt * 64 + d4) = f;
                        *(LAS f32x4*)(qb + tt * 64 + d4) = (f32x4){lo_bf(wq.x), hi_bf(wq.x), lo_bf(wq.y), hi_bf(wq.y)} * 0.125f;
                        *(LAS f32x4*)(kb + tt * 64 + d4) = (f32x4){lo_bf(wk.x), hi_bf(wk.x), lo_bf(wk.y), hi_bf(wk.y)};
                        *(LAS f32x4*)(vb + tt * 64 + d4) = (f32x4){lo_bf(wv.x), hi_bf(wv.x), lo_bf(wv.y), hi_bf(wv.y)};
                    } else {
                        const u32x2 wq = *(const u32x2*)(row + D_Q + hd4), wf = *(const u32x2*)(row + D_F + hd4), wv = *(const u32x2*)(row + D_I + hd4);
                        const f32x4 xq = (f32x4){lo_bf(wq.x), hi_bf(wq.x), lo_bf(wq.y), hi_bf(wq.y)}, xf = (f32x4){lo_bf(wf.x), hi_bf(wf.x), lo_bf(wf.y), hi_bf(wf.y)};
                        f32x4 f, k, q;
#pragma unroll
                        for (int e = 0; e < 4; ++e) { const float sg = sigmoidf_(xf[e]); f[e] = lb4[e] + (1.0f - lb4[e]) * sg; k[e] = (1.0f - lb4[e]) * (1.0f - sg); q[e] = siluf_(xq[e]) * 0.125f; }
                        *(LAS f32x4*)(fb + tt * 64 + d4) = f; *(LAS f32x4*)(kb + tt * 64 + d4) = k; *(LAS f32x4*)(qb + tt * 64 + d4) = q;
                        *(LAS f32x4*)(vb + tt * 64 + d4) = (f32x4){lo_bf(wv.x), hi_bf(wv.x), lo_bf(wv.y), hi_bf(wv.y)};
                    }
                }
            }
        }
    };
    prep(0, wid, 8);
    __syncthreads();
    for (int c = 0; c < nch; ++c) {
        if (is_scan) {
            const LAS float* kb = lds + (c & 1) * MIXBUF_FLOATS; const LAS float* qb = kb + TCH * 64; const LAS float* fb = qb + TCH * 64; const LAS float* vb = fb + TCH * 64; const LAS float* sc = vb + TCH * 64;
            const int ntok = (L - c * TCH) < TCH ? (L - c * TCH) : TCH;
            bf16_t* op = oraw + (size_t)(tokbase + c * TCH) * 768 + MIX * 256 + h * 64 + col;
            const LAS float* kp = kb + ksl * 8; const LAS float* qp = qb + ksl * 8; const LAS float* fp = fb + ksl * 8; const LAS float* vp = vb + col;
            f32x4 k0 = *(const LAS f32x4*)kp, k1 = *(const LAS f32x4*)(kp + 4), q0 = *(const LAS f32x4*)qp, q1 = *(const LAS f32x4*)(qp + 4);
            f32x4 f0 = (f32x4){0.f, 0.f, 0.f, 0.f}, f1 = f0, scv = f0;
            if (MIX == 0) scv = *(const LAS f32x4*)sc; else { f0 = *(const LAS f32x4*)fp; f1 = *(const LAS f32x4*)(fp + 4); }
            float v = vp[0];
            float okeep = 0.f;
            __builtin_amdgcn_s_setprio(3);
#pragma unroll 2
            for (int tt = 0; tt < ntok; ++tt) {
                const int tn = (tt + 1 < TCH) ? tt + 1 : tt;
                const f32x4 nk0 = *(const LAS f32x4*)(kp + tn * 64), nk1 = *(const LAS f32x4*)(kp + tn * 64 + 4), nq0 = *(const LAS f32x4*)(qp + tn * 64), nq1 = *(const LAS f32x4*)(qp + tn * 64 + 4);
                f32x4 nf0 = f0, nf1 = f1, nsc = scv;
                if (MIX == 0) nsc = *(const LAS f32x4*)(sc + tn * 4); else { nf0 = *(const LAS f32x4*)(fp + tn * 64); nf1 = *(const LAS f32x4*)(fp + tn * 64 + 4); }
                const float nv = vp[tn * 64];
                float o;
                if (MIX == 0) {
                    const float eg = scv[0], beta = scv[1], kq = scv[2];
                    const f32x2 ka = {k0[0], k0[1]}, kb2 = {k0[2], k0[3]}, kc = {k1[0], k1[1]}, kd = {k1[2], k1[3]};
                    const f32x2 qa = {q0[0], q0[1]}, qb2 = {q0[2], q0[3]}, qc = {q1[0], q1[1]}, qd = {q1[2], q1[3]};
                    f32x2 dk2 = S2[0] * ka; dk2 = S2[1] * kb2 + dk2; dk2 = S2[2] * kc + dk2; dk2 = S2[3] * kd + dk2;
                    f32x2 dq2 = S2[0] * qa; dq2 = S2[1] * qb2 + dq2; dq2 = S2[2] * qc + dq2; dq2 = S2[3] * qd + dq2;
                    const float dk = red8(dk2.x + dk2.y), dq = red8(dq2.x + dq2.y);
                    const float delta = beta * (v - eg * dk);
                    const f32x2 eg2 = {eg, eg}, de2 = {delta, delta};
                    S2[0] = ka * de2 + S2[0] * eg2; S2[1] = kb2 * de2 + S2[1] * eg2; S2[2] = kc * de2 + S2[2] * eg2; S2[3] = kd * de2 + S2[3] * eg2;
                    o = eg * dq + kq * delta;
                } else {
#pragma unroll
                    for (int i = 0; i < 1; ++i) {}
                    const f32x2 v2 = {v, v};
                    S2[0] = (f32x2){k0[0], k0[1]} * v2 + (f32x2){f0[0], f0[1]} * S2[0]; S2[1] = (f32x2){k0[2], k0[3]} * v2 + (f32x2){f0[2], f0[3]} * S2[1];
                    S2[2] = (f32x2){k1[0], k1[1]} * v2 + (f32x2){f1[0], f1[1]} * S2[2]; S2[3] = (f32x2){k1[2], k1[3]} * v2 + (f32x2){f1[2], f1[3]} * S2[3];
                    f32x2 dq2 = S2[0] * (f32x2){q0[0], q0[1]}; dq2 = S2[1] * (f32x2){q0[2], q0[3]} + dq2; dq2 = S2[2] * (f32x2){q1[0], q1[1]} + dq2; dq2 = S2[3] * (f32x2){q1[2], q1[3]} + dq2;
                    o = red8(dq2.x + dq2.y);
                }
                okeep = ((tt & 7) == ksl) ? o : okeep;
                if ((tt & 7) == 7) op[(size_t)(tt - 7 + ksl) * 768] = f2bf(okeep);
                k0 = nk0; k1 = nk1; q0 = nq0; q1 = nq1; f0 = nf0; f1 = nf1; scv = nsc; v = nv;
            }
            __builtin_amdgcn_s_setprio(0);
            { const int rem = ntok & 7; if (ksl < rem) op[(size_t)(ntok - rem + ksl) * 768] = f2bf(okeep); }
        } else if (c + 1 < nch) prep(c + 1, wid - (nscan >> 6), 8 - (nscan >> 6));
        __syncthreads();
    }
    if (is_scan) {
#pragma unroll
        for (int i = 0; i < 4; ++i) { s_out[(ksl * 8 + 2 * i) * 64 + col] = S2[i].x; s_out[(ksl * 8 + 2 * i + 1) * 64 + col] = S2[i].y; }
    }
}

constexpr int S5_BU_LD = 132, S5_XB_LD = 136, S5_WAVE_BYTES = 16 * S5_BU_LD * 4 + 16 * S5_XB_LD * 2;
template <bool SAMPLE>
__device__ __forceinline__ void s5_wave_item(KPR p, int layer, LAS unsigned char* wl, int g, int tokbase, int L, int seq0) {
    const int lane = otid() & 63, col = lane & 15, quad = lane >> 4;
    const bf16_t* pm = (const bf16_t*)(p.ws + OFF_PM); bf16_t* yg = (bf16_t*)(p.ws + OFF_YG);
    LAS float* bu = (LAS float*)wl; LAS bf16_t* xb = (LAS bf16_t*)(wl + 16 * S5_BU_LD * 4);
    const int lg = layer * 16 + g;
    float ar, ai, zr, zi;
    { const float lr = fminf(p.in[17][lg * 64 + lane], -1e-4f), li = p.in[18][lg * 64 + lane], dt = __expf(p.in[24][lg]);
      const float mag = __expf(lr * dt); float rev = li * dt * 0.15915494309f; rev -= rintf(rev);
      const float sn = __builtin_amdgcn_sinf(rev), cs = __builtin_amdgcn_cosf(rev); ar = mag * cs; ai = mag * sn;
      const float den = lr * lr + li * li; zr = ((ar - 1.0f) * lr + ai * li) / den; zi = (ai * lr - (ar - 1.0f) * li) / den; }
    bf16x8 Bf[8], Cf[4];
#pragma unroll
    for (int tt = 0; tt < 4; ++tt) {
        const int pp = tt * 16 + col; const float zr2 = __shfl(zr, pp), zi2 = __shfl(zi, pp);
        float bre[8], bim[8];
#pragma unroll
        for (int j = 0; j < 8; ++j) { bre[j] = 0.f; bim[j] = 0.f; }
        if (quad < 2) {
            const float* br_ = p.in[19] + ((size_t)lg * 64 + pp) * 16 + quad * 8; const float* bi_ = p.in[20] + ((size_t)lg * 64 + pp) * 16 + quad * 8;
#pragma unroll
            for (int j = 0; j < 8; ++j) { const float r = br_[j], i = bi_[j]; bre[j] = zr2 * r - zi2 * i; bim[j] = zr2 * i + zi2 * r; }
        }
        u32x4 wr_, wi_;
        wr_.x = cvt_pk_bf16(bre[0], bre[1]); wr_.y = cvt_pk_bf16(bre[2], bre[3]); wr_.z = cvt_pk_bf16(bre[4], bre[5]); wr_.w = cvt_pk_bf16(bre[6], bre[7]);
        wi_.x = cvt_pk_bf16(bim[0], bim[1]); wi_.y = cvt_pk_bf16(bim[2], bim[3]); wi_.z = cvt_pk_bf16(bim[4], bim[5]); wi_.w = cvt_pk_bf16(bim[6], bim[7]);
        Bf[tt] = __builtin_bit_cast(bf16x8, wr_); Bf[4 + tt] = __builtin_bit_cast(bf16x8, wi_);
    }
#pragma unroll
    for (int kb = 0; kb < 4; ++kb) {
        const int k0 = (kb & 1) * 32 + quad * 8; const float sgn = kb < 2 ? 1.0f : -1.0f;
        const float* cp = (kb < 2 ? p.in[21] : p.in[22]) + ((size_t)lg * 16 + col) * 64 + k0;
        u32x4 w; w.x = cvt_pk_bf16(sgn * cp[0], sgn * cp[1]); w.y = cvt_pk_bf16(sgn * cp[2], sgn * cp[3]); w.z = cvt_pk_bf16(sgn * cp[4], sgn * cp[5]); w.w = cvt_pk_bf16(sgn * cp[6], sgn * cp[7]);
        Cf[kb] = __builtin_bit_cast(bf16x8, w);
    }
    const float dcoef = p.in[23][layer * 256 + g * 16 + col];
    float xr = 0.f, xi = 0.f;
    const int nch = SAMPLE ? 1 : (L + 15) / 16;
    u32x4 awn = (u32x4){0u, 0u, 0u, 0u}; bf16_t un[4] = {0, 0, 0, 0};
    auto pf = [&](int cc) {
        const int t0 = cc * 16; const int nrow = SAMPLE ? 16 : ((L - t0) < 16 ? (L - t0) : 16);
        awn = (u32x4){0u, 0u, 0u, 0u};
        if (quad < 2 && col < nrow) awn = *(const u32x4*)(pm + (size_t)(tokbase + t0 + col) * NPM + C_U + g * 16 + quad * 8);
#pragma unroll
        for (int i = 0; i < 4; ++i) { const int r = quad * 4 + i; un[i] = (r < nrow) ? pm[(size_t)(tokbase + t0 + r) * NPM + C_U + g * 16 + col] : (bf16_t)0; }
    };
    pf(0);
    for (int c = 0; c < nch; ++c) {
        const int t0 = c * 16; const int nrow = SAMPLE ? 16 : ((L - t0) < 16 ? (L - t0) : 16);
        const u32x4 aw = awn; bf16_t uc[4];
#pragma unroll
        for (int i = 0; i < 4; ++i) uc[i] = un[i];
        if (c + 1 < nch) pf(c + 1);
        const bf16x8 af = __builtin_bit_cast(bf16x8, aw);
#pragma unroll
        for (int tile = 0; tile < 8; ++tile) {
            const f32x4 d = __builtin_amdgcn_mfma_f32_16x16x32_bf16(af, Bf[tile], (f32x4){0.f, 0.f, 0.f, 0.f}, 0, 0, 0);
#pragma unroll
            for (int i = 0; i < 4; ++i) bu[(quad * 4 + i) * S5_BU_LD + tile * 16 + col] = d[i];
        }
        __builtin_amdgcn_fence(__ATOMIC_RELEASE, "wavefront"); __builtin_amdgcn_wave_barrier(); __builtin_amdgcn_fence(__ATOMIC_ACQUIRE, "wavefront");
        for (int r = 0; r < 16; ++r) {
            float nr = 0.f, ni = 0.f;
            if (r < nrow) {
                if (SAMPLE) { const size_t si = ((size_t)(layer * NDEC + seq0 + r) * 16 + g) * 64 + lane; xr = p.in[5][si]; xi = p.in[6][si]; }
                const float br_ = bu[r * S5_BU_LD + lane], bi_ = bu[r * S5_BU_LD + 64 + lane];
                nr = ar * xr - ai * xi + br_; ni = ar * xi + ai * xr + bi_; xr = nr; xi = ni;
                if (SAMPLE) { const size_t so = ((size_t)(layer * NDEC + seq0 + r) * 16 + g) * 64 + lane; p.out[O_SS5R + so] = nr; p.out[O_SS5I + so] = ni; }
            }
            xb[r * S5_XB_LD + lane] = f2bf(nr); xb[r * S5_XB_LD + 64 + lane] = f2bf(ni);
        }
        __builtin_amdgcn_fence(__ATOMIC_RELEASE, "wavefront"); __builtin_amdgcn_wave_barrier(); __builtin_amdgcn_fence(__ATOMIC_ACQUIRE, "wavefront");
        f32x4 ya = (f32x4){0.f, 0.f, 0.f, 0.f};
#pragma unroll
        for (int kb = 0; kb < 4; ++kb) { const bf16x8 xf = *(const LAS bf16x8*)(xb + col * S5_XB_LD + kb * 32 + quad * 8); ya = __builtin_amdgcn_mfma_f32_16x16x32_bf16(xf, Cf[kb], ya, 0, 0, 0); }
#pragma unroll
        for (int i = 0; i < 4; ++i) { const int r = quad * 4 + i;
            if (r < nrow) { const size_t tok = (size_t)(tokbase + t0 + r); const float uu = bf2f(uc[i]);
                const float y = ya[i] + dcoef * uu; const float ge = y * __builtin_amdgcn_rcpf(1.0f + __expf(-1.5957691216f * (y + 0.044715f * y * y * y)));
                yg[tok * 256 + g * 16 + col] = f2bf(ge); } }
        __builtin_amdgcn_fence(__ATOMIC_RELEASE, "wavefront"); __builtin_amdgcn_wave_barrier(); __builtin_amdgcn_fence(__ATOMIC_ACQUIRE, "wavefront");
    }
    if (!SAMPLE) { const size_t so = ((size_t)(layer * NBATCH + seq0) * 16 + g) * 64 + lane; p.out[O_PS5R + so] = xr; p.out[O_PS5I + so] = xi; }
}

__device__ __forceinline__ void phase_mix(KPR p, int layer, LAS unsigned char* ldsb, int bid, int G) {
    LAS float* lds = (LAS float*)ldsb;
    const int wid = __builtin_amdgcn_readfirstlane(otid() >> 6);
    constexpr int NLONG = 208, NSHORT = 16 + 1536;
    for (int it = bid; it < NLONG; it += G) {
        if (it < 192) {
            const int mix = it >> 6, r = it & 63, b = r >> 3, hh = (r >> 1) & 3, half = r & 1;
            const size_t so = ((size_t)(layer * NBATCH + b) * 4 + hh) * 4096;
            if (mix == 0) mix_item<0>(p, layer, lds, b * SEQ, SEQ, hh, half * 32, 32, nullptr, p.out + O_PGDN + so, nullptr, p.out + O_PCONV + (size_t)(layer * NBATCH + b) * 2304);
            else if (mix == 1) mix_item<1>(p, layer, lds, b * SEQ, SEQ, hh, half * 32, 32, nullptr, p.out + O_PGLA + so, nullptr, nullptr);
            else mix_item<2>(p, layer, lds, b * SEQ, SEQ, hh, half * 32, 32, nullptr, p.out + O_PHG + so, nullptr, nullptr);
        } else {
            __syncthreads();
            const int j = (it - 192) * 8 + wid, b = j >> 4, g = j & 15;
            s5_wave_item<false>(p, layer, ldsb + wid * S5_WAVE_BYTES, g, b * SEQ, SEQ, b);
        }
    }
    int js = bid, jstep = G, jend = NSHORT;
    if (G >= 256) { if (bid >= 192) { js = bid - 192; jstep = 64; jend = 1040; } else if (bid >= 64) { js = 1040 + (bid - 64) * 4; jstep = 1; jend = js + 4; } else { js = 0; jend = 0; } }
    for (int j = js; j < jend; j += jstep) {
        if (j < 16) {
            __syncthreads();
            const int jj = j * 8 + wid, g = jj & 15, s0 = (jj >> 4) * 16;
            s5_wave_item<true>(p, layer, ldsb + wid * S5_WAVE_BYTES, g, MPROMPT + s0, 16, s0);
        } else {
            const int jj = j - 16, mix = jj >> 9, s = (jj & 511) >> 2, hh = jj & 3;
            const size_t so = ((size_t)(layer * NDEC + s) * 4 + hh) * 4096;
            if (mix == 0) mix_item<0>(p, layer, lds, MPROMPT + s, 1, hh, 0, 64, p.in[3] + so, p.out + O_SGDN + so, p.in[2] + (size_t)(layer * NDEC + s) * 2304, p.out + O_SCONV + (size_t)(layer * NDEC + s) * 2304);
            else if (mix == 1) mix_item<1>(p, layer, lds, MPROMPT + s, 1, hh, 0, 64, p.in[4] + so, p.out + O_SGLA + so, nullptr, nullptr);
            else mix_item<2>(p, layer, lds, MPROMPT + s, 1, hh, 0, 64, p.in[7] + so, p.out + O_SHG + so, nullptr, nullptr);
        }
    }
    __syncthreads();
}

__device__ __forceinline__ void phase_headnorm(KPR p, int layer, int bid, int G) {
    const int tid_ = otid(); const int wid = __builtin_amdgcn_readfirstlane(tid_ >> 6), lane = tid_ & 63;
    const bf16_t* pm = (const bf16_t*)(p.ws + OFF_PM); const bf16_t* oraw = (const bf16_t*)(p.ws + OFF_ORAW); bf16_t* br = (bf16_t*)(p.ws + OFF_BR);
    for (int j = bid * 8 + wid; j < MTOK * 3; j += G * 8) {
        const int tok = j / 3, mix = j - tok * 3;
        const int gcol = mix == 0 ? A_GATE : (mix == 1 ? B_GATE : D_GATE), slot = mix == 2 ? 3 : mix;
        const float* nw = (mix == 0 ? p.in[13] : (mix == 1 ? p.in[16] : p.in[27])) + layer * 256 + lane * 4;
        const u32x2 ow = *(const u32x2*)(oraw + (size_t)tok * 768 + mix * 256 + lane * 4);
        const u32x2 gw = *(const u32x2*)(pm + (size_t)tok * NPM + gcol + lane * 4);
        const float o0 = lo_bf(ow.x), o1 = hi_bf(ow.x), o2 = lo_bf(ow.y), o3 = hi_bf(ow.y);
        float ss = o0 * o0 + o1 * o1 + o2 * o2 + o3 * o3;
        ss += __shfl_xor(ss, 1); ss += __shfl_xor(ss, 2); ss += __shfl_xor(ss, 4); ss += __shfl_xor(ss, 8);
        const float rs = rsqrtf(ss * (1.0f / 64.0f) + EPS);
        const f32x4 w = *(const f32x4*)nw;
        u32x2 r; r.x = cvt_pk_bf16(o0 * rs * w[0] * siluf_(lo_bf(gw.x)), o1 * rs * w[1] * siluf_(hi_bf(gw.x)));
        r.y = cvt_pk_bf16(o2 * rs * w[2] * siluf_(lo_bf(gw.y)), o3 * rs * w[3] * siluf_(hi_bf(gw.y)));
        *(u32x2*)(br + (size_t)tok * 1024 + slot * 256 + lane * 4) = r;
    }
}

constexpr int PH_PER_LAYER = 9, N_PHASES = 4 * PH_PER_LAYER + 1;
__device__ __forceinline__ void run_phase(KPR p, int ph, LAS unsigned char* lds, int bid, int G) {
    unsigned char* ws = p.ws;
    if (ph == N_PHASES - 1) { phase_norm(p, p.in[34], 2, bid, G); return; }
    const int layer = ph / PH_PER_LAYER, s = ph - layer * PH_PER_LAYER;
    pg8::Sched S; pg8::Gemm g;
    switch (s) {
    case 0: phase_convert(p, layer, (LAS float*)lds, bid, G); phase_norm(p, p.in[8] + layer * 1024, layer == 0 ? 0 : 1, bid, G); break;
    case 1: { S.init(65, 30, 1, G, bid, 16); g = pg8::Gemm{(const bf16_t*)(ws + OFF_XN), (const bf16_t*)(ws + OFF_WIN), 1024, 1024, 16, 0, 0};
              pg8::gemm_phase(lds, g, S, EpiIn{(bf16_t*)(ws + OFF_PM), (bf16_t*)(ws + OFF_GATES)}); } break;
    case 2: phase_mix(p, layer, lds, bid, G); break;
    case 3: { S.init(65, 2, 1, G, bid, 4); g = pg8::Gemm{(const bf16_t*)(ws + OFF_YG), (const bf16_t*)(ws + OFF_WGLU), 256, 256, 4, 0, 0};
              pg8::gemm_phase(lds, g, S, EpiGlu{(bf16_t*)(ws + OFF_BR)}); phase_headnorm(p, layer, bid, G); } break;
    case 4: { S.init(65, 4, 4, G, bid, 4); g = pg8::Gemm{(const bf16_t*)(ws + OFF_BR), (const bf16_t*)(ws + OFF_WBR), 1024, 256, 4, 256, (size_t)1024 * 256};
              pg8::gemm_phase(lds, g, S, EpiBr{(const bf16_t*)(ws + OFF_GATES), (bf16_t*)(ws + OFF_PM)}); } break;
    case 5: { S.init(64, 4, 1, G, bid, 16, 4); g = pg8::Gemm{(const bf16_t*)(ws + OFF_PM), (const bf16_t*)(ws + OFF_WOUT), 1024, 1024, 16, 0, 0};
              pg8::gemm_phase(lds, g, S, EpiRes{(float*)(ws + OFF_H)}); } break;
    case 6: phase_norm(p, p.in[30] + layer * 1024, 1, bid, G); break;
    case 7: { S.init(65, 22, 1, G, bid, 16); g = pg8::Gemm{(const bf16_t*)(ws + OFF_XN), (const bf16_t*)(ws + OFF_WGU), 1024, 1024, 16, 0, 0};
              pg8::gemm_phase(lds, g, S, EpiGU{(bf16_t*)(ws + OFF_PM)}); } break;
    case 8: { S.init(64, 4, 1, G, bid, 44, 4); g = pg8::Gemm{(const bf16_t*)(ws + OFF_PM), (const bf16_t*)(ws + OFF_WDN), DFF, DFF, 44, 0, 0};
              pg8::gemm_phase(lds, g, S, EpiRes{(float*)(ws + OFF_H)}); } break;
    }
}

extern __shared__ __attribute__((aligned(16))) unsigned char dyn_smem[];
#if MULTI_LAUNCH
__global__ void __launch_bounds__(512) k_phase(KP parg, int ph) {
    KPR p = *(const CAS KP*)__builtin_amdgcn_kernarg_segment_ptr();
    run_phase(p, ph, (LAS unsigned char*)dyn_smem, blockIdx.x, gridDim.x);
}
#else
#define XB_TMO      128
#define XB_XCNT(j)  (256  + 64 * (j))
#define XB_XSUB(j)  (1280 + 64 * (j))
#define XB_XGEN(j)  (2304 + 64 * (j))
#define XB_TOP      3328
#define XB_TOPGEN   3392
#define XCD_BAR_WORDS 3456
#define XB_SPIN_CAP (1u << 22)
__device__ __forceinline__ unsigned xb_ld(unsigned* q)              { return __hip_atomic_load(q, __ATOMIC_RELAXED, __HIP_MEMORY_SCOPE_AGENT); }
__device__ __forceinline__ unsigned xb_add(unsigned* q, unsigned v) { return __hip_atomic_fetch_add(q, v, __ATOMIC_RELAXED, __HIP_MEMORY_SCOPE_AGENT); }
__device__ __forceinline__ unsigned xb_xcc_id() { return (unsigned)__builtin_amdgcn_s_getreg((3 << 11) | 20) & 0xFu; }
#define XB_SPIN(cond, bar) do { unsigned _sp = 0; while (cond) { __builtin_amdgcn_s_sleep(1); \
    if ((++_sp & 255u) == 0u) { if (xb_ld(&(bar)[XB_TMO])) break; if (_sp > XB_SPIN_CAP) { atomicAdd(&(bar)[XB_TMO], 1u); break; } } } } while (0)
__device__ __forceinline__ void xcd_barrier_complete(unsigned* bar, unsigned x, unsigned G, unsigned& nloc, unsigned& nx) {
    unsigned sum, cnt, mine, sp = 0u;
    for (;;) {
        sum = 0u; cnt = 0u; mine = 0u;
#pragma unroll
        for (unsigned j = 0; j < 16; ++j) { const unsigned c = xb_ld(&bar[XB_XCNT(j)]); sum += c; cnt += (c > 0u) ? 1u : 0u; mine = (j == x) ? c : mine; }
        if (sum == G) break;
        __builtin_amdgcn_s_sleep(1);
        if ((++sp & 255u) == 0u) { if (xb_ld(&bar[XB_TMO])) break; if (sp > XB_SPIN_CAP) { atomicAdd(&bar[XB_TMO], 1u); break; } }
    }
    nloc = mine > 0u ? mine : 1u; nx = cnt > 0u ? cnt : 1u;
}
__device__ __forceinline__ void grid_bar(unsigned* bar, volatile LAS unsigned* st, int G) {
    asm volatile("s_waitcnt vmcnt(0)" ::: "memory");
    __syncthreads();
    if (otid() == 0) {
        __builtin_amdgcn_s_waitcnt(0);
        const unsigned x = xb_xcc_id();
        unsigned nloc = st[0], nx = st[1];
        if (nloc == 0u) { xcd_barrier_complete(bar, x, (unsigned)G, nloc, nx); st[0] = nloc; st[1] = nx; }
        const unsigned old = xb_add(&bar[XB_XSUB(x)], 1u);
        const unsigned gen = old / nloc;
        if (old + 1u == (gen + 1u) * nloc) {
            __builtin_amdgcn_fence(__ATOMIC_RELEASE, "agent");
            asm volatile("s_waitcnt vmcnt(0)" ::: "memory");
            const unsigned og = xb_add(&bar[XB_TOP], 1u);
            const unsigned tg = og / nx;
            if (og + 1u == (tg + 1u) * nx) xb_add(&bar[XB_TOPGEN], 1u);
            else XB_SPIN(xb_ld(&bar[XB_TOPGEN]) == tg, bar);
            __builtin_amdgcn_fence(__ATOMIC_ACQUIRE, "agent");
            xb_add(&bar[XB_XGEN(x)], 1u);
            asm volatile("s_waitcnt vmcnt(0)" ::: "memory");
        } else {
            XB_SPIN(xb_ld(&bar[XB_XGEN(x)]) == gen, bar);
            __builtin_amdgcn_fence(__ATOMIC_ACQUIRE, "agent");
            asm volatile("s_waitcnt vmcnt(0)" ::: "memory");
        }
    }
    __syncthreads();
}
template <int PH> __device__ __forceinline__ void run_from(KPR p, cg::grid_group& grid) {
    const CAS KP* pp = &p; asm volatile("" : "+s"(pp));
    int bid = blockIdx.x, G = gridDim.x; asm volatile("" : "+s"(bid), "+s"(G));
    run_phase(*pp, PH, (LAS unsigned char*)dyn_smem, bid, G);
    if constexpr (PH + 1 < N_PHASES) {
        if constexpr (PH == 0) grid.sync();
        else grid_bar((unsigned*)(pp->ws + OFF_BAR), (volatile LAS unsigned*)((LAS unsigned char*)dyn_smem + pg8::STAGE_BYTES), G);
        run_from<PH + 1>(p, grid);
    }
}
__global__ void __launch_bounds__(512) k_mega(KP parg) {
    cg::grid_group grid = cg::this_grid();
    KPR p = *(const CAS KP*)__builtin_amdgcn_kernarg_segment_ptr();
    if (threadIdx.x == 0) { volatile LAS unsigned* st = (volatile LAS unsigned*)((LAS unsigned char*)dyn_smem + pg8::STAGE_BYTES); st[0] = 0u; st[1] = 0u;
        (void)xb_add(&((unsigned*)(p.ws + OFF_BAR))[XB_XCNT(xb_xcc_id())], 1u); }
    __syncthreads();
    run_from<0>(p, grid);
}
#endif

extern "C" void kernel_launch(void* const* d_in, const int* in_sizes, int n_in, void* d_out, int out_size, void* d_ws, size_t ws_size, hipStream_t stream) {
    if (ws_size < WS_NEED || n_in < 35) { fprintf(stderr, "workspace too small: %zu < %zu\n", ws_size, (size_t)WS_NEED); return; }
    KP p{};
    for (int i = 0; i < 35; ++i) p.in[i] = (const float*)d_in[i];
    p.out = (float*)d_out; p.ws = (unsigned char*)d_ws;
    constexpr size_t kDynLds = pg8::STAGE_BYTES + 16;
#if MULTI_LAUNCH
    static bool once = false;
    if (!once) { hipFuncSetAttribute((const void*)k_phase, hipFuncAttributeMaxDynamicSharedMemorySize, (int)kDynLds); once = true; }
    for (int ph = 0; ph < N_PHASES; ++ph) hipLaunchKernelGGL(k_phase, dim3(256), dim3(512), kDynLds, stream, p, ph);
#else
    static int grid_blocks = 0;
    if (!grid_blocks) {
        hipFuncSetAttribute((const void*)k_mega, hipFuncAttributeMaxDynamicSharedMemorySize, (int)kDynLds);
        int dev = 0, cus = 0, per_cu = 0;
        hipGetDevice(&dev);
        hipDeviceGetAttribute(&cus, hipDeviceAttributeMultiprocessorCount, dev);
        hipOccupancyMaxActiveBlocksPerMultiprocessor(&per_cu, k_mega, 512, kDynLds);
        if (per_cu < 1) per_cu = 1;
        grid_blocks = cus * per_cu; if (grid_blocks > 256) grid_blocks = 256;
    }
    hipMemsetAsync((unsigned char*)d_ws + OFF_BAR, 0, 16384, stream);
    void* args[] = {&p};
    hipError_t e = hipLaunchCooperativeKernel((void*)k_mega, dim3(grid_blocks), dim3(512), args, kDynLds, stream);
    if (e != hipSuccess) fprintf(stderr, "cooperative launch failed: %s (grid %d)\n", hipGetErrorString(e), grid_blocks);
#endif
}
```

```cpp
#include <hip/hip_runtime.h>
#include <hip/hip_cooperative_groups.h>
#include <cstdio>
namespace cg = cooperative_groups;

#ifndef MULTI_LAUNCH
#define MULTI_LAUNCH 0
#endif

#define LAS __attribute__((address_space(3)))
typedef unsigned short bf16_t;
typedef short bf16x8 __attribute__((ext_vector_type(8)));
typedef float f32x4 __attribute__((ext_vector_type(4)));
typedef float f32x2 __attribute__((ext_vector_type(2)));
typedef unsigned u32x2 __attribute__((ext_vector_type(2)));
typedef unsigned u32x4 __attribute__((ext_vector_type(4)));

constexpr int DM = 1024, SEQ = 2048, NBATCH = 8, NDEC = 128;
constexpr int MPROMPT = NBATCH * SEQ;
constexpr int MTOK = MPROMPT + NDEC;
constexpr int MP = 16640;
constexpr int NPM = 3584, NGATE = 4096, NIN = 7448, DFF = 2816;
constexpr int A_QKV = 0, A_GATE = 768, B_Q = 1024, B_K = 1280, B_V = 1536, B_GATE = 1792, C_U = 2048, D_Q = 2304, D_F = 2560, D_I = 2816, D_GATE = 3072,
              A_ALPHA = 3328, A_BETA = 3332, B_GK = 3336;
constexpr float EPS = 1e-6f;

constexpr size_t SZ_WIN = (size_t)7680 * 1024 * 2, SZ_WGU = (size_t)5632 * 1024 * 2, SZ_WDN = (size_t)1024 * 2816 * 2, SZ_WOUT = (size_t)1024 * 1024 * 2,
                 SZ_WBR = (size_t)4096 * 256 * 2, SZ_WGLU = (size_t)512 * 256 * 2;
constexpr size_t OFF_WIN = 0, OFF_WGU = OFF_WIN + SZ_WIN, OFF_WDN = OFF_WGU + SZ_WGU, OFF_WOUT = OFF_WDN + SZ_WDN, OFF_WBR = OFF_WOUT + SZ_WOUT,
                 OFF_WGLU = OFF_WBR + SZ_WBR, OFF_H = OFF_WGLU + SZ_WGLU, OFF_XN = OFF_H + (size_t)MP * 1024 * 4, OFF_BR = OFF_XN + (size_t)MP * 1024 * 2,
                 OFF_PM = OFF_BR + (size_t)MP * 1024 * 2, OFF_GATES = OFF_PM + (size_t)MP * NPM * 2, OFF_ORAW = OFF_GATES + (size_t)MP * NGATE * 2,
                 OFF_YG = OFF_ORAW + (size_t)MP * 768 * 2, OFF_BAR = OFF_YG + (size_t)MP * 256 * 2, WS_NEED = OFF_BAR + 16384;
constexpr size_t O_PCONV = 16908288, O_PGDN = 16982016, O_PGLA = 17506304, O_PS5R = 18030592, O_PS5I = 18063360, O_PHG = 18096128,
                 O_SCONV = 18620416, O_SGDN = 19800064, O_SGLA = 28188672, O_SS5R = 36577280, O_SS5I = 37101568, O_SHG = 37625856;

struct KP { const float* in[35]; float* out; unsigned char* ws; };
#define CAS __attribute__((address_space(4)))
typedef const CAS KP& KPR;

__device__ __forceinline__ int otid() { int t = threadIdx.x; asm volatile("" : "+v"(t)); return t & 511; }
__device__ __forceinline__ float bf2f(bf16_t b) { return __uint_as_float(((unsigned)b) << 16); }
typedef __bf16 bf16x2_t __attribute__((ext_vector_type(2)));
__device__ __forceinline__ unsigned cvt_pk_bf16(float lo, float hi) { const f32x2 f = {lo, hi}; const bf16x2_t v = __builtin_convertvector(f, bf16x2_t); return __builtin_bit_cast(unsigned, v); }
__device__ __forceinline__ bf16_t f2bf(float f) { return (bf16_t)(cvt_pk_bf16(f, 0.f) & 0xffffu); }
__device__ __forceinline__ float lo_bf(unsigned w) { return __uint_as_float(w << 16); }
__device__ __forceinline__ float hi_bf(unsigned w) { return __uint_as_float(w & 0xffff0000u); }
__device__ __forceinline__ float sigmoidf_(float x) { return __builtin_amdgcn_rcpf(1.0f + __expf(-x)); }
__device__ __forceinline__ float siluf_(float x) { return x * __builtin_amdgcn_rcpf(1.0f + __expf(-x)); }
__device__ __forceinline__ float wave_sum(float v) {
#pragma unroll
    for (int o = 32; o >= 1; o >>= 1) v += __shfl_xor(v, o);
    return v;
}
template <int CTRL> __device__ __forceinline__ float dpp_f(float v) { return __int_as_float(__builtin_amdgcn_update_dpp(0, __float_as_int(v), CTRL, 0xf, 0xf, true)); }
__device__ __forceinline__ float red16(float v) { v += dpp_f<0xB1>(v); v += dpp_f<0x4E>(v); v += dpp_f<0x141>(v); v += dpp_f<0x140>(v); return v; }
__device__ __forceinline__ float red8(float v) { v += dpp_f<0xB1>(v); v += dpp_f<0x4E>(v); v += dpp_f<0x141>(v); return v; }

namespace pg8 {
constexpr int BM = 256, BK = 64, HALF = 128, HTB = HALF * BK * 2, STAGE_BYTES = 8 * HTB, NXCD = 8, WGM = 8;
__device__ __forceinline__ int lds_byte(int r, int c) { const int st = (r >> 4) * 2 + (c >> 5), rr = r & 15, cc = c & 31, ob = rr * 64 + cc * 2; return st * 1024 + (ob ^ (((ob >> 9) & 1) << 5)); }
__device__ __forceinline__ void stage_rc(int b, int& R, int& C) { const int st = b / 1024, sb = b % 1024, swz = sb ^ (((sb >> 9) & 1) << 5); R = (st >> 1) * 16 + swz / 64; C = (st & 1) * 32 + (swz % 64) / 2; }

struct Unit { int pm, pn, kk, k0, nt; };
struct Gemm { const bf16_t* A; const bf16_t* Bt; int lda, ldb, nt; size_t a_kk, b_kk; };
struct Sched {
    int nM, nN, nKK, nwg, G, c, ntf, nts, nextra;
    __device__ void init(int nM_, int nN_, int nKK_, int G_, int c_, int ntf_, int nts_ = 0) { nM = nM_; nN = nN_; nKK = nKK_; nwg = nM * nN; G = G_; c = c_; ntf = ntf_; nts = nts_; nextra = nts_ ? nN_ * (ntf_ / nts_) : 0; }
    __device__ bool next(int i, Unit& u) const {
        const int it = i / nKK; u.kk = i - it * nKK; u.k0 = 0; u.nt = ntf;
        const long L = (long)it * G + c;
        if (L >= nwg) { const int e = (int)(L - nwg); if (e >= nextra) return false; u.pm = nM; u.pn = e % nN; u.k0 = (e / nN) * nts; u.nt = nts; return true; }
        int wgid = (int)L; { const int q = nwg / NXCD, r = nwg % NXCD, xcd = wgid % NXCD, off = wgid / NXCD; wgid = (xcd < r ? xcd * (q + 1) : r * (q + 1) + (xcd - r) * q) + off; }
        const int nig = WGM * nN, gid = wgid / nig, fm = gid * WGM, gsz = (nM - fm) < WGM ? (nM - fm) : WGM;
        u.pm = fm + ((wgid % nig) % gsz); u.pn = (wgid % nig) / gsz; return true;
    }
};

template <class Epi>
__device__ __forceinline__ void gemm_phase(LAS unsigned char* lds, const Gemm g, const Sched& S, const Epi& E) {
    const int tid = otid(), wid = __builtin_amdgcn_readfirstlane(tid >> 6), lane = tid & 63, wr = wid >> 2, wc = wid & 3, fr = lane & 15, fq = lane >> 4;
    unsigned voffA[2], voffB[2];
#pragma unroll
    for (int i = 0; i < 2; ++i) { int R, C; stage_rc(tid * 16 + i * 8192, R, C); voffA[i] = (unsigned)(R * g.lda + C) * 2u; voffB[i] = (unsigned)(R * g.ldb + C) * 2u; }
    const size_t kstep = (size_t)(BK * 2);
    const size_t hstepA = (size_t)HALF * g.lda * 2, hstepB = (size_t)HALF * g.ldb * 2;
    const size_t tstepA = 2 * hstepA, tstepB = 2 * hstepB;
    const unsigned ldsw = (unsigned)wid * 1024u;
    const int aoff = lds_byte(wr * 64 + fr, fq * 8), boff = lds_byte(wc * 32 + fr, fq * 8);
#define PG8_SA(b, h) (((b) * 2 + (h)) * HTB)
#define PG8_SB(b, h) ((4 + (b) * 2 + (h)) * HTB)
#define PG8_STAGE(bufoff, gbase, voff) do { _Pragma("unroll") for (int _i = 0; _i < 2; ++_i) \
        __builtin_amdgcn_global_load_lds((const unsigned*)((const char*)(gbase) + (voff)[_i]), (LAS unsigned*)(lds + (bufoff) + ldsw + _i * 8192), 16, 0, 0); } while (0)
#define PG8_LDA(dst, b, h) do { _Pragma("unroll") for (int m = 0; m < 4; ++m) _Pragma("unroll") for (int k = 0; k < 2; ++k) dst[m][k] = *(const LAS bf16x8*)(lds + PG8_SA(b, h) + aoff + m * 2048 + k * 1024); } while (0)
#define PG8_LDB(dst, b, h) do { _Pragma("unroll") for (int n = 0; n < 2; ++n) _Pragma("unroll") for (int k = 0; k < 2; ++k) dst[n][k] = *(const LAS bf16x8*)(lds + PG8_SB(b, h) + boff + n * 2048 + k * 1024); } while (0)
#define PG8_MMA(ai, bj, At, Bt) do { __builtin_amdgcn_s_setprio(1); _Pragma("unroll") for (int m = 0; m < 4; ++m) _Pragma("unroll") for (int n = 0; n < 2; ++n) _Pragma("unroll") for (int k = 0; k < 2; ++k) \
        acc[ai][bj][m][n] = __builtin_amdgcn_mfma_f32_16x16x32_bf16(Bt[n][k], At[m][k], acc[ai][bj][m][n], 0, 0, 0); __builtin_amdgcn_s_setprio(0); } while (0)
#define PG8_WAIT_V(n) asm volatile("s_waitcnt vmcnt(" #n ")" ::: "memory")
#define PG8_WAIT_L(n) asm volatile("s_waitcnt lgkmcnt(" #n ")" ::: "memory")
#define PG8_BAR __builtin_amdgcn_s_barrier()
#define PG8_SCHED __builtin_amdgcn_sched_barrier(0)
    Unit cur, nxt; int ui = 0;
    if (!S.next(0, cur)) return;
    f32x4 acc[2][2][4][2];
#pragma unroll
    for (int a = 0; a < 2; ++a)
#pragma unroll
        for (int b = 0; b < 2; ++b)
#pragma unroll
            for (int m = 0; m < 4; ++m)
#pragma unroll
                for (int n = 0; n < 2; ++n) acc[a][b][m][n] = (f32x4){0.f, 0.f, 0.f, 0.f};
    bf16x8 At[4][2], B0[2][2], B1[2][2];
    const char* cA = (const char*)(g.A + (size_t)cur.kk * g.a_kk) + (size_t)cur.pm * tstepA + (size_t)cur.k0 * kstep; const char* cB = (const char*)(g.Bt + (size_t)cur.kk * g.b_kk) + (size_t)cur.pn * tstepB + (size_t)cur.k0 * kstep;
    PG8_STAGE(PG8_SB(0, 0), cB, voffB); PG8_STAGE(PG8_SA(0, 0), cA, voffA); PG8_STAGE(PG8_SB(0, 1), cB + hstepB, voffB); PG8_STAGE(PG8_SA(0, 1), cA + hstepA, voffA);
    if (wr == 1) PG8_BAR;
    PG8_WAIT_V(4); PG8_BAR;
    PG8_STAGE(PG8_SB(1, 0), cB + kstep, voffB); PG8_STAGE(PG8_SA(1, 0), cA + kstep, voffA); PG8_STAGE(PG8_SB(1, 1), cB + hstepB + kstep, voffB);
    PG8_WAIT_V(6); PG8_BAR;
    for (;;) {
        const bool has_next = S.next(ui + 1, nxt);
        const char* nA = has_next ? (const char*)(g.A + (size_t)nxt.kk * g.a_kk) + (size_t)nxt.pm * tstepA + (size_t)nxt.k0 * kstep : cA;
        const char* nB = has_next ? (const char*)(g.Bt + (size_t)nxt.kk * g.b_kk) + (size_t)nxt.pn * tstepB + (size_t)nxt.k0 * kstep : cB;
        int nt = cur.nt; asm volatile("" : "+s"(nt));
        for (int t = 0; t < nt; t += 2) {
            const bool last = (t == nt - 2);
            const char* a1 = cA + (size_t)(t + 1) * kstep;
            const char* a2 = last ? nA : cA + (size_t)(t + 2) * kstep; const char* b2 = last ? nB : cB + (size_t)(t + 2) * kstep;
            const char* a3 = a2 + kstep; const char* b3 = b2 + kstep;
            PG8_LDB(B0, 0, 0); PG8_SCHED; PG8_LDA(At, 0, 0); PG8_STAGE(PG8_SA(1, 1), a1 + hstepA, voffA);
            PG8_WAIT_L(8); PG8_BAR; PG8_WAIT_L(0); PG8_MMA(0, 0, At, B0); PG8_BAR; PG8_SCHED;
            PG8_LDB(B1, 0, 1); PG8_STAGE(PG8_SB(0, 0), b2, voffB);
            PG8_BAR; PG8_WAIT_L(0); PG8_MMA(0, 1, At, B1); PG8_BAR;
            PG8_LDA(At, 0, 1); PG8_STAGE(PG8_SA(0, 0), a2, voffA);
            PG8_BAR; PG8_WAIT_L(0); PG8_MMA(1, 0, At, B0); PG8_BAR; PG8_SCHED;
            PG8_STAGE(PG8_SB(0, 1), b2 + hstepB, voffB);
            PG8_WAIT_V(6); PG8_BAR; PG8_MMA(1, 1, At, B1); PG8_BAR;
            PG8_LDB(B0, 1, 0); PG8_SCHED; PG8_LDA(At, 1, 0); PG8_STAGE(PG8_SA(0, 1), a2 + hstepA, voffA);
            PG8_WAIT_L(8); PG8_BAR; PG8_WAIT_L(0); PG8_MMA(0, 0, At, B0); PG8_BAR; PG8_SCHED;
            PG8_LDB(B1, 1, 1); PG8_STAGE(PG8_SB(1, 0), b3, voffB);
            PG8_BAR; PG8_WAIT_L(0); PG8_MMA(0, 1, At, B1); PG8_BAR;
            PG8_LDA(At, 1, 1); PG8_STAGE(PG8_SA(1, 0), a3, voffA);
            PG8_BAR; PG8_WAIT_L(0); PG8_MMA(1, 0, At, B0); PG8_BAR; PG8_SCHED;
            PG8_STAGE(PG8_SB(1, 1), b3 + hstepB, voffB);
            PG8_WAIT_V(6); PG8_BAR; PG8_MMA(1, 1, At, B1); PG8_BAR;
        }
        E(acc, cur, wr, wc, fr, fq);
        if (!has_next) break;
#pragma unroll
        for (int a = 0; a < 2; ++a)
#pragma unroll
            for (int b = 0; b < 2; ++b)
#pragma unroll
                for (int m = 0; m < 4; ++m)
#pragma unroll
                    for (int n = 0; n < 2; ++n) acc[a][b][m][n] = (f32x4){0.f, 0.f, 0.f, 0.f};
        cur = nxt; cA = nA; cB = nB; ++ui;
    }
    PG8_WAIT_V(0);
    if (wr == 0) PG8_BAR;
    PG8_BAR;
    __builtin_amdgcn_s_waitcnt(0);
#undef PG8_SA
#undef PG8_SB
#undef PG8_STAGE
#undef PG8_LDA
#undef PG8_LDB
#undef PG8_MMA
#undef PG8_WAIT_V
#undef PG8_WAIT_L
#undef PG8_BAR
#undef PG8_SCHED
}
}
using pg8::Unit;

#define EPI_LOOP_BEGIN _Pragma("unroll") for (int ai = 0; ai < 2; ++ai) _Pragma("unroll") for (int m = 0; m < 4; ++m) { const size_t row = (size_t)(u.pm * 256 + ai * 128 + wr * 64 + m * 16 + fr); \
        _Pragma("unroll") for (int bj = 0; bj < 2; ++bj) {
#define EPI_LOOP_END } }
struct EpiIn {
    bf16_t* pm; bf16_t* gates;
    __device__ __forceinline__ void operator()(const f32x4 (&acc)[2][2][4][2], const Unit& u, int wr, int wc, int fr, int fq) const {
        const bool main_ = u.pn < 14;
        EPI_LOOP_BEGIN
#pragma unroll
            for (int n = 0; n < 2; ++n) { const int col = u.pn * 256 + bj * 128 + wc * 32 + n * 16 + fq * 4; f32x4 v = acc[ai][bj][m][n]; u32x2 w;
                if (main_) { w.x = cvt_pk_bf16(v[0], v[1]); w.y = cvt_pk_bf16(v[2], v[3]); *(u32x2*)(pm + row * NPM + col) = w; }
                else { w.x = cvt_pk_bf16(sigmoidf_(v[0]), sigmoidf_(v[1])); w.y = cvt_pk_bf16(sigmoidf_(v[2]), sigmoidf_(v[3])); *(u32x2*)(gates + row * NGATE + (col - NPM)) = w; } }
        EPI_LOOP_END
    }
};
struct EpiGlu {
    bf16_t* br;
    __device__ __forceinline__ void operator()(const f32x4 (&acc)[2][2][4][2], const Unit& u, int wr, int wc, int fr, int fq) const {
        EPI_LOOP_BEGIN
            const int j = u.pn * 128 + bj * 64 + wc * 16 + fq * 4; const f32x4 a = acc[ai][bj][m][0], b = acc[ai][bj][m][1]; u32x2 w;
            w.x = cvt_pk_bf16(a[0] * sigmoidf_(b[0]), a[1] * sigmoidf_(b[1])); w.y = cvt_pk_bf16(a[2] * sigmoidf_(b[2]), a[3] * sigmoidf_(b[3]));
            *(u32x2*)(br + row * 1024 + 512 + j) = w;
        EPI_LOOP_END
    }
};
struct EpiGU {
    bf16_t* a;
    __device__ __forceinline__ void operator()(const f32x4 (&acc)[2][2][4][2], const Unit& u, int wr, int wc, int fr, int fq) const {
        EPI_LOOP_BEGIN
            const int j = u.pn * 128 + bj * 64 + wc * 16 + fq * 4; const f32x4 g = acc[ai][bj][m][0], b = acc[ai][bj][m][1]; u32x2 w;
            w.x = cvt_pk_bf16(siluf_(g[0]) * b[0], siluf_(g[1]) * b[1]); w.y = cvt_pk_bf16(siluf_(g[2]) * b[2], siluf_(g[3]) * b[3]);
            *(u32x2*)(a + row * DFF + j) = w;
        EPI_LOOP_END
    }
};
struct EpiBr {
    const bf16_t* gates; bf16_t* mm;
    __device__ __forceinline__ void operator()(const f32x4 (&acc)[2][2][4][2], const Unit& u, int wr, int wc, int fr, int fq) const {
        const int col0 = u.pn * 256 + wc * 32 + fq * 4;
#pragma unroll
        for (int ai = 0; ai < 2; ++ai) {
            if (ai == 1 && u.pm == 64) break;
            const size_t row0 = (size_t)(u.pm * 256 + ai * 128 + wr * 64 + fr);
            u32x2 gw[4][2][2], pw[4][2][2];
#pragma unroll
            for (int m = 0; m < 4; ++m)
#pragma unroll
                for (int bj = 0; bj < 2; ++bj)
#pragma unroll
                    for (int n = 0; n < 2; ++n) { const size_t row = row0 + m * 16; const int col = col0 + bj * 128 + n * 16;
                        gw[m][bj][n] = *(const u32x2*)(gates + row * NGATE + u.kk * 1024 + col);
                        pw[m][bj][n] = (u32x2){0u, 0u}; if (u.kk > 0) pw[m][bj][n] = *(const u32x2*)(mm + row * 1024 + col); }
#pragma unroll
            for (int m = 0; m < 4; ++m)
#pragma unroll
                for (int bj = 0; bj < 2; ++bj)
#pragma unroll
                    for (int n = 0; n < 2; ++n) { const size_t row = row0 + m * 16; const int col = col0 + bj * 128 + n * 16; const f32x4 v = acc[ai][bj][m][n]; const u32x2 g = gw[m][bj][n], q = pw[m][bj][n];
                        u32x2 w; w.x = cvt_pk_bf16(lo_bf(g.x) * v[0] + lo_bf(q.x), hi_bf(g.x) * v[1] + hi_bf(q.x)); w.y = cvt_pk_bf16(lo_bf(g.y) * v[2] + lo_bf(q.y), hi_bf(g.y) * v[3] + hi_bf(q.y));
                        *(u32x2*)(mm + row * 1024 + col) = w; }
        }
    }
};
struct EpiRes {
    float* h;
    __device__ __forceinline__ void operator()(const f32x4 (&acc)[2][2][4][2], const Unit& u, int wr, int wc, int fr, int fq) const {
        const bool split = u.pm == 64;
        EPI_LOOP_BEGIN
#pragma unroll
            for (int n = 0; n < 2; ++n) { const int col = u.pn * 256 + bj * 128 + wc * 32 + n * 16 + fq * 4; float* ptr = h + row * 1024 + col;
                if (split) {
#pragma unroll
                    for (int e = 0; e < 4; ++e) __hip_atomic_fetch_add(ptr + e, acc[ai][bj][m][n][e], __ATOMIC_RELAXED, __HIP_MEMORY_SCOPE_AGENT);
                } else { const f32x4 o = *(const f32x4*)ptr; *(f32x4*)ptr = o + acc[ai][bj][m][n]; } }
        EPI_LOOP_END
    }
};

__device__ __forceinline__ int win_src_col(int n) {
    if (n < 768) return n;
    if (n < 1024) return 776 + (n - 768);
    if (n < 1792) return 1032 + (n - 1024);
    if (n < 2048) return 1816 + (n - 1792);
    if (n < 2304) return 2072 + (n - 2048);
    if (n < 3072) return 2328 + (n - 2304);
    if (n < 3328) return 3096 + (n - 3072);
    if (n < 3336) return 768 + (n - 3328);
    if (n < 3352) return 1800 + (n - 3336);
    if (n < 3584) return -1;
    return 3352 + (n - 3584);
}
__device__ __forceinline__ void phase_convert(KPR p, int layer, LAS float* tile, int bid, int G) {
    const int tid = otid(), tn = tid & 63, tk = __builtin_amdgcn_readfirstlane(tid >> 6);
    constexpr int T0 = 120 * 16, T1 = T0 + 88 * 16, T2 = T1 + 16 * 44, T3 = T2 + 16 * 16, T4 = T3 + 64 * 4, T5 = T4 + 8 * 4;
    for (int j = bid; j < T5; j += G) {
        int n0, k0, K, ld; bf16_t* dst; const float* cp = nullptr;
        if (j < T0) { const int q = j; n0 = (q >> 4) * 64; k0 = (q & 15) * 64; K = 1024; ld = NIN; dst = (bf16_t*)(p.ws + OFF_WIN);
            const int sc = win_src_col(n0 + tn); if (sc >= 0) cp = p.in[9] + (size_t)layer * 1024 * NIN + sc; }
        else if (j < T1) { const int q = j - T0; n0 = (q >> 4) * 64; k0 = (q & 15) * 64; K = 1024; ld = DFF; dst = (bf16_t*)(p.ws + OFF_WGU);
            const int n = n0 + tn, g32 = n >> 5, w = n & 31, jj = g32 * 16 + (w & 15); cp = (w < 16 ? p.in[31] : p.in[32]) + (size_t)layer * 1024 * DFF + jj; }
        else if (j < T2) { const int q = j - T1; n0 = (q / 44) * 64; k0 = (q % 44) * 64; K = DFF; ld = 1024; dst = (bf16_t*)(p.ws + OFF_WDN);
            cp = p.in[33] + (size_t)layer * DFF * 1024 + (n0 + tn); }
        else if (j < T3) { const int q = j - T2; n0 = (q >> 4) * 64; k0 = (q & 15) * 64; K = 1024; ld = 1024; dst = (bf16_t*)(p.ws + OFF_WOUT);
            cp = p.in[29] + (size_t)layer * 1024 * 1024 + (n0 + tn); }
        else if (j < T4) { const int q = j - T3; n0 = (q >> 2) * 64; k0 = (q & 3) * 64; K = 256; ld = 1024; dst = (bf16_t*)(p.ws + OFF_WBR);
            const int n = n0 + tn, kk = n >> 10, d = n & 1023; cp = p.in[28] + ((size_t)(layer * 4 + kk) * 256) * 1024 + d; }
        else { const int q = j - T4; n0 = (q >> 2) * 64; k0 = (q & 3) * 64; K = 256; ld = 512; dst = (bf16_t*)(p.ws + OFF_WGLU);
            const int n = n0 + tn, g32 = n >> 5, w = n & 31, jj = g32 * 16 + (w & 15); cp = p.in[25] + (size_t)layer * 256 * 512 + (w < 16 ? jj : 256 + jj); }
        __syncthreads();
#pragma unroll
        for (int e = 0; e < 8; ++e) { const int k = k0 + tk * 8 + e; tile[tn * 65 + tk * 8 + e] = cp ? cp[(size_t)k * ld] : 0.f; }
        __syncthreads();
        { const int n = tid >> 3, ks = tid & 7; const LAS float* tp = tile + n * 65 + ks * 8; u32x4 w;
          w.x = cvt_pk_bf16(tp[0], tp[1]); w.y = cvt_pk_bf16(tp[2], tp[3]); w.z = cvt_pk_bf16(tp[4], tp[5]); w.w = cvt_pk_bf16(tp[6], tp[7]);
          *(u32x4*)(dst + (size_t)(n0 + n) * K + k0 + ks * 8) = w; }
    }
    __syncthreads();
}

__device__ __forceinline__ void phase_norm(KPR p, const float* w, int mode, int bid, int G) {
    const int tid_ = otid(); const int wid = __builtin_amdgcn_readfirstlane(tid_ >> 6), lane = tid_ & 63;
    float* h = (float*)(p.ws + OFF_H); bf16_t* xn = (bf16_t*)(p.ws + OFF_XN);
    f32x4 wv[4];
#pragma unroll
    for (int i = 0; i < 4; ++i) wv[i] = *(const f32x4*)(w + i * 256 + lane * 4);
    for (int r = bid * 8 + wid; r < MTOK; r += G * 8) {
        const float* src = (mode == 0) ? (r < MPROMPT ? p.in[0] + (size_t)r * 1024 : p.in[1] + (size_t)(r - MPROMPT) * 1024) : h + (size_t)r * 1024;
        f32x4 v[4]; float ss = 0.f;
#pragma unroll
        for (int i = 0; i < 4; ++i) { v[i] = *(const f32x4*)(src + i * 256 + lane * 4); ss += v[i][0] * v[i][0] + v[i][1] * v[i][1] + v[i][2] * v[i][2] + v[i][3] * v[i][3]; }
        ss = wave_sum(ss);
        const float rs = rsqrtf(ss * (1.0f / 1024.0f) + EPS);
#pragma unroll
        for (int i = 0; i < 4; ++i) {
            const f32x4 y = v[i] * rs * wv[i];
            if (mode == 2) *(f32x4*)(p.out + (size_t)r * 1024 + i * 256 + lane * 4) = y;
            else { u32x2 o; o.x = cvt_pk_bf16(y[0], y[1]); o.y = cvt_pk_bf16(y[2], y[3]); *(u32x2*)(xn + (size_t)r * 1024 + i * 256 + lane * 4) = o;
                   if (mode == 0) *(f32x4*)(h + (size_t)r * 1024 + i * 256 + lane * 4) = v[i]; }
        }
    }
}

constexpr int TCH = 32;
constexpr int MIXBUF_FLOATS = 4 * TCH * 64 + TCH * 4;
template <int MIX>
__device__ __forceinline__ void mix_item(KPR p, int layer, LAS float* lds, int tokbase, int L, int h, int col0, int ncols,
                         const float* s_in, float* s_out, const float* conv_in, float* conv_out) {
    const int tid = otid(), wid = __builtin_amdgcn_readfirstlane(tid >> 6), lane = tid & 63;
    const int nscan = ncols * 8; const bool is_scan = wid < (nscan >> 6);
    const int ksl = lane & 7, cl = wid * 8 + (lane >> 3), col = col0 + cl;
    const bf16_t* pm = (const bf16_t*)(p.ws + OFF_PM);
    bf16_t* oraw = (bf16_t*)(p.ws + OFF_ORAW);
    __syncthreads();
    f32x2 S2[4];
#pragma unroll
    for (int i = 0; i < 4; ++i) { S2[i].x = (is_scan && s_in) ? s_in[(ksl * 8 + 2 * i) * 64 + col] : 0.f; S2[i].y = (is_scan && s_in) ? s_in[(ksl * 8 + 2 * i + 1) * 64 + col] : 0.f; }
    const int tl = lane >> 4, d4 = (lane & 15) * 4, hd4 = h * 64 + d4;
    f32x4 cw[3][4]; float c_a = 0.f, c_dt = 0.f; f32x4 gkw[16]; f32x4 gkb = (f32x4){0.f, 0.f, 0.f, 0.f}, lb4 = (f32x4){0.f, 0.f, 0.f, 0.f};
    if (MIX == 0) {
        const float* cwp = p.in[10] + (size_t)layer * 4 * 768;
#pragma unroll
        for (int s = 0; s < 3; ++s)
#pragma unroll
            for (int j = 0; j < 4; ++j) cw[s][j] = *(const f32x4*)(cwp + j * 768 + s * 256 + hd4);
        c_a = -__expf(p.in[11][layer * 4 + h]); c_dt = p.in[12][layer * 4 + h];
        if (conv_out && col0 == 0 && h == 0) {
            for (int idx = tid; idx < 3 * 768; idx += 512) { const int i = idx / 768, c = idx - i * 768, ti = L - 3 + i;
                conv_out[idx] = ti >= 0 ? bf2f(pm[(size_t)(tokbase + ti) * NPM + A_QKV + c]) : (conv_in ? conv_in[(3 + ti) * 768 + c] : 0.f); }
        }
    } else if (MIX == 1) {
#pragma unroll
        for (int r = 0; r < 16; ++r) gkw[r] = *(const f32x4*)(p.in[14] + ((size_t)layer * 16 + r) * 256 + hd4);
        gkb = *(const f32x4*)(p.in[15] + layer * 256 + hd4);
    } else {
        const float* lg = p.in[26] + hd4; const f32x4 a0 = *(const f32x4*)lg, a1 = *(const f32x4*)(lg + 256), a2 = *(const f32x4*)(lg + 512), a3 = *(const f32x4*)(lg + 768);
#pragma unroll
        for (int e = 0; e < 4; ++e) {
            const float mx = fmaxf(fmaxf(a0[e], a1[e]), fmaxf(a2[e], a3[e])); const float l0 = __expf(a0[e] - mx), l1 = __expf(a1[e] - mx), l2 = __expf(a2[e] - mx), l3 = __expf(a3[e] - mx);
            const float inv = 1.0f / (l0 + l1 + l2 + l3);
            lb4[e] = (layer == 0) ? 0.f : (layer == 1) ? l1 * inv : (layer == 2) ? (l1 + l2) * inv : (l1 + l2 + l3) * inv;
        }
    }
    const int nch = (L + TCH - 1) / TCH;
    auto prep = [&](int c, int pw, int npw) {
        LAS float* kb = lds + (c & 1) * MIXBUF_FLOATS; LAS float* qb = kb + TCH * 64; LAS float* fb = qb + TCH * 64; LAS float* vb = fb + TCH * 64; LAS float* sc = vb + TCH * 64;
#pragma unroll
        for (int pass = 0; pass < 2; ++pass) {
            const int tt0 = (pass * npw + pw) * 4;
            if (tt0 < TCH) {
                const int tt = tt0 + tl, t = c * TCH + tt;
                if (t < L) {
                    const bf16_t* row = pm + (size_t)(tokbase + t) * NPM;
                    if (MIX == 0) {
                        f32x4 y[3];
#pragma unroll
                        for (int s = 0; s < 3; ++s) { f32x4 a = (f32x4){0.f, 0.f, 0.f, 0.f};
#pragma unroll
                            for (int j = 0; j < 4; ++j) { const int ti = t - 3 + j; f32x4 xv = (f32x4){0.f, 0.f, 0.f, 0.f};
                                if (ti >= 0) { const u32x2 w = *(const u32x2*)(pm + (size_t)(tokbase + ti) * NPM + A_QKV + s * 256 + hd4); xv = (f32x4){lo_bf(w.x), hi_bf(w.x), lo_bf(w.y), hi_bf(w.y)}; }
                                else if (conv_in) xv = *(const f32x4*)(conv_in + (3 + ti) * 768 + s * 256 + hd4);
                                a += xv * cw[s][j]; }
                            y[s] = (f32x4){siluf_(a[0]), siluf_(a[1]), siluf_(a[2]), siluf_(a[3])}; }
                        const float qq = red16(y[0][0] * y[0][0] + y[0][1] * y[0][1] + y[0][2] * y[0][2] + y[0][3] * y[0][3]);
                        const float kk2 = red16(y[1][0] * y[1][0] + y[1][1] * y[1][1] + y[1][2] * y[1][2] + y[1][3] * y[1][3]);
                        const f32x4 qn = y[0] * (rsqrtf(qq + EPS) * 0.125f), kn = y[1] * rsqrtf(kk2 + EPS);
                        const float kq = red16(qn[0] * kn[0] + qn[1] * kn[1] + qn[2] * kn[2] + qn[3] * kn[3]);
                        *(LAS f32x4*)(kb + tt * 64 + d4) = kn; *(LAS f32x4*)(qb + tt * 64 + d4) = qn; *(LAS f32x4*)(vb + tt * 64 + d4) = y[2];
                        if ((lane & 15) == 0) { const float al = bf2f(row[A_ALPHA + h]) + c_dt; const float sp = fmaxf(al, 0.f) + __logf(1.0f + __expf(-fabsf(al)));
                            *(LAS f32x4*)(sc + tt * 4) = (f32x4){__expf(c_a * sp), sigmoidf_(bf2f(row[A_BETA + h])), kq, 0.f}; }
                    } else if (MIX == 1) {
                        const u32x4 g0 = *(const u32x4*)(row + B_GK), g1 = *(const u32x4*)(row + B_GK + 8);
                        const u32x2 wq = *(const u32x2*)(row + B_Q + hd4), wk = *(const u32x2*)(row + B_K + hd4), wv = *(const u32x2*)(row + B_V + hd4);
                        f32x4 z = gkb;
                        z += lo_bf(g0.x) * gkw[0] + hi_bf(g0.x) * gkw[1] + lo_bf(g0.y) * gkw[2] + hi_bf(g0.y) * gkw[3] + lo_bf(g0.z) * gkw[4] + hi_bf(g0.z) * gkw[5] + lo_bf(g0.w) * gkw[6] + hi_bf(g0.w) * gkw[7];
                        z += lo_bf(g1.x) * gkw[8] + hi_bf(g1.x) * gkw[9] + lo_bf(g1.y) * gkw[10] + hi_bf(g1.y) * gkw[11] + lo_bf(g1.z) * gkw[12] + hi_bf(g1.z) * gkw[13] + lo_bf(g1.w) * gkw[14] + hi_bf(g1.w) * gkw[15];
                        f32x4 f;
#pragma unroll
                        for (int e = 0; e < 4; ++e) { const float sp = fmaxf(-z[e], 0.f) + __logf(1.0f + __expf(-fabsf(z[e]))); f[e] = __expf(-sp * (1.0f / 16.0f)); }
                        *(LAS f32x4*)(fb + tt * 64 + d4) = f;
                        *(LAS f32x4*)(qb + tt * 64 + d4) = (f32x4){lo_bf(wq.x), hi_bf(wq.x), lo_bf(wq.y), hi_bf(wq.y)} * 0.125f;
                        *(LAS f32x4*)(kb + tt * 64 + d4) = (f32x4){lo_bf(wk.x), hi_bf(wk.x), lo_bf(wk.y), hi_bf(wk.y)};
                        *(LAS f32x4*)(vb + tt * 64 + d4) = (f32x4){lo_bf(wv.x), hi_bf(wv.x), lo_bf(wv.y), hi_bf(wv.y)};
                    } else {
                        const u32x2 wq = *(const u32x2*)(row + D_Q + hd4), wf = *(const u32x2*)(row + D_F + hd4), wv = *(const u32x2*)(row + D_I + hd4);
                        const f32x4 xq = (f32x4){lo_bf(wq.x), hi_bf(wq.x), lo_bf(wq.y), hi_bf(wq.y)}, xf = (f32x4){lo_bf(wf.x), hi_bf(wf.x), lo_bf(wf.y), hi_bf(wf.y)};
                        f32x4 f, k, q;
#pragma unroll
                        for (int e = 0; e < 4; ++e) { const float sg = sigmoidf_(xf[e]); f[e] = lb4[e] + (1.0f - lb4[e]) * sg; k[e] = (1.0f - lb4[e]) * (1.0f - sg); q[e] = siluf_(xq[e]) * 0.125f; }
                        *(LAS f32x4*)(fb + tt * 64 + d4) = f; *(LAS f32x4*)(kb + tt * 64 + d4) = k; *(LAS f32x4*)(qb + tt * 64 + d4) = q;
                        *(LAS f32x4*)(vb + tt * 64 + d4) = (f32x4){lo_bf(wv.x), hi_bf(wv.x), lo_bf(wv.y), hi_bf(wv.y)};
                    }
                }
            }
        }
    };
    prep(0, wid, 8);
    __syncthreads();
    for (int c = 0; c < nch; ++c) {
        if (is_scan) {
            const LAS float* kb = lds + (c & 1) * MIXBUF_FLOATS; const LAS float* qb = kb + TCH * 64; const LAS float* fb = qb + TCH * 64; const LAS float* vb = fb + TCH * 64; const LAS float* sc = vb + TCH * 64;
            const int ntok = (L - c * TCH) < TCH ? (L - c * TCH) : TCH;
            bf16_t* op = oraw + (size_t)(tokbase + c * TCH) * 768 + MIX * 256 + h * 64 + col;
            const LAS float* kp = kb + ksl * 8; const LAS float* qp = qb + ksl * 8; const LAS float* fp = fb + ksl * 8; const LAS float* vp = vb + col;
            f32x4 k0 = *(const LAS f32x4*)kp, k1 = *(const LAS f32x4*)(kp + 4), q0 = *(const LAS f32x4*)qp, q1 = *(const LAS f32x4*)(qp + 4);
            f32x4 f0 = (f32x4){0.f, 0.f, 0.f, 0.f}, f1 = f0, scv = f0;
            if (MIX == 0) scv = *(const LAS f32x4*)sc; else { f0 = *(const LAS f32x4*)fp; f1 = *(const LAS f32x4*)(fp + 4); }
            float v = vp[0];
            float okeep = 0.f;
            __builtin_amdgcn_s_setprio(3);
#pragma unroll 8
            for (int tt = 0; tt < ntok; ++tt) {
                const int tn = (tt + 1 < TCH) ? tt + 1 : tt;
                const f32x4 nk0 = *(const LAS f32x4*)(kp + tn * 64), nk1 = *(const LAS f32x4*)(kp + tn * 64 + 4), nq0 = *(const LAS f32x4*)(qp + tn * 64), nq1 = *(const LAS f32x4*)(qp + tn * 64 + 4);
                f32x4 nf0 = f0, nf1 = f1, nsc = scv;
                if (MIX == 0) nsc = *(const LAS f32x4*)(sc + tn * 4); else { nf0 = *(const LAS f32x4*)(fp + tn * 64); nf1 = *(const LAS f32x4*)(fp + tn * 64 + 4); }
                const float nv = vp[tn * 64];
                float o;
                if (MIX == 0) {
                    const float eg = scv[0], beta = scv[1], kq = scv[2];
                    const f32x2 ka = {k0[0], k0[1]}, kb2 = {k0[2], k0[3]}, kc = {k1[0], k1[1]}, kd = {k1[2], k1[3]};
                    const f32x2 qa = {q0[0], q0[1]}, qb2 = {q0[2], q0[3]}, qc = {q1[0], q1[1]}, qd = {q1[2], q1[3]};
                    f32x2 dk2 = S2[0] * ka; dk2 = S2[1] * kb2 + dk2; dk2 = S2[2] * kc + dk2; dk2 = S2[3] * kd + dk2;
                    f32x2 dq2 = S2[0] * qa; dq2 = S2[1] * qb2 + dq2; dq2 = S2[2] * qc + dq2; dq2 = S2[3] * qd + dq2;
                    const float dk = red8(dk2.x + dk2.y), dq = red8(dq2.x + dq2.y);
                    const float delta = beta * (v - eg * dk);
                    const f32x2 eg2 = {eg, eg}, de2 = {delta, delta};
                    S2[0] = ka * de2 + S2[0] * eg2; S2[1] = kb2 * de2 + S2[1] * eg2; S2[2] = kc * de2 + S2[2] * eg2; S2[3] = kd * de2 + S2[3] * eg2;
                    o = eg * dq + kq * delta;
                } else {
#pragma unroll
                    for (int i = 0; i < 1; ++i) {}
                    const f32x2 v2 = {v, v};
                    S2[0] = (f32x2){k0[0], k0[1]} * v2 + (f32x2){f0[0], f0[1]} * S2[0]; S2[1] = (f32x2){k0[2], k0[3]} * v2 + (f32x2){f0[2], f0[3]} * S2[1];
                    S2[2] = (f32x2){k1[0], k1[1]} * v2 + (f32x2){f1[0], f1[1]} * S2[2]; S2[3] = (f32x2){k1[2], k1[3]} * v2 + (f32x2){f1[2], f1[3]} * S2[3];
                    f32x2 dq2 = S2[0] * (f32x2){q0[0], q0[1]}; dq2 = S2[1] * (f32x2){q0[2], q0[3]} + dq2; dq2 = S2[2] * (f32x2){q1[0], q1[1]} + dq2; dq2 = S2[3] * (f32x2){q1[2], q1[3]} + dq2;
                    o = red8(dq2.x + dq2.y);
                }
                okeep = ((tt & 7) == ksl) ? o : okeep;
                if ((tt & 7) == 7) op[(size_t)(tt - 7 + ksl) * 768] = f2bf(okeep);
                k0 = nk0; k1 = nk1; q0 = nq0; q1 = nq1; f0 = nf0; f1 = nf1; scv = nsc; v = nv;
            }
            __builtin_amdgcn_s_setprio(0);
            { const int rem = ntok & 7; if (ksl < rem) op[(size_t)(ntok - rem + ksl) * 768] = f2bf(okeep); }
        } else if (c + 1 < nch) prep(c + 1, wid - (nscan >> 6), 8 - (nscan >> 6));
        __syncthreads();
    }
    if (is_scan) {
#pragma unroll
        for (int i = 0; i < 4; ++i) { s_out[(ksl * 8 + 2 * i) * 64 + col] = S2[i].x; s_out[(ksl * 8 + 2 * i + 1) * 64 + col] = S2[i].y; }
    }
}

constexpr int S5_BU_LD = 132, S5_XB_LD = 136, S5_WAVE_BYTES = 16 * S5_BU_LD * 4 + 16 * S5_XB_LD * 2;
template <bool SAMPLE>
__device__ __forceinline__ void s5_wave_item(KPR p, int layer, LAS unsigned char* wl, int g, int tokbase, int L, int seq0) {
    const int lane = otid() & 63, col = lane & 15, quad = lane >> 4;
    const bf16_t* pm = (const bf16_t*)(p.ws + OFF_PM); bf16_t* yg = (bf16_t*)(p.ws + OFF_YG);
    LAS float* bu = (LAS float*)wl; LAS bf16_t* xb = (LAS bf16_t*)(wl + 16 * S5_BU_LD * 4);
    const int lg = layer * 16 + g;
    float ar, ai, zr, zi;
    { const float lr = fminf(p.in[17][lg * 64 + lane], -1e-4f), li = p.in[18][lg * 64 + lane], dt = __expf(p.in[24][lg]);
      const float mag = __expf(lr * dt); float rev = li * dt * 0.15915494309f; rev -= rintf(rev);
      const float sn = __builtin_amdgcn_sinf(rev), cs = __builtin_amdgcn_cosf(rev); ar = mag * cs; ai = mag * sn;
      const float den = lr * lr + li * li; zr = ((ar - 1.0f) * lr + ai * li) / den; zi = (ai * lr - (ar - 1.0f) * li) / den; }
    bf16x8 Bf[8], Cf[4];
#pragma unroll
    for (int tt = 0; tt < 4; ++tt) {
        const int pp = tt * 16 + col; const float zr2 = __shfl(zr, pp), zi2 = __shfl(zi, pp);
        float bre[8], bim[8];
#pragma unroll
        for (int j = 0; j < 8; ++j) { bre[j] = 0.f; bim[j] = 0.f; }
        if (quad < 2) {
            const float* br_ = p.in[19] + ((size_t)lg * 64 + pp) * 16 + quad * 8; const float* bi_ = p.in[20] + ((size_t)lg * 64 + pp) * 16 + quad * 8;
#pragma unroll
            for (int j = 0; j < 8; ++j) { const float r = br_[j], i = bi_[j]; bre[j] = zr2 * r - zi2 * i; bim[j] = zr2 * i + zi2 * r; }
        }
        u32x4 wr_, wi_;
        wr_.x = cvt_pk_bf16(bre[0], bre[1]); wr_.y = cvt_pk_bf16(bre[2], bre[3]); wr_.z = cvt_pk_bf16(bre[4], bre[5]); wr_.w = cvt_pk_bf16(bre[6], bre[7]);
        wi_.x = cvt_pk_bf16(bim[0], bim[1]); wi_.y = cvt_pk_bf16(bim[2], bim[3]); wi_.z = cvt_pk_bf16(bim[4], bim[5]); wi_.w = cvt_pk_bf16(bim[6], bim[7]);
        Bf[tt] = __builtin_bit_cast(bf16x8, wr_); Bf[4 + tt] = __builtin_bit_cast(bf16x8, wi_);
    }
#pragma unroll
    for (int kb = 0; kb < 4; ++kb) {
        const int k0 = (kb & 1) * 32 + quad * 8; const float sgn = kb < 2 ? 1.0f : -1.0f;
        const float* cp = (kb < 2 ? p.in[21] : p.in[22]) + ((size_t)lg * 16 + col) * 64 + k0;
        u32x4 w; w.x = cvt_pk_bf16(sgn * cp[0], sgn * cp[1]); w.y = cvt_pk_bf16(sgn * cp[2], sgn * cp[3]); w.z = cvt_pk_bf16(sgn * cp[4], sgn * cp[5]); w.w = cvt_pk_bf16(sgn * cp[6], sgn * cp[7]);
        Cf[kb] = __builtin_bit_cast(bf16x8, w);
    }
    const float dcoef = p.in[23][layer * 256 + g * 16 + col];
    float xr = 0.f, xi = 0.f;
    const int nch = SAMPLE ? 1 : (L + 15) / 16;
    u32x4 awn = (u32x4){0u, 0u, 0u, 0u}; bf16_t un[4] = {0, 0, 0, 0};
    auto pf = [&](int cc) {
        const int t0 = cc * 16; const int nrow = SAMPLE ? 16 : ((L - t0) < 16 ? (L - t0) : 16);
        awn = (u32x4){0u, 0u, 0u, 0u};
        if (quad < 2 && col < nrow) awn = *(const u32x4*)(pm + (size_t)(tokbase + t0 + col) * NPM + C_U + g * 16 + quad * 8);
#pragma unroll
        for (int i = 0; i < 4; ++i) { const int r = quad * 4 + i; un[i] = (r < nrow) ? pm[(size_t)(tokbase + t0 + r) * NPM + C_U + g * 16 + col] : (bf16_t)0; }
    };
    pf(0);
    for (int c = 0; c < nch; ++c) {
        const int t0 = c * 16; const int nrow = SAMPLE ? 16 : ((L - t0) < 16 ? (L - t0) : 16);
        const u32x4 aw = awn; bf16_t uc[4];
#pragma unroll
        for (int i = 0; i < 4; ++i) uc[i] = un[i];
        if (c + 1 < nch) pf(c + 1);
        const bf16x8 af = __builtin_bit_cast(bf16x8, aw);
#pragma unroll
        for (int tile = 0; tile < 8; ++tile) {
            const f32x4 d = __builtin_amdgcn_mfma_f32_16x16x32_bf16(af, Bf[tile], (f32x4){0.f, 0.f, 0.f, 0.f}, 0, 0, 0);
#pragma unroll
            for (int i = 0; i < 4; ++i) bu[(quad * 4 + i) * S5_BU_LD + tile * 16 + col] = d[i];
        }
        __builtin_amdgcn_fence(__ATOMIC_RELEASE, "wavefront"); __builtin_amdgcn_wave_barrier(); __builtin_amdgcn_fence(__ATOMIC_ACQUIRE, "wavefront");
        for (int r = 0; r < 16; ++r) {
            float nr = 0.f, ni = 0.f;
            if (r < nrow) {
                if (SAMPLE) { const size_t si = ((size_t)(layer * NDEC + seq0 + r) * 16 + g) * 64 + lane; xr = p.in[5][si]; xi = p.in[6][si]; }
                const float br_ = bu[r * S5_BU_LD + lane], bi_ = bu[r * S5_BU_LD + 64 + lane];
                nr = ar * xr - ai * xi + br_; ni = ar * xi + ai * xr + bi_; xr = nr; xi = ni;
                if (SAMPLE) { const size_t so = ((size_t)(layer * NDEC + seq0 + r) * 16 + g) * 64 + lane; p.out[O_SS5R + so] = nr; p.out[O_SS5I + so] = ni; }
            }
            xb[r * S5_XB_LD + lane] = f2bf(nr); xb[r * S5_XB_LD + 64 + lane] = f2bf(ni);
        }
        __builtin_amdgcn_fence(__ATOMIC_RELEASE, "wavefront"); __builtin_amdgcn_wave_barrier(); __builtin_amdgcn_fence(__ATOMIC_ACQUIRE, "wavefront");
        f32x4 ya = (f32x4){0.f, 0.f, 0.f, 0.f};
#pragma unroll
        for (int kb = 0; kb < 4; ++kb) { const bf16x8 xf = *(const LAS bf16x8*)(xb + col * S5_XB_LD + kb * 32 + quad * 8); ya = __builtin_amdgcn_mfma_f32_16x16x32_bf16(xf, Cf[kb], ya, 0, 0, 0); }
#pragma unroll
        for (int i = 0; i < 4; ++i) { const int r = quad * 4 + i;
            if (r < nrow) { const size_t tok = (size_t)(tokbase + t0 + r); const float uu = bf2f(uc[i]);
                const float y = ya[i] + dcoef * uu; const float ge = y * __builtin_amdgcn_rcpf(1.0f + __expf(-1.5957691216f * (y + 0.044715f * y * y * y)));
                yg[tok * 256 + g * 16 + col] = f2bf(ge); } }
        __builtin_amdgcn_fence(__ATOMIC_RELEASE, "wavefront"); __builtin_amdgcn_wave_barrier(); __builtin_amdgcn_fence(__ATOMIC_ACQUIRE, "wavefront");
    }
    if (!SAMPLE) { const size_t so = ((size_t)(layer * NBATCH + seq0) * 16 + g) * 64 + lane; p.out[O_PS5R + so] = xr; p.out[O_PS5I + so] = xi; }
}

__device__ __forceinline__ void phase_mix(KPR p, int layer, LAS unsigned char* ldsb, int bid, int G) {
    LAS float* lds = (LAS float*)ldsb;
    const int wid = __builtin_amdgcn_readfirstlane(otid() >> 6);
    constexpr int NLONG = 208, NSHORT = 16 + 1536;
    for (int it = bid; it < NLONG; it += G) {
        if (it < 192) {
            const int mix = it >> 6, r = it & 63, b = r >> 3, hh = (r >> 1) & 3, half = r & 1;
            const size_t so = ((size_t)(layer * NBATCH + b) * 4 + hh) * 4096;
            if (mix == 0) mix_item<0>(p, layer, lds, b * SEQ, SEQ, hh, half * 32, 32, nullptr, p.out + O_PGDN + so, nullptr, p.out + O_PCONV + (size_t)(layer * NBATCH + b) * 2304);
            else if (mix == 1) mix_item<1>(p, layer, lds, b * SEQ, SEQ, hh, half * 32, 32, nullptr, p.out + O_PGLA + so, nullptr, nullptr);
            else mix_item<2>(p, layer, lds, b * SEQ, SEQ, hh, half * 32, 32, nullptr, p.out + O_PHG + so, nullptr, nullptr);
        } else {
            __syncthreads();
            const int j = (it - 192) * 8 + wid, b = j >> 4, g = j & 15;
            s5_wave_item<false>(p, layer, ldsb + wid * S5_WAVE_BYTES, g, b * SEQ, SEQ, b);
        }
    }
    int js = bid, jstep = G, jend = NSHORT;
    if (G >= 256) { if (bid >= 192) { js = bid - 192; jstep = 64; jend = 1040; } else if (bid >= 64) { js = 1040 + (bid - 64) * 4; jstep = 1; jend = js + 4; } else { js = 0; jend = 0; } }
    for (int j = js; j < jend; j += jstep) {
        if (j < 16) {
            __syncthreads();
            const int jj = j * 8 + wid, g = jj & 15, s0 = (jj >> 4) * 16;
            s5_wave_item<true>(p, layer, ldsb + wid * S5_WAVE_BYTES, g, MPROMPT + s0, 16, s0);
        } else {
            const int jj = j - 16, mix = jj >> 9, s = (jj & 511) >> 2, hh = jj & 3;
            const size_t so = ((size_t)(layer * NDEC + s) * 4 + hh) * 4096;
            if (mix == 0) mix_item<0>(p, layer, lds, MPROMPT + s, 1, hh, 0, 64, p.in[3] + so, p.out + O_SGDN + so, p.in[2] + (size_t)(layer * NDEC + s) * 2304, p.out + O_SCONV + (size_t)(layer * NDEC + s) * 2304);
            else if (mix == 1) mix_item<1>(p, layer, lds, MPROMPT + s, 1, hh, 0, 64, p.in[4] + so, p.out + O_SGLA + so, nullptr, nullptr);
            else mix_item<2>(p, layer, lds, MPROMPT + s, 1, hh, 0, 64, p.in[7] + so, p.out + O_SHG + so, nullptr, nullptr);
        }
    }
    __syncthreads();
}

__device__ __forceinline__ void phase_headnorm(KPR p, int layer, int bid, int G) {
    const int tid_ = otid(); const int wid = __builtin_amdgcn_readfirstlane(tid_ >> 6), lane = tid_ & 63;
    const bf16_t* pm = (const bf16_t*)(p.ws + OFF_PM); const bf16_t* oraw = (const bf16_t*)(p.ws + OFF_ORAW); bf16_t* br = (bf16_t*)(p.ws + OFF_BR);
    for (int j = bid * 8 + wid; j < MTOK * 3; j += G * 8) {
        const int tok = j / 3, mix = j - tok * 3;
        const int gcol = mix == 0 ? A_GATE : (mix == 1 ? B_GATE : D_GATE), slot = mix == 2 ? 3 : mix;
        const float* nw = (mix == 0 ? p.in[13] : (mix == 1 ? p.in[16] : p.in[27])) + layer * 256 + lane * 4;
        const u32x2 ow = *(const u32x2*)(oraw + (size_t)tok * 768 + mix * 256 + lane * 4);
        const u32x2 gw = *(const u32x2*)(pm + (size_t)tok * NPM + gcol + lane * 4);
        const float o0 = lo_bf(ow.x), o1 = hi_bf(ow.x), o2 = lo_bf(ow.y), o3 = hi_bf(ow.y);
        float ss = o0 * o0 + o1 * o1 + o2 * o2 + o3 * o3;
        ss += __shfl_xor(ss, 1); ss += __shfl_xor(ss, 2); ss += __shfl_xor(ss, 4); ss += __shfl_xor(ss, 8);
        const float rs = rsqrtf(ss * (1.0f / 64.0f) + EPS);
        const f32x4 w = *(const f32x4*)nw;
        u32x2 r; r.x = cvt_pk_bf16(o0 * rs * w[0] * siluf_(lo_bf(gw.x)), o1 * rs * w[1] * siluf_(hi_bf(gw.x)));
        r.y = cvt_pk_bf16(o2 * rs * w[2] * siluf_(lo_bf(gw.y)), o3 * rs * w[3] * siluf_(hi_bf(gw.y)));
        *(u32x2*)(br + (size_t)tok * 1024 + slot * 256 + lane * 4) = r;
    }
}

constexpr int PH_PER_LAYER = 9, N_PHASES = 4 * PH_PER_LAYER + 1;
__device__ __forceinline__ void run_phase(KPR p, int ph, LAS unsigned char* lds, int bid, int G) {
    unsigned char* ws = p.ws;
    if (ph == N_PHASES - 1) { phase_norm(p, p.in[34], 2, bid, G); return; }
    const int layer = ph / PH_PER_LAYER, s = ph - layer * PH_PER_LAYER;
    pg8::Sched S; pg8::Gemm g;
    switch (s) {
    case 0: phase_convert(p, layer, (LAS float*)lds, bid, G); phase_norm(p, p.in[8] + layer * 1024, layer == 0 ? 0 : 1, bid, G); break;
    case 1: { S.init(65, 30, 1, G, bid, 16); g = pg8::Gemm{(const bf16_t*)(ws + OFF_XN), (const bf16_t*)(ws + OFF_WIN), 1024, 1024, 16, 0, 0};
              pg8::gemm_phase(lds, g, S, EpiIn{(bf16_t*)(ws + OFF_PM), (bf16_t*)(ws + OFF_GATES)}); } break;
    case 2: phase_mix(p, layer, lds, bid, G); break;
    case 3: { S.init(65, 2, 1, G, bid, 4); g = pg8::Gemm{(const bf16_t*)(ws + OFF_YG), (const bf16_t*)(ws + OFF_WGLU), 256, 256, 4, 0, 0};
              pg8::gemm_phase(lds, g, S, EpiGlu{(bf16_t*)(ws + OFF_BR)}); phase_headnorm(p, layer, bid, G); } break;
    case 4: { S.init(65, 4, 4, G, bid, 4); g = pg8::Gemm{(const bf16_t*)(ws + OFF_BR), (const bf16_t*)(ws + OFF_WBR), 1024, 256, 4, 256, (size_t)1024 * 256};
              pg8::gemm_phase(lds, g, S, EpiBr{(const bf16_t*)(ws + OFF_GATES), (bf16_t*)(ws + OFF_PM)}); } break;
    case 5: { S.init(64, 4, 1, G, bid, 16, 4); g = pg8::Gemm{(const bf16_t*)(ws + OFF_PM), (const bf16_t*)(ws + OFF_WOUT), 1024, 1024, 16, 0, 0};
              pg8::gemm_phase(lds, g, S, EpiRes{(float*)(ws + OFF_H)}); } break;
    case 6: phase_norm(p, p.in[30] + layer * 1024, 1, bid, G); break;
    case 7: { S.init(65, 22, 1, G, bid, 16); g = pg8::Gemm{(const bf16_t*)(ws + OFF_XN), (const bf16_t*)(ws + OFF_WGU), 1024, 1024, 16, 0, 0};
              pg8::gemm_phase(lds, g, S, EpiGU{(bf16_t*)(ws + OFF_PM)}); } break;
    case 8: { S.init(64, 4, 1, G, bid, 44, 4); g = pg8::Gemm{(const bf16_t*)(ws + OFF_PM), (const bf16_t*)(ws + OFF_WDN), DFF, DFF, 44, 0, 0};
              pg8::gemm_phase(lds, g, S, EpiRes{(float*)(ws + OFF_H)}); } break;
    }
}

extern __shared__ __attribute__((aligned(16))) unsigned char dyn_smem[];
#if MULTI_LAUNCH
__global__ void __launch_bounds__(512) k_phase(KP parg, int ph) {
    KPR p = *(const CAS KP*)__builtin_amdgcn_kernarg_segment_ptr();
    run_phase(p, ph, (LAS unsigned char*)dyn_smem, blockIdx.x, gridDim.x);
}
#else
#define XB_TMO      128
#define XB_XCNT(j)  (256  + 64 * (j))
#define XB_XSUB(j)  (1280 + 64 * (j))
#define XB_XGEN(j)  (2304 + 64 * (j))
#define XB_TOP      3328
#define XB_TOPGEN   3392
#define XCD_BAR_WORDS 3456
#define XB_SPIN_CAP (1u << 22)
__device__ __forceinline__ unsigned xb_ld(unsigned* q)              { return __hip_atomic_load(q, __ATOMIC_RELAXED, __HIP_MEMORY_SCOPE_AGENT); }
__device__ __forceinline__ unsigned xb_add(unsigned* q, unsigned v) { return __hip_atomic_fetch_add(q, v, __ATOMIC_RELAXED, __HIP_MEMORY_SCOPE_AGENT); }
__device__ __forceinline__ unsigned xb_xcc_id() { return (unsigned)__builtin_amdgcn_s_getreg((3 << 11) | 20) & 0xFu; }
#define XB_SPIN(cond, bar) do { unsigned _sp = 0; while (cond) { __builtin_amdgcn_s_sleep(1); \
    if ((++_sp & 255u) == 0u) { if (xb_ld(&(bar)[XB_TMO])) break; if (_sp > XB_SPIN_CAP) { atomicAdd(&(bar)[XB_TMO], 1u); break; } } } } while (0)
__device__ __forceinline__ void xcd_barrier_complete(unsigned* bar, unsigned x, unsigned G, unsigned& nloc, unsigned& nx) {
    unsigned sum, cnt, mine, sp = 0u;
    for (;;) {
        sum = 0u; cnt = 0u; mine = 0u;
#pragma unroll
        for (unsigned j = 0; j < 16; ++j) { const unsigned c = xb_ld(&bar[XB_XCNT(j)]); sum += c; cnt += (c > 0u) ? 1u : 0u; mine = (j == x) ? c : mine; }
        if (sum == G) break;
        __builtin_amdgcn_s_sleep(1);
        if ((++sp & 255u) == 0u) { if (xb_ld(&bar[XB_TMO])) break; if (sp > XB_SPIN_CAP) { atomicAdd(&bar[XB_TMO], 1u); break; } }
    }
    nloc = mine > 0u ? mine : 1u; nx = cnt > 0u ? cnt : 1u;
}
__device__ __forceinline__ void grid_bar(unsigned* bar, volatile LAS unsigned* st, int G) {
    asm volatile("s_waitcnt vmcnt(0)" ::: "memory");
    __syncthreads();
    if (otid() == 0) {
        __builtin_amdgcn_s_waitcnt(0);
        const unsigned x = xb_xcc_id();
        unsigned nloc = st[0], nx = st[1];
        if (nloc == 0u) { xcd_barrier_complete(bar, x, (unsigned)G, nloc, nx); st[0] = nloc; st[1] = nx; }
        const unsigned old = xb_add(&bar[XB_XSUB(x)], 1u);
        const unsigned gen = old / nloc;
        if (old + 1u == (gen + 1u) * nloc) {
            __builtin_amdgcn_fence(__ATOMIC_RELEASE, "agent");
            asm volatile("s_waitcnt vmcnt(0)" ::: "memory");
            const unsigned og = xb_add(&bar[XB_TOP], 1u);
            const unsigned tg = og / nx;
            if (og + 1u == (tg + 1u) * nx) xb_add(&bar[XB_TOPGEN], 1u);
            else XB_SPIN(xb_ld(&bar[XB_TOPGEN]) == tg, bar);
            __builtin_amdgcn_fence(__ATOMIC_ACQUIRE, "agent");
            xb_add(&bar[XB_XGEN(x)], 1u);
            asm volatile("s_waitcnt vmcnt(0)" ::: "memory");
        } else {
            XB_SPIN(xb_ld(&bar[XB_XGEN(x)]) == gen, bar);
            __builtin_amdgcn_fence(__ATOMIC_ACQUIRE, "agent");
            asm volatile("s_waitcnt vmcnt(0)" ::: "memory");
        }
    }
    __syncthreads();
}
template <int PH> __device__ __forceinline__ void run_from(KPR p, cg::grid_group& grid) {
    const CAS KP* pp = &p; asm volatile("" : "+s"(pp));
    int bid = blockIdx.x, G = gridDim.x; asm volatile("" : "+s"(bid), "+s"(G));
    run_phase(*pp, PH, (LAS unsigned char*)dyn_smem, bid, G);
    if constexpr (PH + 1 < N_PHASES) {
        if constexpr (PH == 0) grid.sync();
        else grid_bar((unsigned*)(pp->ws + OFF_BAR), (volatile LAS unsigned*)((LAS unsigned char*)dyn_smem + pg8::STAGE_BYTES), G);
        run_from<PH + 1>(p, grid);
    }
}
__global__ void __launch_bounds__(512) k_mega(KP parg) {
    cg::grid_group grid = cg::this_grid();
    KPR p = *(const CAS KP*)__builtin_amdgcn_kernarg_segment_ptr();
    if (threadIdx.x == 0) { volatile LAS unsigned* st = (volatile LAS unsigned*)((LAS unsigned char*)dyn_smem + pg8::STAGE_BYTES); st[0] = 0u; st[1] = 0u;
        (void)xb_add(&((unsigned*)(p.ws + OFF_BAR))[XB_XCNT(xb_xcc_id())], 1u); }
    __syncthreads();
    run_from<0>(p, grid);
}
#endif

extern "C" void kernel_launch(void* const* d_in, const int* in_sizes, int n_in, void* d_out, int out_size, void* d_ws, size_t ws_size, hipStream_t stream) {
    if (ws_size < WS_NEED || n_in < 35) { fprintf(stderr, "workspace too small: %zu < %zu\n", ws_size, (size_t)WS_NEED); return; }
    KP p{};
    for (int i = 0; i < 35; ++i) p.in[i] = (const float*)d_in[i];
    p.out = (float*)d_out; p.ws = (unsigned char*)d_ws;
    constexpr size_t kDynLds = pg8::STAGE_BYTES + 16;
#if MULTI_LAUNCH
    static bool once = false;
    if (!once) { hipFuncSetAttribute((const void*)k_phase, hipFuncAttributeMaxDynamicSharedMemorySize, (int)kDynLds); once = true; }
    for (int ph = 0; ph < N_PHASES; ++ph) hipLaunchKernelGGL(k_phase, dim3(256), dim3(512), kDynLds, stream, p, ph);
#else
    static int grid_blocks = 0;
    if (!grid_blocks) {
        hipFuncSetAttribute((const void*)k_mega, hipFuncAttributeMaxDynamicSharedMemorySize, (int)kDynLds);
        int dev = 0, cus = 0, per_cu = 0;
        hipGetDevice(&dev);
        hipDeviceGetAttribute(&cus, hipDeviceAttributeMultiprocessorCount, dev);
        hipOccupancyMaxActiveBlocksPerMultiprocessor(&per_cu, k_mega, 512, kDynLds);
        if (per_cu < 1) per_cu = 1;
        grid_blocks = cus * per_cu; if (grid_blocks > 256) grid_blocks = 256;
    }
    hipMemsetAsync((unsigned char*)d_ws + OFF_BAR, 0, 16384, stream);
    void* args[] = {&p};
    hipError_t e = hipLaunchCooperativeKernel((void*)k_mega, dim3(grid_blocks), dim3(512), args, kDynLds, stream);
    if (e != hipSuccess) fprintf(stderr, "cooperative launch failed: %s (grid %d)\n", hipGetErrorString(e), grid_blocks);
#endif
}
```

```cpp
#include <hip/hip_runtime.h>
#include <hip/hip_cooperative_groups.h>
#include <cstdio>
namespace cg = cooperative_groups;

#ifndef MULTI_LAUNCH
#define MULTI_LAUNCH 0
#endif

#define LAS __attribute__((address_space(3)))
typedef unsigned short bf16_t;
typedef short bf16x8 __attribute__((ext_vector_type(8)));
typedef float f32x4 __attribute__((ext_vector_type(4)));
typedef float f32x2 __attribute__((ext_vector_type(2)));
typedef unsigned u32x2 __attribute__((ext_vector_type(2)));
typedef unsigned u32x4 __attribute__((ext_vector_type(4)));

constexpr int DM = 1024, SEQ = 2048, NBATCH = 8, NDEC = 128;
constexpr int MPROMPT = NBATCH * SEQ;
constexpr int MTOK = MPROMPT + NDEC;
constexpr int MP = 16640;
constexpr int NPM = 3584, NGATE = 4096, NIN = 7448, DFF = 2816;
constexpr int A_QKV = 0, A_GATE = 768, B_Q = 1024, B_K = 1280, B_V = 1536, B_GATE = 1792, C_U = 2048, D_Q = 2304, D_F = 2560, D_I = 2816, D_GATE = 3072,
              A_ALPHA = 3328, A_BETA = 3332, B_GK = 3336;
constexpr float EPS = 1e-6f;

constexpr size_t SZ_WIN = (size_t)7680 * 1024 * 2, SZ_WGU = (size_t)5632 * 1024 * 2, SZ_WDN = (size_t)1024 * 2816 * 2, SZ_WOUT = (size_t)1024 * 1024 * 2,
                 SZ_WBR = (size_t)4096 * 256 * 2, SZ_WGLU = (size_t)512 * 256 * 2;
constexpr size_t OFF_WIN = 0, OFF_WGU = OFF_WIN + SZ_WIN, OFF_WDN = OFF_WGU + SZ_WGU, OFF_WOUT = OFF_WDN + SZ_WDN, OFF_WBR = OFF_WOUT + SZ_WOUT,
                 OFF_WGLU = OFF_WBR + SZ_WBR, OFF_H = OFF_WGLU + SZ_WGLU, OFF_XN = OFF_H + (size_t)MP * 1024 * 4, OFF_BR = OFF_XN + (size_t)MP * 1024 * 2,
                 OFF_PM = OFF_BR + (size_t)MP * 1024 * 2, OFF_GATES = OFF_PM + (size_t)MP * NPM * 2, OFF_ORAW = OFF_GATES + (size_t)MP * NGATE * 2,
                 OFF_YG = OFF_ORAW + (size_t)MP * 768 * 2, OFF_BAR = OFF_YG + (size_t)MP * 256 * 2, WS_NEED = OFF_BAR + 16384;
constexpr size_t O_PCONV = 16908288, O_PGDN = 16982016, O_PGLA = 17506304, O_PS5R = 18030592, O_PS5I = 18063360, O_PHG = 18096128,
                 O_SCONV = 18620416, O_SGDN = 19800064, O_SGLA = 28188672, O_SS5R = 36577280, O_SS5I = 37101568, O_SHG = 37625856;

struct KP { const float* in[35]; float* out; unsigned char* ws; };
#define CAS __attribute__((address_space(4)))
typedef const CAS KP& KPR;

__device__ __forceinline__ int otid() { int t = threadIdx.x; asm volatile("" : "+v"(t)); return t & 511; }
__device__ __forceinline__ float bf2f(bf16_t b) { return __uint_as_float(((unsigned)b) << 16); }
typedef __bf16 bf16x2_t __attribute__((ext_vector_type(2)));
__device__ __forceinline__ unsigned cvt_pk_bf16(float lo, float hi) { const f32x2 f = {lo, hi}; const bf16x2_t v = __builtin_convertvector(f, bf16x2_t); return __builtin_bit_cast(unsigned, v); }
__device__ __forceinline__ bf16_t f2bf(float f) { return (bf16_t)(cvt_pk_bf16(f, 0.f) & 0xffffu); }
__device__ __forceinline__ float lo_bf(unsigned w) { return __uint_as_float(w << 16); }
__device__ __forceinline__ float hi_bf(unsigned w) { return __uint_as_float(w & 0xffff0000u); }
__device__ __forceinline__ float sigmoidf_(float x) { return __builtin_amdgcn_rcpf(1.0f + __expf(-x)); }
__device__ __forceinline__ float siluf_(float x) { return x * __builtin_amdgcn_rcpf(1.0f + __expf(-x)); }
__device__ __forceinline__ float wave_sum(float v) {
#pragma unroll
    for (int o = 32; o >= 1; o >>= 1) v += __shfl_xor(v, o);
    return v;
}
template <int CTRL> __device__ __forceinline__ float dpp_f(float v) { return __int_as_float(__builtin_amdgcn_update_dpp(0, __float_as_int(v), CTRL, 0xf, 0xf, true)); }
__device__ __forceinline__ float red16(float v) { v += dpp_f<0xB1>(v); v += dpp_f<0x4E>(v); v += dpp_f<0x141>(v); v += dpp_f<0x140>(v); return v; }
__device__ __forceinline__ float red8(float v) { v += dpp_f<0xB1>(v); v += dpp_f<0x4E>(v); v += dpp_f<0x141>(v); return v; }

namespace pg8 {
constexpr int BM = 256, BK = 64, HALF = 128, HTB = HALF * BK * 2, STAGE_BYTES = 8 * HTB, NXCD = 8, WGM = 8;
__device__ __forceinline__ int lds_byte(int r, int c) { const int st = (r >> 4) * 2 + (c >> 5), rr = r & 15, cc = c & 31, ob = rr * 64 + cc * 2; return st * 1024 + (ob ^ (((ob >> 9) & 1) << 5)); }
__device__ __forceinline__ void stage_rc(int b, int& R, int& C) { const int st = b / 1024, sb = b % 1024, swz = sb ^ (((sb >> 9) & 1) << 5); R = (st >> 1) * 16 + swz / 64; C = (st & 1) * 32 + (swz % 64) / 2; }

struct Unit { int pm, pn, kk, k0, nt; };
struct Gemm { const bf16_t* A; const bf16_t* Bt; int lda, ldb, nt; size_t a_kk, b_kk; };
struct Sched {
    int nM, nN, nKK, nwg, G, c, ntf, nts, nextra;
    __device__ void init(int nM_, int nN_, int nKK_, int G_, int c_, int ntf_, int nts_ = 0) { nM = nM_; nN = nN_; nKK = nKK_; nwg = nM * nN; G = G_; c = c_; ntf = ntf_; nts = nts_; nextra = nts_ ? nN_ * (ntf_ / nts_) : 0; }
    __device__ bool next(int i, Unit& u) const {
        const int it = i / nKK; u.kk = i - it * nKK; u.k0 = 0; u.nt = ntf;
        const long L = (long)it * G + c;
        if (L >= nwg) { const int e = (int)(L - nwg); if (e >= nextra) return false; u.pm = nM; u.pn = e % nN; u.k0 = (e / nN) * nts; u.nt = nts; return true; }
        int wgid = (int)L; { const int q = nwg / NXCD, r = nwg % NXCD, xcd = wgid % NXCD, off = wgid / NXCD; wgid = (xcd < r ? xcd * (q + 1) : r * (q + 1) + (xcd - r) * q) + off; }
        const int nig = WGM * nN, gid = wgid / nig, fm = gid * WGM, gsz = (nM - fm) < WGM ? (nM - fm) : WGM;
        u.pm = fm + ((wgid % nig) % gsz); u.pn = (wgid % nig) / gsz; return true;
    }
};

template <class Epi>
__device__ __forceinline__ void gemm_phase(LAS unsigned char* lds, const Gemm g, const Sched& S, const Epi& E) {
    const int tid = otid(), wid = __builtin_amdgcn_readfirstlane(tid >> 6), lane = tid & 63, wr = wid >> 2, wc = wid & 3, fr = lane & 15, fq = lane >> 4;
    unsigned voffA[2], voffB[2];
#pragma unroll
    for (int i = 0; i < 2; ++i) { int R, C; stage_rc(tid * 16 + i * 8192, R, C); voffA[i] = (unsigned)(R * g.lda + C) * 2u; voffB[i] = (unsigned)(R * g.ldb + C) * 2u; }
    const size_t kstep = (size_t)(BK * 2);
    const size_t hstepA = (size_t)HALF * g.lda * 2, hstepB = (size_t)HALF * g.ldb * 2;
    const size_t tstepA = 2 * hstepA, tstepB = 2 * hstepB;
    const unsigned ldsw = (unsigned)wid * 1024u;
    const int aoff = lds_byte(wr * 64 + fr, fq * 8), boff = lds_byte(wc * 32 + fr, fq * 8);
#define PG8_SA(b, h) (((b) * 2 + (h)) * HTB)
#define PG8_SB(b, h) ((4 + (b) * 2 + (h)) * HTB)
#define PG8_STAGE(bufoff, gbase, voff) do { _Pragma("unroll") for (int _i = 0; _i < 2; ++_i) \
        __builtin_amdgcn_global_load_lds((const unsigned*)((const char*)(gbase) + (voff)[_i]), (LAS unsigned*)(lds + (bufoff) + ldsw + _i * 8192), 16, 0, 0); } while (0)
#define PG8_LDA(dst, b, h) do { _Pragma("unroll") for (int m = 0; m < 4; ++m) _Pragma("unroll") for (int k = 0; k < 2; ++k) dst[m][k] = *(const LAS bf16x8*)(lds + PG8_SA(b, h) + aoff + m * 2048 + k * 1024); } while (0)
#define PG8_LDB(dst, b, h) do { _Pragma("unroll") for (int n = 0; n < 2; ++n) _Pragma("unroll") for (int k = 0; k < 2; ++k) dst[n][k] = *(const LAS bf16x8*)(lds + PG8_SB(b, h) + boff + n * 2048 + k * 1024); } while (0)
#define PG8_MMA(ai, bj, At, Bt) do { __builtin_amdgcn_s_setprio(1); _Pragma("unroll") for (int m = 0; m < 4; ++m) _Pragma("unroll") for (int n = 0; n < 2; ++n) _Pragma("unroll") for (int k = 0; k < 2; ++k) \
        acc[ai][bj][m][n] = __builtin_amdgcn_mfma_f32_16x16x32_bf16(Bt[n][k], At[m][k], acc[ai][bj][m][n], 0, 0, 0); __builtin_amdgcn_s_setprio(0); } while (0)
#define PG8_WAIT_V(n) asm volatile("s_waitcnt vmcnt(" #n ")" ::: "memory")
#define PG8_WAIT_L(n) asm volatile("s_waitcnt lgkmcnt(" #n ")" ::: "memory")
#define PG8_BAR __builtin_amdgcn_s_barrier()
#define PG8_SCHED __builtin_amdgcn_sched_barrier(0)
    Unit cur, nxt; int ui = 0;
    if (!S.next(0, cur)) return;
    f32x4 acc[2][2][4][2];
#pragma unroll
    for (int a = 0; a < 2; ++a)
#pragma unroll
        for (int b = 0; b < 2; ++b)
#pragma unroll
            for (int m = 0; m < 4; ++m)
#pragma unroll
                for (int n = 0; n < 2; ++n) acc[a][b][m][n] = (f32x4){0.f, 0.f, 0.f, 0.f};
    bf16x8 At[4][2], B0[2][2], B1[2][2];
    const char* cA = (const char*)(g.A + (size_t)cur.kk * g.a_kk) + (size_t)cur.pm * tstepA + (size_t)cur.k0 * kstep; const char* cB = (const char*)(g.Bt + (size_t)cur.kk * g.b_kk) + (size_t)cur.pn * tstepB + (size_t)cur.k0 * kstep;
    PG8_STAGE(PG8_SB(0, 0), cB, voffB); PG8_STAGE(PG8_SA(0, 0), cA, voffA); PG8_STAGE(PG8_SB(0, 1), cB + hstepB, voffB); PG8_STAGE(PG8_SA(0, 1), cA + hstepA, voffA);
    if (wr == 1) PG8_BAR;
    PG8_WAIT_V(4); PG8_BAR;
    PG8_STAGE(PG8_SB(1, 0), cB + kstep, voffB); PG8_STAGE(PG8_SA(1, 0), cA + kstep, voffA); PG8_STAGE(PG8_SB(1, 1), cB + hstepB + kstep, voffB);
    PG8_WAIT_V(6); PG8_BAR;
    for (;;) {
        const bool has_next = S.next(ui + 1, nxt);
        const char* nA = has_next ? (const char*)(g.A + (size_t)nxt.kk * g.a_kk) + (size_t)nxt.pm * tstepA + (size_t)nxt.k0 * kstep : cA;
        const char* nB = has_next ? (const char*)(g.Bt + (size_t)nxt.kk * g.b_kk) + (size_t)nxt.pn * tstepB + (size_t)nxt.k0 * kstep : cB;
        int nt = cur.nt; asm volatile("" : "+s"(nt));
        for (int t = 0; t < nt; t += 2) {
            const bool last = (t == nt - 2);
            const char* a1 = cA + (size_t)(t + 1) * kstep;
            const char* a2 = last ? nA : cA + (size_t)(t + 2) * kstep; const char* b2 = last ? nB : cB + (size_t)(t + 2) * kstep;
            const char* a3 = a2 + kstep; const char* b3 = b2 + kstep;
            PG8_LDB(B0, 0, 0); PG8_SCHED; PG8_LDA(At, 0, 0); PG8_STAGE(PG8_SA(1, 1), a1 + hstepA, voffA);
            PG8_WAIT_L(8); PG8_BAR; PG8_WAIT_L(0); PG8_MMA(0, 0, At, B0); PG8_BAR; PG8_SCHED;
            PG8_LDB(B1, 0, 1); PG8_STAGE(PG8_SB(0, 0), b2, voffB);
            PG8_BAR; PG8_WAIT_L(0); PG8_MMA(0, 1, At, B1); PG8_BAR;
            PG8_LDA(At, 0, 1); PG8_STAGE(PG8_SA(0, 0), a2, voffA);
            PG8_BAR; PG8_WAIT_L(0); PG8_MMA(1, 0, At, B0); PG8_BAR; PG8_SCHED;
            PG8_STAGE(PG8_SB(0, 1), b2 + hstepB, voffB);
            PG8_WAIT_V(6); PG8_BAR; PG8_MMA(1, 1, At, B1); PG8_BAR;
            PG8_LDB(B0, 1, 0); PG8_SCHED; PG8_LDA(At, 1, 0); PG8_STAGE(PG8_SA(0, 1), a2 + hstepA, voffA);
            PG8_WAIT_L(8); PG8_BAR; PG8_WAIT_L(0); PG8_MMA(0, 0, At, B0); PG8_BAR; PG8_SCHED;
            PG8_LDB(B1, 1, 1); PG8_STAGE(PG8_SB(1, 0), b3, voffB);
            PG8_BAR; PG8_WAIT_L(0); PG8_MMA(0, 1, At, B1); PG8_BAR;
            PG8_LDA(At, 1, 1); PG8_STAGE(PG8_SA(1, 0), a3, voffA);
            PG8_BAR; PG8_WAIT_L(0); PG8_MMA(1, 0, At, B0); PG8_BAR; PG8_SCHED;
            PG8_STAGE(PG8_SB(1, 1), b3 + hstepB, voffB);
            PG8_WAIT_V(6); PG8_BAR; PG8_MMA(1, 1, At, B1); PG8_BAR;
        }
        E(acc, cur, wr, wc, fr, fq);
        if (!has_next) break;
#pragma unroll
        for (int a = 0; a < 2; ++a)
#pragma unroll
            for (int b = 0; b < 2; ++b)
#pragma unroll
                for (int m = 0; m < 4; ++m)
#pragma unroll
                    for (int n = 0; n < 2; ++n) acc[a][b][m][n] = (f32x4){0.f, 0.f, 0.f, 0.f};
        cur = nxt; cA = nA; cB = nB; ++ui;
    }
    PG8_WAIT_V(0);
    if (wr == 0) PG8_BAR;
    PG8_BAR;
    __builtin_amdgcn_s_waitcnt(0);
#undef PG8_SA
#undef PG8_SB
#undef PG8_STAGE
#undef PG8_LDA
#undef PG8_LDB
#undef PG8_MMA
#undef PG8_WAIT_V
#undef PG8_WAIT_L
#undef PG8_BAR
#undef PG8_SCHED
}
}
using pg8::Unit;

#define EPI_LOOP_BEGIN _Pragma("unroll") for (int ai = 0; ai < 2; ++ai) _Pragma("unroll") for (int m = 0; m < 4; ++m) { const size_t row = (size_t)(u.pm * 256 + ai * 128 + wr * 64 + m * 16 + fr); \
        _Pragma("unroll") for (int bj = 0; bj < 2; ++bj) {
#define EPI_LOOP_END } }
struct EpiIn {
    bf16_t* pm; bf16_t* gates;
    __device__ __forceinline__ void operator()(const f32x4 (&acc)[2][2][4][2], const Unit& u, int wr, int wc, int fr, int fq) const {
        const bool main_ = u.pn < 14;
        EPI_LOOP_BEGIN
#pragma unroll
            for (int n = 0; n < 2; ++n) { const int col = u.pn * 256 + bj * 128 + wc * 32 + n * 16 + fq * 4; f32x4 v = acc[ai][bj][m][n]; u32x2 w;
                if (main_) { w.x = cvt_pk_bf16(v[0], v[1]); w.y = cvt_pk_bf16(v[2], v[3]); *(u32x2*)(pm + row * NPM + col) = w; }
                else { w.x = cvt_pk_bf16(sigmoidf_(v[0]), sigmoidf_(v[1])); w.y = cvt_pk_bf16(sigmoidf_(v[2]), sigmoidf_(v[3])); *(u32x2*)(gates + row * NGATE + (col - NPM)) = w; } }
        EPI_LOOP_END
    }
};
struct EpiGlu {
    bf16_t* br;
    __device__ __forceinline__ void operator()(const f32x4 (&acc)[2][2][4][2], const Unit& u, int wr, int wc, int fr, int fq) const {
        EPI_LOOP_BEGIN
            const int j = u.pn * 128 + bj * 64 + wc * 16 + fq * 4; const f32x4 a = acc[ai][bj][m][0], b = acc[ai][bj][m][1]; u32x2 w;
            w.x = cvt_pk_bf16(a[0] * sigmoidf_(b[0]), a[1] * sigmoidf_(b[1])); w.y = cvt_pk_bf16(a[2] * sigmoidf_(b[2]), a[3] * sigmoidf_(b[3]));
            *(u32x2*)(br + row * 1024 + 512 + j) = w;
        EPI_LOOP_END
    }
};
struct EpiGU {
    bf16_t* a;
    __device__ __forceinline__ void operator()(const f32x4 (&acc)[2][2][4][2], const Unit& u, int wr, int wc, int fr, int fq) const {
        EPI_LOOP_BEGIN
            const int j = u.pn * 128 + bj * 64 + wc * 16 + fq * 4; const f32x4 g = acc[ai][bj][m][0], b = acc[ai][bj][m][1]; u32x2 w;
            w.x = cvt_pk_bf16(siluf_(g[0]) * b[0], siluf_(g[1]) * b[1]); w.y = cvt_pk_bf16(siluf_(g[2]) * b[2], siluf_(g[3]) * b[3]);
            *(u32x2*)(a + row * DFF + j) = w;
        EPI_LOOP_END
    }
};
struct EpiBr {
    const bf16_t* gates; bf16_t* mm;
    __device__ __forceinline__ void operator()(const f32x4 (&acc)[2][2][4][2], const Unit& u, int wr, int wc, int fr, int fq) const {
        const int col0 = u.pn * 256 + wc * 32 + fq * 4;
#pragma unroll
        for (int ai = 0; ai < 2; ++ai) {
            if (ai == 1 && u.pm == 64) break;
            const size_t row0 = (size_t)(u.pm * 256 + ai * 128 + wr * 64 + fr);
            u32x2 gw[4][2][2], pw[4][2][2];
#pragma unroll
            for (int m = 0; m < 4; ++m)
#pragma unroll
                for (int bj = 0; bj < 2; ++bj)
#pragma unroll
                    for (int n = 0; n < 2; ++n) { const size_t row = row0 + m * 16; const int col = col0 + bj * 128 + n * 16;
                        gw[m][bj][n] = *(const u32x2*)(gates + row * NGATE + u.kk * 1024 + col);
                        pw[m][bj][n] = (u32x2){0u, 0u}; if (u.kk > 0) pw[m][bj][n] = *(const u32x2*)(mm + row * 1024 + col); }
#pragma unroll
            for (int m = 0; m < 4; ++m)
#pragma unroll
                for (int bj = 0; bj < 2; ++bj)
#pragma unroll
                    for (int n = 0; n < 2; ++n) { const size_t row = row0 + m * 16; const int col = col0 + bj * 128 + n * 16; const f32x4 v = acc[ai][bj][m][n]; const u32x2 g = gw[m][bj][n], q = pw[m][bj][n];
                        u32x2 w; w.x = cvt_pk_bf16(lo_bf(g.x) * v[0] + lo_bf(q.x), hi_bf(g.x) * v[1] + hi_bf(q.x)); w.y = cvt_pk_bf16(lo_bf(g.y) * v[2] + lo_bf(q.y), hi_bf(g.y) * v[3] + hi_bf(q.y));
                        *(u32x2*)(mm + row * 1024 + col) = w; }
        }
    }
};
struct EpiRes {
    float* h;
    __device__ __forceinline__ void operator()(const f32x4 (&acc)[2][2][4][2], const Unit& u, int wr, int wc, int fr, int fq) const {
        const bool split = u.pm == 64;
        EPI_LOOP_BEGIN
#pragma unroll
            for (int n = 0; n < 2; ++n) { const int col = u.pn * 256 + bj * 128 + wc * 32 + n * 16 + fq * 4; float* ptr = h + row * 1024 + col;
                if (split) {
#pragma unroll
                    for (int e = 0; e < 4; ++e) __hip_atomic_fetch_add(ptr + e, acc[ai][bj][m][n][e], __ATOMIC_RELAXED, __HIP_MEMORY_SCOPE_AGENT);
                } else { const f32x4 o = *(const f32x4*)ptr; *(f32x4*)ptr = o + acc[ai][bj][m][n]; } }
        EPI_LOOP_END
    }
};

__device__ __forceinline__ int win_src_col(int n) {
    if (n < 768) return n;
    if (n < 1024) return 776 + (n - 768);
    if (n < 1792) return 1032 + (n - 1024);
    if (n < 2048) return 1816 + (n - 1792);
    if (n < 2304) return 2072 + (n - 2048);
    if (n < 3072) return 2328 + (n - 2304);
    if (n < 3328) return 3096 + (n - 3072);
    if (n < 3336) return 768 + (n - 3328);
    if (n < 3352) return 1800 + (n - 3336);
    if (n < 3584) return -1;
    return 3352 + (n - 3584);
}
__device__ __forceinline__ void phase_convert(KPR p, int layer, LAS float* tile, int bid, int G) {
    const int tid = otid(), tn = tid & 63, tk = __builtin_amdgcn_readfirstlane(tid >> 6);
    constexpr int T0 = 120 * 16, T1 = T0 + 88 * 16, T2 = T1 + 16 * 44, T3 = T2 + 16 * 16, T4 = T3 + 64 * 4, T5 = T4 + 8 * 4;
    for (int j = bid; j < T5; j += G) {
        int n0, k0, K, ld; bf16_t* dst; const float* cp = nullptr;
        if (j < T0) { const int q = j; n0 = (q >> 4) * 64; k0 = (q & 15) * 64; K = 1024; ld = NIN; dst = (bf16_t*)(p.ws + OFF_WIN);
            const int sc = win_src_col(n0 + tn); if (sc >= 0) cp = p.in[9] + (size_t)layer * 1024 * NIN + sc; }
        else if (j < T1) { const int q = j - T0; n0 = (q >> 4) * 64; k0 = (q & 15) * 64; K = 1024; ld = DFF; dst = (bf16_t*)(p.ws + OFF_WGU);
            const int n = n0 + tn, g32 = n >> 5, w = n & 31, jj = g32 * 16 + (w & 15); cp = (w < 16 ? p.in[31] : p.in[32]) + (size_t)layer * 1024 * DFF + jj; }
        else if (j < T2) { const int q = j - T1; n0 = (q / 44) * 64; k0 = (q % 44) * 64; K = DFF; ld = 1024; dst = (bf16_t*)(p.ws + OFF_WDN);
            cp = p.in[33] + (size_t)layer * DFF * 1024 + (n0 + tn); }
        else if (j < T3) { const int q = j - T2; n0 = (q >> 4) * 64; k0 = (q & 15) * 64; K = 1024; ld = 1024; dst = (bf16_t*)(p.ws + OFF_WOUT);
            cp = p.in[29] + (size_t)layer * 1024 * 1024 + (n0 + tn); }
        else if (j < T4) { const int q = j - T3; n0 = (q >> 2) * 64; k0 = (q & 3) * 64; K = 256; ld = 1024; dst = (bf16_t*)(p.ws + OFF_WBR);
            const int n = n0 + tn, kk = n >> 10, d = n & 1023; cp = p.in[28] + ((size_t)(layer * 4 + kk) * 256) * 1024 + d; }
        else { const int q = j - T4; n0 = (q >> 2) * 64; k0 = (q & 3) * 64; K = 256; ld = 512; dst = (bf16_t*)(p.ws + OFF_WGLU);
            const int n = n0 + tn, g32 = n >> 5, w = n & 31, jj = g32 * 16 + (w & 15); cp = p.in[25] + (size_t)layer * 256 * 512 + (w < 16 ? jj : 256 + jj); }
        __syncthreads();
#pragma unroll
        for (int e = 0; e < 8; ++e) { const int k = k0 + tk * 8 + e; tile[tn * 65 + tk * 8 + e] = cp ? cp[(size_t)k * ld] : 0.f; }
        __syncthreads();
        { const int n = tid >> 3, ks = tid & 7; const LAS float* tp = tile + n * 65 + ks * 8; u32x4 w;
          w.x = cvt_pk_bf16(tp[0], tp[1]); w.y = cvt_pk_bf16(tp[2], tp[3]); w.z = cvt_pk_bf16(tp[4], tp[5]); w.w = cvt_pk_bf16(tp[6], tp[7]);
          *(u32x4*)(dst + (size_t)(n0 + n) * K + k0 + ks * 8) = w; }
    }
    __syncthreads();
}

__device__ __forceinline__ void phase_norm(KPR p, const float* w, int mode, int bid, int G) {
    const int tid_ = otid(); const int wid = __builtin_amdgcn_readfirstlane(tid_ >> 6), lane = tid_ & 63;
    float* h = (float*)(p.ws + OFF_H); bf16_t* xn = (bf16_t*)(p.ws + OFF_XN);
    f32x4 wv[4];
#pragma unroll
    for (int i = 0; i < 4; ++i) wv[i] = *(const f32x4*)(w + i * 256 + lane * 4);
    for (int r = bid * 8 + wid; r < MTOK; r += G * 8) {
        const float* src = (mode == 0) ? (r < MPROMPT ? p.in[0] + (size_t)r * 1024 : p.in[1] + (size_t)(r - MPROMPT) * 1024) : h + (size_t)r * 1024;
        f32x4 v[4]; float ss = 0.f;
#pragma unroll
        for (int i = 0; i < 4; ++i) { v[i] = *(const f32x4*)(src + i * 256 + lane * 4); ss += v[i][0] * v[i][0] + v[i][1] * v[i][1] + v[i][2] * v[i][2] + v[i][3] * v[i][3]; }
        ss = wave_sum(ss);
        const float rs = rsqrtf(ss * (1.0f / 1024.0f) + EPS);
#pragma unroll
        for (int i = 0; i < 4; ++i) {
            const f32x4 y = v[i] * rs * wv[i];
            if (mode == 2) *(f32x4*)(p.out + (size_t)r * 1024 + i * 256 + lane * 4) = y;
            else { u32x2 o; o.x = cvt_pk_bf16(y[0], y[1]); o.y = cvt_pk_bf16(y[2], y[3]); *(u32x2*)(xn + (size_t)r * 1024 + i * 256 + lane * 4) = o;
                   if (mode == 0) *(f32x4*)(h + (size_t)r * 1024 + i * 256 + lane * 4) = v[i]; }
        }
    }
}

constexpr int TCH = 32;
constexpr int MIXBUF_FLOATS = 4 * TCH * 64 + TCH * 4;
template <int MIX>
__device__ __forceinline__ void mix_item(KPR p, int layer, LAS float* lds, int tokbase, int L, int h, int col0, int ncols,
                         const float* s_in, float* s_out, const float* conv_in, float* conv_out) {
    const int tid = otid(), wid = __builtin_amdgcn_readfirstlane(tid >> 6), lane = tid & 63;
    const int nscan = ncols * 8; const bool is_scan = wid < (nscan >> 6);
    const int ksl = lane & 7, cl = wid * 8 + (lane >> 3), col = col0 + cl;
    const bf16_t* pm = (const bf16_t*)(p.ws + OFF_PM);
    bf16_t* oraw = (bf16_t*)(p.ws + OFF_ORAW);
    __syncthreads();
    f32x2 S2[4];
#pragma unroll
    for (int i = 0; i < 4; ++i) { S2[i].x = (is_scan && s_in) ? s_in[(ksl * 8 + 2 * i) * 64 + col] : 0.f; S2[i].y = (is_scan && s_in) ? s_in[(ksl * 8 + 2 * i + 1) * 64 + col] : 0.f; }
    const int tl = lane >> 4, d4 = (lane & 15) * 4, hd4 = h * 64 + d4;
    f32x4 cw[3][4]; float c_a = 0.f, c_dt = 0.f; f32x4 gkw[16]; f32x4 gkb = (f32x4){0.f, 0.f, 0.f, 0.f}, lb4 = (f32x4){0.f, 0.f, 0.f, 0.f};
    if (MIX == 0) {
        const float* cwp = p.in[10] + (size_t)layer * 4 * 768;
#pragma unroll
        for (int s = 0; s < 3; ++s)
#pragma unroll
            for (int j = 0; j < 4; ++j) cw[s][j] = *(const f32x4*)(cwp + j * 768 + s * 256 + hd4);
        c_a = -__expf(p.in[11][layer * 4 + h]); c_dt = p.in[12][layer * 4 + h];
        if (conv_out && col0 == 0 && h == 0) {
            for (int idx = tid; idx < 3 * 768; idx += 512) { const int i = idx / 768, c = idx - i * 768, ti = L - 3 + i;
                conv_out[idx] = ti >= 0 ? bf2f(pm[(size_t)(tokbase + ti) * NPM + A_QKV + c]) : (conv_in ? conv_in[(3 + ti) * 768 + c] : 0.f); }
        }
    } else if (MIX == 1) {
#pragma unroll
        for (int r = 0; r < 16; ++r) gkw[r] = *(const f32x4*)(p.in[14] + ((size_t)layer * 16 + r) * 256 + hd4);
        gkb = *(const f32x4*)(p.in[15] + layer * 256 + hd4);
    } else {
        const float* lg = p.in[26] + hd4; const f32x4 a0 = *(const f32x4*)lg, a1 = *(const f32x4*)(lg + 256), a2 = *(const f32x4*)(lg + 512), a3 = *(const f32x4*)(lg + 768);
#pragma unroll
        for (int e = 0; e < 4; ++e) {
            const float mx = fmaxf(fmaxf(a0[e], a1[e]), fmaxf(a2[e], a3[e])); const float l0 = __expf(a0[e] - mx), l1 = __expf(a1[e] - mx), l2 = __expf(a2[e] - mx), l3 = __expf(a3[e] - mx);
            const float inv = 1.0f / (l0 + l1 + l2 + l3);
            lb4[e] = (layer == 0) ? 0.f : (layer == 1) ? l1 * inv : (layer == 2) ? (l1 + l2) * inv : (l1 + l2 + l3) * inv;
        }
    }
    const int nch = (L + TCH - 1) / TCH;
    auto prep = [&](int c, int pw, int npw) {
        LAS float* kb = lds + (c & 1) * MIXBUF_FLOATS; LAS float* qb = kb + TCH * 64; LAS float* fb = qb + TCH * 64; LAS float* vb = fb + TCH * 64; LAS float* sc = vb + TCH * 64;
#pragma unroll
        for (int pass = 0; pass < 2; ++pass) {
            const int tt0 = (pass * npw + pw) * 4;
            if (tt0 < TCH) {
                const int tt = tt0 + tl, t = c * TCH + tt;
                if (t < L) {
                    const bf16_t* row = pm + (size_t)(tokbase + t) * NPM;
                    if (MIX == 0) {
                        f32x4 y[3];
#pragma unroll
                        for (int s = 0; s < 3; ++s) { f32x4 a = (f32x4){0.f, 0.f, 0.f, 0.f};
#pragma unroll
                            for (int j = 0; j < 4; ++j) { const int ti = t - 3 + j; f32x4 xv = (f32x4){0.f, 0.f, 0.f, 0.f};
                                if (ti >= 0) { const u32x2 w = *(const u32x2*)(pm + (size_t)(tokbase + ti) * NPM + A_QKV + s * 256 + hd4); xv = (f32x4){lo_bf(w.x), hi_bf(w.x), lo_bf(w.y), hi_bf(w.y)}; }
                                else if (conv_in) xv = *(const f32x4*)(conv_in + (3 + ti) * 768 + s * 256 + hd4);
                                a += xv * cw[s][j]; }
                            y[s] = (f32x4){siluf_(a[0]), siluf_(a[1]), siluf_(a[2]), siluf_(a[3])}; }
                        const float qq = red16(y[0][0] * y[0][0] + y[0][1] * y[0][1] + y[0][2] * y[0][2] + y[0][3] * y[0][3]);
                        const float kk2 = red16(y[1][0] * y[1][0] + y[1][1] * y[1][1] + y[1][2] * y[1][2] + y[1][3] * y[1][3]);
                        const f32x4 qn = y[0] * (rsqrtf(qq + EPS) * 0.125f), kn = y[1] * rsqrtf(kk2 + EPS);
                        const float kq = red16(qn[0] * kn[0] + qn[1] * kn[1] + qn[2] * kn[2] + qn[3] * kn[3]);
                        *(LAS f32x4*)(kb + tt * 64 + d4) = kn; *(LAS f32x4*)(qb + tt * 64 + d4) = qn; *(LAS f32x4*)(vb + tt * 64 + d4) = y[2];
                        if ((lane & 15) == 0) { const float al = bf2f(row[A_ALPHA + h]) + c_dt; const float sp = fmaxf(al, 0.f) + __logf(1.0f + __expf(-fabsf(al)));
                            *(LAS f32x4*)(sc + tt * 4) = (f32x4){__expf(c_a * sp), sigmoidf_(bf2f(row[A_BETA + h])), kq, 0.f}; }
                    } else if (MIX == 1) {
                        const u32x4 g0 = *(const u32x4*)(row + B_GK), g1 = *(const u32x4*)(row + B_GK + 8);
                        const u32x2 wq = *(const u32x2*)(row + B_Q + hd4), wk = *(const u32x2*)(row + B_K + hd4), wv = *(const u32x2*)(row + B_V + hd4);
                        f32x4 z = gkb;
                        z += lo_bf(g0.x) * gkw[0] + hi_bf(g0.x) * gkw[1] + lo_bf(g0.y) * gkw[2] + hi_bf(g0.y) * gkw[3] + lo_bf(g0.z) * gkw[4] + hi_bf(g0.z) * gkw[5] + lo_bf(g0.w) * gkw[6] + hi_bf(g0.w) * gkw[7];
                        z += lo_bf(g1.x) * gkw[8] + hi_bf(g1.x) * gkw[9] + lo_bf(g1.y) * gkw[10] + hi_bf(g1.y) * gkw[11] + lo_bf(g1.z) * gkw[12] + hi_bf(g1.z) * gkw[13] + lo_bf(g1.w) * gkw[14] + hi_bf(g1.w) * gkw[15];
                        f32x4 f;
#pragma unroll
                        for (int e = 0; e < 4; ++e) { const float sp = fmaxf(-z[e], 0.f) + __logf(1.0f + __expf(-fabsf(z[e]))); f[e] = __expf(-sp * (1.0f / 16.0f)); }
                        *(LAS f32x4*)(fb + tt * 64 + d4) = f;
                        *(LAS f32x4*)(qb + tt * 64 + d4) = (f32x4){lo_bf(wq.x), hi_bf(wq.x), lo_bf(wq.y), hi_bf(wq.y)} * 0.125f;
                        *(LAS f32x4*)(kb + tt * 64 + d4) = (f32x4){lo_bf(wk.x), hi_bf(wk.x), lo_bf(wk.y), hi_bf(wk.y)};
                        *(LAS f32x4*)(vb + tt * 64 + d4) = (f32x4){lo_bf(wv.x), hi_bf(wv.x), lo_bf(wv.y), hi_bf(wv.y)};
                    } else {
                        const u32x2 wq = *(const u32x2*)(row + D_Q + hd4), wf = *(const u32x2*)(row + D_F + hd4), wv = *(const u32x2*)(row + D_I + hd4);
                        const f32x4 xq = (f32x4){lo_bf(wq.x), hi_bf(wq.x), lo_bf(wq.y), hi_bf(wq.y)}, xf = (f32x4){lo_bf(wf.x), hi_bf(wf.x), lo_bf(wf.y), hi_bf(wf.y)};
                        f32x4 f, k, q;
#pragma unroll
                        for (int e = 0; e < 4; ++e) { const float sg = sigmoidf_(xf[e]); f[e] = lb4[e] + (1.0f - lb4[e]) * sg; k[e] = (1.0f - lb4[e]) * (1.0f - sg); q[e] = siluf_(xq[e]) * 0.125f; }
                        *(LAS f32x4*)(fb + tt * 64 + d4) = f; *(LAS f32x4*)(kb + tt * 64 + d4) = k; *(LAS f32x4*)(qb + tt * 64 + d4) = q;
                        *(LAS f32x4*)(vb + tt * 64 + d4) = (f32x4){lo_bf(wv.x), hi_bf(wv.x), lo_bf(wv.y), hi_bf(wv.y)};
                    }
                }
            }
        }
    };
    prep(0, wid, 8);
    __syncthreads();
    for (int c = 0; c < nch; ++c) {
        if (is_scan) {
            const LAS float* kb = lds + (c & 1) * MIXBUF_FLOATS; const LAS float* qb = kb + TCH * 64; const LAS float* fb = qb + TCH * 64; const LAS float* vb = fb + TCH * 64; const LAS float* sc = vb + TCH * 64;
            const int ntok = (L - c * TCH) < TCH ? (L - c * TCH) : TCH;
            bf16_t* op = oraw + (size_t)(tokbase + c * TCH) * 768 + MIX * 256 + h * 64 + col;
            const LAS float* kp = kb + ksl * 8; const LAS float* qp = qb + ksl * 8; const LAS float* fp = fb + ksl * 8; const LAS float* vp = vb + col;
            f32x4 k0 = *(const LAS f32x4*)kp, k1 = *(const LAS f32x4*)(kp + 4), q0 = *(const LAS f32x4*)qp, q1 = *(const LAS f32x4*)(qp + 4);
            f32x4 f0 = (f32x4){0.f, 0.f, 0.f, 0.f}, f1 = f0, scv = f0;
            if (MIX == 0) scv = *(const LAS f32x4*)sc; else { f0 = *(const LAS f32x4*)fp; f1 = *(const LAS f32x4*)(fp + 4); }
            float v = vp[0];
            float okeep = 0.f;
            __builtin_amdgcn_s_setprio(3);
#pragma unroll 8
            for (int tt = 0; tt < ntok; ++tt) {
                const int tn = (tt + 1 < TCH) ? tt + 1 : tt;
                const f32x4 nk0 = *(const LAS f32x4*)(kp + tn * 64), nk1 = *(const LAS f32x4*)(kp + tn * 64 + 4), nq0 = *(const LAS f32x4*)(qp + tn * 64), nq1 = *(const LAS f32x4*)(qp + tn * 64 + 4);
                f32x4 nf0 = f0, nf1 = f1, nsc = scv;
                if (MIX == 0) nsc = *(const LAS f32x4*)(sc + tn * 4); else { nf0 = *(const LAS f32x4*)(fp + tn * 64); nf1 = *(const LAS f32x4*)(fp + tn * 64 + 4); }
                const float nv = vp[tn * 64];
                float o;
                if (MIX == 0) {
                    const float eg = scv[0], beta = scv[1], kq = scv[2];
                    const f32x2 ka = {k0[0], k0[1]}, kb2 = {k0[2], k0[3]}, kc = {k1[0], k1[1]}, kd = {k1[2], k1[3]};
                    const f32x2 qa = {q0[0], q0[1]}, qb2 = {q0[2], q0[3]}, qc = {q1[0], q1[1]}, qd = {q1[2], q1[3]};
                    f32x2 dk2 = S2[0] * ka; dk2 = S2[1] * kb2 + dk2; dk2 = S2[2] * kc + dk2; dk2 = S2[3] * kd + dk2;
                    f32x2 dq2 = S2[0] * qa; dq2 = S2[1] * qb2 + dq2; dq2 = S2[2] * qc + dq2; dq2 = S2[3] * qd + dq2;
                    const float dk = red8(dk2.x + dk2.y), dq = red8(dq2.x + dq2.y);
                    const float delta = beta * (v - eg * dk);
                    const f32x2 eg2 = {eg, eg}, de2 = {delta, delta};
                    S2[0] = ka * de2 + S2[0] * eg2; S2[1] = kb2 * de2 + S2[1] * eg2; S2[2] = kc * de2 + S2[2] * eg2; S2[3] = kd * de2 + S2[3] * eg2;
                    o = eg * dq + kq * delta;
                } else {
#pragma unroll
                    for (int i = 0; i < 1; ++i) {}
                    const f32x2 v2 = {v, v};
                    S2[0] = (f32x2){k0[0], k0[1]} * v2 + (f32x2){f0[0], f0[1]} * S2[0]; S2[1] = (f32x2){k0[2], k0[3]} * v2 + (f32x2){f0[2], f0[3]} * S2[1];
                    S2[2] = (f32x2){k1[0], k1[1]} * v2 + (f32x2){f1[0], f1[1]} * S2[2]; S2[3] = (f32x2){k1[2], k1[3]} * v2 + (f32x2){f1[2], f1[3]} * S2[3];
                    f32x2 dq2 = S2[0] * (f32x2){q0[0], q0[1]}; dq2 = S2[1] * (f32x2){q0[2], q0[3]} + dq2; dq2 = S2[2] * (f32x2){q1[0], q1[1]} + dq2; dq2 = S2[3] * (f32x2){q1[2], q1[3]} + dq2;
                    o = red8(dq2.x + dq2.y);
                }
                okeep = ((tt & 7) == ksl) ? o : okeep;
                if ((tt & 7) == 7) op[(size_t)(tt - 7 + ksl) * 768] = f2bf(okeep);
                k0 = nk0; k1 = nk1; q0 = nq0; q1 = nq1; f0 = nf0; f1 = nf1; scv = nsc; v = nv;
            }
            __builtin_amdgcn_s_setprio(0);
            { const int rem = ntok & 7; if (ksl < rem) op[(size_t)(ntok - rem + ksl) * 768] = f2bf(okeep); }
        } else if (c + 1 < nch) prep(c + 1, wid - (nscan >> 6), 8 - (nscan >> 6));
        __syncthreads();
    }
    if (is_scan) {
#pragma unroll
        for (int i = 0; i < 4; ++i) { s_out[(ksl * 8 + 2 * i) * 64 + col] = S2[i].x; s_out[(ksl * 8 + 2 * i + 1) * 64 + col] = S2[i].y; }
    }
}

constexpr int S5_BU_LD = 132, S5_XB_LD = 136, S5_WAVE_BYTES = 16 * S5_BU_LD * 4 + 16 * S5_XB_LD * 2;
template <bool SAMPLE>
__device__ __forceinline__ void s5_wave_item(KPR p, int layer, LAS unsigned char* wl, int g, int tokbase, int L, int seq0) {
    const int lane = otid() & 63, col = lane & 15, quad = lane >> 4;
    const bf16_t* pm = (const bf16_t*)(p.ws + OFF_PM); bf16_t* yg = (bf16_t*)(p.ws + OFF_YG);
    LAS float* bu = (LAS float*)wl; LAS bf16_t* xb = (LAS bf16_t*)(wl + 16 * S5_BU_LD * 4);
    const int lg = layer * 16 + g;
    float ar, ai, zr, zi;
    { const float lr = fminf(p.in[17][lg * 64 + lane], -1e-4f), li = p.in[18][lg * 64 + lane], dt = __expf(p.in[24][lg]);
      const float mag = __expf(lr * dt); float rev = li * dt * 0.15915494309f; rev -= rintf(rev);
      const float sn = __builtin_amdgcn_sinf(rev), cs = __builtin_amdgcn_cosf(rev); ar = mag * cs; ai = mag * sn;
      const float den = lr * lr + li * li; zr = ((ar - 1.0f) * lr + ai * li) / den; zi = (ai * lr - (ar - 1.0f) * li) / den; }
    bf16x8 Bf[8], Cf[4];
#pragma unroll
    for (int tt = 0; tt < 4; ++tt) {
        const int pp = tt * 16 + col; const float zr2 = __shfl(zr, pp), zi2 = __shfl(zi, pp);
        float bre[8], bim[8];
#pragma unroll
        for (int j = 0; j < 8; ++j) { bre[j] = 0.f; bim[j] = 0.f; }
        if (quad < 2) {
            const float* br_ = p.in[19] + ((size_t)lg * 64 + pp) * 16 + quad * 8; const float* bi_ = p.in[20] + ((size_t)lg * 64 + pp) * 16 + quad * 8;
#pragma unroll
            for (int j = 0; j < 8; ++j) { const float r = br_[j], i = bi_[j]; bre[j] = zr2 * r - zi2 * i; bim[j] = zr2 * i + zi2 * r; }
        }
        u32x4 wr_, wi_;
        wr_.x = cvt_pk_bf16(bre[0], bre[1]); wr_.y = cvt_pk_bf16(bre[2], bre[3]); wr_.z = cvt_pk_bf16(bre[4], bre[5]); wr_.w = cvt_pk_bf16(bre[6], bre[7]);
        wi_.x = cvt_pk_bf16(bim[0], bim[1]); wi_.y = cvt_pk_bf16(bim[2], bim[3]); wi_.z = cvt_pk_bf16(bim[4], bim[5]); wi_.w = cvt_pk_bf16(bim[6], bim[7]);
        Bf[tt] = __builtin_bit_cast(bf16x8, wr_); Bf[4 + tt] = __builtin_bit_cast(bf16x8, wi_);
    }
#pragma unroll
    for (int kb = 0; kb < 4; ++kb) {
        const int k0 = (kb & 1) * 32 + quad * 8; const float sgn = kb < 2 ? 1.0f : -1.0f;
        const float* cp = (kb < 2 ? p.in[21] : p.in[22]) + ((size_t)lg * 16 + col) * 64 + k0;
        u32x4 w; w.x = cvt_pk_bf16(sgn * cp[0], sgn * cp[1]); w.y = cvt_pk_bf16(sgn * cp[2], sgn * cp[3]); w.z = cvt_pk_bf16(sgn * cp[4], sgn * cp[5]); w.w = cvt_pk_bf16(sgn * cp[6], sgn * cp[7]);
        Cf[kb] = __builtin_bit_cast(bf16x8, w);
    }
    const float dcoef = p.in[23][layer * 256 + g * 16 + col];
    float xr = 0.f, xi = 0.f;
    const int nch = SAMPLE ? 1 : (L + 15) / 16;
    u32x4 awn = (u32x4){0u, 0u, 0u, 0u}; bf16_t un[4] = {0, 0, 0, 0};
    auto pf = [&](int cc) {
        const int t0 = cc * 16; const int nrow = SAMPLE ? 16 : ((L - t0) < 16 ? (L - t0) : 16);
        awn = (u32x4){0u, 0u, 0u, 0u};
        if (quad < 2 && col < nrow) awn = *(const u32x4*)(pm + (size_t)(tokbase + t0 + col) * NPM + C_U + g * 16 + quad * 8);
#pragma unroll
        for (int i = 0; i < 4; ++i) { const int r = quad * 4 + i; un[i] = (r < nrow) ? pm[(size_t)(tokbase + t0 + r) * NPM + C_U + g * 16 + col] : (bf16_t)0; }
    };
    pf(0);
    for (int c = 0; c < nch; ++c) {
        const int t0 = c * 16; const int nrow = SAMPLE ? 16 : ((L - t0) < 16 ? (L - t0) : 16);
        const u32x4 aw = awn; bf16_t uc[4];
#pragma unroll
        for (int i = 0; i < 4; ++i) uc[i] = un[i];
        if (c + 1 < nch) pf(c + 1);
        const bf16x8 af = __builtin_bit_cast(bf16x8, aw);
#pragma unroll
        for (int tile = 0; tile < 8; ++tile) {
            const f32x4 d = __builtin_amdgcn_mfma_f32_16x16x32_bf16(af, Bf[tile], (f32x4){0.f, 0.f, 0.f, 0.f}, 0, 0, 0);
#pragma unroll
            for (int i = 0; i < 4; ++i) bu[(quad * 4 + i) * S5_BU_LD + tile * 16 + col] = d[i];
        }
        __builtin_amdgcn_fence(__ATOMIC_RELEASE, "wavefront"); __builtin_amdgcn_wave_barrier(); __builtin_amdgcn_fence(__ATOMIC_ACQUIRE, "wavefront");
        for (int r = 0; r < 16; ++r) {
            float nr = 0.f, ni = 0.f;
            if (r < nrow) {
                if (SAMPLE) { const size_t si = ((size_t)(layer * NDEC + seq0 + r) * 16 + g) * 64 + lane; xr = p.in[5][si]; xi = p.in[6][si]; }
                const float br_ = bu[r * S5_BU_LD + lane], bi_ = bu[r * S5_BU_LD + 64 + lane];
                nr = ar * xr - ai * xi + br_; ni = ar * xi + ai * xr + bi_; xr = nr; xi = ni;
                if (SAMPLE) { const size_t so = ((size_t)(layer * NDEC + seq0 + r) * 16 + g) * 64 + lane; p.out[O_SS5R + so] = nr; p.out[O_SS5I + so] = ni; }
            }
            xb[r * S5_XB_LD + lane] = f2bf(nr); xb[r * S5_XB_LD + 64 + lane] = f2bf(ni);
        }
        __builtin_amdgcn_fence(__ATOMIC_RELEASE, "wavefront"); __builtin_amdgcn_wave_barrier(); __builtin_amdgcn_fence(__ATOMIC_ACQUIRE, "wavefront");
        f32x4 ya = (f32x4){0.f, 0.f, 0.f, 0.f};
#pragma unroll
        for (int kb = 0; kb < 4; ++kb) { const bf16x8 xf = *(const LAS bf16x8*)(xb + col * S5_XB_LD + kb * 32 + quad * 8); ya = __builtin_amdgcn_mfma_f32_16x16x32_bf16(xf, Cf[kb], ya, 0, 0, 0); }
#pragma unroll
        for (int i = 0; i < 4; ++i) { const int r = quad * 4 + i;
            if (r < nrow) { const size_t tok = (size_t)(tokbase + t0 + r); const float uu = bf2f(uc[i]);
                const float y = ya[i] + dcoef * uu; const float ge = y * __builtin_amdgcn_rcpf(1.0f + __expf(-1.5957691216f * (y + 0.044715f * y * y * y)));
                yg[tok * 256 + g * 16 + col] = f2bf(ge); } }
        __builtin_amdgcn_fence(__ATOMIC_RELEASE, "wavefront"); __builtin_amdgcn_wave_barrier(); __builtin_amdgcn_fence(__ATOMIC_ACQUIRE, "wavefront");
    }
    if (!SAMPLE) { const size_t so = ((size_t)(layer * NBATCH + seq0) * 16 + g) * 64 + lane; p.out[O_PS5R + so] = xr; p.out[O_PS5I + so] = xi; }
}

__device__ __forceinline__ void phase_mix(KPR p, int layer, LAS unsigned char* ldsb, int bid, int G) {
    LAS float* lds = (LAS float*)ldsb;
    const int wid = __builtin_amdgcn_readfirstlane(otid() >> 6);
    constexpr int NLONG = 208, NSHORT = 16 + 1536;
    for (int it = bid; it < NLONG; it += G) {
        if (it < 192) {
            const int mix = it >> 6, r = it & 63, b = r >> 3, hh = (r >> 1) & 3, half = r & 1;
            const size_t so = ((size_t)(layer * NBATCH + b) * 4 + hh) * 4096;
            if (mix == 0) mix_item<0>(p, layer, lds, b * SEQ, SEQ, hh, half * 32, 32, nullptr, p.out + O_PGDN + so, nullptr, p.out + O_PCONV + (size_t)(layer * NBATCH + b) * 2304);
            else if (mix == 1) mix_item<1>(p, layer, lds, b * SEQ, SEQ, hh, half * 32, 32, nullptr, p.out + O_PGLA + so, nullptr, nullptr);
            else mix_item<2>(p, layer, lds, b * SEQ, SEQ, hh, half * 32, 32, nullptr, p.out + O_PHG + so, nullptr, nullptr);
        } else {
            __syncthreads();
            const int j = (it - 192) * 8 + wid, b = j >> 4, g = j & 15;
            s5_wave_item<false>(p, layer, ldsb + wid * S5_WAVE_BYTES, g, b * SEQ, SEQ, b);
        }
    }
    unsigned* qc = (unsigned*)(p.ws + OFF_BAR) + 3520 + 64 * layer;
    volatile LAS unsigned* shq = (volatile LAS unsigned*)(ldsb + pg8::STAGE_BYTES + 8);
    for (;;) {
    __syncthreads();
    if (otid() == 0) *shq = __hip_atomic_fetch_add(qc, 1u, __ATOMIC_RELAXED, __HIP_MEMORY_SCOPE_AGENT);
    __syncthreads();
    const int j0 = (int)(*shq) * 2;
    if (j0 >= NSHORT) break;
#pragma unroll 1
    for (int j = j0; j < j0 + 2; ++j) {
        if (j < 16) {
            __syncthreads();
            const int jj = j * 8 + wid, g = jj & 15, s0 = (jj >> 4) * 16;
            s5_wave_item<true>(p, layer, ldsb + wid * S5_WAVE_BYTES, g, MPROMPT + s0, 16, s0);
        } else {
            const int jj = j - 16, mix = jj >> 9, s = (jj & 511) >> 2, hh = jj & 3;
            const size_t so = ((size_t)(layer * NDEC + s) * 4 + hh) * 4096;
            if (mix == 0) mix_item<0>(p, layer, lds, MPROMPT + s, 1, hh, 0, 64, p.in[3] + so, p.out + O_SGDN + so, p.in[2] + (size_t)(layer * NDEC + s) * 2304, p.out + O_SCONV + (size_t)(layer * NDEC + s) * 2304);
            else if (mix == 1) mix_item<1>(p, layer, lds, MPROMPT + s, 1, hh, 0, 64, p.in[4] + so, p.out + O_SGLA + so, nullptr, nullptr);
            else mix_item<2>(p, layer, lds, MPROMPT + s, 1, hh, 0, 64, p.in[7] + so, p.out + O_SHG + so, nullptr, nullptr);
        }
    }
    }
    __syncthreads();
}

__device__ __forceinline__ void phase_headnorm(KPR p, int layer, int bid, int G) {
    const int tid_ = otid(); const int wid = __builtin_amdgcn_readfirstlane(tid_ >> 6), lane = tid_ & 63;
    const bf16_t* pm = (const bf16_t*)(p.ws + OFF_PM); const bf16_t* oraw = (const bf16_t*)(p.ws + OFF_ORAW); bf16_t* br = (bf16_t*)(p.ws + OFF_BR);
    for (int j = bid * 8 + wid; j < MTOK * 3; j += G * 8) {
        const int tok = j / 3, mix = j - tok * 3;
        const int gcol = mix == 0 ? A_GATE : (mix == 1 ? B_GATE : D_GATE), slot = mix == 2 ? 3 : mix;
        const float* nw = (mix == 0 ? p.in[13] : (mix == 1 ? p.in[16] : p.in[27])) + layer * 256 + lane * 4;
        const u32x2 ow = *(const u32x2*)(oraw + (size_t)tok * 768 + mix * 256 + lane * 4);
        const u32x2 gw = *(const u32x2*)(pm + (size_t)tok * NPM + gcol + lane * 4);
        const float o0 = lo_bf(ow.x), o1 = hi_bf(ow.x), o2 = lo_bf(ow.y), o3 = hi_bf(ow.y);
        float ss = o0 * o0 + o1 * o1 + o2 * o2 + o3 * o3;
        ss += __shfl_xor(ss, 1); ss += __shfl_xor(ss, 2); ss += __shfl_xor(ss, 4); ss += __shfl_xor(ss, 8);
        const float rs = rsqrtf(ss * (1.0f / 64.0f) + EPS);
        const f32x4 w = *(const f32x4*)nw;
        u32x2 r; r.x = cvt_pk_bf16(o0 * rs * w[0] * siluf_(lo_bf(gw.x)), o1 * rs * w[1] * siluf_(hi_bf(gw.x)));
        r.y = cvt_pk_bf16(o2 * rs * w[2] * siluf_(lo_bf(gw.y)), o3 * rs * w[3] * siluf_(hi_bf(gw.y)));
        *(u32x2*)(br + (size_t)tok * 1024 + slot * 256 + lane * 4) = r;
    }
}

constexpr int PH_PER_LAYER = 9, N_PHASES = 4 * PH_PER_LAYER + 1;
__device__ __forceinline__ void run_phase(KPR p, int ph, LAS unsigned char* lds, int bid, int G) {
    unsigned char* ws = p.ws;
    if (ph == N_PHASES - 1) { phase_norm(p, p.in[34], 2, bid, G); return; }
    const int layer = ph / PH_PER_LAYER, s = ph - layer * PH_PER_LAYER;
    pg8::Sched S; pg8::Gemm g;
    switch (s) {
    case 0: phase_convert(p, layer, (LAS float*)lds, bid, G); phase_norm(p, p.in[8] + layer * 1024, layer == 0 ? 0 : 1, bid, G); break;
    case 1: { S.init(65, 30, 1, G, bid, 16); g = pg8::Gemm{(const bf16_t*)(ws + OFF_XN), (const bf16_t*)(ws + OFF_WIN), 1024, 1024, 16, 0, 0};
              pg8::gemm_phase(lds, g, S, EpiIn{(bf16_t*)(ws + OFF_PM), (bf16_t*)(ws + OFF_GATES)}); } break;
    case 2: phase_mix(p, layer, lds, bid, G); break;
    case 3: { S.init(65, 2, 1, G, bid, 4); g = pg8::Gemm{(const bf16_t*)(ws + OFF_YG), (const bf16_t*)(ws + OFF_WGLU), 256, 256, 4, 0, 0};
              pg8::gemm_phase(lds, g, S, EpiGlu{(bf16_t*)(ws + OFF_BR)}); phase_headnorm(p, layer, bid, G); } break;
    case 4: { S.init(65, 4, 4, G, bid, 4); g = pg8::Gemm{(const bf16_t*)(ws + OFF_BR), (const bf16_t*)(ws + OFF_WBR), 1024, 256, 4, 256, (size_t)1024 * 256};
              pg8::gemm_phase(lds, g, S, EpiBr{(const bf16_t*)(ws + OFF_GATES), (bf16_t*)(ws + OFF_PM)}); } break;
    case 5: { S.init(64, 4, 1, G, bid, 16, 4); g = pg8::Gemm{(const bf16_t*)(ws + OFF_PM), (const bf16_t*)(ws + OFF_WOUT), 1024, 1024, 16, 0, 0};
              pg8::gemm_phase(lds, g, S, EpiRes{(float*)(ws + OFF_H)}); } break;
    case 6: phase_norm(p, p.in[30] + layer * 1024, 1, bid, G); break;
    case 7: { S.init(65, 22, 1, G, bid, 16); g = pg8::Gemm{(const bf16_t*)(ws + OFF_XN), (const bf16_t*)(ws + OFF_WGU), 1024, 1024, 16, 0, 0};
              pg8::gemm_phase(lds, g, S, EpiGU{(bf16_t*)(ws + OFF_PM)}); } break;
    case 8: { S.init(64, 4, 1, G, bid, 44, 4); g = pg8::Gemm{(const bf16_t*)(ws + OFF_PM), (const bf16_t*)(ws + OFF_WDN), DFF, DFF, 44, 0, 0};
              pg8::gemm_phase(lds, g, S, EpiRes{(float*)(ws + OFF_H)}); } break;
    }
}

extern __shared__ __attribute__((aligned(16))) unsigned char dyn_smem[];
#if MULTI_LAUNCH
__global__ void __launch_bounds__(512) k_phase(KP parg, int ph) {
    KPR p = *(const CAS KP*)__builtin_amdgcn_kernarg_segment_ptr();
    run_phase(p, ph, (LAS unsigned char*)dyn_smem, blockIdx.x, gridDim.x);
}
#else
#define XB_TMO      128
#define XB_XCNT(j)  (256  + 64 * (j))
#define XB_XSUB(j)  (1280 + 64 * (j))
#define XB_XGEN(j)  (2304 + 64 * (j))
#define XB_TOP      3328
#define XB_TOPGEN   3392
#define XCD_BAR_WORDS 3456
#define XB_SPIN_CAP (1u << 22)
__device__ __forceinline__ unsigned xb_ld(unsigned* q)              { return __hip_atomic_load(q, __ATOMIC_RELAXED, __HIP_MEMORY_SCOPE_AGENT); }
__device__ __forceinline__ unsigned xb_add(unsigned* q, unsigned v) { return __hip_atomic_fetch_add(q, v, __ATOMIC_RELAXED, __HIP_MEMORY_SCOPE_AGENT); }
__device__ __forceinline__ unsigned xb_xcc_id() { return (unsigned)__builtin_amdgcn_s_getreg((3 << 11) | 20) & 0xFu; }
#define XB_SPIN(cond, bar) do { unsigned _sp = 0; while (cond) { __builtin_amdgcn_s_sleep(1); \
    if ((++_sp & 255u) == 0u) { if (xb_ld(&(bar)[XB_TMO])) break; if (_sp > XB_SPIN_CAP) { atomicAdd(&(bar)[XB_TMO], 1u); break; } } } } while (0)
__device__ __forceinline__ void xcd_barrier_complete(unsigned* bar, unsigned x, unsigned G, unsigned& nloc, unsigned& nx) {
    unsigned sum, cnt, mine, sp = 0u;
    for (;;) {
        sum = 0u; cnt = 0u; mine = 0u;
#pragma unroll
        for (unsigned j = 0; j < 16; ++j) { const unsigned c = xb_ld(&bar[XB_XCNT(j)]); sum += c; cnt += (c > 0u) ? 1u : 0u; mine = (j == x) ? c : mine; }
        if (sum == G) break;
        __builtin_amdgcn_s_sleep(1);
        if ((++sp & 255u) == 0u) { if (xb_ld(&bar[XB_TMO])) break; if (sp > XB_SPIN_CAP) { atomicAdd(&bar[XB_TMO], 1u); break; } }
    }
    nloc = mine > 0u ? mine : 1u; nx = cnt > 0u ? cnt : 1u;
}
__device__ __forceinline__ void grid_bar(unsigned* bar, volatile LAS unsigned* st, int G) {
    asm volatile("s_waitcnt vmcnt(0)" ::: "memory");
    __syncthreads();
    if (otid() == 0) {
        __builtin_amdgcn_s_waitcnt(0);
        const unsigned x = xb_xcc_id();
        unsigned nloc = st[0], nx = st[1];
        if (nloc == 0u) { xcd_barrier_complete(bar, x, (unsigned)G, nloc, nx); st[0] = nloc; st[1] = nx; }
        const unsigned old = xb_add(&bar[XB_XSUB(x)], 1u);
        const unsigned gen = old / nloc;
        if (old + 1u == (gen + 1u) * nloc) {
            __builtin_amdgcn_fence(__ATOMIC_RELEASE, "agent");
            asm volatile("s_waitcnt vmcnt(0)" ::: "memory");
            const unsigned og = xb_add(&bar[XB_TOP], 1u);
            const unsigned tg = og / nx;
            if (og + 1u == (tg + 1u) * nx) xb_add(&bar[XB_TOPGEN], 1u);
            else XB_SPIN(xb_ld(&bar[XB_TOPGEN]) == tg, bar);
            __builtin_amdgcn_fence(__ATOMIC_ACQUIRE, "agent");
            xb_add(&bar[XB_XGEN(x)], 1u);
            asm volatile("s_waitcnt vmcnt(0)" ::: "memory");
        } else {
            XB_SPIN(xb_ld(&bar[XB_XGEN(x)]) == gen, bar);
            __builtin_amdgcn_fence(__ATOMIC_ACQUIRE, "agent");
            asm volatile("s_waitcnt vmcnt(0)" ::: "memory");
        }
    }
    __syncthreads();
}
template <int PH> __device__ __forceinline__ void run_from(KPR p, cg::grid_group& grid) {
    const CAS KP* pp = &p; asm volatile("" : "+s"(pp));
    int bid = blockIdx.x, G = gridDim.x; asm volatile("" : "+s"(bid), "+s"(G));
    run_phase(*pp, PH, (LAS unsigned char*)dyn_smem, bid, G);
    if constexpr (PH + 1 < N_PHASES) {
        if constexpr (PH == 0) grid.sync();
        else grid_bar((unsigned*)(pp->ws + OFF_BAR), (volatile LAS unsigned*)((LAS unsigned char*)dyn_smem + pg8::STAGE_BYTES), G);
        run_from<PH + 1>(p, grid);
    }
}
__global__ void __launch_bounds__(512) k_mega(KP parg) {
    cg::grid_group grid = cg::this_grid();
    KPR p = *(const CAS KP*)__builtin_amdgcn_kernarg_segment_ptr();
    if (threadIdx.x == 0) { volatile LAS unsigned* st = (volatile LAS unsigned*)((LAS unsigned char*)dyn_smem + pg8::STAGE_BYTES); st[0] = 0u; st[1] = 0u;
        (void)xb_add(&((unsigned*)(p.ws + OFF_BAR))[XB_XCNT(xb_xcc_id())], 1u); }
    __syncthreads();
    run_from<0>(p, grid);
}
#endif

extern "C" void kernel_launch(void* const* d_in, const int* in_sizes, int n_in, void* d_out, int out_size, void* d_ws, size_t ws_size, hipStream_t stream) {
    if (ws_size < WS_NEED || n_in < 35) { fprintf(stderr, "workspace too small: %zu < %zu\n", ws_size, (size_t)WS_NEED); return; }
    KP p{};
    for (int i = 0; i < 35; ++i) p.in[i] = (const float*)d_in[i];
    p.out = (float*)d_out; p.ws = (unsigned char*)d_ws;
    constexpr size_t kDynLds = pg8::STAGE_BYTES + 16;
#if MULTI_LAUNCH
    static bool once = false;
    if (!once) { hipFuncSetAttribute((const void*)k_phase, hipFuncAttributeMaxDynamicSharedMemorySize, (int)kDynLds); once = true; }
    for (int ph = 0; ph < N_PHASES; ++ph) hipLaunchKernelGGL(k_phase, dim3(256), dim3(512), kDynLds, stream, p, ph);
#else
    static int grid_blocks = 0;
    if (!grid_blocks) {
        hipFuncSetAttribute((const void*)k_mega, hipFuncAttributeMaxDynamicSharedMemorySize, (int)kDynLds);
        int dev = 0, cus = 0, per_cu = 0;
        hipGetDevice(&dev);
        hipDeviceGetAttribute(&cus, hipDeviceAttributeMultiprocessorCount, dev);
        hipOccupancyMaxActiveBlocksPerMultiprocessor(&per_cu, k_mega, 512, kDynLds);
        if (per_cu < 1) per_cu = 1;
        grid_blocks = cus * per_cu; if (grid_blocks > 256) grid_blocks = 256;
    }
    hipMemsetAsync((unsigned char*)d_ws + OFF_BAR, 0, 16384, stream);
    void* args[] = {&p};
    hipError_t e = hipLaunchCooperativeKernel((void*)k_mega, dim3(grid_blocks), dim3(512), args, kDynLds, stream);
    if (e != hipSuccess) fprintf(stderr, "cooperative launch failed: %s (grid %d)\n", hipGetErrorString(e), grid_blocks);
#endif
}
```

```cpp
#include <hip/hip_runtime.h>
#include <hip/hip_cooperative_groups.h>
#include <cstdio>
namespace cg = cooperative_groups;

#ifndef MULTI_LAUNCH
#define MULTI_LAUNCH 0
#endif

#define LAS __attribute__((address_space(3)))
typedef unsigned short bf16_t;
typedef short bf16x8 __attribute__((ext_vector_type(8)));
typedef float f32x4 __attribute__((ext_vector_type(4)));
typedef float f32x2 __attribute__((ext_vector_type(2)));
typedef unsigned u32x2 __attribute__((ext_vector_type(2)));
typedef unsigned u32x4 __attribute__((ext_vector_type(4)));

constexpr int DM = 1024, SEQ = 2048, NBATCH = 8, NDEC = 128;
constexpr int MPROMPT = NBATCH * SEQ;
constexpr int MTOK = MPROMPT + NDEC;
constexpr int MP = 16640;
constexpr int NPM = 3584, NGATE = 4096, NIN = 7448, DFF = 2816;
constexpr int A_QKV = 0, A_GATE = 768, B_Q = 1024, B_K = 1280, B_V = 1536, B_GATE = 1792, C_U = 2048, D_Q = 2304, D_F = 2560, D_I = 2816, D_GATE = 3072,
              A_ALPHA = 3328, A_BETA = 3332, B_GK = 3336;
constexpr float EPS = 1e-6f;

constexpr size_t SZ_WIN = (size_t)7680 * 1024 * 2, SZ_WGU = (size_t)5632 * 1024 * 2, SZ_WDN = (size_t)1024 * 2816 * 2, SZ_WOUT = (size_t)1024 * 1024 * 2,
                 SZ_WBR = (size_t)4096 * 256 * 2, SZ_WGLU = (size_t)512 * 256 * 2;
constexpr size_t OFF_WIN = 0, OFF_WGU = OFF_WIN + SZ_WIN, OFF_WDN = OFF_WGU + SZ_WGU, OFF_WOUT = OFF_WDN + SZ_WDN, OFF_WBR = OFF_WOUT + SZ_WOUT,
                 OFF_WGLU = OFF_WBR + SZ_WBR, OFF_H = OFF_WGLU + SZ_WGLU, OFF_XN = OFF_H + (size_t)MP * 1024 * 4, OFF_BR = OFF_XN + (size_t)MP * 1024 * 2,
                 OFF_PM = OFF_BR + (size_t)MP * 1024 * 2, OFF_GATES = OFF_PM + (size_t)MP * NPM * 2, OFF_ORAW = OFF_GATES + (size_t)MP * NGATE * 2,
                 OFF_YG = OFF_ORAW + (size_t)MP * 768 * 2, OFF_BAR = OFF_YG + (size_t)MP * 256 * 2, WS_NEED = OFF_BAR + 16384;
constexpr size_t O_PCONV = 16908288, O_PGDN = 16982016, O_PGLA = 17506304, O_PS5R = 18030592, O_PS5I = 18063360, O_PHG = 18096128,
                 O_SCONV = 18620416, O_SGDN = 19800064, O_SGLA = 28188672, O_SS5R = 36577280, O_SS5I = 37101568, O_SHG = 37625856;

struct KP { const float* in[35]; float* out; unsigned char* ws; };
#define CAS __attribute__((address_space(4)))
typedef const CAS KP& KPR;

__device__ __forceinline__ int otid() { int t = threadIdx.x; asm volatile("" : "+v"(t)); return t & 511; }
__device__ __forceinline__ float bf2f(bf16_t b) { return __uint_as_float(((unsigned)b) << 16); }
typedef __bf16 bf16x2_t __attribute__((ext_vector_type(2)));
__device__ __forceinline__ unsigned cvt_pk_bf16(float lo, float hi) { const f32x2 f = {lo, hi}; const bf16x2_t v = __builtin_convertvector(f, bf16x2_t); return __builtin_bit_cast(unsigned, v); }
__device__ __forceinline__ bf16_t f2bf(float f) { return (bf16_t)(cvt_pk_bf16(f, 0.f) & 0xffffu); }
__device__ __forceinline__ float lo_bf(unsigned w) { return __uint_as_float(w << 16); }
__device__ __forceinline__ float hi_bf(unsigned w) { return __uint_as_float(w & 0xffff0000u); }
__device__ __forceinline__ float sigmoidf_(float x) { return __builtin_amdgcn_rcpf(1.0f + __expf(-x)); }
__device__ __forceinline__ float siluf_(float x) { return x * __builtin_amdgcn_rcpf(1.0f + __expf(-x)); }
__device__ __forceinline__ float wave_sum(float v) {
#pragma unroll
    for (int o = 32; o >= 1; o >>= 1) v += __shfl_xor(v, o);
    return v;
}
template <int CTRL> __device__ __forceinline__ float dpp_f(float v) { return __int_as_float(__builtin_amdgcn_update_dpp(0, __float_as_int(v), CTRL, 0xf, 0xf, true)); }
__device__ __forceinline__ float red16(float v) { v += dpp_f<0xB1>(v); v += dpp_f<0x4E>(v); v += dpp_f<0x141>(v); v += dpp_f<0x140>(v); return v; }
__device__ __forceinline__ float red8(float v) { v += dpp_f<0xB1>(v); v += dpp_f<0x4E>(v); v += dpp_f<0x141>(v); return v; }

namespace pg8 {
constexpr int BM = 256, BK = 64, HALF = 128, HTB = HALF * BK * 2, STAGE_BYTES = 8 * HTB, NXCD = 8, WGM = 8;
__device__ __forceinline__ int lds_byte(int r, int c) { const int st = (r >> 4) * 2 + (c >> 5), rr = r & 15, cc = c & 31, ob = rr * 64 + cc * 2; return st * 1024 + (ob ^ (((ob >> 9) & 1) << 5)); }
__device__ __forceinline__ void stage_rc(int b, int& R, int& C) { const int st = b / 1024, sb = b % 1024, swz = sb ^ (((sb >> 9) & 1) << 5); R = (st >> 1) * 16 + swz / 64; C = (st & 1) * 32 + (swz % 64) / 2; }

__device__ __forceinline__ int perm32(int rho) { const int n = rho >> 4, i = rho & 15; return 8 * (i >> 2) + 4 * n + (i & 3); }
struct Unit { int pm, pn, kk, k0, nt; };
struct Gemm { const bf16_t* A; const bf16_t* Bt; int lda, ldb, nt; size_t a_kk, b_kk; };
struct Sched {
    int nM, nN, nKK, nwg, G, c, ntf, nts, nextra;
    __device__ void init(int nM_, int nN_, int nKK_, int G_, int c_, int ntf_, int nts_ = 0) { nM = nM_; nN = nN_; nKK = nKK_; nwg = nM * nN; G = G_; c = c_; ntf = ntf_; nts = nts_; nextra = nts_ ? nN_ * (ntf_ / nts_) : 0; }
    __device__ bool next(int i, Unit& u) const {
        const int it = i / nKK; u.kk = i - it * nKK; u.k0 = 0; u.nt = ntf;
        const long L = (long)it * G + c;
        if (L >= nwg) { const int e = (int)(L - nwg); if (e >= nextra) return false; u.pm = nM; u.pn = e % nN; u.k0 = (e / nN) * nts; u.nt = nts; return true; }
        int wgid = (int)L; { const int q = nwg / NXCD, r = nwg % NXCD, xcd = wgid % NXCD, off = wgid / NXCD; wgid = (xcd < r ? xcd * (q + 1) : r * (q + 1) + (xcd - r) * q) + off; }
        const int nig = WGM * nN, gid = wgid / nig, fm = gid * WGM, gsz = (nM - fm) < WGM ? (nM - fm) : WGM;
        u.pm = fm + ((wgid % nig) % gsz); u.pn = (wgid % nig) / gsz; return true;
    }
};

template <class Epi>
__device__ __forceinline__ void gemm_phase(LAS unsigned char* lds, const Gemm g, const Sched& S, const Epi& E) {
    const int tid = otid(), wid = __builtin_amdgcn_readfirstlane(tid >> 6), lane = tid & 63, wr = wid >> 2, wc = wid & 3, fr = lane & 15, fq = lane >> 4;
    unsigned voffA[2], voffB[2];
#pragma unroll
    for (int i = 0; i < 2; ++i) { int R, C; stage_rc(tid * 16 + i * 8192, R, C); const int Rb = Epi::PERM ? ((R & ~31) + perm32(R & 31)) : R;
        voffA[i] = (unsigned)(R * g.lda + C) * 2u; voffB[i] = (unsigned)(Rb * g.ldb + C) * 2u; }
    const size_t kstep = (size_t)(BK * 2);
    const size_t hstepA = (size_t)HALF * g.lda * 2, hstepB = (size_t)HALF * g.ldb * 2;
    const size_t tstepA = 2 * hstepA, tstepB = 2 * hstepB;
    const unsigned ldsw = (unsigned)wid * 1024u;
    const int aoff = lds_byte(wr * 64 + fr, fq * 8), boff = lds_byte(wc * 32 + fr, fq * 8);
#define PG8_SA(b, h) (((b) * 2 + (h)) * HTB)
#define PG8_SB(b, h) ((4 + (b) * 2 + (h)) * HTB)
#define PG8_STAGE(bufoff, gbase, voff) do { _Pragma("unroll") for (int _i = 0; _i < 2; ++_i) \
        __builtin_amdgcn_global_load_lds((const unsigned*)((const char*)(gbase) + (voff)[_i]), (LAS unsigned*)(lds + (bufoff) + ldsw + _i * 8192), 16, 0, 0); } while (0)
#define PG8_LDA(dst, b, h) do { _Pragma("unroll") for (int m = 0; m < 4; ++m) _Pragma("unroll") for (int k = 0; k < 2; ++k) dst[m][k] = *(const LAS bf16x8*)(lds + PG8_SA(b, h) + aoff + m * 2048 + k * 1024); } while (0)
#define PG8_LDB(dst, b, h) do { _Pragma("unroll") for (int n = 0; n < 2; ++n) _Pragma("unroll") for (int k = 0; k < 2; ++k) dst[n][k] = *(const LAS bf16x8*)(lds + PG8_SB(b, h) + boff + n * 2048 + k * 1024); } while (0)
#define PG8_MMA(ai, bj, At, Bt) do { __builtin_amdgcn_s_setprio(1); _Pragma("unroll") for (int m = 0; m < 4; ++m) _Pragma("unroll") for (int n = 0; n < 2; ++n) _Pragma("unroll") for (int k = 0; k < 2; ++k) \
        acc[ai][bj][m][n] = __builtin_amdgcn_mfma_f32_16x16x32_bf16(Bt[n][k], At[m][k], acc[ai][bj][m][n], 0, 0, 0); __builtin_amdgcn_s_setprio(0); } while (0)
#define PG8_WAIT_V(n) asm volatile("s_waitcnt vmcnt(" #n ")" ::: "memory")
#define PG8_WAIT_L(n) asm volatile("s_waitcnt lgkmcnt(" #n ")" ::: "memory")
#define PG8_BAR __builtin_amdgcn_s_barrier()
#define PG8_SCHED __builtin_amdgcn_sched_barrier(0)
    Unit cur, nxt; int ui = 0;
    if (!S.next(0, cur)) return;
    f32x4 acc[2][2][4][2];
#pragma unroll
    for (int a = 0; a < 2; ++a)
#pragma unroll
        for (int b = 0; b < 2; ++b)
#pragma unroll
            for (int m = 0; m < 4; ++m)
#pragma unroll
                for (int n = 0; n < 2; ++n) acc[a][b][m][n] = (f32x4){0.f, 0.f, 0.f, 0.f};
    bf16x8 At[4][2], B0[2][2], B1[2][2];
    const char* cA = (const char*)(g.A + (size_t)cur.kk * g.a_kk) + (size_t)cur.pm * tstepA + (size_t)cur.k0 * kstep; const char* cB = (const char*)(g.Bt + (size_t)cur.kk * g.b_kk) + (size_t)cur.pn * tstepB + (size_t)cur.k0 * kstep;
    PG8_STAGE(PG8_SB(0, 0), cB, voffB); PG8_STAGE(PG8_SA(0, 0), cA, voffA); PG8_STAGE(PG8_SB(0, 1), cB + hstepB, voffB); PG8_STAGE(PG8_SA(0, 1), cA + hstepA, voffA);
    if (wr == 1) PG8_BAR;
    PG8_WAIT_V(4); PG8_BAR;
    PG8_STAGE(PG8_SB(1, 0), cB + kstep, voffB); PG8_STAGE(PG8_SA(1, 0), cA + kstep, voffA); PG8_STAGE(PG8_SB(1, 1), cB + hstepB + kstep, voffB);
    PG8_WAIT_V(6); PG8_BAR;
    for (;;) {
        const bool has_next = S.next(ui + 1, nxt);
        const char* nA = has_next ? (const char*)(g.A + (size_t)nxt.kk * g.a_kk) + (size_t)nxt.pm * tstepA + (size_t)nxt.k0 * kstep : cA;
        const char* nB = has_next ? (const char*)(g.Bt + (size_t)nxt.kk * g.b_kk) + (size_t)nxt.pn * tstepB + (size_t)nxt.k0 * kstep : cB;
        int nt = cur.nt; asm volatile("" : "+s"(nt));
        for (int t = 0; t < nt; t += 2) {
            const bool last = (t == nt - 2);
            const char* a1 = cA + (size_t)(t + 1) * kstep;
            const char* a2 = last ? nA : cA + (size_t)(t + 2) * kstep; const char* b2 = last ? nB : cB + (size_t)(t + 2) * kstep;
            const char* a3 = a2 + kstep; const char* b3 = b2 + kstep;
            PG8_LDB(B0, 0, 0); PG8_SCHED; PG8_LDA(At, 0, 0); PG8_STAGE(PG8_SA(1, 1), a1 + hstepA, voffA);
            PG8_WAIT_L(8); PG8_BAR; PG8_WAIT_L(0); PG8_MMA(0, 0, At, B0); PG8_BAR; PG8_SCHED;
            PG8_LDB(B1, 0, 1); PG8_STAGE(PG8_SB(0, 0), b2, voffB);
            PG8_BAR; PG8_WAIT_L(0); PG8_MMA(0, 1, At, B1); PG8_BAR;
            PG8_LDA(At, 0, 1); PG8_STAGE(PG8_SA(0, 0), a2, voffA);
            PG8_BAR; PG8_WAIT_L(0); PG8_MMA(1, 0, At, B0); PG8_BAR; PG8_SCHED;
            PG8_STAGE(PG8_SB(0, 1), b2 + hstepB, voffB);
            PG8_WAIT_V(6); PG8_BAR; PG8_MMA(1, 1, At, B1); PG8_BAR;
            PG8_LDB(B0, 1, 0); PG8_SCHED; PG8_LDA(At, 1, 0); PG8_STAGE(PG8_SA(0, 1), a2 + hstepA, voffA);
            PG8_WAIT_L(8); PG8_BAR; PG8_WAIT_L(0); PG8_MMA(0, 0, At, B0); PG8_BAR; PG8_SCHED;
            PG8_LDB(B1, 1, 1); PG8_STAGE(PG8_SB(1, 0), b3, voffB);
            PG8_BAR; PG8_WAIT_L(0); PG8_MMA(0, 1, At, B1); PG8_BAR;
            PG8_LDA(At, 1, 1); PG8_STAGE(PG8_SA(1, 0), a3, voffA);
            PG8_BAR; PG8_WAIT_L(0); PG8_MMA(1, 0, At, B0); PG8_BAR; PG8_SCHED;
            PG8_STAGE(PG8_SB(1, 1), b3 + hstepB, voffB);
            PG8_WAIT_V(6); PG8_BAR; PG8_MMA(1, 1, At, B1); PG8_BAR;
        }
        E(acc, cur, wr, wc, fr, fq);
        if (!has_next) break;
#pragma unroll
        for (int a = 0; a < 2; ++a)
#pragma unroll
            for (int b = 0; b < 2; ++b)
#pragma unroll
                for (int m = 0; m < 4; ++m)
#pragma unroll
                    for (int n = 0; n < 2; ++n) acc[a][b][m][n] = (f32x4){0.f, 0.f, 0.f, 0.f};
        cur = nxt; cA = nA; cB = nB; ++ui;
    }
    PG8_WAIT_V(0);
    if (wr == 0) PG8_BAR;
    PG8_BAR;
    __builtin_amdgcn_s_waitcnt(0);
#undef PG8_SA
#undef PG8_SB
#undef PG8_STAGE
#undef PG8_LDA
#undef PG8_LDB
#undef PG8_MMA
#undef PG8_WAIT_V
#undef PG8_WAIT_L
#undef PG8_BAR
#undef PG8_SCHED
}
}
using pg8::Unit;

#define EPI_LOOP_BEGIN _Pragma("unroll") for (int ai = 0; ai < 2; ++ai) _Pragma("unroll") for (int m = 0; m < 4; ++m) { const size_t row = (size_t)(u.pm * 256 + ai * 128 + wr * 64 + m * 16 + fr); \
        _Pragma("unroll") for (int bj = 0; bj < 2; ++bj) {
#define EPI_LOOP_END } }
struct EpiIn {
    static constexpr bool PERM = true; bf16_t* pm; bf16_t* gates;
    __device__ __forceinline__ void operator()(const f32x4 (&acc)[2][2][4][2], const Unit& u, int wr, int wc, int fr, int fq) const {
        const bool main_ = u.pn < 14;
        EPI_LOOP_BEGIN
            const int col = u.pn * 256 + bj * 128 + wc * 32 + fq * 8; const f32x4 v0 = acc[ai][bj][m][0], v1 = acc[ai][bj][m][1]; u32x4 w;
            if (main_) { w.x = cvt_pk_bf16(v0[0], v0[1]); w.y = cvt_pk_bf16(v0[2], v0[3]); w.z = cvt_pk_bf16(v1[0], v1[1]); w.w = cvt_pk_bf16(v1[2], v1[3]); *(u32x4*)(pm + row * NPM + col) = w; }
            else { w.x = cvt_pk_bf16(sigmoidf_(v0[0]), sigmoidf_(v0[1])); w.y = cvt_pk_bf16(sigmoidf_(v0[2]), sigmoidf_(v0[3])); w.z = cvt_pk_bf16(sigmoidf_(v1[0]), sigmoidf_(v1[1])); w.w = cvt_pk_bf16(sigmoidf_(v1[2]), sigmoidf_(v1[3]));
                   *(u32x4*)(gates + row * NGATE + (col - NPM)) = w; }
        EPI_LOOP_END
    }
};
struct EpiGlu {
    static constexpr bool PERM = false; bf16_t* br;
    __device__ __forceinline__ void operator()(const f32x4 (&acc)[2][2][4][2], const Unit& u, int wr, int wc, int fr, int fq) const {
        EPI_LOOP_BEGIN
            const int j = u.pn * 128 + bj * 64 + wc * 16 + fq * 4; const f32x4 a = acc[ai][bj][m][0], b = acc[ai][bj][m][1]; u32x2 w;
            w.x = cvt_pk_bf16(a[0] * sigmoidf_(b[0]), a[1] * sigmoidf_(b[1])); w.y = cvt_pk_bf16(a[2] * sigmoidf_(b[2]), a[3] * sigmoidf_(b[3]));
            *(u32x2*)(br + row * 1024 + 512 + j) = w;
        EPI_LOOP_END
    }
};
struct EpiGU {
    static constexpr bool PERM = false; bf16_t* a;
    __device__ __forceinline__ void operator()(const f32x4 (&acc)[2][2][4][2], const Unit& u, int wr, int wc, int fr, int fq) const {
        EPI_LOOP_BEGIN
            const int j = u.pn * 128 + bj * 64 + wc * 16 + fq * 4; const f32x4 g = acc[ai][bj][m][0], b = acc[ai][bj][m][1]; u32x2 w;
            w.x = cvt_pk_bf16(siluf_(g[0]) * b[0], siluf_(g[1]) * b[1]); w.y = cvt_pk_bf16(siluf_(g[2]) * b[2], siluf_(g[3]) * b[3]);
            *(u32x2*)(a + row * DFF + j) = w;
        EPI_LOOP_END
    }
};
struct EpiBr {
    static constexpr bool PERM = true; const bf16_t* gates; bf16_t* mm;
    __device__ __forceinline__ void operator()(const f32x4 (&acc)[2][2][4][2], const Unit& u, int wr, int wc, int fr, int fq) const {
        const int col0 = u.pn * 256 + wc * 32 + fq * 8;
#pragma unroll
        for (int ai = 0; ai < 2; ++ai) {
            if (ai == 1 && u.pm == 64) break;
            const size_t row0 = (size_t)(u.pm * 256 + ai * 128 + wr * 64 + fr);
            u32x4 gw[4][2], pw[4][2];
#pragma unroll
            for (int m = 0; m < 4; ++m)
#pragma unroll
                for (int bj = 0; bj < 2; ++bj) { const size_t row = row0 + m * 16; const int col = col0 + bj * 128;
                    gw[m][bj] = *(const u32x4*)(gates + row * NGATE + u.kk * 1024 + col);
                    pw[m][bj] = (u32x4){0u, 0u, 0u, 0u}; if (u.kk > 0) pw[m][bj] = *(const u32x4*)(mm + row * 1024 + col); }
#pragma unroll
            for (int m = 0; m < 4; ++m)
#pragma unroll
                for (int bj = 0; bj < 2; ++bj) { const size_t row = row0 + m * 16; const int col = col0 + bj * 128; const f32x4 v0 = acc[ai][bj][m][0], v1 = acc[ai][bj][m][1]; const u32x4 g = gw[m][bj], q = pw[m][bj];
                    u32x4 w; w.x = cvt_pk_bf16(lo_bf(g.x) * v0[0] + lo_bf(q.x), hi_bf(g.x) * v0[1] + hi_bf(q.x)); w.y = cvt_pk_bf16(lo_bf(g.y) * v0[2] + lo_bf(q.y), hi_bf(g.y) * v0[3] + hi_bf(q.y));
                    w.z = cvt_pk_bf16(lo_bf(g.z) * v1[0] + lo_bf(q.z), hi_bf(g.z) * v1[1] + hi_bf(q.z)); w.w = cvt_pk_bf16(lo_bf(g.w) * v1[2] + lo_bf(q.w), hi_bf(g.w) * v1[3] + hi_bf(q.w));
                    *(u32x4*)(mm + row * 1024 + col) = w; }
        }
    }
};
struct EpiRes {
    static constexpr bool PERM = false; float* h;
    __device__ __forceinline__ void operator()(const f32x4 (&acc)[2][2][4][2], const Unit& u, int wr, int wc, int fr, int fq) const {
        const bool split = u.pm == 64;
        EPI_LOOP_BEGIN
#pragma unroll
            for (int n = 0; n < 2; ++n) { const int col = u.pn * 256 + bj * 128 + wc * 32 + n * 16 + fq * 4; float* ptr = h + row * 1024 + col;
                if (split) {
#pragma unroll
                    for (int e = 0; e < 4; ++e) __hip_atomic_fetch_add(ptr + e, acc[ai][bj][m][n][e], __ATOMIC_RELAXED, __HIP_MEMORY_SCOPE_AGENT);
                } else { const f32x4 o = *(const f32x4*)ptr; *(f32x4*)ptr = o + acc[ai][bj][m][n]; } }
        EPI_LOOP_END
    }
};

__device__ __forceinline__ int win_src_col(int n) {
    if (n < 768) return n;
    if (n < 1024) return 776 + (n - 768);
    if (n < 1792) return 1032 + (n - 1024);
    if (n < 2048) return 1816 + (n - 1792);
    if (n < 2304) return 2072 + (n - 2048);
    if (n < 3072) return 2328 + (n - 2304);
    if (n < 3328) return 3096 + (n - 3072);
    if (n < 3336) return 768 + (n - 3328);
    if (n < 3352) return 1800 + (n - 3336);
    if (n < 3584) return -1;
    return 3352 + (n - 3584);
}
__device__ __forceinline__ void phase_convert(KPR p, int layer, LAS float* tile, int bid, int G) {
    const int tid = otid(), tn = tid & 63, tk = __builtin_amdgcn_readfirstlane(tid >> 6);
    constexpr int T0 = 120 * 16, T1 = T0 + 88 * 16, T2 = T1 + 16 * 44, T3 = T2 + 16 * 16, T4 = T3 + 64 * 4, T5 = T4 + 8 * 4;
    for (int j = bid; j < T5; j += G) {
        int n0, k0, K, ld; bf16_t* dst; const float* cp = nullptr;
        if (j < T0) { const int q = j; n0 = (q >> 4) * 64; k0 = (q & 15) * 64; K = 1024; ld = NIN; dst = (bf16_t*)(p.ws + OFF_WIN);
            const int sc = win_src_col(n0 + tn); if (sc >= 0) cp = p.in[9] + (size_t)layer * 1024 * NIN + sc; }
        else if (j < T1) { const int q = j - T0; n0 = (q >> 4) * 64; k0 = (q & 15) * 64; K = 1024; ld = DFF; dst = (bf16_t*)(p.ws + OFF_WGU);
            const int n = n0 + tn, g32 = n >> 5, w = n & 31, jj = g32 * 16 + (w & 15); cp = (w < 16 ? p.in[31] : p.in[32]) + (size_t)layer * 1024 * DFF + jj; }
        else if (j < T2) { const int q = j - T1; n0 = (q / 44) * 64; k0 = (q % 44) * 64; K = DFF; ld = 1024; dst = (bf16_t*)(p.ws + OFF_WDN);
            cp = p.in[33] + (size_t)layer * DFF * 1024 + (n0 + tn); }
        else if (j < T3) { const int q = j - T2; n0 = (q >> 4) * 64; k0 = (q & 15) * 64; K = 1024; ld = 1024; dst = (bf16_t*)(p.ws + OFF_WOUT);
            cp = p.in[29] + (size_t)layer * 1024 * 1024 + (n0 + tn); }
        else if (j < T4) { const int q = j - T3; n0 = (q >> 2) * 64; k0 = (q & 3) * 64; K = 256; ld = 1024; dst = (bf16_t*)(p.ws + OFF_WBR);
            const int n = n0 + tn, kk = n >> 10, d = n & 1023; cp = p.in[28] + ((size_t)(layer * 4 + kk) * 256) * 1024 + d; }
        else { const int q = j - T4; n0 = (q >> 2) * 64; k0 = (q & 3) * 64; K = 256; ld = 512; dst = (bf16_t*)(p.ws + OFF_WGLU);
            const int n = n0 + tn, g32 = n >> 5, w = n & 31, jj = g32 * 16 + (w & 15); cp = p.in[25] + (size_t)layer * 256 * 512 + (w < 16 ? jj : 256 + jj); }
        __syncthreads();
#pragma unroll
        for (int e = 0; e < 8; ++e) { const int k = k0 + tk * 8 + e; tile[tn * 65 + tk * 8 + e] = cp ? cp[(size_t)k * ld] : 0.f; }
        __syncthreads();
        { const int n = tid >> 3, ks = tid & 7; const LAS float* tp = tile + n * 65 + ks * 8; u32x4 w;
          w.x = cvt_pk_bf16(tp[0], tp[1]); w.y = cvt_pk_bf16(tp[2], tp[3]); w.z = cvt_pk_bf16(tp[4], tp[5]); w.w = cvt_pk_bf16(tp[6], tp[7]);
          *(u32x4*)(dst + (size_t)(n0 + n) * K + k0 + ks * 8) = w; }
    }
    __syncthreads();
}

__device__ __forceinline__ void phase_norm(KPR p, const float* w, int mode, int bid, int G) {
    const int tid_ = otid(); const int wid = __builtin_amdgcn_readfirstlane(tid_ >> 6), lane = tid_ & 63;
    float* h = (float*)(p.ws + OFF_H); bf16_t* xn = (bf16_t*)(p.ws + OFF_XN);
    f32x4 wv[4];
#pragma unroll
    for (int i = 0; i < 4; ++i) wv[i] = *(const f32x4*)(w + i * 256 + lane * 4);
    for (int r = bid * 8 + wid; r < MTOK; r += G * 8) {
        const float* src = (mode == 0) ? (r < MPROMPT ? p.in[0] + (size_t)r * 1024 : p.in[1] + (size_t)(r - MPROMPT) * 1024) : h + (size_t)r * 1024;
        f32x4 v[4]; float ss = 0.f;
#pragma unroll
        for (int i = 0; i < 4; ++i) { v[i] = *(const f32x4*)(src + i * 256 + lane * 4); ss += v[i][0] * v[i][0] + v[i][1] * v[i][1] + v[i][2] * v[i][2] + v[i][3] * v[i][3]; }
        ss = wave_sum(ss);
        const float rs = rsqrtf(ss * (1.0f / 1024.0f) + EPS);
#pragma unroll
        for (int i = 0; i < 4; ++i) {
            const f32x4 y = v[i] * rs * wv[i];
            if (mode == 2) *(f32x4*)(p.out + (size_t)r * 1024 + i * 256 + lane * 4) = y;
            else { u32x2 o; o.x = cvt_pk_bf16(y[0], y[1]); o.y = cvt_pk_bf16(y[2], y[3]); *(u32x2*)(xn + (size_t)r * 1024 + i * 256 + lane * 4) = o;
                   if (mode == 0) *(f32x4*)(h + (size_t)r * 1024 + i * 256 + lane * 4) = v[i]; }
        }
    }
}

constexpr int TCH = 32;
constexpr int MIXBUF_FLOATS = 4 * TCH * 64 + TCH * 4;
template <int MIX>
__device__ __forceinline__ void mix_item(KPR p, int layer, LAS float* lds, int tokbase, int L, int h, int col0, int ncols,
                         const float* s_in, float* s_out, const float* conv_in, float* conv_out) {
    const int tid = otid(), wid = __builtin_amdgcn_readfirstlane(tid >> 6), lane = tid & 63;
    const int nscan = ncols * 8; const bool is_scan = wid < (nscan >> 6);
    const int ksl = lane & 7, cl = wid * 8 + (lane >> 3), col = col0 + cl;
    const bf16_t* pm = (const bf16_t*)(p.ws + OFF_PM);
    bf16_t* oraw = (bf16_t*)(p.ws + OFF_ORAW);
    __syncthreads();
    f32x2 S2[4];
#pragma unroll
    for (int i = 0; i < 4; ++i) { S2[i].x = (is_scan && s_in) ? s_in[(ksl * 8 + 2 * i) * 64 + col] : 0.f; S2[i].y = (is_scan && s_in) ? s_in[(ksl * 8 + 2 * i + 1) * 64 + col] : 0.f; }
    const int tl = lane >> 4, d4 = (lane & 15) * 4, hd4 = h * 64 + d4;
    f32x4 cw[3][4]; float c_a = 0.f, c_dt = 0.f; f32x4 gkw[16]; f32x4 gkb = (f32x4){0.f, 0.f, 0.f, 0.f}, lb4 = (f32x4){0.f, 0.f, 0.f, 0.f};
    if (MIX == 0) {
        const float* cwp = p.in[10] + (size_t)layer * 4 * 768;
#pragma unroll
        for (int s = 0; s < 3; ++s)
#pragma unroll
            for (int j = 0; j < 4; ++j) cw[s][j] = *(const f32x4*)(cwp + j * 768 + s * 256 + hd4);
        c_a = -__expf(p.in[11][layer * 4 + h]); c_dt = p.in[12][layer * 4 + h];
        if (conv_out && col0 == 0 && h == 0) {
            for (int idx = tid; idx < 3 * 768; idx += 512) { const int i = idx / 768, c = idx - i * 768, ti = L - 3 + i;
                conv_out[idx] = ti >= 0 ? bf2f(pm[(size_t)(tokbase + ti) * NPM + A_QKV + c]) : (conv_in ? conv_in[(3 + ti) * 768 + c] : 0.f); }
        }
    } else if (MIX == 1) {
#pragma unroll
        for (int r = 0; r < 16; ++r) gkw[r] = *(const f32x4*)(p.in[14] + ((size_t)layer * 16 + r) * 256 + hd4);
        gkb = *(const f32x4*)(p.in[15] + layer * 256 + hd4);
    } else {
        const float* lg = p.in[26] + hd4; const f32x4 a0 = *(const f32x4*)lg, a1 = *(const f32x4*)(lg + 256), a2 = *(const f32x4*)(lg + 512), a3 = *(const f32x4*)(lg + 768);
#pragma unroll
        for (int e = 0; e < 4; ++e) {
            const float mx = fmaxf(fmaxf(a0[e], a1[e]), fmaxf(a2[e], a3[e])); const float l0 = __expf(a0[e] - mx), l1 = __expf(a1[e] - mx), l2 = __expf(a2[e] - mx), l3 = __expf(a3[e] - mx);
            const float inv = 1.0f / (l0 + l1 + l2 + l3);
            lb4[e] = (layer == 0) ? 0.f : (layer == 1) ? l1 * inv : (layer == 2) ? (l1 + l2) * inv : (l1 + l2 + l3) * inv;
        }
    }
    const int nch = (L + TCH - 1) / TCH;
    auto prep = [&](int c, int pw, int npw) {
        LAS float* kb = lds + (c & 1) * MIXBUF_FLOATS; LAS float* qb = kb + TCH * 64; LAS float* fb = qb + TCH * 64; LAS float* vb = fb + TCH * 64; LAS float* sc = vb + TCH * 64;
#pragma unroll
        for (int pass = 0; pass < 2; ++pass) {
            const int tt0 = (pass * npw + pw) * 4;
            if (tt0 < TCH) {
                const int tt = tt0 + tl, t = c * TCH + tt;
                if (t < L) {
                    const bf16_t* row = pm + (size_t)(tokbase + t) * NPM;
                    if (MIX == 0) {
                        f32x4 y[3];
#pragma unroll
                        for (int s = 0; s < 3; ++s) { f32x4 a = (f32x4){0.f, 0.f, 0.f, 0.f};
#pragma unroll
                            for (int j = 0; j < 4; ++j) { const int ti = t - 3 + j; f32x4 xv = (f32x4){0.f, 0.f, 0.f, 0.f};
                                if (ti >= 0) { const u32x2 w = *(const u32x2*)(pm + (size_t)(tokbase + ti) * NPM + A_QKV + s * 256 + hd4); xv = (f32x4){lo_bf(w.x), hi_bf(w.x), lo_bf(w.y), hi_bf(w.y)}; }
                                else if (conv_in) xv = *(const f32x4*)(conv_in + (3 + ti) * 768 + s * 256 + hd4);
                                a += xv * cw[s][j]; }
                            y[s] = (f32x4){siluf_(a[0]), siluf_(a[1]), siluf_(a[2]), siluf_(a[3])}; }
                        const float qq = red16(y[0][0] * y[0][0] + y[0][1] * y[0][1] + y[0][2] * y[0][2] + y[0][3] * y[0][3]);
                        const float kk2 = red16(y[1][0] * y[1][0] + y[1][1] * y[1][1] + y[1][2] * y[1][2] + y[1][3] * y[1][3]);
                        const f32x4 qn = y[0] * (rsqrtf(qq + EPS) * 0.125f), kn = y[1] * rsqrtf(kk2 + EPS);
                        const float kq = red16(qn[0] * kn[0] + qn[1] * kn[1] + qn[2] * kn[2] + qn[3] * kn[3]);
                        *(LAS f32x4*)(kb + tt * 64 + d4) = kn; *(LAS f32x4*)(qb + tt * 64 + d4) = qn; *(LAS f32x4*)(vb + tt * 64 + d4) = y[2];
                        if ((lane & 15) == 0) { const float al = bf2f(row[A_ALPHA + h]) + c_dt; const float sp = fmaxf(al, 0.f) + __logf(1.0f + __expf(-fabsf(al)));
                            *(LAS f32x4*)(sc + tt * 4) = (f32x4){__expf(c_a * sp), sigmoidf_(bf2f(row[A_BETA + h])), kq, 0.f}; }
                    } else if (MIX == 1) {
                        const u32x4 g0 = *(const u32x4*)(row + B_GK), g1 = *(const u32x4*)(row + B_GK + 8);
                        const u32x2 wq = *(const u32x2*)(row + B_Q + hd4), wk = *(const u32x2*)(row + B_K + hd4), wv = *(const u32x2*)(row + B_V + hd4);
                        f32x4 z = gkb;
                        z += lo_bf(g0.x) * gkw[0] + hi_bf(g0.x) * gkw[1] + lo_bf(g0.y) * gkw[2] + hi_bf(g0.y) * gkw[3] + lo_bf(g0.z) * gkw[4] + hi_bf(g0.z) * gkw[5] + lo_bf(g0.w) * gkw[6] + hi_bf(g0.w) * gkw[7];
                        z += lo_bf(g1.x) * gkw[8] + hi_bf(g1.x) * gkw[9] + lo_bf(g1.y) * gkw[10] + hi_bf(g1.y) * gkw[11] + lo_bf(g1.z) * gkw[12] + hi_bf(g1.z) * gkw[13] + lo_bf(g1.w) * gkw[14] + hi_bf(g1.w) * gkw[15];
                        f32x4 f;
#pragma unroll
                        for (int e = 0; e < 4; ++e) { const float sp = fmaxf(-z[e], 0.f) + __logf(1.0f + __expf(-fabsf(z[e]))); f[e] = __expf(-sp * (1.0f / 16.0f)); }
                        *(LAS f32x4*)(fb + tt * 64 + d4) = f;
                        *(LAS f32x4*)(qb + tt * 64 + d4) = (f32x4){lo_bf(wq.x), hi_bf(wq.x), lo_bf(wq.y), hi_bf(wq.y)} * 0.125f;
                        *(LAS f32x4*)(kb + tt * 64 + d4) = (f32x4){lo_bf(wk.x), hi_bf(wk.x), lo_bf(wk.y), hi_bf(wk.y)};
                        *(LAS f32x4*)(vb + tt * 64 + d4) = (f32x4){lo_bf(wv.x), hi_bf(wv.x), lo_bf(wv.y), hi_bf(wv.y)};
                    } else {
                        const u32x2 wq = *(const u32x2*)(row + D_Q + hd4), wf = *(const u32x2*)(row + D_F + hd4), wv = *(const u32x2*)(row + D_I + hd4);
                        const f32x4 xq = (f32x4){lo_bf(wq.x), hi_bf(wq.x), lo_bf(wq.y), hi_bf(wq.y)}, xf = (f32x4){lo_bf(wf.x), hi_bf(wf.x), lo_bf(wf.y), hi_bf(wf.y)};
                        f32x4 f, k, q;
#pragma unroll
                        for (int e = 0; e < 4; ++e) { const float sg = sigmoidf_(xf[e]); f[e] = lb4[e] + (1.0f - lb4[e]) * sg; k[e] = (1.0f - lb4[e]) * (1.0f - sg); q[e] = siluf_(xq[e]) * 0.125f; }
                        *(LAS f32x4*)(fb + tt * 64 + d4) = f; *(LAS f32x4*)(kb + tt * 64 + d4) = k; *(LAS f32x4*)(qb + tt * 64 + d4) = q;
                        *(LAS f32x4*)(vb + tt * 64 + d4) = (f32x4){lo_bf(wv.x), hi_bf(wv.x), lo_bf(wv.y), hi_bf(wv.y)};
                    }
                }
            }
        }
    };
    prep(0, wid, 8);
    __syncthreads();
    for (int c = 0; c < nch; ++c) {
        if (is_scan) {
            const LAS float* kb = lds + (c & 1) * MIXBUF_FLOATS; const LAS float* qb = kb + TCH * 64; const LAS float* fb = qb + TCH * 64; const LAS float* vb = fb + TCH * 64; const LAS float* sc = vb + TCH * 64;
            const int ntok = (L - c * TCH) < TCH ? (L - c * TCH) : TCH;
            bf16_t* op = oraw + (size_t)(tokbase + c * TCH) * 768 + MIX * 256 + h * 64 + col;
            const LAS float* kp = kb + ksl * 8; const LAS float* qp = qb + ksl * 8; const LAS float* fp = fb + ksl * 8; const LAS float* vp = vb + col;
            f32x4 k0 = *(const LAS f32x4*)kp, k1 = *(const LAS f32x4*)(kp + 4), q0 = *(const LAS f32x4*)qp, q1 = *(const LAS f32x4*)(qp + 4);
            f32x4 f0 = (f32x4){0.f, 0.f, 0.f, 0.f}, f1 = f0, scv = f0;
            if (MIX == 0) scv = *(const LAS f32x4*)sc; else { f0 = *(const LAS f32x4*)fp; f1 = *(const LAS f32x4*)(fp + 4); }
            float v = vp[0];
            float okeep = 0.f;
            __builtin_amdgcn_s_setprio(3);
#pragma unroll 8
            for (int tt = 0; tt < ntok; ++tt) {
                const int tn = (tt + 1 < TCH) ? tt + 1 : tt;
                const f32x4 nk0 = *(const LAS f32x4*)(kp + tn * 64), nk1 = *(const LAS f32x4*)(kp + tn * 64 + 4), nq0 = *(const LAS f32x4*)(qp + tn * 64), nq1 = *(const LAS f32x4*)(qp + tn * 64 + 4);
                f32x4 nf0 = f0, nf1 = f1, nsc = scv;
                if (MIX == 0) nsc = *(const LAS f32x4*)(sc + tn * 4); else { nf0 = *(const LAS f32x4*)(fp + tn * 64); nf1 = *(const LAS f32x4*)(fp + tn * 64 + 4); }
                const float nv = vp[tn * 64];
                float o;
                if (MIX == 0) {
                    const float eg = scv[0], beta = scv[1], kq = scv[2];
                    const f32x2 ka = {k0[0], k0[1]}, kb2 = {k0[2], k0[3]}, kc = {k1[0], k1[1]}, kd = {k1[2], k1[3]};
                    const f32x2 qa = {q0[0], q0[1]}, qb2 = {q0[2], q0[3]}, qc = {q1[0], q1[1]}, qd = {q1[2], q1[3]};
                    f32x2 dk2 = S2[0] * ka; dk2 = S2[1] * kb2 + dk2; dk2 = S2[2] * kc + dk2; dk2 = S2[3] * kd + dk2;
                    f32x2 dq2 = S2[0] * qa; dq2 = S2[1] * qb2 + dq2; dq2 = S2[2] * qc + dq2; dq2 = S2[3] * qd + dq2;
                    const float dk = red8(dk2.x + dk2.y), dq = red8(dq2.x + dq2.y);
                    const float delta = beta * (v - eg * dk);
                    const f32x2 eg2 = {eg, eg}, de2 = {delta, delta};
                    S2[0] = ka * de2 + S2[0] * eg2; S2[1] = kb2 * de2 + S2[1] * eg2; S2[2] = kc * de2 + S2[2] * eg2; S2[3] = kd * de2 + S2[3] * eg2;
                    o = eg * dq + kq * delta;
                } else {
#pragma unroll
                    for (int i = 0; i < 1; ++i) {}
                    const f32x2 v2 = {v, v};
                    S2[0] = (f32x2){k0[0], k0[1]} * v2 + (f32x2){f0[0], f0[1]} * S2[0]; S2[1] = (f32x2){k0[2], k0[3]} * v2 + (f32x2){f0[2], f0[3]} * S2[1];
                    S2[2] = (f32x2){k1[0], k1[1]} * v2 + (f32x2){f1[0], f1[1]} * S2[2]; S2[3] = (f32x2){k1[2], k1[3]} * v2 + (f32x2){f1[2], f1[3]} * S2[3];
                    f32x2 dq2 = S2[0] * (f32x2){q0[0], q0[1]}; dq2 = S2[1] * (f32x2){q0[2], q0[3]} + dq2; dq2 = S2[2] * (f32x2){q1[0], q1[1]} + dq2; dq2 = S2[3] * (f32x2){q1[2], q1[3]} + dq2;
                    o = red8(dq2.x + dq2.y);
                }
                okeep = ((tt & 7) == ksl) ? o : okeep;
                if ((tt & 7) == 7) op[(size_t)(tt - 7 + ksl) * 768] = f2bf(okeep);
                k0 = nk0; k1 = nk1; q0 = nq0; q1 = nq1; f0 = nf0; f1 = nf1; scv = nsc; v = nv;
            }
            __builtin_amdgcn_s_setprio(0);
            { const int rem = ntok & 7; if (ksl < rem) op[(size_t)(ntok - rem + ksl) * 768] = f2bf(okeep); }
        } else if (c + 1 < nch) prep(c + 1, wid - (nscan >> 6), 8 - (nscan >> 6));
        __syncthreads();
    }
    if (is_scan) {
#pragma unroll
        for (int i = 0; i < 4; ++i) { s_out[(ksl * 8 + 2 * i) * 64 + col] = S2[i].x; s_out[(ksl * 8 + 2 * i + 1) * 64 + col] = S2[i].y; }
    }
}

constexpr int S5_BU_LD = 132, S5_XB_LD = 136, S5_WAVE_BYTES = 16 * S5_BU_LD * 4 + 16 * S5_XB_LD * 2;
template <bool SAMPLE>
__device__ __forceinline__ void s5_wave_item(KPR p, int layer, LAS unsigned char* wl, int g, int tokbase, int L, int seq0) {
    const int lane = otid() & 63, col = lane & 15, quad = lane >> 4;
    const bf16_t* pm = (const bf16_t*)(p.ws + OFF_PM); bf16_t* yg = (bf16_t*)(p.ws + OFF_YG);
    LAS float* bu = (LAS float*)wl; LAS bf16_t* xb = (LAS bf16_t*)(wl + 16 * S5_BU_LD * 4);
    const int lg = layer * 16 + g;
    float ar, ai, zr, zi;
    { const float lr = fminf(p.in[17][lg * 64 + lane], -1e-4f), li = p.in[18][lg * 64 + lane], dt = __expf(p.in[24][lg]);
      const float mag = __expf(lr * dt); float rev = li * dt * 0.15915494309f; rev -= rintf(rev);
      const float sn = __builtin_amdgcn_sinf(rev), cs = __builtin_amdgcn_cosf(rev); ar = mag * cs; ai = mag * sn;
      const float den = lr * lr + li * li; zr = ((ar - 1.0f) * lr + ai * li) / den; zi = (ai * lr - (ar - 1.0f) * li) / den; }
    bf16x8 Bf[8], Cf[4];
#pragma unroll
    for (int tt = 0; tt < 4; ++tt) {
        const int pp = tt * 16 + col; const float zr2 = __shfl(zr, pp), zi2 = __shfl(zi, pp);
        float bre[8], bim[8];
#pragma unroll
        for (int j = 0; j < 8; ++j) { bre[j] = 0.f; bim[j] = 0.f; }
        if (quad < 2) {
            const float* br_ = p.in[19] + ((size_t)lg * 64 + pp) * 16 + quad * 8; const float* bi_ = p.in[20] + ((size_t)lg * 64 + pp) * 16 + quad * 8;
#pragma unroll
            for (int j = 0; j < 8; ++j) { const float r = br_[j], i = bi_[j]; bre[j] = zr2 * r - zi2 * i; bim[j] = zr2 * i + zi2 * r; }
        }
        u32x4 wr_, wi_;
        wr_.x = cvt_pk_bf16(bre[0], bre[1]); wr_.y = cvt_pk_bf16(bre[2], bre[3]); wr_.z = cvt_pk_bf16(bre[4], bre[5]); wr_.w = cvt_pk_bf16(bre[6], bre[7]);
        wi_.x = cvt_pk_bf16(bim[0], bim[1]); wi_.y = cvt_pk_bf16(bim[2], bim[3]); wi_.z = cvt_pk_bf16(bim[4], bim[5]); wi_.w = cvt_pk_bf16(bim[6], bim[7]);
        Bf[tt] = __builtin_bit_cast(bf16x8, wr_); Bf[4 + tt] = __builtin_bit_cast(bf16x8, wi_);
    }
#pragma unroll
    for (int kb = 0; kb < 4; ++kb) {
        const int k0 = (kb & 1) * 32 + quad * 8; const float sgn = kb < 2 ? 1.0f : -1.0f;
        const float* cp = (kb < 2 ? p.in[21] : p.in[22]) + ((size_t)lg * 16 + col) * 64 + k0;
        u32x4 w; w.x = cvt_pk_bf16(sgn * cp[0], sgn * cp[1]); w.y = cvt_pk_bf16(sgn * cp[2], sgn * cp[3]); w.z = cvt_pk_bf16(sgn * cp[4], sgn * cp[5]); w.w = cvt_pk_bf16(sgn * cp[6], sgn * cp[7]);
        Cf[kb] = __builtin_bit_cast(bf16x8, w);
    }
    const float dcoef = p.in[23][layer * 256 + g * 16 + col];
    float xr = 0.f, xi = 0.f;
    const int nch = SAMPLE ? 1 : (L + 15) / 16;
    u32x4 awn = (u32x4){0u, 0u, 0u, 0u}; bf16_t un[4] = {0, 0, 0, 0};
    auto pf = [&](int cc) {
        const int t0 = cc * 16; const int nrow = SAMPLE ? 16 : ((L - t0) < 16 ? (L - t0) : 16);
        awn = (u32x4){0u, 0u, 0u, 0u};
        if (quad < 2 && col < nrow) awn = *(const u32x4*)(pm + (size_t)(tokbase + t0 + col) * NPM + C_U + g * 16 + quad * 8);
#pragma unroll
        for (int i = 0; i < 4; ++i) { const int r = quad * 4 + i; un[i] = (r < nrow) ? pm[(size_t)(tokbase + t0 + r) * NPM + C_U + g * 16 + col] : (bf16_t)0; }
    };
    pf(0);
    for (int c = 0; c < nch; ++c) {
        const int t0 = c * 16; const int nrow = SAMPLE ? 16 : ((L - t0) < 16 ? (L - t0) : 16);
        const u32x4 aw = awn; bf16_t uc[4];
#pragma unroll
        for (int i = 0; i < 4; ++i) uc[i] = un[i];
        if (c + 1 < nch) pf(c + 1);
        const bf16x8 af = __builtin_bit_cast(bf16x8, aw);
#pragma unroll
        for (int tile = 0; tile < 8; ++tile) {
            const f32x4 d = __builtin_amdgcn_mfma_f32_16x16x32_bf16(af, Bf[tile], (f32x4){0.f, 0.f, 0.f, 0.f}, 0, 0, 0);
#pragma unroll
            for (int i = 0; i < 4; ++i) bu[(quad * 4 + i) * S5_BU_LD + tile * 16 + col] = d[i];
        }
        __builtin_amdgcn_fence(__ATOMIC_RELEASE, "wavefront"); __builtin_amdgcn_wave_barrier(); __builtin_amdgcn_fence(__ATOMIC_ACQUIRE, "wavefront");
        for (int r = 0; r < 16; ++r) {
            float nr = 0.f, ni = 0.f;
            if (r < nrow) {
                if (SAMPLE) { const size_t si = ((size_t)(layer * NDEC + seq0 + r) * 16 + g) * 64 + lane; xr = p.in[5][si]; xi = p.in[6][si]; }
                const float br_ = bu[r * S5_BU_LD + lane], bi_ = bu[r * S5_BU_LD + 64 + lane];
                nr = ar * xr - ai * xi + br_; ni = ar * xi + ai * xr + bi_; xr = nr; xi = ni;
                if (SAMPLE) { const size_t so = ((size_t)(layer * NDEC + seq0 + r) * 16 + g) * 64 + lane; p.out[O_SS5R + so] = nr; p.out[O_SS5I + so] = ni; }
            }
            xb[r * S5_XB_LD + lane] = f2bf(nr); xb[r * S5_XB_LD + 64 + lane] = f2bf(ni);
        }
        __builtin_amdgcn_fence(__ATOMIC_RELEASE, "wavefront"); __builtin_amdgcn_wave_barrier(); __builtin_amdgcn_fence(__ATOMIC_ACQUIRE, "wavefront");
        f32x4 ya = (f32x4){0.f, 0.f, 0.f, 0.f};
#pragma unroll
        for (int kb = 0; kb < 4; ++kb) { const bf16x8 xf = *(const LAS bf16x8*)(xb + col * S5_XB_LD + kb * 32 + quad * 8); ya = __builtin_amdgcn_mfma_f32_16x16x32_bf16(xf, Cf[kb], ya, 0, 0, 0); }
#pragma unroll
        for (int i = 0; i < 4; ++i) { const int r = quad * 4 + i;
            if (r < nrow) { const size_t tok = (size_t)(tokbase + t0 + r); const float uu = bf2f(uc[i]);
                const float y = ya[i] + dcoef * uu; const float ge = y * __builtin_amdgcn_rcpf(1.0f + __expf(-1.5957691216f * (y + 0.044715f * y * y * y)));
                yg[tok * 256 + g * 16 + col] = f2bf(ge); } }
        __builtin_amdgcn_fence(__ATOMIC_RELEASE, "wavefront"); __builtin_amdgcn_wave_barrier(); __builtin_amdgcn_fence(__ATOMIC_ACQUIRE, "wavefront");
    }
    if (!SAMPLE) { const size_t so = ((size_t)(layer * NBATCH + seq0) * 16 + g) * 64 + lane; p.out[O_PS5R + so] = xr; p.out[O_PS5I + so] = xi; }
}

__device__ __forceinline__ void phase_mix(KPR p, int layer, LAS unsigned char* ldsb, int bid, int G) {
    LAS float* lds = (LAS float*)ldsb;
    const int wid = __builtin_amdgcn_readfirstlane(otid() >> 6);
    constexpr int NLONG = 208, NSHORT = 16 + 1536;
    for (int it = bid; it < NLONG; it += G) {
        if (it < 192) {
            const int mix = it >> 6, r = it & 63, b = r >> 3, hh = (r >> 1) & 3, half = r & 1;
            const size_t so = ((size_t)(layer * NBATCH + b) * 4 + hh) * 4096;
            if (mix == 0) mix_item<0>(p, layer, lds, b * SEQ, SEQ, hh, half * 32, 32, nullptr, p.out + O_PGDN + so, nullptr, p.out + O_PCONV + (size_t)(layer * NBATCH + b) * 2304);
            else if (mix == 1) mix_item<1>(p, layer, lds, b * SEQ, SEQ, hh, half * 32, 32, nullptr, p.out + O_PGLA + so, nullptr, nullptr);
            else mix_item<2>(p, layer, lds, b * SEQ, SEQ, hh, half * 32, 32, nullptr, p.out + O_PHG + so, nullptr, nullptr);
        } else {
            __syncthreads();
            const int j = (it - 192) * 8 + wid, b = j >> 4, g = j & 15;
            s5_wave_item<false>(p, layer, ldsb + wid * S5_WAVE_BYTES, g, b * SEQ, SEQ, b);
        }
    }
    unsigned* qc = (unsigned*)(p.ws + OFF_BAR) + 3520 + 64 * layer;
    volatile LAS unsigned* shq = (volatile LAS unsigned*)(ldsb + pg8::STAGE_BYTES + 8);
    for (;;) {
    __syncthreads();
    if (otid() == 0) *shq = __hip_atomic_fetch_add(qc, 1u, __ATOMIC_RELAXED, __HIP_MEMORY_SCOPE_AGENT);
    __syncthreads();
    const int j0 = (int)(*shq) * 2;
    if (j0 >= NSHORT) break;
#pragma unroll 1
    for (int j = j0; j < j0 + 2; ++j) {
        if (j < 16) {
            __syncthreads();
            const int jj = j * 8 + wid, g = jj & 15, s0 = (jj >> 4) * 16;
            s5_wave_item<true>(p, layer, ldsb + wid * S5_WAVE_BYTES, g, MPROMPT + s0, 16, s0);
        } else {
            const int jj = j - 16, mix = jj >> 9, s = (jj & 511) >> 2, hh = jj & 3;
            const size_t so = ((size_t)(layer * NDEC + s) * 4 + hh) * 4096;
            if (mix == 0) mix_item<0>(p, layer, lds, MPROMPT + s, 1, hh, 0, 64, p.in[3] + so, p.out + O_SGDN + so, p.in[2] + (size_t)(layer * NDEC + s) * 2304, p.out + O_SCONV + (size_t)(layer * NDEC + s) * 2304);
            else if (mix == 1) mix_item<1>(p, layer, lds, MPROMPT + s, 1, hh, 0, 64, p.in[4] + so, p.out + O_SGLA + so, nullptr, nullptr);
            else mix_item<2>(p, layer, lds, MPROMPT + s, 1, hh, 0, 64, p.in[7] + so, p.out + O_SHG + so, nullptr, nullptr);
        }
    }
    }
    __syncthreads();
}

__device__ __forceinline__ void phase_headnorm(KPR p, int layer, int bid, int G) {
    const int tid_ = otid(); const int wid = __builtin_amdgcn_readfirstlane(tid_ >> 6), lane = tid_ & 63;
    const bf16_t* pm = (const bf16_t*)(p.ws + OFF_PM); const bf16_t* oraw = (const bf16_t*)(p.ws + OFF_ORAW); bf16_t* br = (bf16_t*)(p.ws + OFF_BR);
    for (int j = bid * 8 + wid; j < MTOK * 3; j += G * 8) {
        const int tok = j / 3, mix = j - tok * 3;
        const int gcol = mix == 0 ? A_GATE : (mix == 1 ? B_GATE : D_GATE), slot = mix == 2 ? 3 : mix;
        const float* nw = (mix == 0 ? p.in[13] : (mix == 1 ? p.in[16] : p.in[27])) + layer * 256 + lane * 4;
        const u32x2 ow = *(const u32x2*)(oraw + (size_t)tok * 768 + mix * 256 + lane * 4);
        const u32x2 gw = *(const u32x2*)(pm + (size_t)tok * NPM + gcol + lane * 4);
        const float o0 = lo_bf(ow.x), o1 = hi_bf(ow.x), o2 = lo_bf(ow.y), o3 = hi_bf(ow.y);
        float ss = o0 * o0 + o1 * o1 + o2 * o2 + o3 * o3;
        ss += __shfl_xor(ss, 1); ss += __shfl_xor(ss, 2); ss += __shfl_xor(ss, 4); ss += __shfl_xor(ss, 8);
        const float rs = rsqrtf(ss * (1.0f / 64.0f) + EPS);
        const f32x4 w = *(const f32x4*)nw;
        u32x2 r; r.x = cvt_pk_bf16(o0 * rs * w[0] * siluf_(lo_bf(gw.x)), o1 * rs * w[1] * siluf_(hi_bf(gw.x)));
        r.y = cvt_pk_bf16(o2 * rs * w[2] * siluf_(lo_bf(gw.y)), o3 * rs * w[3] * siluf_(hi_bf(gw.y)));
        *(u32x2*)(br + (size_t)tok * 1024 + slot * 256 + lane * 4) = r;
    }
}

constexpr int PH_PER_LAYER = 9, N_PHASES = 4 * PH_PER_LAYER + 1;
__device__ __forceinline__ void run_phase(KPR p, int ph, LAS unsigned char* lds, int bid, int G) {
    unsigned char* ws = p.ws;
    if (ph == N_PHASES - 1) { phase_norm(p, p.in[34], 2, bid, G); return; }
    const int layer = ph / PH_PER_LAYER, s = ph - layer * PH_PER_LAYER;
    pg8::Sched S; pg8::Gemm g;
    switch (s) {
    case 0: phase_convert(p, layer, (LAS float*)lds, bid, G); phase_norm(p, p.in[8] + layer * 1024, layer == 0 ? 0 : 1, bid, G); break;
    case 1: { S.init(65, 30, 1, G, bid, 16); g = pg8::Gemm{(const bf16_t*)(ws + OFF_XN), (const bf16_t*)(ws + OFF_WIN), 1024, 1024, 16, 0, 0};
              pg8::gemm_phase(lds, g, S, EpiIn{(bf16_t*)(ws + OFF_PM), (bf16_t*)(ws + OFF_GATES)}); } break;
    case 2: phase_mix(p, layer, lds, bid, G); break;
    case 3: { S.init(65, 2, 1, G, bid, 4); g = pg8::Gemm{(const bf16_t*)(ws + OFF_YG), (const bf16_t*)(ws + OFF_WGLU), 256, 256, 4, 0, 0};
              pg8::gemm_phase(lds, g, S, EpiGlu{(bf16_t*)(ws + OFF_BR)}); phase_headnorm(p, layer, bid, G); } break;
    case 4: { S.init(65, 4, 4, G, bid, 4); g = pg8::Gemm{(const bf16_t*)(ws + OFF_BR), (const bf16_t*)(ws + OFF_WBR), 1024, 256, 4, 256, (size_t)1024 * 256};
              pg8::gemm_phase(lds, g, S, EpiBr{(const bf16_t*)(ws + OFF_GATES), (bf16_t*)(ws + OFF_PM)}); } break;
    case 5: { S.init(64, 4, 1, G, bid, 16, 4); g = pg8::Gemm{(const bf16_t*)(ws + OFF_PM), (const bf16_t*)(ws + OFF_WOUT), 1024, 1024, 16, 0, 0};
              pg8::gemm_phase(lds, g, S, EpiRes{(float*)(ws + OFF_H)}); } break;
    case 6: phase_norm(p, p.in[30] + layer * 1024, 1, bid, G); break;
    case 7: { S.init(65, 22, 1, G, bid, 16); g = pg8::Gemm{(const bf16_t*)(ws + OFF_XN), (const bf16_t*)(ws + OFF_WGU), 1024, 1024, 16, 0, 0};
              pg8::gemm_phase(lds, g, S, EpiGU{(bf16_t*)(ws + OFF_PM)}); } break;
    case 8: { S.init(64, 4, 1, G, bid, 44, 4); g = pg8::Gemm{(const bf16_t*)(ws + OFF_PM), (const bf16_t*)(ws + OFF_WDN), DFF, DFF, 44, 0, 0};
              pg8::gemm_phase(lds, g, S, EpiRes{(float*)(ws + OFF_H)}); } break;
    }
}

extern __shared__ __attribute__((aligned(16))) unsigned char dyn_smem[];
#if MULTI_LAUNCH
__global__ void __launch_bounds__(512) k_phase(KP parg, int ph) {
    KPR p = *(const CAS KP*)__builtin_amdgcn_kernarg_segment_ptr();
    run_phase(p, ph, (LAS unsigned char*)dyn_smem, blockIdx.x, gridDim.x);
}
#else
#define XB_TMO      128
#define XB_XCNT(j)  (256  + 64 * (j))
#define XB_XSUB(j)  (1280 + 64 * (j))
#define XB_XGEN(j)  (2304 + 64 * (j))
#define XB_TOP      3328
#define XB_TOPGEN   3392
#define XCD_BAR_WORDS 3456
#define XB_SPIN_CAP (1u << 22)
__device__ __forceinline__ unsigned xb_ld(unsigned* q)              { return __hip_atomic_load(q, __ATOMIC_RELAXED, __HIP_MEMORY_SCOPE_AGENT); }
__device__ __forceinline__ unsigned xb_add(unsigned* q, unsigned v) { return __hip_atomic_fetch_add(q, v, __ATOMIC_RELAXED, __HIP_MEMORY_SCOPE_AGENT); }
__device__ __forceinline__ unsigned xb_xcc_id() { return (unsigned)__builtin_amdgcn_s_getreg((3 << 11) | 20) & 0xFu; }
#define XB_SPIN(cond, bar) do { unsigned _sp = 0; while (cond) { __builtin_amdgcn_s_sleep(1); \
    if ((++_sp & 255u) == 0u) { if (xb_ld(&(bar)[XB_TMO])) break; if (_sp > XB_SPIN_CAP) { atomicAdd(&(bar)[XB_TMO], 1u); break; } } } } while (0)
__device__ __forceinline__ void xcd_barrier_complete(unsigned* bar, unsigned x, unsigned G, unsigned& nloc, unsigned& nx) {
    unsigned sum, cnt, mine, sp = 0u;
    for (;;) {
        sum = 0u; cnt = 0u; mine = 0u;
#pragma unroll
        for (unsigned j = 0; j < 16; ++j) { const unsigned c = xb_ld(&bar[XB_XCNT(j)]); sum += c; cnt += (c > 0u) ? 1u : 0u; mine = (j == x) ? c : mine; }
        if (sum == G) break;
        __builtin_amdgcn_s_sleep(1);
        if ((++sp & 255u) == 0u) { if (xb_ld(&bar[XB_TMO])) break; if (sp > XB_SPIN_CAP) { atomicAdd(&bar[XB_TMO], 1u); break; } }
    }
    nloc = mine > 0u ? mine : 1u; nx = cnt > 0u ? cnt : 1u;
}
__device__ __forceinline__ void grid_bar(unsigned* bar, volatile LAS unsigned* st, int G) {
    asm volatile("s_waitcnt vmcnt(0)" ::: "memory");
    __syncthreads();
    if (otid() == 0) {
        __builtin_amdgcn_s_waitcnt(0);
        const unsigned x = xb_xcc_id();
        unsigned nloc = st[0], nx = st[1];
        if (nloc == 0u) { xcd_barrier_complete(bar, x, (unsigned)G, nloc, nx); st[0] = nloc; st[1] = nx; }
        const unsigned old = xb_add(&bar[XB_XSUB(x)], 1u);
        const unsigned gen = old / nloc;
        if (old + 1u == (gen + 1u) * nloc) {
            __builtin_amdgcn_fence(__ATOMIC_RELEASE, "agent");
            asm volatile("s_waitcnt vmcnt(0)" ::: "memory");
            const unsigned og = xb_add(&bar[XB_TOP], 1u);
            const unsigned tg = og / nx;
            if (og + 1u == (tg + 1u) * nx) xb_add(&bar[XB_TOPGEN], 1u);
            else XB_SPIN(xb_ld(&bar[XB_TOPGEN]) == tg, bar);
            __builtin_amdgcn_fence(__ATOMIC_ACQUIRE, "agent");
            xb_add(&bar[XB_XGEN(x)], 1u);
            asm volatile("s_waitcnt vmcnt(0)" ::: "memory");
        } else {
            XB_SPIN(xb_ld(&bar[XB_XGEN(x)]) == gen, bar);
            __builtin_amdgcn_fence(__ATOMIC_ACQUIRE, "agent");
            asm volatile("s_waitcnt vmcnt(0)" ::: "memory");
        }
    }
    __syncthreads();
}
template <int PH> __device__ __forceinline__ void run_from(KPR p, cg::grid_group& grid) {
    const CAS KP* pp = &p; asm volatile("" : "+s"(pp));
    int bid = blockIdx.x, G = gridDim.x; asm volatile("" : "+s"(bid), "+s"(G));
    run_phase(*pp, PH, (LAS unsigned char*)dyn_smem, bid, G);
    if constexpr (PH + 1 < N_PHASES) {
        if constexpr (PH == 0) grid.sync();
        else grid_bar((unsigned*)(pp->ws + OFF_BAR), (volatile LAS unsigned*)((LAS unsigned char*)dyn_smem + pg8::STAGE_BYTES), G);
        run_from<PH + 1>(p, grid);
    }
}
__global__ void __launch_bounds__(512) k_mega(KP parg) {
    cg::grid_group grid = cg::this_grid();
    KPR p = *(const CAS KP*)__builtin_amdgcn_kernarg_segment_ptr();
    if (threadIdx.x == 0) { volatile LAS unsigned* st = (volatile LAS unsigned*)((LAS unsigned char*)dyn_smem + pg8::STAGE_BYTES); st[0] = 0u; st[1] = 0u;
        (void)xb_add(&((unsigned*)(p.ws + OFF_BAR))[XB_XCNT(xb_xcc_id())], 1u); }
    __syncthreads();
    run_from<0>(p, grid);
}
#endif

extern "C" void kernel_launch(void* const* d_in, const int* in_sizes, int n_in, void* d_out, int out_size, void* d_ws, size_t ws_size, hipStream_t stream) {
    if (ws_size < WS_NEED || n_in < 35) { fprintf(stderr, "workspace too small: %zu < %zu\n", ws_size, (size_t)WS_NEED); return; }
    KP p{};
    for (int i = 0; i < 35; ++i) p.in[i] = (const float*)d_in[i];
    p.out = (float*)d_out; p.ws = (unsigned char*)d_ws;
    constexpr size_t kDynLds = pg8::STAGE_BYTES + 16;
#if MULTI_LAUNCH
    static bool once = false;
    if (!once) { hipFuncSetAttribute((const void*)k_phase, hipFuncAttributeMaxDynamicSharedMemorySize, (int)kDynLds); once = true; }
    for (int ph = 0; ph < N_PHASES; ++ph) hipLaunchKernelGGL(k_phase, dim3(256), dim3(512), kDynLds, stream, p, ph);
#else
    static int grid_blocks = 0;
    if (!grid_blocks) {
        hipFuncSetAttribute((const void*)k_mega, hipFuncAttributeMaxDynamicSharedMemorySize, (int)kDynLds);
        int dev = 0, cus = 0, per_cu = 0;
        hipGetDevice(&dev);
        hipDeviceGetAttribute(&cus, hipDeviceAttributeMultiprocessorCount, dev);
        hipOccupancyMaxActiveBlocksPerMultiprocessor(&per_cu, k_mega, 512, kDynLds);
        if (per_cu < 1) per_cu = 1;
        grid_blocks = cus * per_cu; if (grid_blocks > 256) grid_blocks = 256;
    }
    hipMemsetAsync((unsigned char*)d_ws + OFF_BAR, 0, 16384, stream);
    void* args[] = {&p};
    hipError_t e = hipLaunchCooperativeKernel((void*)k_mega, dim3(grid_blocks), dim3(512), args, kDynLds, stream);
    if (e != hipSuccess) fprintf(stderr, "cooperative launch failed: %s (grid %d)\n", hipGetErrorString(e), grid_blocks);
#endif
}
```
